# Optimizing an MI355X kernel written in HIP

```python
import jax
import jax.numpy as jnp
from jax import lax
import numpy as np


D_MODEL = 1024
BATCH = 8
SEQ = 4096
DEPTH = 4

HEAD_DIM = 64
MLA_HEADS = 6
MLA_NOPE = 64
MLA_ROPE = 32
MLA_V = 64
MLA_Q_RANK = 256
MLA_KV_RANK = 128
ROPE_THETA = 10000.0
MLA_Q_BLOCK = 128
MOBA_HEADS = 6
MOBA_BLOCK = 256
MOBA_TOPK = 3
MOBA_Q_CHUNK = 32
DIL_PATTERNS = ((128, 1), (512, 4), (2048, 16))
DIL_GROUP_HEADS = 4
DIL_HEADS = DIL_GROUP_HEADS * len(DIL_PATTERNS)
N_ALIBI = DIL_HEADS + MOBA_HEADS
N_BRANCHES = 3
D_FF = 2816
NORM_EPS = 1e-6
NEG_INF = -1e30
MLA_IN = MLA_Q_RANK + MLA_KV_RANK + MLA_ROPE
MOBA_IN = 3 * MOBA_HEADS * HEAD_DIM
DIL_IN = 3 * DIL_HEADS * HEAD_DIM
GATE_IN = N_BRANCHES * D_MODEL
IN_COLS = MLA_IN + MOBA_IN + DIL_IN + GATE_IN
MLA_OUT = MLA_HEADS * MLA_V
MOBA_OUT = MOBA_HEADS * HEAD_DIM
DIL_OUT = DIL_GROUP_HEADS * HEAD_DIM

kernel_name = 'hybrid_mla_moba_dilated_block'


def rms_norm(x, gain):
    xf = x.astype(jnp.float32)
    y = xf * lax.rsqrt(jnp.mean(xf * xf, axis=-1, keepdims=True) + NORM_EPS)
    return (y * gain.astype(jnp.float32)).astype(x.dtype)


def swiglu(h, w_gate, w_up, w_down):
    a = jnp.einsum('bsd,df->bsf', h, w_gate)
    u = jnp.einsum('bsd,df->bsf', h, w_up)
    return jnp.einsum('bsf,fd->bsd', jax.nn.silu(a) * u, w_down)


def alibi_slopes():
    return 2.0 ** (-8.0 * jnp.arange(1, N_ALIBI + 1, dtype=jnp.float32) / N_ALIBI)


def rope_tables(seq):
    pos = jnp.arange(seq, dtype=jnp.float32)
    inv = ROPE_THETA ** (-jnp.arange(0, MLA_ROPE, 2, dtype=jnp.float32) / MLA_ROPE)
    ang = pos[:, None] * inv[None, :]
    return jnp.cos(ang), jnp.sin(ang)


def apply_rope(t, cos, sin):
    cos = cos.astype(t.dtype)
    sin = sin.astype(t.dtype)
    t1, t2 = jnp.split(t, 2, axis=-1)
    return jnp.concatenate([t1 * cos - t2 * sin, t1 * sin + t2 * cos], axis=-1)


def mla_attention(h_cq, h_ckv, h_krope, q_norm, w_uq, kv_norm, w_ukv):
    B, S, _ = h_cq.shape
    cos, sin = rope_tables(S)
    c_q = rms_norm(h_cq, q_norm)
    q = jnp.einsum('bsr,rk->bsk', c_q, w_uq).reshape(B, S, MLA_HEADS, MLA_NOPE + MLA_ROPE)
    q = jnp.concatenate([q[..., :MLA_NOPE], apply_rope(q[..., MLA_NOPE:], cos[:, None], sin[:, None])], axis=-1)
    c_kv = rms_norm(h_ckv, kv_norm)
    kv = jnp.einsum('bsr,rk->bsk', c_kv, w_ukv).reshape(B, S, MLA_HEADS, MLA_NOPE + MLA_V)
    k_rope = apply_rope(h_krope, cos, sin)
    k = jnp.concatenate([kv[..., :MLA_NOPE], jnp.broadcast_to(k_rope[:, :, None, :], (B, S, MLA_HEADS, MLA_ROPE))], axis=-1)
    v = kv[..., MLA_NOPE:]
    q, k, v = (t.transpose(0, 2, 1, 3) for t in (q, k, v))
    scale = (MLA_NOPE + MLA_ROPE) ** -0.5
    nb = S // MLA_Q_BLOCK
    q_blocks = q.reshape(B, MLA_HEADS, nb, MLA_Q_BLOCK, MLA_NOPE + MLA_ROPE).transpose(2, 0, 1, 3, 4)
    kpos = jnp.arange(S)

    def block(args):
        qi, i = args
        s = jnp.einsum('bhqd,bhkd->bhqk', qi, k).astype(jnp.float32) * scale
        qpos = i * MLA_Q_BLOCK + jnp.arange(MLA_Q_BLOCK)
        s = jnp.where(kpos[None, :] <= qpos[:, None], s, NEG_INF)
        p = jax.nn.softmax(s, axis=-1).astype(v.dtype)
        return jnp.einsum('bhqk,bhkd->bhqd', p, v)

    o = lax.map(block, (q_blocks, jnp.arange(nb)))
    return o.transpose(1, 0, 3, 2, 4).reshape(B, S, MLA_OUT)


def moba_attention(q, k, v, slopes):
    B, H, S, D = q.shape
    nb = -(-S // MOBA_BLOCK)
    sp = nb * MOBA_BLOCK
    pad = ((0, 0), (0, 0), (0, sp - S), (0, 0))
    qp, kp, vp = (jnp.pad(t, pad) for t in (q, k, v))
    kb = kp.reshape(B, H, nb, MOBA_BLOCK, D)
    vb = vp.reshape(B, H, nb, MOBA_BLOCK, D)
    k_mean = jnp.mean(kb, axis=3)
    k_sel_n = min(MOBA_TOPK, nb)
    scale = D ** -0.5
    bi = jnp.arange(B)[:, None, None, None]
    hi = jnp.arange(H)[None, :, None, None]
    blk_ids = jnp.arange(nb)
    offs = jnp.arange(MOBA_BLOCK)
    slope5 = slopes[None, :, None, None, None]

    def chunk(c):
        start = c * MOBA_Q_CHUNK
        qc = lax.dynamic_slice_in_dim(qp, start, MOBA_Q_CHUNK, axis=2)
        b_own = start // MOBA_BLOCK
        tpos = start + jnp.arange(MOBA_Q_CHUNK)
        gate = jnp.einsum('bhqd,bhnd->bhqn', qc, k_mean).astype(jnp.float32)
        gate = jnp.where(blk_ids < b_own, gate, NEG_INF)
        _, idx = lax.top_k(gate, k_sel_n)
        sel_ok = idx < b_own
        k_sel = kb[bi, hi, idx]
        v_sel = vb[bi, hi, idx]
        s_sel = jnp.einsum('bhqd,bhqnpd->bhqnp', qc, k_sel).astype(jnp.float32) * scale
        kpos_sel = idx[..., None] * MOBA_BLOCK + offs
        dist_sel = (tpos[None, None, :, None, None] - kpos_sel).astype(jnp.float32)
        s_sel = jnp.where(sel_ok[..., None], s_sel - slope5 * dist_sel, NEG_INF)
        k_own = lax.dynamic_index_in_dim(kb, b_own, axis=2, keepdims=False)
        v_own = lax.dynamic_index_in_dim(vb, b_own, axis=2, keepdims=False)
        kpos_own = b_own * MOBA_BLOCK + offs
        dist_own = (tpos[:, None] - kpos_own[None, :]).astype(jnp.float32)
        s_own = jnp.einsum('bhqd,bhpd->bhqp', qc, k_own).astype(jnp.float32) * scale
        s_own = jnp.where(dist_own >= 0, s_own - slopes[None, :, None, None] * dist_own, NEG_INF)
        n_sel = k_sel_n * MOBA_BLOCK
        s = jnp.concatenate([s_sel.reshape(B, H, MOBA_Q_CHUNK, n_sel), s_own], axis=-1)
        p = jax.nn.softmax(s, axis=-1).astype(v.dtype)
        p_sel = p[..., :n_sel].reshape(B, H, MOBA_Q_CHUNK, k_sel_n, MOBA_BLOCK)
        p_own = p[..., n_sel:]
        return (jnp.einsum('bhqnp,bhqnpd->bhqd', p_sel, v_sel)
                + jnp.einsum('bhqp,bhpd->bhqd', p_own, v_own))

    o = lax.map(chunk, jnp.arange(sp // MOBA_Q_CHUNK))
    return o.transpose(1, 0, 3, 2, 4).reshape(B, sp, H * D)[:, :S]


def dilated_group_attention(q, k, v, window, dilation, slopes):
    B, H, S, D = q.shape
    L = window // dilation
    span = dilation * L
    P = -(-S // span) * span
    M = P // dilation
    nbk = M // L

    def to_blocks(t):
        t = jnp.pad(t, ((0, 0), (0, 0), (0, P - S), (0, 0)))
        return t.reshape(B, H, M, dilation, D).transpose(0, 1, 3, 2, 4).reshape(B, H, dilation, nbk, L, D)

    def window_keys(t):
        prev = jnp.pad(t[:, :, :, :-1], ((0, 0), (0, 0), (0, 0), (1, 0), (0, 0), (0, 0)))
        return jnp.concatenate([prev, t], axis=4)

    qb = to_blocks(q)
    kw = window_keys(to_blocks(k))
    vw = window_keys(to_blocks(v))
    s = jnp.einsum('bhrnqd,bhrnkd->bhrnqk', qb, kw).astype(jnp.float32) * (D ** -0.5)
    steps = L + jnp.arange(L)[:, None] - jnp.arange(2 * L)[None, :]
    band = (steps >= 0) & (steps <= L)
    before_start = (jnp.arange(nbk)[:, None, None] == 0) & (jnp.arange(2 * L) < L)[None, None, :]
    valid = band[None] & ~before_start
    dist = (steps * dilation).astype(jnp.float32)
    s = jnp.where(valid, s - slopes[None, :, None, None, None, None] * dist, NEG_INF)
    m = jnp.max(s, axis=-1, keepdims=True)
    e = jnp.exp(s - m)
    den = jnp.sum(e, axis=-1)
    o = jnp.einsum('bhrnqk,bhrnkd->bhrnqd', (e / den[..., None]).astype(v.dtype), vw)
    lse = m[..., 0] + jnp.log(den)
    o = o.reshape(B, H, dilation, M, D).transpose(0, 1, 3, 2, 4).reshape(B, H, P, D)[:, :, :S]
    lse = lse.reshape(B, H, dilation, M).transpose(0, 1, 3, 2).reshape(B, H, P)[:, :, :S]
    return o, lse


def hybrid_mixer(h, w_in, q_norm, w_uq, kv_norm, w_ukv, w_br_mla, w_br_moba, w_br_dil, w_out):
    B, S, _ = h.shape
    proj = jnp.einsum('bsd,dk->bsk', h, w_in)
    i0 = MLA_Q_RANK
    i1 = i0 + MLA_KV_RANK
    i2 = i1 + MLA_ROPE
    i3 = i2 + MOBA_IN
    i4 = i3 + DIL_IN
    h_cq, h_ckv, h_kr, h_moba, h_dil, h_gate = jnp.split(proj, [i0, i1, i2, i3, i4], axis=-1)
    slopes = alibi_slopes()
    a = mla_attention(h_cq, h_ckv, h_kr, q_norm, w_uq, kv_norm, w_ukv)
    mqkv = h_moba.reshape(B, S, 3, MOBA_HEADS, HEAD_DIM).transpose(2, 0, 3, 1, 4)
    b = moba_attention(mqkv[0], mqkv[1], mqkv[2], slopes[DIL_HEADS:])
    dqkv = h_dil.reshape(B, S, 3, DIL_HEADS, HEAD_DIM).transpose(2, 0, 3, 1, 4)
    outs, lses = [], []
    for g, (window, dilation) in enumerate(DIL_PATTERNS):
        hs = slice(g * DIL_GROUP_HEADS, (g + 1) * DIL_GROUP_HEADS)
        o_g, l_g = dilated_group_attention(dqkv[0][:, hs], dqkv[1][:, hs], dqkv[2][:, hs], window, dilation, slopes[hs])
        outs.append(o_g)
        lses.append(l_g)
    alpha = jax.nn.softmax(jnp.stack(lses), axis=0)
    c = jnp.einsum('gbhs,gbhsd->bhsd', alpha.astype(outs[0].dtype), jnp.stack(outs))
    c = c.transpose(0, 2, 1, 3).reshape(B, S, DIL_OUT)
    gates = jax.nn.sigmoid(h_gate).reshape(B, S, N_BRANCHES, D_MODEL)
    merged = (gates[:, :, 0] * jnp.einsum('bsk,kd->bsd', a, w_br_mla)
              + gates[:, :, 1] * jnp.einsum('bsk,kd->bsd', b, w_br_moba)
              + gates[:, :, 2] * jnp.einsum('bsk,kd->bsd', c, w_br_dil))
    return jnp.einsum('bsd,de->bse', merged, w_out)


def setup_inputs(seed: int = 0) -> dict:
    key = jax.random.key(seed)
    ks = jax.random.split(key, 20)

    def nrm(k, shape, fan_in):
        return jax.random.normal(k, shape, jnp.float32) * (fan_in ** -0.5)

    def gain(k, shape):
        return 1.0 + 0.01 * jax.random.normal(k, shape, jnp.float32)

    return {
        'x': jax.random.normal(ks[0], (BATCH, SEQ, D_MODEL), jnp.float32),
        'ffn1_norm': gain(ks[1], (DEPTH, D_MODEL)),
        'ffn1_w_gate': nrm(ks[2], (DEPTH, D_MODEL, D_FF), D_MODEL),
        'ffn1_w_up': nrm(ks[3], (DEPTH, D_MODEL, D_FF), D_MODEL),
        'ffn1_w_down': nrm(ks[4], (DEPTH, D_FF, D_MODEL), D_FF),
        'mix_norm': gain(ks[5], (DEPTH, D_MODEL)),
        'w_in': nrm(ks[6], (DEPTH, D_MODEL, IN_COLS), D_MODEL),
        'q_norm': gain(ks[7], (DEPTH, MLA_Q_RANK)),
        'w_uq': nrm(ks[8], (DEPTH, MLA_Q_RANK, MLA_HEADS * (MLA_NOPE + MLA_ROPE)), MLA_Q_RANK),
        'kv_norm': gain(ks[9], (DEPTH, MLA_KV_RANK)),
        'w_ukv': nrm(ks[10], (DEPTH, MLA_KV_RANK, MLA_HEADS * (MLA_NOPE + MLA_V)), MLA_KV_RANK),
        'w_br_mla': nrm(ks[11], (DEPTH, MLA_OUT, D_MODEL), MLA_OUT),
        'w_br_moba': nrm(ks[12], (DEPTH, MOBA_OUT, D_MODEL), MOBA_OUT),
        'w_br_dil': nrm(ks[13], (DEPTH, DIL_OUT, D_MODEL), DIL_OUT),
        'w_out': nrm(ks[14], (DEPTH, D_MODEL, D_MODEL), D_MODEL),
        'ffn2_norm': gain(ks[15], (DEPTH, D_MODEL)),
        'ffn2_w_gate': nrm(ks[16], (DEPTH, D_MODEL, D_FF), D_MODEL),
        'ffn2_w_up': nrm(ks[17], (DEPTH, D_MODEL, D_FF), D_MODEL),
        'ffn2_w_down': nrm(ks[18], (DEPTH, D_FF, D_MODEL), D_FF),
        'final_norm': gain(ks[19], (D_MODEL,)),
    }


def reference(x, ffn1_norm, ffn1_w_gate, ffn1_w_up, ffn1_w_down, mix_norm, w_in, q_norm, w_uq,
              kv_norm, w_ukv, w_br_mla, w_br_moba, w_br_dil, w_out, ffn2_norm, ffn2_w_gate,
              ffn2_w_up, ffn2_w_down, final_norm):
    for l in range(DEPTH):
        x = x + 0.5 * swiglu(rms_norm(x, ffn1_norm[l]), ffn1_w_gate[l], ffn1_w_up[l], ffn1_w_down[l])
        x = x + hybrid_mixer(rms_norm(x, mix_norm[l]), w_in[l], q_norm[l], w_uq[l], kv_norm[l], w_ukv[l],
                             w_br_mla[l], w_br_moba[l], w_br_dil[l], w_out[l])
        x = x + 0.5 * swiglu(rms_norm(x, ffn2_norm[l]), ffn2_w_gate[l], ffn2_w_up[l], ffn2_w_down[l])
    return rms_norm(x, final_norm)
```

```cpp
#include <hip/hip_runtime.h>
#include <cstdio>
#include <cstdint>

#ifndef MK_PER_PHASE
#define MK_PER_PHASE 0
#endif

#ifndef MK_STOP_AFTER
#define MK_STOP_AFTER 999
#endif
#ifndef MK_NOGATE
#define MK_NOGATE 0
#define MK_NOACC 0
#endif
#ifndef MK_BRANCH_MASK
#define MK_BRANCH_MASK 7
#endif
constexpr int BATCH = 8, SEQ = 4096, DM = 1024, DEPTH = 4, FF = 2816, T = BATCH * SEQ;
constexpr int PP = 4096;
constexpr int PC_DQ = 0, PC_DK = 768, PC_DV = 1536, PC_MQ = 2304, PC_MK = 2688, PC_MV = 3072, PC_CKV = 3456, PC_CQ = 3584, PC_KR = 3840;
constexpr int IN_COLS = 6944;
constexpr float NORM_EPS = 1e-6f;

namespace pg8 {
#define PG8_LAS __attribute__((address_space(3)))
typedef unsigned short bf16_t;
typedef short bf16x8 __attribute__((ext_vector_type(8)));
typedef float f32x4 __attribute__((ext_vector_type(4)));
typedef unsigned u32x4 __attribute__((ext_vector_type(4)));
typedef unsigned u32x2 __attribute__((ext_vector_type(2)));
constexpr int BM = 256, BK = 64, HALF = 128, HTB = HALF * BK * 2, STAGE_BYTES = 8 * HTB, NXCD = 8, WGM = 8;

__host__ __device__ __forceinline__ int lds_byte(int r, int c) { const int st = (r >> 4) * 2 + (c >> 5), rr = r & 15, cc = c & 31, ob = rr * 64 + cc * 2; return st * 1024 + (ob ^ (((ob >> 9) & 1) << 5)); }
__host__ __device__ __forceinline__ void stage_rc(int b, int& R, int& C) { const int st = b / 1024, sb = b % 1024, swz = sb ^ (((sb >> 9) & 1) << 5); R = (st >> 1) * 16 + swz / 64; C = (st & 1) * 32 + (swz % 64) / 2; }
__host__ __device__ __forceinline__ int perm32(int rho) { const int n = rho >> 4, i = rho & 15; return 8 * (i >> 2) + 4 * n + (i & 3); }

struct Unit { int pm, pn; };
struct Gemm { const bf16_t* A; const bf16_t* Bt; int M, N, K, lda, ldb; };

struct StaticOrder {
    int nM, nN, nwg, G, c;
    __host__ __device__ void init(int M, int N, int G_, int c_) { nM = M / BM; nN = N / BM; nwg = nM * nN; G = G_; c = c_; }
    __host__ __device__ bool next(int i, Unit& u) const {
        const long L = (long)i * G + c; if (L >= nwg) return false;
        int wgid = (int)L; { const int q = nwg / NXCD, r = nwg % NXCD, xcd = wgid % NXCD, off = wgid / NXCD; wgid = (xcd < r ? xcd * (q + 1) : r * (q + 1) + (xcd - r) * q) + off; }
        const int nig = WGM * nN, gid = wgid / nig, fm = gid * WGM, gsz = (nM - fm) < WGM ? (nM - fm) : WGM;
        u.pm = fm + ((wgid % nig) % gsz); u.pn = (wgid % nig) / gsz; return true;
    }
    __device__ __forceinline__ void a_ready(const Unit&) const {}
    __device__ __forceinline__ void done(const Unit&) const {}
};

typedef float f32x2_t __attribute__((ext_vector_type(2))); typedef __bf16 bf16x2_t __attribute__((ext_vector_type(2)));
__device__ __forceinline__ unsigned cvt_pk_bf16(float lo, float hi) { f32x2_t v = {lo, hi}; bf16x2_t b = __builtin_convertvector(v, bf16x2_t); return __builtin_bit_cast(unsigned, b); }
__device__ __forceinline__ float bflo(unsigned w) { return __uint_as_float(w << 16); }
__device__ __forceinline__ float bfhi(unsigned w) { return __uint_as_float(w & 0xffff0000u); }

template <int NP> __device__ __forceinline__ float row_scale(const float* p, int row, float invn) {
    float s = 0.f;
#pragma unroll
    for (int i = 0; i < NP / 4; ++i) { const f32x4 a = *(const f32x4*)(p + (size_t)row * NP + 4 * i); s += (a[0] + a[1]) + (a[2] + a[3]); }
    return 1.0f / sqrtf(s * invn + NORM_EPS);
}
__device__ __forceinline__ float silu_f(float a) { return a * __builtin_amdgcn_rcpf(1.0f + __builtin_amdgcn_exp2f(-1.4426950408889634f * a)); }
__device__ __forceinline__ float sigm_f(float a) { return __builtin_amdgcn_rcpf(1.0f + __builtin_amdgcn_exp2f(-1.4426950408889634f * a)); }

struct EpiSwiGLU { static constexpr bool PERM = true, AFTER_DRAIN = false;
    bf16_t* O; int ldc; const float* rsp;
    __device__ __forceinline__ void operator()(const f32x4 (&acc)[2][2][4][2], const Unit& u, int wr, int wc, int fr, int fq) const {
        const int row0 = u.pm * BM + wr * 64 + fr, col0 = u.pn * HALF + wc * 32 + 8 * fq;
#pragma unroll
        for (int ai = 0; ai < 2; ++ai)
#pragma unroll
            for (int m = 0; m < 4; ++m) { const int row = row0 + ai * HALF + m * 16; const float s = row_scale<16>(rsp, row, 1.0f / DM);
                float y[8];
#pragma unroll
                for (int n = 0; n < 2; ++n)
#pragma unroll
                    for (int j = 0; j < 4; ++j) y[4 * n + j] = silu_f(acc[ai][0][m][n][j] * s) * (acc[ai][1][m][n][j] * s);
                u32x4 w; w.x = cvt_pk_bf16(y[0], y[1]); w.y = cvt_pk_bf16(y[2], y[3]); w.z = cvt_pk_bf16(y[4], y[5]); w.w = cvt_pk_bf16(y[6], y[7]);
                *(u32x4*)(O + (size_t)row * ldc + col0) = w; }
    }
};
struct EpiResid { static constexpr bool PERM = false, AFTER_DRAIN = false;
    const float* base; float* out; bf16_t* xb; float* rsp; float alpha;
    __device__ __forceinline__ void operator()(const f32x4 (&acc)[2][2][4][2], const Unit& u, int wr, int wc, int fr, int fq) const {
        const int row0 = u.pm * BM + wr * 64 + fr, col0 = u.pn * BM + wc * 32 + 4 * fq;
#pragma unroll
        for (int ai = 0; ai < 2; ++ai)
#pragma unroll
            for (int m = 0; m < 4; ++m) { const int row = row0 + ai * HALF + m * 16; const size_t off = (size_t)row * DM + col0; float ss = 0.f;
#pragma unroll
                for (int bj = 0; bj < 2; ++bj)
#pragma unroll
                    for (int n = 0; n < 2; ++n) { const f32x4 b = *(const f32x4*)(base + off + bj * HALF + n * 16); const f32x4 o = b + acc[ai][bj][m][n] * alpha;
                        *(f32x4*)(out + off + bj * HALF + n * 16) = o; u32x2 w; w.x = cvt_pk_bf16(o[0], o[1]); w.y = cvt_pk_bf16(o[2], o[3]); *(u32x2*)(xb + off + bj * HALF + n * 16) = w;
                        ss += (o[0] * o[0] + o[1] * o[1]) + (o[2] * o[2] + o[3] * o[3]); }
                ss += __shfl_xor(ss, 16); ss += __shfl_xor(ss, 32);
                if (fq == 0) rsp[(size_t)row * 16 + u.pn * 4 + wc] = ss;
                asm volatile("" ::: "memory"); }
    }
};
struct EpiProj { static constexpr bool PERM = true, AFTER_DRAIN = false;
    bf16_t* O; const float* rsp; float* rsq; float* rskv;
    __device__ __forceinline__ void operator()(const f32x4 (&acc)[2][2][4][2], const Unit& u, int wr, int wc, int fr, int fq) const {
        const int row0 = u.pm * BM + wr * 64 + fr, col0 = u.pn * BM + wc * 32 + 8 * fq;
#pragma unroll
        for (int ai = 0; ai < 2; ++ai)
#pragma unroll
            for (int m = 0; m < 4; ++m) { const int row = row0 + ai * HALF + m * 16; const float s = row_scale<16>(rsp, row, 1.0f / DM); float ssb[2];
#pragma unroll
                for (int bj = 0; bj < 2; ++bj) { const f32x4 v0 = acc[ai][bj][m][0] * s, v1 = acc[ai][bj][m][1] * s;
                    u32x4 w; w.x = cvt_pk_bf16(v0[0], v0[1]); w.y = cvt_pk_bf16(v0[2], v0[3]); w.z = cvt_pk_bf16(v1[0], v1[1]); w.w = cvt_pk_bf16(v1[2], v1[3]);
                    *(u32x4*)(O + (size_t)row * PP + col0 + bj * HALF) = w;
                    ssb[bj] = ((v0[0] * v0[0] + v0[1] * v0[1]) + (v0[2] * v0[2] + v0[3] * v0[3])) + ((v1[0] * v1[0] + v1[1] * v1[1]) + (v1[2] * v1[2] + v1[3] * v1[3])); }
                if (u.pn == 14) { float ss = ssb[0] + ssb[1]; ss += __shfl_xor(ss, 16); ss += __shfl_xor(ss, 32); if (fq == 0) rsq[(size_t)row * 4 + wc] = ss; }
                if (u.pn == 13) { float ss = ssb[1]; ss += __shfl_xor(ss, 16); ss += __shfl_xor(ss, 32); if (fq == 0) rskv[(size_t)row * 4 + wc] = ss; } }
    }
};
struct EpiQup { static constexpr bool PERM = false, AFTER_DRAIN = false;
    bf16_t* Q; const float* rsq; const float* cosT; const float* sinT;
    __device__ __forceinline__ void operator()(const f32x4 (&acc)[2][2][4][2], const Unit& u, int wr, int wc, int fr, int fq) const {
        const int row0 = u.pm * BM + wr * 64 + fr;
#pragma unroll
        for (int bj = 0; bj < 2; ++bj) { const int c32 = u.pn * BM + bj * HALF + wc * 32; if (c32 >= 576) continue; const bool rope = (c32 % 96) == 64;
#pragma unroll
            for (int ai = 0; ai < 2; ++ai)
#pragma unroll
                for (int m = 0; m < 4; ++m) { const int row = row0 + ai * HALF + m * 16; const float s = row_scale<4>(rsq, row, 1.0f / 256.0f);
                    f32x4 v0 = acc[ai][bj][m][0] * s, v1 = acc[ai][bj][m][1] * s;
                    if (rope) { const int pos = row & (SEQ - 1); const f32x4 cs = *(const f32x4*)(cosT + pos * 16 + 4 * fq), sn = *(const f32x4*)(sinT + pos * 16 + 4 * fq);
                        const f32x4 o0 = v0 * cs - v1 * sn, o1 = v0 * sn + v1 * cs; v0 = o0; v1 = o1; }
                    u32x2 w0, w1; w0.x = cvt_pk_bf16(v0[0], v0[1]); w0.y = cvt_pk_bf16(v0[2], v0[3]); w1.x = cvt_pk_bf16(v1[0], v1[1]); w1.y = cvt_pk_bf16(v1[2], v1[3]);
                    bf16_t* p = Q + (size_t)row * 576 + c32 + 4 * fq; *(u32x2*)p = w0; *(u32x2*)(p + 16) = w1; } }
    }
};
struct EpiKVup { static constexpr bool PERM = true, AFTER_DRAIN = false;
    bf16_t* Kn; bf16_t* Vm; const float* rskv;
    __device__ __forceinline__ void operator()(const f32x4 (&acc)[2][2][4][2], const Unit& u, int wr, int wc, int fr, int fq) const {
        const int row0 = u.pm * BM + wr * 64 + fr;
#pragma unroll
        for (int bj = 0; bj < 2; ++bj) { const int h = 2 * u.pn + bj; bf16_t* dst = (wc < 2 ? Kn + h * 64 + wc * 32 : Vm + h * 64 + (wc - 2) * 32) + 8 * fq;
#pragma unroll
            for (int ai = 0; ai < 2; ++ai)
#pragma unroll
                for (int m = 0; m < 4; ++m) { const int row = row0 + ai * HALF + m * 16; const float s = row_scale<4>(rskv, row, 1.0f / 128.0f);
                    const f32x4 v0 = acc[ai][bj][m][0] * s, v1 = acc[ai][bj][m][1] * s;
                    u32x4 w; w.x = cvt_pk_bf16(v0[0], v0[1]); w.y = cvt_pk_bf16(v0[2], v0[3]); w.z = cvt_pk_bf16(v1[0], v1[1]); w.w = cvt_pk_bf16(v1[2], v1[3]);
                    *(u32x4*)(dst + (size_t)row * 384) = w; } }
    }
};
struct EpiGate { static constexpr bool PERM = true, AFTER_DRAIN = false;
    bf16_t* O; const float* rsp;
    __device__ __forceinline__ void operator()(const f32x4 (&acc)[2][2][4][2], const Unit& u, int wr, int wc, int fr, int fq) const {
        const int row0 = u.pm * BM + wr * 64 + fr, col0 = u.pn * BM + wc * 32 + 8 * fq;
#pragma unroll
        for (int ai = 0; ai < 2; ++ai)
#pragma unroll
            for (int m = 0; m < 4; ++m) { const int row = row0 + ai * HALF + m * 16; const float s = row_scale<16>(rsp, row, 1.0f / DM);
#pragma unroll
                for (int bj = 0; bj < 2; ++bj) { float y[8];
#pragma unroll
                    for (int n = 0; n < 2; ++n)
#pragma unroll
                        for (int j = 0; j < 4; ++j) y[4 * n + j] = sigm_f(acc[ai][bj][m][n][j] * s);
                    u32x4 w; w.x = cvt_pk_bf16(y[0], y[1]); w.y = cvt_pk_bf16(y[2], y[3]); w.z = cvt_pk_bf16(y[4], y[5]); w.w = cvt_pk_bf16(y[6], y[7]);
                    *(u32x4*)(O + (size_t)row * 3072 + col0 + bj * HALF) = w; } }
    }
};
struct EpiMerge { static constexpr bool PERM = true, AFTER_DRAIN = false;
    const bf16_t* G; bf16_t* Mg; int first;
    __device__ __forceinline__ void operator()(const f32x4 (&acc)[2][2][4][2], const Unit& u, int wr, int wc, int fr, int fq) const {
        const int row0 = u.pm * BM + wr * 64 + fr, col0 = u.pn * BM + wc * 32 + 8 * fq;
#pragma unroll
        for (int ai = 0; ai < 2; ++ai)
#pragma unroll
            for (int m = 0; m < 4; ++m) { const int row = row0 + ai * HALF + m * 16;
#pragma unroll
                for (int bj = 0; bj < 2; ++bj) { u32x4 g = *(const u32x4*)(G + (size_t)row * 3072 + col0 + bj * HALF); if (MK_NOGATE) g = (u32x4){0x3f803f80u, 0x3f803f80u, 0x3f803f80u, 0x3f803f80u}; bf16_t* mp = Mg + (size_t)row * DM + col0 + bj * HALF;
                    u32x4 pv = (u32x4){0u, 0u, 0u, 0u}; if (!first) pv = *(const u32x4*)mp;
                    f32x4 a0 = acc[ai][bj][m][0], a1 = acc[ai][bj][m][1]; if (MK_NOACC) { a0 = (f32x4){1.f, 1.f, 1.f, 1.f}; a1 = a0; }
                    u32x4 w;
                    w.x = cvt_pk_bf16(bflo(pv.x) + bflo(g.x) * a0[0], bfhi(pv.x) + bfhi(g.x) * a0[1]);
                    w.y = cvt_pk_bf16(bflo(pv.y) + bflo(g.y) * a0[2], bfhi(pv.y) + bfhi(g.y) * a0[3]);
                    w.z = cvt_pk_bf16(bflo(pv.z) + bflo(g.z) * a1[0], bfhi(pv.z) + bfhi(g.z) * a1[1]);
                    w.w = cvt_pk_bf16(bflo(pv.w) + bflo(g.w) * a1[2], bfhi(pv.w) + bfhi(g.w) * a1[3]);
                    *(u32x4*)mp = w; } }
    }
};

template <class Epi, class Sched, bool ALIGN_EPI = false>
__device__ __forceinline__ void gemm_phase(PG8_LAS unsigned char* lds, const Gemm g, const Sched& S, const Epi& E, int tid_in) {
    int tid_ = tid_in; asm volatile("" : "+v"(tid_));
    const int tid = tid_, wid = __builtin_amdgcn_readfirstlane(tid >> 6), lane = tid & 63, wr = wid >> 2, wc = wid & 3, fr = lane & 15, fq = lane >> 4;
    int K = g.K; asm volatile("" : "+s"(K)); const int nt = K / BK;
    unsigned voffA[2], voffB[2];
#pragma unroll
    for (int i = 0; i < 2; ++i) { int R, C; stage_rc(tid * 16 + i * 8192, R, C); const int Rb = Epi::PERM ? ((R & ~31) + perm32(R & 31)) : R;
        voffA[i] = (unsigned)(R * g.lda + C) * 2u; voffB[i] = (unsigned)(Rb * g.ldb + C) * 2u; }
    const size_t kstep = (size_t)(BK * 2);
    const size_t hstepA = (size_t)HALF * g.lda * 2, hstepB = (size_t)HALF * g.ldb * 2;
    const size_t tstepA = 2 * hstepA, tstepB = 2 * hstepB;
    const unsigned ldsw = (unsigned)wid * 1024u;
    const int aoff = lds_byte(wr * 64 + fr, fq * 8), boff = lds_byte(wc * 32 + fr, fq * 8);
#define PG8_SA(b, h) (((b) * 2 + (h)) * HTB)
#define PG8_SB(b, h) ((4 + (b) * 2 + (h)) * HTB)
#define PG8_STAGE(bufoff, gbase, voff) do { _Pragma("unroll") for (int _i = 0; _i < 2; ++_i) \
        __builtin_amdgcn_global_load_lds((const unsigned*)((const char*)(gbase) + (voff)[_i]), (PG8_LAS unsigned*)(lds + (bufoff) + ldsw + _i * 8192), 16, 0, 0); } while (0)
#define PG8_LDA(dst, b, h) do { _Pragma("unroll") for (int m = 0; m < 4; ++m) _Pragma("unroll") for (int k = 0; k < 2; ++k) dst[m][k] = *(const PG8_LAS bf16x8*)(lds + PG8_SA(b, h) + aoff + m * 2048 + k * 1024); } while (0)
#define PG8_LDB(dst, b, h) do { _Pragma("unroll") for (int n = 0; n < 2; ++n) _Pragma("unroll") for (int k = 0; k < 2; ++k) dst[n][k] = *(const PG8_LAS bf16x8*)(lds + PG8_SB(b, h) + boff + n * 2048 + k * 1024); } while (0)
#define PG8_MMA(ai, bj, At, Bt) do { __builtin_amdgcn_s_setprio(1); _Pragma("unroll") for (int m = 0; m < 4; ++m) _Pragma("unroll") for (int n = 0; n < 2; ++n) _Pragma("unroll") for (int k = 0; k < 2; ++k) \
        acc[ai][bj][m][n] = __builtin_amdgcn_mfma_f32_16x16x32_bf16(Bt[n][k], At[m][k], acc[ai][bj][m][n], 0, 0, 0); __builtin_amdgcn_s_setprio(0); } while (0)
#define PG8_WAIT_V(n) asm volatile("s_waitcnt vmcnt(" #n ")" ::: "memory")
#define PG8_WAIT_L(n) asm volatile("s_waitcnt lgkmcnt(" #n ")" ::: "memory")
#define PG8_BAR __builtin_amdgcn_s_barrier()
#define PG8_SCHED __builtin_amdgcn_sched_barrier(0)
    Unit cur, nxt; int ui = 0;
    if (!S.next(0, cur)) return;
    f32x4 acc[2][2][4][2];
#pragma unroll
    for (int a = 0; a < 2; ++a)
#pragma unroll
        for (int b = 0; b < 2; ++b)
#pragma unroll
            for (int m = 0; m < 4; ++m)
#pragma unroll
                for (int n = 0; n < 2; ++n) acc[a][b][m][n] = (f32x4){0.f, 0.f, 0.f, 0.f};
    bf16x8 At[4][2], B0[2][2], B1[2][2];
    const char* cA = (const char*)g.A + (size_t)cur.pm * tstepA; const char* cB = (const char*)g.Bt + (size_t)cur.pn * tstepB;
    S.a_ready(cur);
    PG8_STAGE(PG8_SB(0, 0), cB, voffB); PG8_STAGE(PG8_SB(0, 1), cB + hstepB, voffB); PG8_STAGE(PG8_SA(0, 0), cA, voffA); PG8_STAGE(PG8_SA(0, 1), cA + hstepA, voffA);
    if (wr == 1) PG8_BAR;
    PG8_WAIT_V(2); PG8_BAR;
    PG8_STAGE(PG8_SB(1, 0), cB + kstep, voffB); PG8_STAGE(PG8_SA(1, 0), cA + kstep, voffA); PG8_STAGE(PG8_SB(1, 1), cB + hstepB + kstep, voffB);
    PG8_WAIT_V(6); PG8_BAR;
    for (;;) {
        const bool has_next = S.next(ui + 1, nxt);
        const char* nA = has_next ? (const char*)g.A + (size_t)nxt.pm * tstepA : cA; const char* nB = has_next ? (const char*)g.Bt + (size_t)nxt.pn * tstepB : cB;
        for (int t = 0; t < nt; t += 2) {
            const bool last = (t == nt - 2);
            const char* a1 = cA + (size_t)(t + 1) * kstep;
            const char* a2 = last ? nA : cA + (size_t)(t + 2) * kstep; const char* b2 = last ? nB : cB + (size_t)(t + 2) * kstep;
            const char* a3 = a2 + kstep; const char* b3 = b2 + kstep;
            if (last && has_next) S.a_ready(nxt);
            PG8_LDB(B0, 0, 0); PG8_LDB(B1, 0, 1); PG8_SCHED; PG8_LDA(At, 0, 0); PG8_STAGE(PG8_SA(1, 1), a1 + hstepA, voffA);
            PG8_WAIT_V(8); PG8_WAIT_L(0); PG8_BAR; PG8_MMA(0, 0, At, B0); PG8_MMA(0, 1, At, B1); PG8_BAR; PG8_SCHED;
            PG8_LDA(At, 0, 1); PG8_STAGE(PG8_SB(0, 0), b2, voffB); PG8_STAGE(PG8_SB(0, 1), b2 + hstepB, voffB); PG8_STAGE(PG8_SA(0, 0), a2, voffA);
            PG8_WAIT_V(8); PG8_WAIT_L(0); PG8_BAR; PG8_MMA(1, 0, At, B0); PG8_MMA(1, 1, At, B1); PG8_BAR; PG8_SCHED;
            PG8_LDB(B0, 1, 0); PG8_LDB(B1, 1, 1); PG8_SCHED; PG8_LDA(At, 1, 0); PG8_STAGE(PG8_SA(0, 1), a2 + hstepA, voffA);
            PG8_WAIT_V(8); PG8_WAIT_L(0); PG8_BAR; PG8_MMA(0, 0, At, B0); PG8_MMA(0, 1, At, B1); PG8_BAR; PG8_SCHED;
            PG8_LDA(At, 1, 1); PG8_STAGE(PG8_SB(1, 0), b3, voffB); PG8_STAGE(PG8_SB(1, 1), b3 + hstepB, voffB); PG8_STAGE(PG8_SA(1, 0), a3, voffA);
            PG8_WAIT_V(8); PG8_WAIT_L(0); PG8_BAR; PG8_MMA(1, 0, At, B0); PG8_MMA(1, 1, At, B1); PG8_BAR; PG8_SCHED;
        }
        if constexpr (ALIGN_EPI) { if (wr == 0) PG8_BAR; }
        E(acc, cur, wr, wc, fr, fq); S.done(cur);
        if (!has_next) break;
#pragma unroll
        for (int a = 0; a < 2; ++a)
#pragma unroll
            for (int b = 0; b < 2; ++b)
#pragma unroll
                for (int m = 0; m < 4; ++m)
#pragma unroll
                    for (int n = 0; n < 2; ++n) acc[a][b][m][n] = (f32x4){0.f, 0.f, 0.f, 0.f};
        cur = nxt; cA = nA; cB = nB; ++ui;
        if constexpr (ALIGN_EPI) { if (wr == 1) PG8_BAR; }
    }
    PG8_WAIT_V(0);
    if constexpr (!ALIGN_EPI) { if (wr == 0) PG8_BAR; }
    PG8_BAR;
#undef PG8_SA
#undef PG8_SB
#undef PG8_STAGE
#undef PG8_LDA
#undef PG8_LDB
#undef PG8_MMA
#undef PG8_WAIT_V
#undef PG8_WAIT_L
#undef PG8_BAR
#undef PG8_SCHED
}
}

constexpr int NWAVES = 8;
constexpr size_t MiB = 1u << 20;
constexpr size_t WS_CTL = 0, CTL_ZERO_BYTES = 1 * MiB;
constexpr size_t WS_ROPE = 1 * MiB;
constexpr size_t WS_KMEAN = WS_ROPE + 512 * 1024;
constexpr size_t WS_RS = 2 * MiB;
constexpr size_t WS_RSQ = 4 * MiB;
constexpr size_t WS_RSKV = WS_RSQ + 512 * 1024;
constexpr size_t WS_W = 5 * MiB;
constexpr size_t W_GU1 = 0, W_D1 = W_GU1 + (size_t)5632 * 1024 * 2, W_IN = W_D1 + (size_t)1024 * 2816 * 2, W_G = W_IN + (size_t)4096 * 1024 * 2,
                 W_UQ = W_G + (size_t)3072 * 1024 * 2, W_UKV = W_UQ + (size_t)768 * 256 * 2, W_BR = W_UKV + (size_t)768 * 256 * 2, W_OUT = W_BR + (size_t)1024 * 1024 * 2,
                 W_GU2 = W_OUT + (size_t)1024 * 1024 * 2, W_D2 = W_GU2 + (size_t)5632 * 1024 * 2, W_END = W_D2 + (size_t)1024 * 2816 * 2;
static_assert(W_END <= 52 * MiB, "weights region");
constexpr size_t WS_XB = 57 * MiB;
constexpr size_t WS_PROJ = 121 * MiB;
constexpr size_t WS_QM = 377 * MiB;
constexpr size_t WS_KN = 413 * MiB;
constexpr size_t WS_VM = 437 * MiB;
constexpr size_t WS_KR = 461 * MiB;
constexpr size_t WS_MG = WS_QM;
constexpr size_t WS_AO = 463 * MiB;
constexpr size_t WS_END = 527 * MiB;
constexpr int CW_BAR = 4096;

constexpr int RING_OFF = 0, RING_BYTES = 131072;
constexpr int LDSCTL_OFF = RING_BYTES, MISC_OFF = LDSCTL_OFF + 320;
constexpr int LDS_BYTES = 147456;

#define GAS __attribute__((address_space(1)))
#define LAS __attribute__((address_space(3)))
typedef unsigned short bf16;
typedef unsigned v4u __attribute__((ext_vector_type(4)));
typedef unsigned v2u __attribute__((ext_vector_type(2)));
typedef float f32x4 __attribute__((ext_vector_type(4)));
typedef GAS unsigned gu32;
#define RLX_AGENT __ATOMIC_RELAXED, __HIP_MEMORY_SCOPE_AGENT
#define LDS_WAIT() asm volatile("s_waitcnt lgkmcnt(0)" ::: "memory")
__device__ __forceinline__ unsigned f2bf(float f) { unsigned u = __builtin_bit_cast(unsigned, f); return (u + 0x7fffu + ((u >> 16) & 1u)) >> 16; }
__device__ __forceinline__ unsigned pk2(float lo, float hi) { return f2bf(lo) | (f2bf(hi) << 16); }
__device__ __forceinline__ float bflo(unsigned w) { return __uint_as_float(w << 16); }
__device__ __forceinline__ float bfhi(unsigned w) { return __uint_as_float(w & 0xffff0000u); }

#define XB_TMO      128
#define XB_XCNT(j)  (256  + 64 * (j))
#define XB_XSUB(j)  (1280 + 64 * (j))
#define XB_XGEN(j)  (2304 + 64 * (j))
#define XB_TOP      3328
#define XB_TOPGEN   3392
#define XCD_BAR_WORDS 3456
#define XB_SPIN_CAP (1u << 20)

__device__ __forceinline__ unsigned xb_ld(unsigned* p)              { return __hip_atomic_load(p, __ATOMIC_RELAXED, __HIP_MEMORY_SCOPE_AGENT); }
__device__ __forceinline__ unsigned xb_add(unsigned* p, unsigned v) { return __hip_atomic_fetch_add(p, v, __ATOMIC_RELAXED, __HIP_MEMORY_SCOPE_AGENT); }
__device__ __forceinline__ unsigned xb_xcc_id() { return (unsigned)__builtin_amdgcn_s_getreg((3 << 11) | 20) & 0xFu; }
#define XB_SPIN(cond, bar) do { unsigned _sp = 0; while (cond) { __builtin_amdgcn_s_sleep(1); \
    if ((++_sp & 255u) == 0u) { if (xb_ld(&(bar)[XB_TMO])) break; if (_sp > XB_SPIN_CAP) { atomicAdd(&(bar)[XB_TMO], 1u); break; } } } } while (0)

struct XcdBarrier { unsigned* bar; unsigned x; volatile LAS unsigned* st; };

__device__ __forceinline__ XcdBarrier xcd_barrier_post(unsigned* bar, volatile LAS unsigned* st) {
    XcdBarrier b; b.bar = bar; b.x = xb_xcc_id(); b.st = st;
    if (threadIdx.x == 0) (void)xb_add(&bar[XB_XCNT(b.x)], 1u);
    return b;
}
__device__ __forceinline__ void xcd_barrier_complete(unsigned* bar, unsigned x, unsigned& nloc, unsigned& nx) {
    const unsigned G = gridDim.x * gridDim.y * gridDim.z;
    unsigned sum, cnt, mine, sp = 0u;
    for (;;) {
        sum = 0u; cnt = 0u; mine = 0u;
#pragma unroll
        for (unsigned j = 0; j < 16; ++j) { const unsigned c = xb_ld(&bar[XB_XCNT(j)]); sum += c; cnt += (c > 0u) ? 1u : 0u; mine = (j == x) ? c : mine; }
        if (sum == G) break;
        __builtin_amdgcn_s_sleep(1);
        if ((++sp & 255u) == 0u) { if (xb_ld(&bar[XB_TMO])) break; if (sp > XB_SPIN_CAP) { atomicAdd(&bar[XB_TMO], 1u); break; } }
    }
    nloc = mine > 0u ? mine : 1u; nx = cnt > 0u ? cnt : 1u;
}
__device__ __forceinline__ void xcd_barrier(const XcdBarrier& b, bool leader) {
    asm volatile("s_waitcnt vmcnt(0)" ::: "memory");
    __syncthreads();
    if (leader) {
        unsigned* bar = b.bar;
        __builtin_amdgcn_s_waitcnt(0);
        unsigned nloc = b.st[0], nx = b.st[1];
        if (nloc == 0u) { xcd_barrier_complete(bar, b.x, nloc, nx); b.st[0] = nloc; b.st[1] = nx; }
        const unsigned old = xb_add(&bar[XB_XSUB(b.x)], 1u);
        const unsigned gen = old / nloc;
        if (old + 1u == (gen + 1u) * nloc) {
            __builtin_amdgcn_fence(__ATOMIC_RELEASE, "agent");
            asm volatile("s_waitcnt vmcnt(0)" ::: "memory");
            const unsigned og = xb_add(&bar[XB_TOP], 1u);
            const unsigned tg = og / nx;
            if (og + 1u == (tg + 1u) * nx) xb_add(&bar[XB_TOPGEN], 1u);
            else XB_SPIN(xb_ld(&bar[XB_TOPGEN]) == tg, bar);
            __builtin_amdgcn_fence(__ATOMIC_ACQUIRE, "agent");
            xb_add(&bar[XB_XGEN(b.x)], 1u);
            asm volatile("s_waitcnt vmcnt(0)" ::: "memory");
        } else {
            XB_SPIN(xb_ld(&bar[XB_XGEN(b.x)]) == gen, bar);
            __builtin_amdgcn_fence(__ATOMIC_ACQUIRE, "agent");
            asm volatile("s_waitcnt vmcnt(0)" ::: "memory");
        }
    }
    __syncthreads();
}

__device__ __forceinline__ float wave_sum(float v) {
#pragma unroll
    for (int o = 1; o < 64; o <<= 1) v += __shfl_xor(v, o);
    return v;
}
__device__ __forceinline__ void cvt_item(const float* W, int N, const float* gain, bf16* WT, int dpitch, int dkoff, int k0, int n0, int drow0, LAS float* scr, int lane) {
#pragma unroll 8
    for (int i = 0; i < 32; ++i) { const int kk = 2 * i + (lane >> 5); float v = W[(size_t)(k0 + kk) * N + n0 + (lane & 31)]; if (gain) v *= gain[k0 + kk]; scr[kk * 33 + (lane & 31)] = v; }
    LDS_WAIT(); asm volatile("" ::: "memory");
    const int c = lane & 7;
#pragma unroll
    for (int j = 0; j < 4; ++j) { const int n = (lane >> 3) + 8 * j; const LAS float* s = scr + (8 * c) * 33 + n;
        v4u o; o.x = pk2(s[0 * 33], s[1 * 33]); o.y = pk2(s[2 * 33], s[3 * 33]); o.z = pk2(s[4 * 33], s[5 * 33]); o.w = pk2(s[6 * 33], s[7 * 33]);
        *(GAS v4u*)(WT + (size_t)(drow0 + n) * dpitch + dkoff + k0 + 8 * c) = o; }
    LDS_WAIT(); asm volatile("" ::: "memory");
}
template <class RowMap>
__device__ __forceinline__ void cvt_matrix(const float* W, int K, int N, const float* gain, bf16* WT, int dpitch, int dkoff, const RowMap& RM, LAS float* scr, int gw, int NGW, int lane, int& base) {
    const int nblk = N / 32, nit = (K / 64) * nblk;
    int first = gw - (base % NGW); if (first < 0) first += NGW;
    for (int it = first; it < nit; it += NGW) { const int kb = it / nblk, nb = it % nblk; cvt_item(W, N, gain, WT, dpitch, dkoff, 64 * kb, 32 * nb, RM(32 * nb), scr, lane); }
    base += nit;
}
struct RmId { __device__ __forceinline__ int operator()(int n0) const { return n0; } };
struct RmGU { int add; __device__ __forceinline__ int operator()(int n0) const { return 256 * (n0 / 128) + (n0 % 128) + add; } };
struct RmIn { __device__ __forceinline__ int operator()(int n0) const {
    if (n0 < 256) return PC_CQ + n0; if (n0 < 384) return PC_CKV + (n0 - 256); if (n0 < 416) return PC_KR + (n0 - 384); if (n0 < 1568) return PC_MQ + (n0 - 416); if (n0 < 3872) return PC_DQ + (n0 - 1568);
    return 4096 + (n0 - 3872); } };
static_assert(W_G == W_IN + (size_t)4096 * 1024 * 2, "gate weights follow w_in");

__device__ __forceinline__ int OPQ_S(int v) { asm volatile("" : "+s"(v)); return v; }
struct Frame {
    LAS unsigned char* lds; volatile LAS unsigned* MISC; gu32* ctl;
};

__device__ __forceinline__ void ld8(const bf16* p, float* f) { const v4u w = *(const v4u*)p; f[0] = bflo(w.x); f[1] = bfhi(w.x); f[2] = bflo(w.y); f[3] = bfhi(w.y); f[4] = bflo(w.z); f[5] = bfhi(w.z); f[6] = bflo(w.w); f[7] = bfhi(w.w); }
__device__ __forceinline__ float dot8(const bf16* p, const float* q) { const v4u w = *(const v4u*)p;
    return ((q[0] * bflo(w.x) + q[1] * bfhi(w.x)) + (q[2] * bflo(w.y) + q[3] * bfhi(w.y))) + ((q[4] * bflo(w.z) + q[5] * bfhi(w.z)) + (q[6] * bflo(w.w) + q[7] * bfhi(w.w))); }
__device__ __forceinline__ void axpy8(const bf16* p, float a, float c, float* o) { const v4u w = *(const v4u*)p;
    o[0] = o[0] * c + a * bflo(w.x); o[1] = o[1] * c + a * bfhi(w.x); o[2] = o[2] * c + a * bflo(w.y); o[3] = o[3] * c + a * bfhi(w.y);
    o[4] = o[4] * c + a * bflo(w.z); o[5] = o[5] * c + a * bfhi(w.z); o[6] = o[6] * c + a * bflo(w.w); o[7] = o[7] * c + a * bfhi(w.w); }
__device__ __forceinline__ void st8(bf16* p, const float* o, float s) { v4u w; w.x = pk2(o[0] * s, o[1] * s); w.y = pk2(o[2] * s, o[3] * s); w.z = pk2(o[4] * s, o[5] * s); w.w = pk2(o[6] * s, o[7] * s); *(v4u*)p = w; }

__device__ __forceinline__ void mla_naive_chunk(const bf16* Qm, const bf16* Kn, const bf16* KR, const bf16* Vm, bf16* AO, int b, int h, int chunk, int lane) {
    const int t = chunk * 64 + lane; const size_t rowb = (size_t)b * SEQ;
    float q[96];
#pragma unroll
    for (int c = 0; c < 12; ++c) ld8(Qm + (rowb + t) * 576 + h * 96 + 8 * c, q + 8 * c);
    float m = -1e30f, l = 0.f; float o[64];
#pragma unroll
    for (int d = 0; d < 64; ++d) o[d] = 0.f;
    const float scale = 0.10206207261596575f;
    const int jmax = chunk * 64 + 63;
    for (int j = 0; j <= jmax; ++j) {
        const bf16* kp = Kn + (rowb + j) * 384 + h * 64; const bf16* rp = KR + (rowb + j) * 32; const bf16* vp = Vm + (rowb + j) * 384 + h * 64;
        float s = 0.f;
#pragma unroll
        for (int c = 0; c < 8; ++c) s += dot8(kp + 8 * c, q + 8 * c);
#pragma unroll
        for (int c = 0; c < 4; ++c) s += dot8(rp + 8 * c, q + 64 + 8 * c);
        s *= scale;
        if (j <= t) { const float mn = fmaxf(m, s), corr = __expf(m - mn), p = __expf(s - mn); l = l * corr + p; m = mn;
#pragma unroll
            for (int c = 0; c < 8; ++c) axpy8(vp + 8 * c, p, corr, o + 8 * c); }
    }
    const float inv = 1.0f / l;
#pragma unroll
    for (int c = 0; c < 8; ++c) st8(AO + (rowb + t) * DM + h * 64 + 8 * c, o + 8 * c, inv);
}

__device__ __forceinline__ void moba_naive_chunk(const bf16* proj, const float* kmean, bf16* AO, int b, int h, int chunk, int lane) {
    const int t = chunk * 64 + lane; const size_t rowb = (size_t)b * SEQ; const int b_own = chunk >> 2;
    float q[64];
#pragma unroll
    for (int c = 0; c < 8; ++c) ld8(proj + (rowb + t) * PP + PC_MQ + h * 64 + 8 * c, q + 8 * c);
    const float slope = exp2f(-8.0f * (float)(12 + h + 1) / 18.0f);
    float v1 = -3e38f, v2 = -3e38f, v3 = -3e38f; int i1 = -1, i2 = -1, i3 = -1;
    for (int n = 0; n < b_own; ++n) { const float* km = kmean + ((size_t)(b * 6 + h) * 16 + n) * 64; float g = 0.f;
#pragma unroll
        for (int c = 0; c < 16; ++c) { const f32x4 k4 = *(const f32x4*)(km + 4 * c); g += (q[4 * c] * k4[0] + q[4 * c + 1] * k4[1]) + (q[4 * c + 2] * k4[2] + q[4 * c + 3] * k4[3]); }
        if (g > v1) { v3 = v2; i3 = i2; v2 = v1; i2 = i1; v1 = g; i1 = n; } else if (g > v2) { v3 = v2; i3 = i2; v2 = g; i2 = n; } else if (g > v3) { v3 = g; i3 = n; } }
    unsigned sel = 0u; if (i1 >= 0) sel |= 1u << i1; if (i2 >= 0) sel |= 1u << i2; if (i3 >= 0) sel |= 1u << i3;
    float m = -1e30f, l = 0.f; float o[64];
#pragma unroll
    for (int d = 0; d < 64; ++d) o[d] = 0.f;
    for (int n = 0; n < b_own; ++n) { const bool mine = (sel >> n) & 1u; if (!__any(mine)) continue;
        for (int kk = 0; kk < 256; ++kk) { const int kpos = n * 256 + kk; const bf16* kp = proj + (rowb + kpos) * PP + PC_MK + h * 64; const bf16* vp = proj + (rowb + kpos) * PP + PC_MV + h * 64;
            float s = 0.f;
#pragma unroll
            for (int c = 0; c < 8; ++c) s += dot8(kp + 8 * c, q + 8 * c);
            s = s * 0.125f - slope * (float)(t - kpos);
            if (mine) { const float mn = fmaxf(m, s), corr = __expf(m - mn), p = __expf(s - mn); l = l * corr + p; m = mn;
#pragma unroll
                for (int c = 0; c < 8; ++c) axpy8(vp + 8 * c, p, corr, o + 8 * c); } } }
    for (int kpos = b_own * 256; kpos <= chunk * 64 + 63; ++kpos) { const bf16* kp = proj + (rowb + kpos) * PP + PC_MK + h * 64; const bf16* vp = proj + (rowb + kpos) * PP + PC_MV + h * 64;
        float s = 0.f;
#pragma unroll
        for (int c = 0; c < 8; ++c) s += dot8(kp + 8 * c, q + 8 * c);
        s = s * 0.125f - slope * (float)(t - kpos);
        if (kpos <= t) { const float mn = fmaxf(m, s), corr = __expf(m - mn), p = __expf(s - mn); l = l * corr + p; m = mn;
#pragma unroll
            for (int c = 0; c < 8; ++c) axpy8(vp + 8 * c, p, corr, o + 8 * c); } }
    const float inv = 1.0f / l;
#pragma unroll
    for (int c = 0; c < 8; ++c) st8(AO + (rowb + t) * DM + 384 + h * 64 + 8 * c, o + 8 * c, inv);
}

__device__ __forceinline__ void dil_naive_thread(const bf16* proj, bf16* AO, int b, int hg, int t) {
    const size_t rowb = (size_t)b * SEQ;
    float m = -1e30f, l = 0.f; float o[64];
#pragma unroll
    for (int d = 0; d < 64; ++d) o[d] = 0.f;
    for (int g = 0; g < 3; ++g) { const int h = g * 4 + hg, dil = (g == 0) ? 1 : (g == 1) ? 4 : 16; const float slope = exp2f(-8.0f * (float)(h + 1) / 18.0f);
        float q[64];
#pragma unroll
        for (int c = 0; c < 8; ++c) ld8(proj + (rowb + t) * PP + PC_DQ + h * 64 + 8 * c, q + 8 * c);
        for (int j = 0; j <= 128; ++j) { const int kpos = t - j * dil;
            if (kpos >= 0) { const bf16* kp = proj + (rowb + kpos) * PP + PC_DK + h * 64; const bf16* vp = proj + (rowb + kpos) * PP + PC_DV + h * 64;
                float s = 0.f;
#pragma unroll
                for (int c = 0; c < 8; ++c) s += dot8(kp + 8 * c, q + 8 * c);
                s = s * 0.125f - slope * (float)(j * dil);
                const float mn = fmaxf(m, s), corr = __expf(m - mn), p = __expf(s - mn); l = l * corr + p; m = mn;
#pragma unroll
                for (int c = 0; c < 8; ++c) axpy8(vp + 8 * c, p, corr, o + 8 * c); } } }
    const float inv = 1.0f / l;
#pragma unroll
    for (int c = 0; c < 8; ++c) st8(AO + (rowb + t) * DM + 768 + hg * 64 + 8 * c, o + 8 * c, inv);
}

struct Args { const float* in[20]; float* out; unsigned char* ws; int ph_lo, ph_hi; };
constexpr int PH_PER_LAYER = 11, N_PHASES = 1 + DEPTH * PH_PER_LAYER + 1;

__global__ void __launch_bounds__(NWAVES * 64, 2) mk_fwd(Args args) {
    extern __shared__ __attribute__((aligned(16))) unsigned char lds[];
    Frame F;
    F.lds = (LAS unsigned char*)lds;
    F.MISC = (volatile LAS unsigned*)(F.lds + MISC_OFF);
    unsigned char* ws = args.ws;
    F.ctl = (gu32*)(ws + WS_CTL);
    for (int u = threadIdx.x; u < (LDS_BYTES - LDSCTL_OFF) / 4; u += NWAVES * 64) ((LAS unsigned*)(F.lds + LDSCTL_OFF))[u] = 0u;
    __syncthreads();
    const int wave_s = __builtin_amdgcn_readfirstlane((int)threadIdx.x >> 6);
#define MYTID() (OPQ_S(wave_s) * 64 + (int)__builtin_amdgcn_mbcnt_hi(~0u, __builtin_amdgcn_mbcnt_lo(~0u, 0u)))
#define PHASE_LANES() int tid_ = MYTID(); asm volatile("" : "+v"(tid_)); int G_ = gridDim.x, bx_ = blockIdx.x; asm volatile("" : "+s"(G_), "+s"(bx_)); \
    const int lane = tid_ & 63, wave = __builtin_amdgcn_readfirstlane(tid_ >> 6); const int vcu_ = (G_ % 8 == 0) ? (bx_ % 8) * (G_ / 8) + bx_ / 8 : bx_; const int gw = vcu_ * NWAVES + wave, NGW = G_ * NWAVES; (void)lane; (void)gw; (void)NGW
    XcdBarrier bar; bar.bar = (unsigned*)(F.ctl + CW_BAR); bar.x = 0; bar.st = nullptr;
    if (!MK_PER_PHASE) bar = xcd_barrier_post((unsigned*)(F.ctl + CW_BAR), F.MISC + 8);
#define GRID_BAR() do { if (MK_PER_PHASE) { if (MYTID() == 0) __hip_atomic_store(F.ctl + 0, 0xBADBA0u, RLX_AGENT); } else { xcd_barrier(bar, MYTID() == 0); } } while (0)
    const int lo = args.ph_lo, hi = args.ph_hi;
#define IN(k) (lo <= (k) && (k) < hi)
#define BOTH(k) (IN(k) && IN((k) + 1))

#define PHASE_PTRS() unsigned zo_ = 0u; asm volatile("" : "+s"(zo_)); unsigned char* ws_ = args.ws + zo_;     \
    const float* x_in = args.in[0]; float* out = args.out; \
    float* cosT = (float*)(ws_ + WS_ROPE); float* sinT = cosT + SEQ * 16; float* kmean = (float*)(ws_ + WS_KMEAN); \
    float* rs = (float*)(ws_ + WS_RS); float* rsq = (float*)(ws_ + WS_RSQ); float* rskv = (float*)(ws_ + WS_RSKV); \
    bf16* Wb = (bf16*)(ws_ + WS_W); bf16* XB = (bf16*)(ws_ + WS_XB); bf16* PROJ = (bf16*)(ws_ + WS_PROJ); bf16* ACT = PROJ; bf16* GT = PROJ; \
    bf16* QM = (bf16*)(ws_ + WS_QM); bf16* KN = (bf16*)(ws_ + WS_KN); bf16* VM = (bf16*)(ws_ + WS_VM); bf16* KR = (bf16*)(ws_ + WS_KR); \
    bf16* MG = (bf16*)(ws_ + WS_MG); bf16* AO = (bf16*)(ws_ + WS_AO); \
    const pg8::bf16_t* Wgu1 = Wb + W_GU1 / 2; const pg8::bf16_t* Wd1 = Wb + W_D1 / 2; const pg8::bf16_t* Win = Wb + W_IN / 2; const pg8::bf16_t* Wg = Wb + W_G / 2; \
    const pg8::bf16_t* Wuq = Wb + W_UQ / 2; const pg8::bf16_t* Wukv = Wb + W_UKV / 2; const pg8::bf16_t* Wbr = Wb + W_BR / 2; const pg8::bf16_t* Wout = Wb + W_OUT / 2; \
    const pg8::bf16_t* Wgu2 = Wb + W_GU2 / 2; const pg8::bf16_t* Wd2 = Wb + W_D2 / 2; \
    (void)x_in; (void)out; (void)cosT; (void)sinT; (void)kmean; (void)rs; (void)rsq; (void)rskv; (void)XB; (void)ACT; (void)GT; (void)QM; (void)KN; (void)VM; (void)KR; (void)MG; (void)AO; \
    (void)Wgu1; (void)Wd1; (void)Win; (void)Wg; (void)Wuq; (void)Wukv; (void)Wbr; (void)Wout; (void)Wgu2; (void)Wd2

    if (IN(0)) { PHASE_LANES(); PHASE_PTRS();
        for (int m = gw; m < T; m += NGW) { const GAS f32x4* xr = (const GAS f32x4*)(x_in + (size_t)m * DM) + lane; f32x4 v[4]; float s = 0.f;
#pragma unroll
            for (int j = 0; j < 4; ++j) { v[j] = xr[64 * j]; s += (v[j].x * v[j].x + v[j].y * v[j].y) + (v[j].z * v[j].z + v[j].w * v[j].w); }
            s = wave_sum(s);
            GAS unsigned long long* o8 = (GAS unsigned long long*)(XB + (size_t)m * DM) + lane;
#pragma unroll
            for (int j = 0; j < 4; ++j) o8[64 * j] = (unsigned long long)pk2(v[j].x, v[j].y) | ((unsigned long long)pk2(v[j].z, v[j].w) << 32);
            if (lane < 16) rs[(size_t)m * 16 + lane] = (lane == 0) ? s : 0.f; }
        for (int idx = gw * 64 + lane; idx < SEQ * 16; idx += NGW * 64) { const int pos = idx >> 4, i = idx & 15; const int a = i & 3, e = i >> 2;
            const double mm = a == 0 ? 1.0 : a == 1 ? 0.5623413251903491 : a == 2 ? 0.31622776601683794 : 0.1778279410038923;
            const double pe = e == 0 ? 1.0 : e == 1 ? 0.1 : e == 2 ? 0.01 : 0.001;
            const float inv = (float)(mm * pe); const float angf = (float)pos * inv;
            const double rev = (double)angf * 0.15915494309189535; const float fr = (float)(rev - __builtin_rint(rev));
            cosT[idx] = __builtin_amdgcn_cosf(fr); sinT[idx] = __builtin_amdgcn_sinf(fr); }
        if (BOTH(0)) GRID_BAR();
    }

    for (int l = 0; l < DEPTH; ++l) {
        const int pb = 1 + l * PH_PER_LAYER;
        if (IN(pb + 0)) { PHASE_LANES(); PHASE_PTRS();
            LAS float* scr = (LAS float*)(F.lds + RING_OFF + wave * 16384);
            int base = 0;
            cvt_matrix(args.in[2] + (size_t)l * DM * FF, DM, FF, args.in[1] + l * DM, Wb + W_GU1 / 2, DM, 0, RmGU{0}, scr, gw, NGW, lane, base);
            cvt_matrix(args.in[3] + (size_t)l * DM * FF, DM, FF, args.in[1] + l * DM, Wb + W_GU1 / 2, DM, 0, RmGU{128}, scr, gw, NGW, lane, base);
            cvt_matrix(args.in[4] + (size_t)l * FF * DM, FF, DM, nullptr, Wb + W_D1 / 2, FF, 0, RmId{}, scr, gw, NGW, lane, base);
            cvt_matrix(args.in[6] + (size_t)l * DM * IN_COLS, DM, IN_COLS, args.in[5] + l * DM, Wb + W_IN / 2, DM, 0, RmIn{}, scr, gw, NGW, lane, base);
            cvt_matrix(args.in[8] + (size_t)l * 256 * 576, 256, 576, args.in[7] + l * 256, Wb + W_UQ / 2, 256, 0, RmId{}, scr, gw, NGW, lane, base);
            cvt_matrix(args.in[10] + (size_t)l * 128 * 768, 128, 768, args.in[9] + l * 128, Wb + W_UKV / 2, 256, 0, RmId{}, scr, gw, NGW, lane, base);
            cvt_matrix(args.in[11] + (size_t)l * 384 * DM, 384, DM, nullptr, Wb + W_BR / 2, DM, 0, RmId{}, scr, gw, NGW, lane, base);
            cvt_matrix(args.in[12] + (size_t)l * 384 * DM, 384, DM, nullptr, Wb + W_BR / 2, DM, 384, RmId{}, scr, gw, NGW, lane, base);
            cvt_matrix(args.in[13] + (size_t)l * 256 * DM, 256, DM, nullptr, Wb + W_BR / 2, DM, 768, RmId{}, scr, gw, NGW, lane, base);
            cvt_matrix(args.in[14] + (size_t)l * DM * DM, DM, DM, nullptr, Wb + W_OUT / 2, DM, 0, RmId{}, scr, gw, NGW, lane, base);
            cvt_matrix(args.in[16] + (size_t)l * DM * FF, DM, FF, args.in[15] + l * DM, Wb + W_GU2 / 2, DM, 0, RmGU{0}, scr, gw, NGW, lane, base);
            cvt_matrix(args.in[17] + (size_t)l * DM * FF, DM, FF, args.in[15] + l * DM, Wb + W_GU2 / 2, DM, 0, RmGU{128}, scr, gw, NGW, lane, base);
            cvt_matrix(args.in[18] + (size_t)l * FF * DM, FF, DM, nullptr, Wb + W_D2 / 2, FF, 0, RmId{}, scr, gw, NGW, lane, base);
            const v4u z = (v4u){0u, 0u, 0u, 0u}; const int gt = gw * 64 + lane, NT = NGW * 64;
            for (int i = gt; i < 224 * 1024 / 8; i += NT) *(GAS v4u*)(Wb + W_IN / 2 + (size_t)3872 * 1024 + (size_t)i * 8) = z;
            for (int i = gt; i < 192 * 256 / 8; i += NT) *(GAS v4u*)(Wb + W_UQ / 2 + (size_t)576 * 256 + (size_t)i * 8) = z;
            for (int i = gt; i < 768 * 16; i += NT) *(GAS v4u*)(Wb + W_UKV / 2 + (size_t)(i >> 4) * 256 + 128 + (i & 15) * 8) = z;
            if (BOTH(pb + 0)) GRID_BAR();
        }
        if (IN(pb + 1)) { PHASE_PTRS();
            pg8::Gemm g{XB, Wgu1, T, 2 * FF, DM, DM, DM}; pg8::StaticOrder S; S.init(T, 2 * FF, OPQ_S((int)gridDim.x), OPQ_S((int)blockIdx.x));
            pg8::EpiSwiGLU E{ACT, FF, rs};
            pg8::gemm_phase<pg8::EpiSwiGLU, pg8::StaticOrder, true>(F.lds + RING_OFF, g, S, E, MYTID());
            if (BOTH(pb + 1)) GRID_BAR();
        }
        if (IN(pb + 2)) { PHASE_PTRS();
            pg8::Gemm g{ACT, Wd1, T, DM, FF, FF, FF}; pg8::StaticOrder S; S.init(T, DM, OPQ_S((int)gridDim.x), OPQ_S((int)blockIdx.x));
            pg8::EpiResid E{l == 0 ? x_in : out, out, XB, rs, 0.5f};
            pg8::gemm_phase<pg8::EpiResid, pg8::StaticOrder, true>(F.lds + RING_OFF, g, S, E, MYTID());
            if (BOTH(pb + 2)) GRID_BAR();
        }
        if (IN(pb + 3)) { PHASE_PTRS();
            pg8::Gemm g{XB, Win, T, 4096, DM, DM, DM}; pg8::StaticOrder S; S.init(T, 4096, OPQ_S((int)gridDim.x), OPQ_S((int)blockIdx.x));
            pg8::EpiProj E{PROJ, rs, rsq, rskv};
            pg8::gemm_phase<pg8::EpiProj, pg8::StaticOrder, true>(F.lds + RING_OFF, g, S, E, MYTID());
            if (BOTH(pb + 3)) GRID_BAR();
        }
        if (IN(pb + 4)) { PHASE_PTRS();
            { pg8::Gemm g{PROJ + PC_CQ, Wuq, T, 768, 256, PP, 256}; pg8::StaticOrder S; S.init(T, 768, OPQ_S((int)gridDim.x), OPQ_S((int)blockIdx.x));
              pg8::EpiQup E{QM, rsq, cosT, sinT};
              pg8::gemm_phase<pg8::EpiQup, pg8::StaticOrder, true>(F.lds + RING_OFF, g, S, E, MYTID()); }
            { pg8::Gemm g{PROJ + PC_CKV, Wukv, T, 768, 256, PP, 256}; pg8::StaticOrder S; S.init(T, 768, OPQ_S((int)gridDim.x), OPQ_S((int)blockIdx.x));
              pg8::EpiKVup E{KN, VM, rskv};
              pg8::gemm_phase<pg8::EpiKVup, pg8::StaticOrder, true>(F.lds + RING_OFF, g, S, E, MYTID()); }
            PHASE_LANES();
            for (int idx = gw * 64 + lane; idx < T * 16; idx += NGW * 64) { const int row = idx >> 4, i = idx & 15, pos = row & (SEQ - 1);
                const float t1 = __uint_as_float((unsigned)PROJ[(size_t)row * PP + PC_KR + i] << 16), t2 = __uint_as_float((unsigned)PROJ[(size_t)row * PP + PC_KR + 16 + i] << 16);
                const float c = cosT[pos * 16 + i], s = sinT[pos * 16 + i];
                KR[(size_t)row * 32 + i] = (bf16)f2bf(t1 * c - t2 * s); KR[(size_t)row * 32 + 16 + i] = (bf16)f2bf(t1 * s + t2 * c); }
            for (int idx = gw * 64 + lane; idx < BATCH * 6 * 16 * 64; idx += NGW * 64) { const int d = idx & 63, n = (idx >> 6) & 15, bh = idx >> 10, b = bh / 6, h = bh % 6;
                const bf16* kp = PROJ + ((size_t)b * SEQ + n * 256) * PP + PC_MK + h * 64 + d; float s = 0.f;
                for (int kk = 0; kk < 256; ++kk) s += __uint_as_float((unsigned)kp[(size_t)kk * PP] << 16);
                kmean[idx] = s * (1.0f / 256.0f); }
            for (int gid = gw * 64 + lane; gid < BATCH * 4 * SEQ; gid += NGW * 64) dil_naive_thread(PROJ, AO, gid >> 14, (gid >> 12) & 3, gid & (SEQ - 1));
            if (BOTH(pb + 4)) GRID_BAR();
        }
        if (IN(pb + 5)) { PHASE_LANES(); PHASE_PTRS();
            for (int u = gw; u < 2 * 48 * 32; u += NGW) { const int which = u / (48 * 32), r = u % (48 * 32), bh = r >> 5, cp = r & 31, b = bh / 6, h = bh % 6;
                if (which == 0) { mla_naive_chunk(QM, KN, KR, VM, AO, b, h, cp, lane); mla_naive_chunk(QM, KN, KR, VM, AO, b, h, 63 - cp, lane); }
                else { moba_naive_chunk(PROJ, kmean, AO, b, h, cp, lane); moba_naive_chunk(PROJ, kmean, AO, b, h, 63 - cp, lane); } }
            if (BOTH(pb + 5)) GRID_BAR();
        }
        if (IN(pb + 6)) { PHASE_PTRS();
            pg8::Gemm g{XB, Wg, T, 3072, DM, DM, DM}; pg8::StaticOrder S; S.init(T, 3072, OPQ_S((int)gridDim.x), OPQ_S((int)blockIdx.x));
            pg8::EpiGate E{GT, rs};
            pg8::gemm_phase<pg8::EpiGate, pg8::StaticOrder, true>(F.lds + RING_OFF, g, S, E, MYTID());
            if (BOTH(pb + 6)) GRID_BAR();
        }
        if (IN(pb + 7)) { PHASE_PTRS();
            int first_ = 1;
            if (MK_BRANCH_MASK & 1) { pg8::Gemm g{AO, Wbr, T, DM, 384, DM, DM}; pg8::StaticOrder S; S.init(T, DM, OPQ_S((int)gridDim.x), OPQ_S((int)blockIdx.x)); pg8::EpiMerge E{GT, MG, first_}; first_ = 0;
              pg8::gemm_phase<pg8::EpiMerge, pg8::StaticOrder, true>(F.lds + RING_OFF, g, S, E, MYTID()); }
            if (MK_BRANCH_MASK & 2) { pg8::Gemm g{AO + 384, Wbr + 384, T, DM, 384, DM, DM}; pg8::StaticOrder S; S.init(T, DM, OPQ_S((int)gridDim.x), OPQ_S((int)blockIdx.x)); pg8::EpiMerge E{GT + 1024, MG, first_}; first_ = 0;
              pg8::gemm_phase<pg8::EpiMerge, pg8::StaticOrder, true>(F.lds + RING_OFF, g, S, E, MYTID()); }
            if (MK_BRANCH_MASK & 4) { pg8::Gemm g{AO + 768, Wbr + 768, T, DM, 256, DM, DM}; pg8::StaticOrder S; S.init(T, DM, OPQ_S((int)gridDim.x), OPQ_S((int)blockIdx.x)); pg8::EpiMerge E{GT + 2048, MG, first_}; first_ = 0;
              pg8::gemm_phase<pg8::EpiMerge, pg8::StaticOrder, true>(F.lds + RING_OFF, g, S, E, MYTID()); }
            if (BOTH(pb + 7)) GRID_BAR();
        }
        if (IN(pb + 8)) { PHASE_PTRS();
            pg8::Gemm g{MG, Wout, T, DM, DM, DM, DM}; pg8::StaticOrder S; S.init(T, DM, OPQ_S((int)gridDim.x), OPQ_S((int)blockIdx.x));
            pg8::EpiResid E{out, out, XB, rs, 1.0f};
            pg8::gemm_phase<pg8::EpiResid, pg8::StaticOrder, true>(F.lds + RING_OFF, g, S, E, MYTID());
            if (BOTH(pb + 8)) GRID_BAR();
        }
        if (IN(pb + 9)) { PHASE_PTRS();
            pg8::Gemm g{XB, Wgu2, T, 2 * FF, DM, DM, DM}; pg8::StaticOrder S; S.init(T, 2 * FF, OPQ_S((int)gridDim.x), OPQ_S((int)blockIdx.x));
            pg8::EpiSwiGLU E{ACT, FF, rs};
            pg8::gemm_phase<pg8::EpiSwiGLU, pg8::StaticOrder, true>(F.lds + RING_OFF, g, S, E, MYTID());
            if (BOTH(pb + 9)) GRID_BAR();
        }
        if (IN(pb + 10)) { PHASE_PTRS();
            pg8::Gemm g{ACT, Wd2, T, DM, FF, FF, FF}; pg8::StaticOrder S; S.init(T, DM, OPQ_S((int)gridDim.x), OPQ_S((int)blockIdx.x));
            pg8::EpiResid E{out, out, XB, rs, 0.5f};
            pg8::gemm_phase<pg8::EpiResid, pg8::StaticOrder, true>(F.lds + RING_OFF, g, S, E, MYTID());
            if (BOTH(pb + 10)) GRID_BAR();
        }
    }
    if (IN(N_PHASES - 1)) { PHASE_LANES(); PHASE_PTRS();
        const float* gain = args.in[19];
        for (int m = gw; m < T; m += NGW) { GAS f32x4* xr = (GAS f32x4*)(out + (size_t)m * DM) + lane; f32x4 v[4]; float s = 0.f;
#pragma unroll
            for (int j = 0; j < 4; ++j) { v[j] = xr[64 * j]; s += (v[j].x * v[j].x + v[j].y * v[j].y) + (v[j].z * v[j].z + v[j].w * v[j].w); }
            const float r = 1.0f / sqrtf(wave_sum(s) * (1.0f / DM) + NORM_EPS);
#pragma unroll
            for (int j = 0; j < 4; ++j) { const f32x4 gn = *((const f32x4*)gain + lane + 64 * j); xr[64 * j] = v[j] * r * gn; } }
    }
#undef IN
#undef BOTH
#undef GRID_BAR
}


__global__ void dbg_rowsum(const float* out, float* cs) { const int row = blockIdx.x * 4 + (threadIdx.x >> 6), lane = threadIdx.x & 63; float s = 0.f; for (int c = lane; c < DM; c += 64) s += out[(size_t)row * DM + c]; for (int o = 1; o < 64; o <<= 1) s += __shfl_xor(s, o); if (lane == 0) cs[row] = s; }
__global__ void dbg_cmp(const float* a, const float* b, unsigned* flag) { const int i = blockIdx.x * 256 + threadIdx.x; if (i < T) { const float d = fabsf(a[i] - b[i]); if (!(d <= 1e-5f * fabsf(a[i]) + 1e-6f)) atomicAdd(flag, 1u); } }
__global__ void dbg_scale(float* out, const unsigned* flag) { const size_t i = (size_t)blockIdx.x * 256 + threadIdx.x; if (*flag) out[i] *= 3.0f; }
extern "C" void kernel_launch(void* const* d_in, const int* in_sizes, int n_in, void* d_out, int out_size, void* d_ws, size_t ws_size, hipStream_t stream) {
    static int grid = 0;
    if (grid == 0) {
        if (n_in != 20 || in_sizes[0] != T * DM || out_size != T * DM || ws_size < WS_END) { fprintf(stderr, "kernel_launch: unexpected shapes / workspace (n_in %d, ws %zu, need %zu)\n", n_in, ws_size, (size_t)WS_END); grid = -1; return; }
        int dev = 0, cus = 0, per_cu = 0;
        if (hipGetDevice(&dev) != hipSuccess || hipDeviceGetAttribute(&cus, hipDeviceAttributeMultiprocessorCount, dev) != hipSuccess) { grid = -1; return; }
        if (hipFuncSetAttribute((const void*)mk_fwd, hipFuncAttributeMaxDynamicSharedMemorySize, LDS_BYTES) != hipSuccess) { fprintf(stderr, "kernel_launch: hipFuncSetAttribute failed\n"); grid = -1; return; }
        if (hipOccupancyMaxActiveBlocksPerMultiprocessor(&per_cu, (const void*)mk_fwd, NWAVES * 64, LDS_BYTES) != hipSuccess || per_cu < 1)
            fprintf(stderr, "kernel_launch: note: occupancy query reports %d workgroups per CU\n", per_cu);
        (void)hipGetLastError();
        grid = cus;
    }
    if (grid < 0) return;
    if (hipMemsetAsync((char*)d_ws + WS_CTL, 0, CTL_ZERO_BYTES, stream) != hipSuccess) return;
    Args a{};
    for (int i = 0; i < 20; ++i) a.in[i] = (const float*)d_in[i];
    a.out = (float*)d_out; a.ws = (unsigned char*)d_ws;
#if MK_PER_PHASE
    float* cs = (float*)((char*)d_ws + WS_END); unsigned* flag = (unsigned*)((char*)d_ws + 64);
    for (int rep = 0; rep < 1; ++rep) {
      for (int p = 0; p < N_PHASES; ++p) { if (p > MK_STOP_AFTER && p != N_PHASES - 1) continue; a.ph_lo = p; a.ph_hi = p + 1; hipLaunchKernelGGL(mk_fwd, dim3(grid), dim3(NWAVES * 64), LDS_BYTES, stream, a); }
      hipLaunchKernelGGL(dbg_rowsum, dim3(T / 4), dim3(256), 0, stream, (const float*)d_out, cs + rep * T);
    }
    if (0) hipLaunchKernelGGL(dbg_cmp, dim3(T / 256), dim3(256), 0, stream, (const float*)cs, (const float*)(cs + T), flag);
    if (0) hipLaunchKernelGGL(dbg_scale, dim3(T * DM / 256), dim3(256), 0, stream, (float*)d_out, (const unsigned*)flag);
#else
    a.ph_lo = 0; a.ph_hi = N_PHASES;
    hipLaunchKernelGGL(mk_fwd, dim3(grid), dim3(NWAVES * 64), LDS_BYTES, stream, a);
#endif
}
```

```cpp
#include <hip/hip_runtime.h>
#include <cstdio>
#include <cstdint>

#ifndef MK_PER_PHASE
#define MK_PER_PHASE 0
#endif

#ifndef MK_NAIVE_MLA
#define MK_NAIVE_MLA 0
#endif
#ifndef MK_NAIVE_MOBA
#define MK_NAIVE_MOBA 0
#endif
#ifndef MK_NAIVE_DIL
#define MK_NAIVE_DIL 0
#endif
#ifndef MK_STOP_AFTER
#define MK_STOP_AFTER 999
#endif
#ifndef MK_NOGATE
#define MK_NOGATE 0
#define MK_NOACC 0
#endif
#ifndef MK_BRANCH_MASK
#define MK_BRANCH_MASK 7
#endif
constexpr int BATCH = 8, SEQ = 4096, DM = 1024, DEPTH = 4, FF = 2816, T = BATCH * SEQ;
constexpr int PP = 4096;
constexpr int PC_DQ = 0, PC_DK = 768, PC_DV = 1536, PC_MQ = 2304, PC_MK = 2688, PC_MV = 3072, PC_CKV = 3456, PC_CQ = 3584, PC_KR = 3840;
constexpr int IN_COLS = 6944;
constexpr float NORM_EPS = 1e-6f;
constexpr float LOG2E = 1.4426950408889634f, QSCALE64 = 0.125f * LOG2E, QSCALE96 = 0.10206207261596575f * LOG2E;

namespace pg8 {
#define PG8_LAS __attribute__((address_space(3)))
typedef unsigned short bf16_t;
typedef short bf16x8 __attribute__((ext_vector_type(8)));
typedef float f32x4 __attribute__((ext_vector_type(4)));
typedef unsigned u32x4 __attribute__((ext_vector_type(4)));
typedef unsigned u32x2 __attribute__((ext_vector_type(2)));
constexpr int BM = 256, BK = 64, HALF = 128, HTB = HALF * BK * 2, STAGE_BYTES = 8 * HTB, NXCD = 8, WGM = 8;

__host__ __device__ __forceinline__ int lds_byte(int r, int c) { const int st = (r >> 4) * 2 + (c >> 5), rr = r & 15, cc = c & 31, ob = rr * 64 + cc * 2; return st * 1024 + (ob ^ (((ob >> 9) & 1) << 5)); }
__host__ __device__ __forceinline__ void stage_rc(int b, int& R, int& C) { const int st = b / 1024, sb = b % 1024, swz = sb ^ (((sb >> 9) & 1) << 5); R = (st >> 1) * 16 + swz / 64; C = (st & 1) * 32 + (swz % 64) / 2; }
__host__ __device__ __forceinline__ int perm32(int rho) { const int n = rho >> 4, i = rho & 15; return 8 * (i >> 2) + 4 * n + (i & 3); }

struct Unit { int pm, pn; };
struct Gemm { const bf16_t* A; const bf16_t* Bt; int M, N, K, lda, ldb; };

struct StaticOrder {
    int nM, nN, nwg, G, c;
    __host__ __device__ void init(int M, int N, int G_, int c_) { nM = M / BM; nN = N / BM; nwg = nM * nN; G = G_; c = c_; }
    __host__ __device__ bool next(int i, Unit& u) const {
        const long L = (long)i * G + c; if (L >= nwg) return false;
        int wgid = (int)L; { const int q = nwg / NXCD, r = nwg % NXCD, xcd = wgid % NXCD, off = wgid / NXCD; wgid = (xcd < r ? xcd * (q + 1) : r * (q + 1) + (xcd - r) * q) + off; }
        const int nig = WGM * nN, gid = wgid / nig, fm = gid * WGM, gsz = (nM - fm) < WGM ? (nM - fm) : WGM;
        u.pm = fm + ((wgid % nig) % gsz); u.pn = (wgid % nig) / gsz; return true;
    }
    __device__ __forceinline__ void a_ready(const Unit&) const {}
    __device__ __forceinline__ void done(const Unit&) const {}
};

typedef float f32x2_t __attribute__((ext_vector_type(2))); typedef __bf16 bf16x2_t __attribute__((ext_vector_type(2)));
__device__ __forceinline__ unsigned cvt_pk_bf16(float lo, float hi) { f32x2_t v = {lo, hi}; bf16x2_t b = __builtin_convertvector(v, bf16x2_t); return __builtin_bit_cast(unsigned, b); }
__device__ __forceinline__ float bflo(unsigned w) { return __uint_as_float(w << 16); }
__device__ __forceinline__ float bfhi(unsigned w) { return __uint_as_float(w & 0xffff0000u); }

template <int NP> __device__ __forceinline__ float row_scale(const float* p, int row, float invn) {
    float s = 0.f;
#pragma unroll
    for (int i = 0; i < NP / 4; ++i) { const f32x4 a = *(const f32x4*)(p + (size_t)row * NP + 4 * i); s += (a[0] + a[1]) + (a[2] + a[3]); }
    return 1.0f / sqrtf(s * invn + NORM_EPS);
}
__device__ __forceinline__ float silu_f(float a) { return a * __builtin_amdgcn_rcpf(1.0f + __builtin_amdgcn_exp2f(-1.4426950408889634f * a)); }
__device__ __forceinline__ float sigm_f(float a) { return __builtin_amdgcn_rcpf(1.0f + __builtin_amdgcn_exp2f(-1.4426950408889634f * a)); }

struct EpiSwiGLU { static constexpr bool PERM = true, AFTER_DRAIN = false;
    bf16_t* O; int ldc; const float* rsp;
    __device__ __forceinline__ void operator()(const f32x4 (&acc)[2][2][4][2], const Unit& u, int wr, int wc, int fr, int fq) const {
        const int row0 = u.pm * BM + wr * 64 + fr, col0 = u.pn * HALF + wc * 32 + 8 * fq;
#pragma unroll
        for (int ai = 0; ai < 2; ++ai)
#pragma unroll
            for (int m = 0; m < 4; ++m) { const int row = row0 + ai * HALF + m * 16; const float s = row_scale<16>(rsp, row, 1.0f / DM);
                float y[8];
#pragma unroll
                for (int n = 0; n < 2; ++n)
#pragma unroll
                    for (int j = 0; j < 4; ++j) y[4 * n + j] = silu_f(acc[ai][0][m][n][j] * s) * (acc[ai][1][m][n][j] * s);
                u32x4 w; w.x = cvt_pk_bf16(y[0], y[1]); w.y = cvt_pk_bf16(y[2], y[3]); w.z = cvt_pk_bf16(y[4], y[5]); w.w = cvt_pk_bf16(y[6], y[7]);
                *(u32x4*)(O + (size_t)row * ldc + col0) = w; }
    }
};
struct EpiResid { static constexpr bool PERM = false, AFTER_DRAIN = false;
    const float* base; float* out; bf16_t* xb; float* rsp; float alpha;
    __device__ __forceinline__ void operator()(const f32x4 (&acc)[2][2][4][2], const Unit& u, int wr, int wc, int fr, int fq) const {
        const int row0 = u.pm * BM + wr * 64 + fr, col0 = u.pn * BM + wc * 32 + 4 * fq;
#pragma unroll
        for (int ai = 0; ai < 2; ++ai)
#pragma unroll
            for (int m = 0; m < 4; ++m) { const int row = row0 + ai * HALF + m * 16; const size_t off = (size_t)row * DM + col0; float ss = 0.f;
#pragma unroll
                for (int bj = 0; bj < 2; ++bj)
#pragma unroll
                    for (int n = 0; n < 2; ++n) { const f32x4 b = *(const f32x4*)(base + off + bj * HALF + n * 16); const f32x4 o = b + acc[ai][bj][m][n] * alpha;
                        *(f32x4*)(out + off + bj * HALF + n * 16) = o; u32x2 w; w.x = cvt_pk_bf16(o[0], o[1]); w.y = cvt_pk_bf16(o[2], o[3]); *(u32x2*)(xb + off + bj * HALF + n * 16) = w;
                        ss += (o[0] * o[0] + o[1] * o[1]) + (o[2] * o[2] + o[3] * o[3]); }
                ss += __shfl_xor(ss, 16); ss += __shfl_xor(ss, 32);
                if (fq == 0) rsp[(size_t)row * 16 + u.pn * 4 + wc] = ss;
                asm volatile("" ::: "memory"); }
    }
};
struct EpiProj { static constexpr bool PERM = true, AFTER_DRAIN = false;
    bf16_t* O; const float* rsp; float* rsq; float* rskv;
    __device__ __forceinline__ void operator()(const f32x4 (&acc)[2][2][4][2], const Unit& u, int wr, int wc, int fr, int fq) const {
        const int row0 = u.pm * BM + wr * 64 + fr, col0 = u.pn * BM + wc * 32 + 8 * fq;
#pragma unroll
        for (int ai = 0; ai < 2; ++ai)
#pragma unroll
            for (int m = 0; m < 4; ++m) { const int row = row0 + ai * HALF + m * 16; const float s = row_scale<16>(rsp, row, 1.0f / DM); float ssb[2];
#pragma unroll
                for (int bj = 0; bj < 2; ++bj) { const float sq = (u.pn < 3 || u.pn == 9 || (u.pn == 10 && bj == 0)) ? s * QSCALE64 : s;
                    const f32x4 v0 = acc[ai][bj][m][0] * sq, v1 = acc[ai][bj][m][1] * sq;
                    u32x4 w; w.x = cvt_pk_bf16(v0[0], v0[1]); w.y = cvt_pk_bf16(v0[2], v0[3]); w.z = cvt_pk_bf16(v1[0], v1[1]); w.w = cvt_pk_bf16(v1[2], v1[3]);
                    *(u32x4*)(O + (size_t)row * PP + col0 + bj * HALF) = w;
                    ssb[bj] = ((v0[0] * v0[0] + v0[1] * v0[1]) + (v0[2] * v0[2] + v0[3] * v0[3])) + ((v1[0] * v1[0] + v1[1] * v1[1]) + (v1[2] * v1[2] + v1[3] * v1[3])); }
                if (u.pn == 14) { float ss = ssb[0] + ssb[1]; ss += __shfl_xor(ss, 16); ss += __shfl_xor(ss, 32); if (fq == 0) rsq[(size_t)row * 4 + wc] = ss; }
                if (u.pn == 13) { float ss = ssb[1]; ss += __shfl_xor(ss, 16); ss += __shfl_xor(ss, 32); if (fq == 0) rskv[(size_t)row * 4 + wc] = ss; } }
    }
};
struct EpiQup { static constexpr bool PERM = false, AFTER_DRAIN = false;
    bf16_t* Q; const float* rsq; const float* cosT; const float* sinT;
    __device__ __forceinline__ void operator()(const f32x4 (&acc)[2][2][4][2], const Unit& u, int wr, int wc, int fr, int fq) const {
        const int row0 = u.pm * BM + wr * 64 + fr;
#pragma unroll
        for (int bj = 0; bj < 2; ++bj) { const int c32 = u.pn * BM + bj * HALF + wc * 32; if (c32 >= 576) continue; const bool rope = (c32 % 96) == 64;
#pragma unroll
            for (int ai = 0; ai < 2; ++ai)
#pragma unroll
                for (int m = 0; m < 4; ++m) { const int row = row0 + ai * HALF + m * 16; const float s = row_scale<4>(rsq, row, 1.0f / 256.0f) * QSCALE96;
                    f32x4 v0 = acc[ai][bj][m][0] * s, v1 = acc[ai][bj][m][1] * s;
                    if (rope) { const int pos = row & (SEQ - 1); const f32x4 cs = *(const f32x4*)(cosT + pos * 16 + 4 * fq), sn = *(const f32x4*)(sinT + pos * 16 + 4 * fq);
                        const f32x4 o0 = v0 * cs - v1 * sn, o1 = v0 * sn + v1 * cs; v0 = o0; v1 = o1; }
                    u32x2 w0, w1; w0.x = cvt_pk_bf16(v0[0], v0[1]); w0.y = cvt_pk_bf16(v0[2], v0[3]); w1.x = cvt_pk_bf16(v1[0], v1[1]); w1.y = cvt_pk_bf16(v1[2], v1[3]);
                    bf16_t* p = Q + (size_t)row * 576 + c32 + 4 * fq; *(u32x2*)p = w0; *(u32x2*)(p + 16) = w1; } }
    }
};
struct EpiKVup { static constexpr bool PERM = true, AFTER_DRAIN = false;
    bf16_t* Kn; bf16_t* Vm; const float* rskv;
    __device__ __forceinline__ void operator()(const f32x4 (&acc)[2][2][4][2], const Unit& u, int wr, int wc, int fr, int fq) const {
        const int row0 = u.pm * BM + wr * 64 + fr;
#pragma unroll
        for (int bj = 0; bj < 2; ++bj) { const int h = 2 * u.pn + bj; bf16_t* dst = (wc < 2 ? Kn + h * 64 + wc * 32 : Vm + h * 64 + (wc - 2) * 32) + 8 * fq;
#pragma unroll
            for (int ai = 0; ai < 2; ++ai)
#pragma unroll
                for (int m = 0; m < 4; ++m) { const int row = row0 + ai * HALF + m * 16; const float s = row_scale<4>(rskv, row, 1.0f / 128.0f);
                    const f32x4 v0 = acc[ai][bj][m][0] * s, v1 = acc[ai][bj][m][1] * s;
                    u32x4 w; w.x = cvt_pk_bf16(v0[0], v0[1]); w.y = cvt_pk_bf16(v0[2], v0[3]); w.z = cvt_pk_bf16(v1[0], v1[1]); w.w = cvt_pk_bf16(v1[2], v1[3]);
                    *(u32x4*)(dst + (size_t)row * 384) = w; } }
    }
};
struct EpiGate { static constexpr bool PERM = true, AFTER_DRAIN = false;
    bf16_t* O; const float* rsp;
    __device__ __forceinline__ void operator()(const f32x4 (&acc)[2][2][4][2], const Unit& u, int wr, int wc, int fr, int fq) const {
        const int row0 = u.pm * BM + wr * 64 + fr, col0 = u.pn * BM + wc * 32 + 8 * fq;
#pragma unroll
        for (int ai = 0; ai < 2; ++ai)
#pragma unroll
            for (int m = 0; m < 4; ++m) { const int row = row0 + ai * HALF + m * 16; const float s = row_scale<16>(rsp, row, 1.0f / DM);
#pragma unroll
                for (int bj = 0; bj < 2; ++bj) { float y[8];
#pragma unroll
                    for (int n = 0; n < 2; ++n)
#pragma unroll
                        for (int j = 0; j < 4; ++j) y[4 * n + j] = sigm_f(acc[ai][bj][m][n][j] * s);
                    u32x4 w; w.x = cvt_pk_bf16(y[0], y[1]); w.y = cvt_pk_bf16(y[2], y[3]); w.z = cvt_pk_bf16(y[4], y[5]); w.w = cvt_pk_bf16(y[6], y[7]);
                    *(u32x4*)(O + (size_t)row * 3072 + col0 + bj * HALF) = w; } }
    }
};
struct EpiMerge { static constexpr bool PERM = true, AFTER_DRAIN = false;
    const bf16_t* G; bf16_t* Mg; int first;
    __device__ __forceinline__ void operator()(const f32x4 (&acc)[2][2][4][2], const Unit& u, int wr, int wc, int fr, int fq) const {
        const int row0 = u.pm * BM + wr * 64 + fr, col0 = u.pn * BM + wc * 32 + 8 * fq;
#pragma unroll
        for (int ai = 0; ai < 2; ++ai)
#pragma unroll
            for (int m = 0; m < 4; ++m) { const int row = row0 + ai * HALF + m * 16;
#pragma unroll
                for (int bj = 0; bj < 2; ++bj) { u32x4 g = *(const u32x4*)(G + (size_t)row * 3072 + col0 + bj * HALF); if (MK_NOGATE) g = (u32x4){0x3f803f80u, 0x3f803f80u, 0x3f803f80u, 0x3f803f80u}; bf16_t* mp = Mg + (size_t)row * DM + col0 + bj * HALF;
                    u32x4 pv = (u32x4){0u, 0u, 0u, 0u}; if (!first) pv = *(const u32x4*)mp;
                    f32x4 a0 = acc[ai][bj][m][0], a1 = acc[ai][bj][m][1]; if (MK_NOACC) { a0 = (f32x4){1.f, 1.f, 1.f, 1.f}; a1 = a0; }
                    u32x4 w;
                    w.x = cvt_pk_bf16(bflo(pv.x) + bflo(g.x) * a0[0], bfhi(pv.x) + bfhi(g.x) * a0[1]);
                    w.y = cvt_pk_bf16(bflo(pv.y) + bflo(g.y) * a0[2], bfhi(pv.y) + bfhi(g.y) * a0[3]);
                    w.z = cvt_pk_bf16(bflo(pv.z) + bflo(g.z) * a1[0], bfhi(pv.z) + bfhi(g.z) * a1[1]);
                    w.w = cvt_pk_bf16(bflo(pv.w) + bflo(g.w) * a1[2], bfhi(pv.w) + bfhi(g.w) * a1[3]);
                    *(u32x4*)mp = w; } }
    }
};

template <class Epi, class Sched, bool ALIGN_EPI = false>
__device__ __forceinline__ void gemm_phase(PG8_LAS unsigned char* lds, const Gemm g, const Sched& S, const Epi& E, int tid_in) {
    int tid_ = tid_in; asm volatile("" : "+v"(tid_));
    const int tid = tid_, wid = __builtin_amdgcn_readfirstlane(tid >> 6), lane = tid & 63, wr = wid >> 2, wc = wid & 3, fr = lane & 15, fq = lane >> 4;
    int K = g.K; asm volatile("" : "+s"(K)); const int nt = K / BK;
    unsigned voffA[2], voffB[2];
#pragma unroll
    for (int i = 0; i < 2; ++i) { int R, C; stage_rc(tid * 16 + i * 8192, R, C); const int Rb = Epi::PERM ? ((R & ~31) + perm32(R & 31)) : R;
        voffA[i] = (unsigned)(R * g.lda + C) * 2u; voffB[i] = (unsigned)(Rb * g.ldb + C) * 2u; }
    const size_t kstep = (size_t)(BK * 2);
    const size_t hstepA = (size_t)HALF * g.lda * 2, hstepB = (size_t)HALF * g.ldb * 2;
    const size_t tstepA = 2 * hstepA, tstepB = 2 * hstepB;
    const unsigned ldsw = (unsigned)wid * 1024u;
    const int aoff = lds_byte(wr * 64 + fr, fq * 8), boff = lds_byte(wc * 32 + fr, fq * 8);
#define PG8_SA(b, h) (((b) * 2 + (h)) * HTB)
#define PG8_SB(b, h) ((4 + (b) * 2 + (h)) * HTB)
#define PG8_STAGE(bufoff, gbase, voff) do { _Pragma("unroll") for (int _i = 0; _i < 2; ++_i) \
        __builtin_amdgcn_global_load_lds((const unsigned*)((const char*)(gbase) + (voff)[_i]), (PG8_LAS unsigned*)(lds + (bufoff) + ldsw + _i * 8192), 16, 0, 0); } while (0)
#define PG8_LDA(dst, b, h) do { _Pragma("unroll") for (int m = 0; m < 4; ++m) _Pragma("unroll") for (int k = 0; k < 2; ++k) dst[m][k] = *(const PG8_LAS bf16x8*)(lds + PG8_SA(b, h) + aoff + m * 2048 + k * 1024); } while (0)
#define PG8_LDB(dst, b, h) do { _Pragma("unroll") for (int n = 0; n < 2; ++n) _Pragma("unroll") for (int k = 0; k < 2; ++k) dst[n][k] = *(const PG8_LAS bf16x8*)(lds + PG8_SB(b, h) + boff + n * 2048 + k * 1024); } while (0)
#define PG8_MMA(ai, bj, At, Bt) do { __builtin_amdgcn_s_setprio(1); _Pragma("unroll") for (int m = 0; m < 4; ++m) _Pragma("unroll") for (int n = 0; n < 2; ++n) _Pragma("unroll") for (int k = 0; k < 2; ++k) \
        acc[ai][bj][m][n] = __builtin_amdgcn_mfma_f32_16x16x32_bf16(Bt[n][k], At[m][k], acc[ai][bj][m][n], 0, 0, 0); __builtin_amdgcn_s_setprio(0); } while (0)
#define PG8_WAIT_V(n) asm volatile("s_waitcnt vmcnt(" #n ")" ::: "memory")
#define PG8_WAIT_L(n) asm volatile("s_waitcnt lgkmcnt(" #n ")" ::: "memory")
#define PG8_BAR __builtin_amdgcn_s_barrier()
#define PG8_SCHED __builtin_amdgcn_sched_barrier(0)
    Unit cur, nxt; int ui = 0;
    if (!S.next(0, cur)) return;
    f32x4 acc[2][2][4][2];
#pragma unroll
    for (int a = 0; a < 2; ++a)
#pragma unroll
        for (int b = 0; b < 2; ++b)
#pragma unroll
            for (int m = 0; m < 4; ++m)
#pragma unroll
                for (int n = 0; n < 2; ++n) acc[a][b][m][n] = (f32x4){0.f, 0.f, 0.f, 0.f};
    bf16x8 At[4][2], B0[2][2], B1[2][2];
    const char* cA = (const char*)g.A + (size_t)cur.pm * tstepA; const char* cB = (const char*)g.Bt + (size_t)cur.pn * tstepB;
    S.a_ready(cur);
    PG8_STAGE(PG8_SB(0, 0), cB, voffB); PG8_STAGE(PG8_SB(0, 1), cB + hstepB, voffB); PG8_STAGE(PG8_SA(0, 0), cA, voffA); PG8_STAGE(PG8_SA(0, 1), cA + hstepA, voffA);
    if (wr == 1) PG8_BAR;
    PG8_WAIT_V(2); PG8_BAR;
    PG8_STAGE(PG8_SB(1, 0), cB + kstep, voffB); PG8_STAGE(PG8_SA(1, 0), cA + kstep, voffA); PG8_STAGE(PG8_SB(1, 1), cB + hstepB + kstep, voffB);
    PG8_WAIT_V(6); PG8_BAR;
    for (;;) {
        const bool has_next = S.next(ui + 1, nxt);
        const char* nA = has_next ? (const char*)g.A + (size_t)nxt.pm * tstepA : cA; const char* nB = has_next ? (const char*)g.Bt + (size_t)nxt.pn * tstepB : cB;
        for (int t = 0; t < nt; t += 2) {
            const bool last = (t == nt - 2);
            const char* a1 = cA + (size_t)(t + 1) * kstep;
            const char* a2 = last ? nA : cA + (size_t)(t + 2) * kstep; const char* b2 = last ? nB : cB + (size_t)(t + 2) * kstep;
            const char* a3 = a2 + kstep; const char* b3 = b2 + kstep;
            if (last && has_next) S.a_ready(nxt);
            PG8_LDB(B0, 0, 0); PG8_LDB(B1, 0, 1); PG8_SCHED; PG8_LDA(At, 0, 0); PG8_STAGE(PG8_SA(1, 1), a1 + hstepA, voffA);
            PG8_WAIT_V(8); PG8_WAIT_L(0); PG8_BAR; PG8_MMA(0, 0, At, B0); PG8_MMA(0, 1, At, B1); PG8_BAR; PG8_SCHED;
            PG8_LDA(At, 0, 1); PG8_STAGE(PG8_SB(0, 0), b2, voffB); PG8_STAGE(PG8_SB(0, 1), b2 + hstepB, voffB); PG8_STAGE(PG8_SA(0, 0), a2, voffA);
            PG8_WAIT_V(8); PG8_WAIT_L(0); PG8_BAR; PG8_MMA(1, 0, At, B0); PG8_MMA(1, 1, At, B1); PG8_BAR; PG8_SCHED;
            PG8_LDB(B0, 1, 0); PG8_LDB(B1, 1, 1); PG8_SCHED; PG8_LDA(At, 1, 0); PG8_STAGE(PG8_SA(0, 1), a2 + hstepA, voffA);
            PG8_WAIT_V(8); PG8_WAIT_L(0); PG8_BAR; PG8_MMA(0, 0, At, B0); PG8_MMA(0, 1, At, B1); PG8_BAR; PG8_SCHED;
            PG8_LDA(At, 1, 1); PG8_STAGE(PG8_SB(1, 0), b3, voffB); PG8_STAGE(PG8_SB(1, 1), b3 + hstepB, voffB); PG8_STAGE(PG8_SA(1, 0), a3, voffA);
            PG8_WAIT_V(8); PG8_WAIT_L(0); PG8_BAR; PG8_MMA(1, 0, At, B0); PG8_MMA(1, 1, At, B1); PG8_BAR; PG8_SCHED;
        }
        if constexpr (ALIGN_EPI) { if (wr == 0) PG8_BAR; }
        E(acc, cur, wr, wc, fr, fq); S.done(cur);
        if (!has_next) break;
#pragma unroll
        for (int a = 0; a < 2; ++a)
#pragma unroll
            for (int b = 0; b < 2; ++b)
#pragma unroll
                for (int m = 0; m < 4; ++m)
#pragma unroll
                    for (int n = 0; n < 2; ++n) acc[a][b][m][n] = (f32x4){0.f, 0.f, 0.f, 0.f};
        cur = nxt; cA = nA; cB = nB; ++ui;
        if constexpr (ALIGN_EPI) { if (wr == 1) PG8_BAR; }
    }
    PG8_WAIT_V(0);
    if constexpr (!ALIGN_EPI) { if (wr == 0) PG8_BAR; }
    PG8_BAR;
#undef PG8_SA
#undef PG8_SB
#undef PG8_STAGE
#undef PG8_LDA
#undef PG8_LDB
#undef PG8_MMA
#undef PG8_WAIT_V
#undef PG8_WAIT_L
#undef PG8_BAR
#undef PG8_SCHED
}
}

constexpr int NWAVES = 8;
constexpr size_t MiB = 1u << 20;
constexpr size_t WS_CTL = 0, CTL_ZERO_BYTES = 1 * MiB;
constexpr size_t WS_ROPE = 1 * MiB;
constexpr size_t WS_KMEAN = WS_ROPE + 512 * 1024;
constexpr size_t WS_RS = 2 * MiB;
constexpr size_t WS_RSQ = 4 * MiB;
constexpr size_t WS_RSKV = WS_RSQ + 512 * 1024;
constexpr size_t WS_W = 5 * MiB;
constexpr size_t W_GU1 = 0, W_D1 = W_GU1 + (size_t)5632 * 1024 * 2, W_IN = W_D1 + (size_t)1024 * 2816 * 2, W_G = W_IN + (size_t)4096 * 1024 * 2,
                 W_UQ = W_G + (size_t)3072 * 1024 * 2, W_UKV = W_UQ + (size_t)768 * 256 * 2, W_BR = W_UKV + (size_t)768 * 256 * 2, W_OUT = W_BR + (size_t)1024 * 1024 * 2,
                 W_GU2 = W_OUT + (size_t)1024 * 1024 * 2, W_D2 = W_GU2 + (size_t)5632 * 1024 * 2, W_END = W_D2 + (size_t)1024 * 2816 * 2;
static_assert(W_END <= 52 * MiB, "weights region");
constexpr size_t WS_XB = 57 * MiB;
constexpr size_t WS_PROJ = 121 * MiB;
constexpr size_t WS_QM = 377 * MiB;
constexpr size_t WS_KN = 413 * MiB;
constexpr size_t WS_VM = 437 * MiB;
constexpr size_t WS_KR = 461 * MiB;
constexpr size_t WS_MG = WS_QM;
constexpr size_t WS_AO = 463 * MiB;
constexpr size_t WS_LSE = 527 * MiB;
constexpr size_t WS_END = 529 * MiB;
constexpr int CW_BAR = 4096;
constexpr int CW_QUEUE = 8192;

constexpr int RING_OFF = 0, RING_BYTES = 131072;
constexpr int LDSCTL_OFF = RING_BYTES, MISC_OFF = LDSCTL_OFF + 320;
constexpr int LDS_BYTES = 147456;

#define GAS __attribute__((address_space(1)))
#define LAS __attribute__((address_space(3)))
typedef unsigned short bf16;
typedef unsigned v4u __attribute__((ext_vector_type(4)));
typedef unsigned v2u __attribute__((ext_vector_type(2)));
typedef float f32x4 __attribute__((ext_vector_type(4)));
typedef GAS unsigned gu32;
#define RLX_AGENT __ATOMIC_RELAXED, __HIP_MEMORY_SCOPE_AGENT
#define LDS_WAIT() asm volatile("s_waitcnt lgkmcnt(0)" ::: "memory")
__device__ __forceinline__ unsigned f2bf(float f) { unsigned u = __builtin_bit_cast(unsigned, f); return (u + 0x7fffu + ((u >> 16) & 1u)) >> 16; }
__device__ __forceinline__ unsigned pk2(float lo, float hi) { return f2bf(lo) | (f2bf(hi) << 16); }
__device__ __forceinline__ float bflo(unsigned w) { return __uint_as_float(w << 16); }
__device__ __forceinline__ float bfhi(unsigned w) { return __uint_as_float(w & 0xffff0000u); }

#define XB_TMO      128
#define XB_XCNT(j)  (256  + 64 * (j))
#define XB_XSUB(j)  (1280 + 64 * (j))
#define XB_XGEN(j)  (2304 + 64 * (j))
#define XB_TOP      3328
#define XB_TOPGEN   3392
#define XCD_BAR_WORDS 3456
#define XB_SPIN_CAP (1u << 20)

__device__ __forceinline__ unsigned xb_ld(unsigned* p)              { return __hip_atomic_load(p, __ATOMIC_RELAXED, __HIP_MEMORY_SCOPE_AGENT); }
__device__ __forceinline__ unsigned xb_add(unsigned* p, unsigned v) { return __hip_atomic_fetch_add(p, v, __ATOMIC_RELAXED, __HIP_MEMORY_SCOPE_AGENT); }
__device__ __forceinline__ unsigned xb_xcc_id() { return (unsigned)__builtin_amdgcn_s_getreg((3 << 11) | 20) & 0xFu; }
#define XB_SPIN(cond, bar) do { unsigned _sp = 0; while (cond) { __builtin_amdgcn_s_sleep(1); \
    if ((++_sp & 255u) == 0u) { if (xb_ld(&(bar)[XB_TMO])) break; if (_sp > XB_SPIN_CAP) { atomicAdd(&(bar)[XB_TMO], 1u); break; } } } } while (0)

struct XcdBarrier { unsigned* bar; unsigned x; volatile LAS unsigned* st; };

__device__ __forceinline__ XcdBarrier xcd_barrier_post(unsigned* bar, volatile LAS unsigned* st) {
    XcdBarrier b; b.bar = bar; b.x = xb_xcc_id(); b.st = st;
    if (threadIdx.x == 0) (void)xb_add(&bar[XB_XCNT(b.x)], 1u);
    return b;
}
__device__ __forceinline__ void xcd_barrier_complete(unsigned* bar, unsigned x, unsigned& nloc, unsigned& nx) {
    const unsigned G = gridDim.x * gridDim.y * gridDim.z;
    unsigned sum, cnt, mine, sp = 0u;
    for (;;) {
        sum = 0u; cnt = 0u; mine = 0u;
#pragma unroll
        for (unsigned j = 0; j < 16; ++j) { const unsigned c = xb_ld(&bar[XB_XCNT(j)]); sum += c; cnt += (c > 0u) ? 1u : 0u; mine = (j == x) ? c : mine; }
        if (sum == G) break;
        __builtin_amdgcn_s_sleep(1);
        if ((++sp & 255u) == 0u) { if (xb_ld(&bar[XB_TMO])) break; if (sp > XB_SPIN_CAP) { atomicAdd(&bar[XB_TMO], 1u); break; } }
    }
    nloc = mine > 0u ? mine : 1u; nx = cnt > 0u ? cnt : 1u;
}
__device__ __forceinline__ void xcd_barrier(const XcdBarrier& b, bool leader) {
    asm volatile("s_waitcnt vmcnt(0)" ::: "memory");
    __syncthreads();
    if (leader) {
        unsigned* bar = b.bar;
        __builtin_amdgcn_s_waitcnt(0);
        unsigned nloc = b.st[0], nx = b.st[1];
        if (nloc == 0u) { xcd_barrier_complete(bar, b.x, nloc, nx); b.st[0] = nloc; b.st[1] = nx; }
        const unsigned old = xb_add(&bar[XB_XSUB(b.x)], 1u);
        const unsigned gen = old / nloc;
        if (old + 1u == (gen + 1u) * nloc) {
            __builtin_amdgcn_fence(__ATOMIC_RELEASE, "agent");
            asm volatile("s_waitcnt vmcnt(0)" ::: "memory");
            const unsigned og = xb_add(&bar[XB_TOP], 1u);
            const unsigned tg = og / nx;
            if (og + 1u == (tg + 1u) * nx) xb_add(&bar[XB_TOPGEN], 1u);
            else XB_SPIN(xb_ld(&bar[XB_TOPGEN]) == tg, bar);
            __builtin_amdgcn_fence(__ATOMIC_ACQUIRE, "agent");
            xb_add(&bar[XB_XGEN(b.x)], 1u);
            asm volatile("s_waitcnt vmcnt(0)" ::: "memory");
        } else {
            XB_SPIN(xb_ld(&bar[XB_XGEN(b.x)]) == gen, bar);
            __builtin_amdgcn_fence(__ATOMIC_ACQUIRE, "agent");
            asm volatile("s_waitcnt vmcnt(0)" ::: "memory");
        }
    }
    __syncthreads();
}

__device__ __forceinline__ float wave_sum(float v) {
#pragma unroll
    for (int o = 1; o < 64; o <<= 1) v += __shfl_xor(v, o);
    return v;
}
__device__ __forceinline__ void cvt_item(const float* W, int N, const float* gain, bf16* WT, int dpitch, int dkoff, int k0, int n0, int drow0, LAS float* scr, int lane) {
#pragma unroll 8
    for (int i = 0; i < 32; ++i) { const int kk = 2 * i + (lane >> 5); float v = W[(size_t)(k0 + kk) * N + n0 + (lane & 31)]; if (gain) v *= gain[k0 + kk]; scr[kk * 33 + (lane & 31)] = v; }
    LDS_WAIT(); asm volatile("" ::: "memory");
    const int c = lane & 7;
#pragma unroll
    for (int j = 0; j < 4; ++j) { const int n = (lane >> 3) + 8 * j; const LAS float* s = scr + (8 * c) * 33 + n;
        v4u o; o.x = pk2(s[0 * 33], s[1 * 33]); o.y = pk2(s[2 * 33], s[3 * 33]); o.z = pk2(s[4 * 33], s[5 * 33]); o.w = pk2(s[6 * 33], s[7 * 33]);
        *(GAS v4u*)(WT + (size_t)(drow0 + n) * dpitch + dkoff + k0 + 8 * c) = o; }
    LDS_WAIT(); asm volatile("" ::: "memory");
}
template <class RowMap>
__device__ __forceinline__ void cvt_matrix(const float* W, int K, int N, const float* gain, bf16* WT, int dpitch, int dkoff, const RowMap& RM, LAS float* scr, int gw, int NGW, int lane, int& base) {
    const int nblk = N / 32, nit = (K / 64) * nblk;
    int first = gw - (base % NGW); if (first < 0) first += NGW;
    for (int it = first; it < nit; it += NGW) { const int kb = it / nblk, nb = it % nblk; cvt_item(W, N, gain, WT, dpitch, dkoff, 64 * kb, 32 * nb, RM(32 * nb), scr, lane); }
    base += nit;
}
struct RmId { __device__ __forceinline__ int operator()(int n0) const { return n0; } };
struct RmGU { int add; __device__ __forceinline__ int operator()(int n0) const { return 256 * (n0 / 128) + (n0 % 128) + add; } };
struct RmIn { __device__ __forceinline__ int operator()(int n0) const {
    if (n0 < 256) return PC_CQ + n0; if (n0 < 384) return PC_CKV + (n0 - 256); if (n0 < 416) return PC_KR + (n0 - 384); if (n0 < 1568) return PC_MQ + (n0 - 416); if (n0 < 3872) return PC_DQ + (n0 - 1568);
    return 4096 + (n0 - 3872); } };
static_assert(W_G == W_IN + (size_t)4096 * 1024 * 2, "gate weights follow w_in");

__device__ __forceinline__ int OPQ_S(int v) { asm volatile("" : "+s"(v)); return v; }
struct Frame {
    LAS unsigned char* lds; volatile LAS unsigned* MISC; gu32* ctl;
};

__device__ __forceinline__ void ld8(const bf16* p, float* f) { const v4u w = *(const v4u*)p; f[0] = bflo(w.x); f[1] = bfhi(w.x); f[2] = bflo(w.y); f[3] = bfhi(w.y); f[4] = bflo(w.z); f[5] = bfhi(w.z); f[6] = bflo(w.w); f[7] = bfhi(w.w); }
__device__ __forceinline__ float dot8(const bf16* p, const float* q) { const v4u w = *(const v4u*)p;
    return ((q[0] * bflo(w.x) + q[1] * bfhi(w.x)) + (q[2] * bflo(w.y) + q[3] * bfhi(w.y))) + ((q[4] * bflo(w.z) + q[5] * bfhi(w.z)) + (q[6] * bflo(w.w) + q[7] * bfhi(w.w))); }
__device__ __forceinline__ void axpy8(const bf16* p, float a, float c, float* o) { const v4u w = *(const v4u*)p;
    o[0] = o[0] * c + a * bflo(w.x); o[1] = o[1] * c + a * bfhi(w.x); o[2] = o[2] * c + a * bflo(w.y); o[3] = o[3] * c + a * bfhi(w.y);
    o[4] = o[4] * c + a * bflo(w.z); o[5] = o[5] * c + a * bfhi(w.z); o[6] = o[6] * c + a * bflo(w.w); o[7] = o[7] * c + a * bfhi(w.w); }
__device__ __forceinline__ void st8(bf16* p, const float* o, float s) { v4u w; w.x = pk2(o[0] * s, o[1] * s); w.y = pk2(o[2] * s, o[3] * s); w.z = pk2(o[4] * s, o[5] * s); w.w = pk2(o[6] * s, o[7] * s); *(v4u*)p = w; }

__device__ __forceinline__ void mla_naive_chunk(const bf16* Qm, const bf16* Kn, const bf16* KR, const bf16* Vm, bf16* AO, int b, int h, int chunk, int lane) {
    const int t = chunk * 64 + lane; const size_t rowb = (size_t)b * SEQ;
    float q[96];
#pragma unroll
    for (int c = 0; c < 12; ++c) ld8(Qm + (rowb + t) * 576 + h * 96 + 8 * c, q + 8 * c);
    float m = -1e30f, l = 0.f; float o[64];
#pragma unroll
    for (int d = 0; d < 64; ++d) o[d] = 0.f;
    const int jmax = chunk * 64 + 63;
    for (int j = 0; j <= jmax; ++j) {
        const bf16* kp = Kn + (rowb + j) * 384 + h * 64; const bf16* rp = KR + (rowb + j) * 32; const bf16* vp = Vm + (rowb + j) * 384 + h * 64;
        float s = 0.f;
#pragma unroll
        for (int c = 0; c < 8; ++c) s += dot8(kp + 8 * c, q + 8 * c);
#pragma unroll
        for (int c = 0; c < 4; ++c) s += dot8(rp + 8 * c, q + 64 + 8 * c);
        if (j <= t) { const float mn = fmaxf(m, s), corr = exp2f(m - mn), p = exp2f(s - mn); l = l * corr + p; m = mn;
#pragma unroll
            for (int c = 0; c < 8; ++c) axpy8(vp + 8 * c, p, corr, o + 8 * c); }
    }
    const float inv = 1.0f / l;
#pragma unroll
    for (int c = 0; c < 8; ++c) st8(AO + (rowb + t) * DM + h * 64 + 8 * c, o + 8 * c, inv);
}

__device__ __forceinline__ void moba_naive_chunk(const bf16* proj, const float* kmean, bf16* AO, int b, int h, int chunk, int lane) {
    const int t = chunk * 64 + lane; const size_t rowb = (size_t)b * SEQ; const int b_own = chunk >> 2;
    float q[64];
#pragma unroll
    for (int c = 0; c < 8; ++c) ld8(proj + (rowb + t) * PP + PC_MQ + h * 64 + 8 * c, q + 8 * c);
    const float slope = exp2f(-8.0f * (float)(12 + h + 1) / 18.0f) * LOG2E;
    float v1 = -3e38f, v2 = -3e38f, v3 = -3e38f; int i1 = -1, i2 = -1, i3 = -1;
    for (int n = 0; n < b_own; ++n) { const float* km = kmean + ((size_t)(b * 6 + h) * 16 + n) * 64; float g = 0.f;
#pragma unroll
        for (int c = 0; c < 16; ++c) { const f32x4 k4 = *(const f32x4*)(km + 4 * c); g += (q[4 * c] * k4[0] + q[4 * c + 1] * k4[1]) + (q[4 * c + 2] * k4[2] + q[4 * c + 3] * k4[3]); }
        if (g > v1) { v3 = v2; i3 = i2; v2 = v1; i2 = i1; v1 = g; i1 = n; } else if (g > v2) { v3 = v2; i3 = i2; v2 = g; i2 = n; } else if (g > v3) { v3 = g; i3 = n; } }
    unsigned sel = 0u; if (i1 >= 0) sel |= 1u << i1; if (i2 >= 0) sel |= 1u << i2; if (i3 >= 0) sel |= 1u << i3;
    float m = -1e30f, l = 0.f; float o[64];
#pragma unroll
    for (int d = 0; d < 64; ++d) o[d] = 0.f;
    for (int n = 0; n < b_own; ++n) { const bool mine = (sel >> n) & 1u; if (!__any(mine)) continue;
        for (int kk = 0; kk < 256; ++kk) { const int kpos = n * 256 + kk; const bf16* kp = proj + (rowb + kpos) * PP + PC_MK + h * 64; const bf16* vp = proj + (rowb + kpos) * PP + PC_MV + h * 64;
            float s = 0.f;
#pragma unroll
            for (int c = 0; c < 8; ++c) s += dot8(kp + 8 * c, q + 8 * c);
            s = s - slope * (float)(t - kpos);
            if (mine) { const float mn = fmaxf(m, s), corr = exp2f(m - mn), p = exp2f(s - mn); l = l * corr + p; m = mn;
#pragma unroll
                for (int c = 0; c < 8; ++c) axpy8(vp + 8 * c, p, corr, o + 8 * c); } } }
    for (int kpos = b_own * 256; kpos <= chunk * 64 + 63; ++kpos) { const bf16* kp = proj + (rowb + kpos) * PP + PC_MK + h * 64; const bf16* vp = proj + (rowb + kpos) * PP + PC_MV + h * 64;
        float s = 0.f;
#pragma unroll
        for (int c = 0; c < 8; ++c) s += dot8(kp + 8 * c, q + 8 * c);
        s = s - slope * (float)(t - kpos);
        if (kpos <= t) { const float mn = fmaxf(m, s), corr = exp2f(m - mn), p = exp2f(s - mn); l = l * corr + p; m = mn;
#pragma unroll
            for (int c = 0; c < 8; ++c) axpy8(vp + 8 * c, p, corr, o + 8 * c); } }
    const float inv = 1.0f / l;
#pragma unroll
    for (int c = 0; c < 8; ++c) st8(AO + (rowb + t) * DM + 384 + h * 64 + 8 * c, o + 8 * c, inv);
}

__device__ __forceinline__ void dil_naive_thread(const bf16* proj, bf16* AO, int b, int hg, int t) {
    const size_t rowb = (size_t)b * SEQ;
    float m = -1e30f, l = 0.f; float o[64];
#pragma unroll
    for (int d = 0; d < 64; ++d) o[d] = 0.f;
    for (int g = 0; g < 3; ++g) { const int h = g * 4 + hg, dil = (g == 0) ? 1 : (g == 1) ? 4 : 16; const float slope = exp2f(-8.0f * (float)(h + 1) / 18.0f) * LOG2E;
        float q[64];
#pragma unroll
        for (int c = 0; c < 8; ++c) ld8(proj + (rowb + t) * PP + PC_DQ + h * 64 + 8 * c, q + 8 * c);
        for (int j = 0; j <= 128; ++j) { const int kpos = t - j * dil;
            if (kpos >= 0) { const bf16* kp = proj + (rowb + kpos) * PP + PC_DK + h * 64; const bf16* vp = proj + (rowb + kpos) * PP + PC_DV + h * 64;
                float s = 0.f;
#pragma unroll
                for (int c = 0; c < 8; ++c) s += dot8(kp + 8 * c, q + 8 * c);
                s = s - slope * (float)(j * dil);
                const float mn = fmaxf(m, s), corr = exp2f(m - mn), p = exp2f(s - mn); l = l * corr + p; m = mn;
#pragma unroll
                for (int c = 0; c < 8; ++c) axpy8(vp + 8 * c, p, corr, o + 8 * c); } } }
    const float inv = 1.0f / l;
#pragma unroll
    for (int c = 0; c < 8; ++c) st8(AO + (rowb + t) * DM + 768 + hg * 64 + 8 * c, o + 8 * c, inv);
}

namespace fa {
typedef float f32x16 __attribute__((ext_vector_type(16)));
typedef short bf16x8 __attribute__((ext_vector_type(8)));
typedef short s16x4 __attribute__((ext_vector_type(4)));
#define FLAS __attribute__((address_space(3)))
constexpr float NEG = -1.0e30f, POS = 1.0e30f;
__device__ __forceinline__ int crow(int r, int hi) { return (r & 3) + 8 * (r >> 2) + 4 * hi; }
__device__ __forceinline__ float xmax(float v) { auto rr = __builtin_amdgcn_permlane32_swap(__float_as_uint(v), __float_as_uint(v), false, false); return fmaxf(__uint_as_float(rr[0]), __uint_as_float(rr[1])); }
__device__ __forceinline__ float xsum(float v) { auto rr = __builtin_amdgcn_permlane32_swap(__float_as_uint(v), __float_as_uint(v), false, false); return __uint_as_float(rr[0]) + __uint_as_float(rr[1]); }
__device__ __forceinline__ float xother(float v, int hi) { auto rr = __builtin_amdgcn_permlane32_swap(__float_as_uint(v), __float_as_uint(v), false, false); return hi ? __uint_as_float(rr[0]) : __uint_as_float(rr[1]); }
__device__ __forceinline__ float max16(const f32x16& a) { float x = fmaxf(fmaxf(a[0], a[1]), fmaxf(a[2], a[3])), y = fmaxf(fmaxf(a[4], a[5]), fmaxf(a[6], a[7])), z = fmaxf(fmaxf(a[8], a[9]), fmaxf(a[10], a[11])), w = fmaxf(fmaxf(a[12], a[13]), fmaxf(a[14], a[15])); return fmaxf(fmaxf(x, y), fmaxf(z, w)); }
__device__ __forceinline__ bf16x8 pack8(const f32x16& p, int s8) {
    v4u w; w.x = pg8::cvt_pk_bf16(p[s8 + 0], p[s8 + 1]); w.y = pg8::cvt_pk_bf16(p[s8 + 2], p[s8 + 3]); w.z = pg8::cvt_pk_bf16(p[s8 + 4], p[s8 + 5]); w.w = pg8::cvt_pk_bf16(p[s8 + 6], p[s8 + 7]);
    return __builtin_bit_cast(bf16x8, w); }
#define FA_MFMA(a, b, c) __builtin_amdgcn_mfma_f32_32x32x16_bf16((a), (b), (c), 0, 0, 0)
template <int DK> __device__ __forceinline__ f32x16 qk_half(const FLAS char* krow, int hi, const bf16x8* qf, const f32x16& c) {
    f32x16 s = c;
#pragma unroll
    for (int d0 = 0; d0 < DK / 16; ++d0) { const bf16x8 kf = *(const FLAS bf16x8*)(krow + d0 * 32 + hi * 16); s = FA_MFMA(kf, qf[d0], s); }
    return s; }
__device__ __forceinline__ void pv_half(f32x16& o0, f32x16& o1, const FLAS char* vrow, int VP, int hi, const f32x16& p) {
#pragma unroll
    for (int s = 0; s < 2; ++s) { const bf16x8 pf = pack8(p, 8 * s);
        const FLAS char* v0 = vrow + (16 * s + 4 * hi) * 2; const FLAS char* v1 = v0 + 32 * VP;
        const s16x4 a0 = *(const FLAS s16x4*)v0, a1 = *(const FLAS s16x4*)(v0 + 16), b0 = *(const FLAS s16x4*)v1, b1 = *(const FLAS s16x4*)(v1 + 16);
        o0 = FA_MFMA(((bf16x8){a0[0], a0[1], a0[2], a0[3], a1[0], a1[1], a1[2], a1[3]}), pf, o0);
        o1 = FA_MFMA(((bf16x8){b0[0], b0[1], b0[2], b0[3], b1[0], b1[1], b1[2], b1[3]}), pf, o1); }
}
__device__ __forceinline__ void store_o(bf16* orow, const f32x16& o0, const f32x16& o1, float inv, int hi) {
#pragma unroll
    for (int g = 0; g < 4; ++g) { v2u w0, w1;
        w0.x = pg8::cvt_pk_bf16(o0[4 * g] * inv, o0[4 * g + 1] * inv); w0.y = pg8::cvt_pk_bf16(o0[4 * g + 2] * inv, o0[4 * g + 3] * inv);
        w1.x = pg8::cvt_pk_bf16(o1[4 * g] * inv, o1[4 * g + 1] * inv); w1.y = pg8::cvt_pk_bf16(o1[4 * g + 2] * inv, o1[4 * g + 3] * inv);
        *(v2u*)(orow + 8 * g + 4 * hi) = w0; *(v2u*)(orow + 32 + 8 * g + 4 * hi) = w1; }
}

template <int DK, bool MOBA>
__device__ __forceinline__ void flash_unit(FLAS char* lds, int tid, int b, int qb,
        const bf16* Qh, int qpitch, const bf16* Kh, int kpitch, const bf16* KRb, const bf16* Vh, int vpitch, bf16* Oh,
        const bf16* kmh, const bf16* kml, float slope2) {
    constexpr int KP = DK * 2 + 16, VP = 136, KBUF = 64 * KP, VBUF = 64 * VP;
    const int lane = tid & 63, w = __builtin_amdgcn_readfirstlane(tid >> 6), r32 = lane & 31, hi = lane >> 5;
    const size_t rowb = (size_t)b * SEQ; const int q0 = qb * 256;
    bf16x8 qf[DK / 16];
    { const bf16* qp = Qh + (rowb + q0 + 32 * w + r32) * qpitch + 8 * hi;
#pragma unroll
      for (int d0 = 0; d0 < DK / 16; ++d0) qf[d0] = *(const bf16x8*)(qp + 16 * d0); }
    unsigned sel = 0u;
    f32x16 cinit;
#pragma unroll
    for (int r = 0; r < 16; ++r) cinit[r] = 0.f;
    if constexpr (MOBA) {
        f32x16 ga = cinit;
#pragma unroll
        for (int d0 = 0; d0 < 4; ++d0) { const bf16x8 ah = *(const bf16x8*)(kmh + (r32 & 15) * 64 + 16 * d0 + 8 * hi), al = *(const bf16x8*)(kml + (r32 & 15) * 64 + 16 * d0 + 8 * hi);
            ga = FA_MFMA(ah, qf[d0], ga); ga = FA_MFMA(al, qf[d0], ga); }
        float g[16];
#pragma unroll
        for (int i = 0; i < 8; ++i) { const float mine = ga[i], oth = xother(mine, hi); const float lo_ = hi ? oth : mine, hi_ = hi ? mine : oth;
            g[(i & 3) + 8 * (i >> 2)] = lo_; g[(i & 3) + 8 * (i >> 2) + 4] = hi_; }
        float v1 = -3e38f, v2 = -3e38f, v3 = -3e38f; int i1 = -1, i2 = -1, i3 = -1;
#pragma unroll
        for (int n = 0; n < 16; ++n) if (n < qb) { const float gv = g[n];
            if (gv > v1) { v3 = v2; i3 = i2; v2 = v1; i2 = i1; v1 = gv; i1 = n; } else if (gv > v2) { v3 = v2; i3 = i2; v2 = gv; i2 = n; } else if (gv > v3) { v3 = gv; i3 = n; } }
        if (i1 >= 0) sel |= 1u << i1; if (i2 >= 0) sel |= 1u << i2; if (i3 >= 0) sel |= 1u << i3;
#pragma unroll
        for (int r = 0; r < 16; ++r) cinit[r] = slope2 * (float)crow(r, hi);
    }
    const float c32 = MOBA ? 32.f * slope2 : 0.f;
    const int kkey = tid >> 3, kch = tid & 7, rkey = tid >> 2, rch = tid & 3;
    const bf16* ksrc = Kh + (rowb + kkey) * kpitch + kch * 8; const bf16* rsrc = (DK == 96) ? KRb + (rowb + rkey) * 32 + rch * 8 : nullptr; const bf16* vsrc = Vh + (rowb + lane) * vpitch + w * 8;
    FLAS char* kdst = lds + kkey * KP + kch * 16; FLAS char* rdst = lds + rkey * KP + 128 + rch * 16; FLAS char* vdst = lds + 2 * KBUF + (8 * w) * VP + lane * 2;
    v4u kreg, rreg, vreg; rreg = (v4u){0u, 0u, 0u, 0u};
    const int NT = 4 * (qb + 1);
#define FA_LOAD(t) do { kreg = *(const v4u*)(ksrc + (size_t)(t) * 64 * kpitch); if (DK == 96 && tid < 256) rreg = *(const v4u*)(rsrc + (size_t)(t) * 64 * 32); vreg = *(const v4u*)(vsrc + (size_t)(t) * 64 * vpitch); } while (0)
#define FA_STORE(buf) do { *(FLAS v4u*)(kdst + (buf) * KBUF) = kreg; if (DK == 96 && tid < 256) *(FLAS v4u*)(rdst + (buf) * KBUF) = rreg; \
        FLAS char* vd_ = vdst + (buf) * VBUF; \
        *(FLAS unsigned short*)(vd_ + 0 * VP) = (unsigned short)(vreg.x & 0xffffu); *(FLAS unsigned short*)(vd_ + 1 * VP) = (unsigned short)(vreg.x >> 16); \
        *(FLAS unsigned short*)(vd_ + 2 * VP) = (unsigned short)(vreg.y & 0xffffu); *(FLAS unsigned short*)(vd_ + 3 * VP) = (unsigned short)(vreg.y >> 16); \
        *(FLAS unsigned short*)(vd_ + 4 * VP) = (unsigned short)(vreg.z & 0xffffu); *(FLAS unsigned short*)(vd_ + 5 * VP) = (unsigned short)(vreg.z >> 16); \
        *(FLAS unsigned short*)(vd_ + 6 * VP) = (unsigned short)(vreg.w & 0xffffu); *(FLAS unsigned short*)(vd_ + 7 * VP) = (unsigned short)(vreg.w >> 16); } while (0)
    FA_LOAD(0); FA_STORE(0); __syncthreads();
    float m = NEG, l = 0.f; f32x16 o0, o1;
#pragma unroll
    for (int r = 0; r < 16; ++r) { o0[r] = 0.f; o1[r] = 0.f; }
    const int rowrel = 32 * w + r32;
    for (int t = 0; t < NT; ++t) {
        const int buf = t & 1;
        if (t + 1 < NT) FA_LOAD(t + 1);
        const int n = t >> 2, jd = t & 3; const bool diag = (n == qb);
        bool lane_on = true; if (MOBA && !diag) lane_on = (sel >> n) & 1u;
        bool wave_on = diag ? (64 * jd <= 32 * w + 31) : (MOBA ? (__any(lane_on) != 0) : true);
        if (wave_on) {
            const FLAS char* kt = lds + buf * KBUF + r32 * KP; const FLAS char* vt = lds + 2 * KBUF + buf * VBUF + r32 * VP;
            f32x16 s0 = qk_half<DK>(kt, hi, qf, cinit), s1 = qk_half<DK>(kt + 32 * KP, hi, qf, cinit);
            if (diag && (64 * jd + 63 > 32 * w)) {
#pragma unroll
                for (int r = 0; r < 16; ++r) { const int kr = 64 * jd + crow(r, hi); if (kr > rowrel) s0[r] = NEG; if (kr + 32 > rowrel) s1[r] = NEG; } }
            const float tb = MOBA ? slope2 * (float)(64 * t) : 0.f;
            float mx = xmax(fmaxf(max16(s0), max16(s1) + c32)) + tb;
            if (!lane_on) mx = NEG;
            const float mn = fmaxf(m, mx);
            if (__any(mn > m)) { const float a = __builtin_amdgcn_exp2f(m - mn); l *= a;
#pragma unroll
                for (int r = 0; r < 16; ++r) { o0[r] *= a; o1[r] *= a; }
                m = mn; }
            const float mref0 = lane_on ? (m - tb) : POS, mref1 = mref0 - c32;
            float ls = 0.f;
#pragma unroll
            for (int r = 0; r < 16; ++r) { s0[r] = __builtin_amdgcn_exp2f(s0[r] - mref0); s1[r] = __builtin_amdgcn_exp2f(s1[r] - mref1); ls += s0[r] + s1[r]; }
            l += ls;
            pv_half(o0, o1, vt, VP, hi, s0); pv_half(o0, o1, vt + 64, VP, hi, s1);
        }
        if (t + 1 < NT) FA_STORE(buf ^ 1);
        __syncthreads();
    }
#undef FA_LOAD
#undef FA_STORE
    const float lt = xsum(l);
    store_o(Oh + (rowb + q0 + 32 * w + r32) * DM, o0, o1, 1.0f / lt, hi);
}

__device__ __forceinline__ void dil_unit(FLAS char* lds, int tid, int b, int h, int dil, int res, int ch, bf16* proj, float* lse, float slope2d) {
    constexpr int KP = 144, VP = 776, VOFF = 384 * KP;
    const int lane = tid & 63, w = __builtin_amdgcn_readfirstlane(tid >> 6), r32 = lane & 31, hi = lane >> 5;
    const size_t rowb = (size_t)b * SEQ; const int m0 = 256 * ch;
#pragma unroll
    for (int i = 0; i < 6; ++i) { const int idx = tid + 512 * i, kk = idx >> 3, kch = idx & 7, mp = m0 - 128 + kk; v4u v = (v4u){0u, 0u, 0u, 0u};
        if (mp >= 0) v = *(const v4u*)(proj + (rowb + (size_t)mp * dil + res) * PP + PC_DK + h * 64 + kch * 8);
        *(FLAS v4u*)(lds + kk * KP + kch * 16) = v; }
#pragma unroll
    for (int i = 0; i < 6; ++i) { const int kk = 64 * i + lane, mp = m0 - 128 + kk; v4u v = (v4u){0u, 0u, 0u, 0u};
        if (mp >= 0) v = *(const v4u*)(proj + (rowb + (size_t)mp * dil + res) * PP + PC_DV + h * 64 + w * 8);
        FLAS char* vd = lds + VOFF + (8 * w) * VP + kk * 2;
        *(FLAS unsigned short*)(vd + 0 * VP) = (unsigned short)(v.x & 0xffffu); *(FLAS unsigned short*)(vd + 1 * VP) = (unsigned short)(v.x >> 16);
        *(FLAS unsigned short*)(vd + 2 * VP) = (unsigned short)(v.y & 0xffffu); *(FLAS unsigned short*)(vd + 3 * VP) = (unsigned short)(v.y >> 16);
        *(FLAS unsigned short*)(vd + 4 * VP) = (unsigned short)(v.z & 0xffffu); *(FLAS unsigned short*)(vd + 5 * VP) = (unsigned short)(v.z >> 16);
        *(FLAS unsigned short*)(vd + 6 * VP) = (unsigned short)(v.w & 0xffffu); *(FLAS unsigned short*)(vd + 7 * VP) = (unsigned short)(v.w >> 16); }
    const size_t qrow = rowb + (size_t)(m0 + 32 * w + r32) * dil + res;
    bf16x8 qf[4];
#pragma unroll
    for (int d0 = 0; d0 < 4; ++d0) qf[d0] = *(const bf16x8*)(proj + qrow * PP + PC_DQ + h * 64 + 16 * d0 + 8 * hi);
    f32x16 cinit;
#pragma unroll
    for (int r = 0; r < 16; ++r) cinit[r] = slope2d * (float)crow(r, hi);
    __syncthreads();
    f32x16 s[5]; float mx = NEG;
#pragma unroll
    for (int i = 0; i < 5; ++i) { s[i] = qk_half<64>(lds + (32 * (w + i) + r32) * KP, hi, qf, cinit);
        const bool dead = (ch == 0) && (w + i < 4);
#pragma unroll
        for (int r = 0; r < 16; ++r) { const int kr = crow(r, hi); bool ok = !dead; if (i == 0) ok = ok && (kr >= r32); if (i == 4) ok = ok && (kr <= r32); if (!ok) s[i][r] = NEG; }
        mx = fmaxf(mx, max16(s[i]) + (float)(32 * i) * slope2d); }
    mx = xmax(mx);
    float ls = 0.f; f32x16 o0, o1;
#pragma unroll
    for (int r = 0; r < 16; ++r) { o0[r] = 0.f; o1[r] = 0.f; }
#pragma unroll
    for (int i = 0; i < 5; ++i) { const float mref = mx - (float)(32 * i) * slope2d;
#pragma unroll
        for (int r = 0; r < 16; ++r) { s[i][r] = __builtin_amdgcn_exp2f(s[i][r] - mref); ls += s[i][r]; }
        pv_half(o0, o1, lds + VOFF + r32 * VP + (32 * (w + i)) * 2, VP, hi, s[i]); }
    const float lt = xsum(ls);
    if (hi == 0) lse[qrow * 12 + h] = mx + __builtin_amdgcn_logf(lt) - slope2d * (float)(r32 + 128);
    __syncthreads();
    store_o(proj + qrow * PP + PC_DQ + h * 64, o0, o1, 1.0f / lt, hi);
}
#undef FA_MFMA
}

struct Args { const float* in[20]; float* out; unsigned char* ws; int ph_lo, ph_hi; };
constexpr int PH_PER_LAYER = 11, N_PHASES = 1 + DEPTH * PH_PER_LAYER + 1;

__global__ void __launch_bounds__(NWAVES * 64, 2) mk_fwd(Args args) {
    extern __shared__ __attribute__((aligned(16))) unsigned char lds[];
    Frame F;
    F.lds = (LAS unsigned char*)lds;
    F.MISC = (volatile LAS unsigned*)(F.lds + MISC_OFF);
    unsigned char* ws = args.ws;
    F.ctl = (gu32*)(ws + WS_CTL);
    for (int u = threadIdx.x; u < (LDS_BYTES - LDSCTL_OFF) / 4; u += NWAVES * 64) ((LAS unsigned*)(F.lds + LDSCTL_OFF))[u] = 0u;
    __syncthreads();
    const int wave_s = __builtin_amdgcn_readfirstlane((int)threadIdx.x >> 6);
#define MYTID() (OPQ_S(wave_s) * 64 + (int)__builtin_amdgcn_mbcnt_hi(~0u, __builtin_amdgcn_mbcnt_lo(~0u, 0u)))
#define PHASE_LANES() int tid_ = MYTID(); asm volatile("" : "+v"(tid_)); int G_ = gridDim.x, bx_ = blockIdx.x; asm volatile("" : "+s"(G_), "+s"(bx_)); \
    const int lane = tid_ & 63, wave = __builtin_amdgcn_readfirstlane(tid_ >> 6); const int vcu_ = (G_ % 8 == 0) ? (bx_ % 8) * (G_ / 8) + bx_ / 8 : bx_; const int gw = vcu_ * NWAVES + wave, NGW = G_ * NWAVES; (void)lane; (void)gw; (void)NGW
    XcdBarrier bar; bar.bar = (unsigned*)(F.ctl + CW_BAR); bar.x = 0; bar.st = nullptr;
    if (!MK_PER_PHASE) bar = xcd_barrier_post((unsigned*)(F.ctl + CW_BAR), F.MISC + 8);
#define GRID_BAR() do { if (MK_PER_PHASE) { if (MYTID() == 0) __hip_atomic_store(F.ctl + 0, 0xBADBA0u, RLX_AGENT); } else { xcd_barrier(bar, MYTID() == 0); } } while (0)
    const int lo = args.ph_lo, hi = args.ph_hi;
#define IN(k) (lo <= (k) && (k) < hi)
#define BOTH(k) (IN(k) && IN((k) + 1))

#define PHASE_PTRS() unsigned zo_ = 0u; asm volatile("" : "+s"(zo_)); unsigned char* ws_ = args.ws + zo_;     \
    const float* x_in = args.in[0]; float* out = args.out; \
    float* cosT = (float*)(ws_ + WS_ROPE); float* sinT = cosT + SEQ * 16; float* kmean = (float*)(ws_ + WS_KMEAN); bf16* kmh = (bf16*)(ws_ + WS_KMEAN + 192 * 1024); bf16* kml = kmh + BATCH * 6 * 16 * 64; float* lse = (float*)(ws_ + WS_LSE); (void)kmh; (void)kml; (void)lse; \
    float* rs = (float*)(ws_ + WS_RS); float* rsq = (float*)(ws_ + WS_RSQ); float* rskv = (float*)(ws_ + WS_RSKV); \
    bf16* Wb = (bf16*)(ws_ + WS_W); bf16* XB = (bf16*)(ws_ + WS_XB); bf16* PROJ = (bf16*)(ws_ + WS_PROJ); bf16* ACT = PROJ; bf16* GT = PROJ; \
    bf16* QM = (bf16*)(ws_ + WS_QM); bf16* KN = (bf16*)(ws_ + WS_KN); bf16* VM = (bf16*)(ws_ + WS_VM); bf16* KR = (bf16*)(ws_ + WS_KR); \
    bf16* MG = (bf16*)(ws_ + WS_MG); bf16* AO = (bf16*)(ws_ + WS_AO); \
    const pg8::bf16_t* Wgu1 = Wb + W_GU1 / 2; const pg8::bf16_t* Wd1 = Wb + W_D1 / 2; const pg8::bf16_t* Win = Wb + W_IN / 2; const pg8::bf16_t* Wg = Wb + W_G / 2; \
    const pg8::bf16_t* Wuq = Wb + W_UQ / 2; const pg8::bf16_t* Wukv = Wb + W_UKV / 2; const pg8::bf16_t* Wbr = Wb + W_BR / 2; const pg8::bf16_t* Wout = Wb + W_OUT / 2; \
    const pg8::bf16_t* Wgu2 = Wb + W_GU2 / 2; const pg8::bf16_t* Wd2 = Wb + W_D2 / 2; \
    (void)x_in; (void)out; (void)cosT; (void)sinT; (void)kmean; (void)rs; (void)rsq; (void)rskv; (void)XB; (void)ACT; (void)GT; (void)QM; (void)KN; (void)VM; (void)KR; (void)MG; (void)AO; \
    (void)Wgu1; (void)Wd1; (void)Win; (void)Wg; (void)Wuq; (void)Wukv; (void)Wbr; (void)Wout; (void)Wgu2; (void)Wd2

    if (IN(0)) { PHASE_LANES(); PHASE_PTRS();
        for (int m = gw; m < T; m += NGW) { const GAS f32x4* xr = (const GAS f32x4*)(x_in + (size_t)m * DM) + lane; f32x4 v[4]; float s = 0.f;
#pragma unroll
            for (int j = 0; j < 4; ++j) { v[j] = xr[64 * j]; s += (v[j].x * v[j].x + v[j].y * v[j].y) + (v[j].z * v[j].z + v[j].w * v[j].w); }
            s = wave_sum(s);
            GAS unsigned long long* o8 = (GAS unsigned long long*)(XB + (size_t)m * DM) + lane;
#pragma unroll
            for (int j = 0; j < 4; ++j) o8[64 * j] = (unsigned long long)pk2(v[j].x, v[j].y) | ((unsigned long long)pk2(v[j].z, v[j].w) << 32);
            if (lane < 16) rs[(size_t)m * 16 + lane] = (lane == 0) ? s : 0.f; }
        for (int idx = gw * 64 + lane; idx < SEQ * 16; idx += NGW * 64) { const int pos = idx >> 4, i = idx & 15; const int a = i & 3, e = i >> 2;
            const double mm = a == 0 ? 1.0 : a == 1 ? 0.5623413251903491 : a == 2 ? 0.31622776601683794 : 0.1778279410038923;
            const double pe = e == 0 ? 1.0 : e == 1 ? 0.1 : e == 2 ? 0.01 : 0.001;
            const float inv = (float)(mm * pe); const float angf = (float)pos * inv;
            const double rev = (double)angf * 0.15915494309189535; const float fr = (float)(rev - __builtin_rint(rev));
            cosT[idx] = __builtin_amdgcn_cosf(fr); sinT[idx] = __builtin_amdgcn_sinf(fr); }
        if (BOTH(0)) GRID_BAR();
    }

    for (int l = 0; l < DEPTH; ++l) {
        const int pb = 1 + l * PH_PER_LAYER;
        if (IN(pb + 0)) { PHASE_LANES(); PHASE_PTRS();
            LAS float* scr = (LAS float*)(F.lds + RING_OFF + wave * 16384);
            int base = 0;
            cvt_matrix(args.in[2] + (size_t)l * DM * FF, DM, FF, args.in[1] + l * DM, Wb + W_GU1 / 2, DM, 0, RmGU{0}, scr, gw, NGW, lane, base);
            cvt_matrix(args.in[3] + (size_t)l * DM * FF, DM, FF, args.in[1] + l * DM, Wb + W_GU1 / 2, DM, 0, RmGU{128}, scr, gw, NGW, lane, base);
            cvt_matrix(args.in[4] + (size_t)l * FF * DM, FF, DM, nullptr, Wb + W_D1 / 2, FF, 0, RmId{}, scr, gw, NGW, lane, base);
            cvt_matrix(args.in[6] + (size_t)l * DM * IN_COLS, DM, IN_COLS, args.in[5] + l * DM, Wb + W_IN / 2, DM, 0, RmIn{}, scr, gw, NGW, lane, base);
            cvt_matrix(args.in[8] + (size_t)l * 256 * 576, 256, 576, args.in[7] + l * 256, Wb + W_UQ / 2, 256, 0, RmId{}, scr, gw, NGW, lane, base);
            cvt_matrix(args.in[10] + (size_t)l * 128 * 768, 128, 768, args.in[9] + l * 128, Wb + W_UKV / 2, 256, 0, RmId{}, scr, gw, NGW, lane, base);
            cvt_matrix(args.in[11] + (size_t)l * 384 * DM, 384, DM, nullptr, Wb + W_BR / 2, DM, 0, RmId{}, scr, gw, NGW, lane, base);
            cvt_matrix(args.in[12] + (size_t)l * 384 * DM, 384, DM, nullptr, Wb + W_BR / 2, DM, 384, RmId{}, scr, gw, NGW, lane, base);
            cvt_matrix(args.in[13] + (size_t)l * 256 * DM, 256, DM, nullptr, Wb + W_BR / 2, DM, 768, RmId{}, scr, gw, NGW, lane, base);
            cvt_matrix(args.in[14] + (size_t)l * DM * DM, DM, DM, nullptr, Wb + W_OUT / 2, DM, 0, RmId{}, scr, gw, NGW, lane, base);
            cvt_matrix(args.in[16] + (size_t)l * DM * FF, DM, FF, args.in[15] + l * DM, Wb + W_GU2 / 2, DM, 0, RmGU{0}, scr, gw, NGW, lane, base);
            cvt_matrix(args.in[17] + (size_t)l * DM * FF, DM, FF, args.in[15] + l * DM, Wb + W_GU2 / 2, DM, 0, RmGU{128}, scr, gw, NGW, lane, base);
            cvt_matrix(args.in[18] + (size_t)l * FF * DM, FF, DM, nullptr, Wb + W_D2 / 2, FF, 0, RmId{}, scr, gw, NGW, lane, base);
            const v4u z = (v4u){0u, 0u, 0u, 0u}; const int gt = gw * 64 + lane, NT = NGW * 64;
            for (int i = gt; i < 224 * 1024 / 8; i += NT) *(GAS v4u*)(Wb + W_IN / 2 + (size_t)3872 * 1024 + (size_t)i * 8) = z;
            for (int i = gt; i < 192 * 256 / 8; i += NT) *(GAS v4u*)(Wb + W_UQ / 2 + (size_t)576 * 256 + (size_t)i * 8) = z;
            for (int i = gt; i < 768 * 16; i += NT) *(GAS v4u*)(Wb + W_UKV / 2 + (size_t)(i >> 4) * 256 + 128 + (i & 15) * 8) = z;
            if (BOTH(pb + 0)) GRID_BAR();
        }
        if (IN(pb + 1)) { PHASE_PTRS();
            pg8::Gemm g{XB, Wgu1, T, 2 * FF, DM, DM, DM}; pg8::StaticOrder S; S.init(T, 2 * FF, OPQ_S((int)gridDim.x), OPQ_S((int)blockIdx.x));
            pg8::EpiSwiGLU E{ACT, FF, rs};
            pg8::gemm_phase<pg8::EpiSwiGLU, pg8::StaticOrder, true>(F.lds + RING_OFF, g, S, E, MYTID());
            if (BOTH(pb + 1)) GRID_BAR();
        }
        if (IN(pb + 2)) { PHASE_PTRS();
            pg8::Gemm g{ACT, Wd1, T, DM, FF, FF, FF}; pg8::StaticOrder S; S.init(T, DM, OPQ_S((int)gridDim.x), OPQ_S((int)blockIdx.x));
            pg8::EpiResid E{l == 0 ? x_in : out, out, XB, rs, 0.5f};
            pg8::gemm_phase<pg8::EpiResid, pg8::StaticOrder, true>(F.lds + RING_OFF, g, S, E, MYTID());
            if (BOTH(pb + 2)) GRID_BAR();
        }
        if (IN(pb + 3)) { PHASE_PTRS();
            pg8::Gemm g{XB, Win, T, 4096, DM, DM, DM}; pg8::StaticOrder S; S.init(T, 4096, OPQ_S((int)gridDim.x), OPQ_S((int)blockIdx.x));
            pg8::EpiProj E{PROJ, rs, rsq, rskv};
            pg8::gemm_phase<pg8::EpiProj, pg8::StaticOrder, true>(F.lds + RING_OFF, g, S, E, MYTID());
            if (BOTH(pb + 3)) GRID_BAR();
        }
        if (IN(pb + 4)) { PHASE_PTRS();
            { pg8::Gemm g{PROJ + PC_CQ, Wuq, T, 768, 256, PP, 256}; pg8::StaticOrder S; S.init(T, 768, OPQ_S((int)gridDim.x), OPQ_S((int)blockIdx.x));
              pg8::EpiQup E{QM, rsq, cosT, sinT};
              pg8::gemm_phase<pg8::EpiQup, pg8::StaticOrder, true>(F.lds + RING_OFF, g, S, E, MYTID()); }
            { pg8::Gemm g{PROJ + PC_CKV, Wukv, T, 768, 256, PP, 256}; pg8::StaticOrder S; S.init(T, 768, OPQ_S((int)gridDim.x), OPQ_S((int)blockIdx.x));
              pg8::EpiKVup E{KN, VM, rskv};
              pg8::gemm_phase<pg8::EpiKVup, pg8::StaticOrder, true>(F.lds + RING_OFF, g, S, E, MYTID()); }
            PHASE_LANES();
            for (int idx = gw * 64 + lane; idx < T * 16; idx += NGW * 64) { const int row = idx >> 4, i = idx & 15, pos = row & (SEQ - 1);
                const float t1 = __uint_as_float((unsigned)PROJ[(size_t)row * PP + PC_KR + i] << 16), t2 = __uint_as_float((unsigned)PROJ[(size_t)row * PP + PC_KR + 16 + i] << 16);
                const float c = cosT[pos * 16 + i], s = sinT[pos * 16 + i];
                KR[(size_t)row * 32 + i] = (bf16)f2bf(t1 * c - t2 * s); KR[(size_t)row * 32 + 16 + i] = (bf16)f2bf(t1 * s + t2 * c); }
            for (int idx = gw * 64 + lane; idx < BATCH * 6 * 16 * 64; idx += NGW * 64) { const int d = idx & 63, n = (idx >> 6) & 15, bh = idx >> 10, b = bh / 6, h = bh % 6;
                const bf16* kp = PROJ + ((size_t)b * SEQ + n * 256) * PP + PC_MK + h * 64 + d; float s = 0.f;
                for (int kk = 0; kk < 256; ++kk) s += __uint_as_float((unsigned)kp[(size_t)kk * PP] << 16);
                const float km = s * (1.0f / 256.0f); kmean[idx] = km; const unsigned hb = f2bf(km); kmh[idx] = (bf16)hb; kml[idx] = (bf16)f2bf(km - __uint_as_float(hb << 16)); }
#if MK_NAIVE_DIL
            for (int gid = gw * 64 + lane; gid < BATCH * 4 * SEQ; gid += NGW * 64) dil_naive_thread(PROJ, AO, gid >> 14, (gid >> 12) & 3, gid & (SEQ - 1));
#else
            __syncthreads();
            for (int u = bx_; u < BATCH * 12 * 16; u += G_) { const int b = u / 192, h = (u >> 4) % 12, i16 = u & 15, g = h >> 2, dil = (g == 0) ? 1 : (g == 1) ? 4 : 16, nch = 16 / dil;
                fa::dil_unit((LAS char*)(F.lds + RING_OFF), tid_, b, h, dil, i16 / nch, i16 % nch, PROJ, lse, exp2f(-8.0f * (float)(h + 1) / 18.0f) * LOG2E * (float)dil);
                __syncthreads(); }
#endif
            if (BOTH(pb + 4)) GRID_BAR();
        }
        if (IN(pb + 5)) { PHASE_LANES(); PHASE_PTRS();
#if !MK_NAIVE_DIL
            for (int idx = gw * 64 + lane; idx < T * 32; idx += NGW * 64) { const int row = idx >> 5, hg = (idx >> 3) & 3, c = idx & 7;
                const float l0 = lse[(size_t)row * 12 + hg], l1 = lse[(size_t)row * 12 + 4 + hg], l2 = lse[(size_t)row * 12 + 8 + hg], lm = fmaxf(l0, fmaxf(l1, l2));
                float w0 = exp2f(l0 - lm), w1 = exp2f(l1 - lm), w2 = exp2f(l2 - lm); const float wi = 1.0f / (w0 + w1 + w2); w0 *= wi; w1 *= wi; w2 *= wi;
                const bf16* op = PROJ + (size_t)row * PP + PC_DQ + hg * 64 + c * 8; float a0[8], a1[8], a2[8], r[8];
                ld8(op, a0); ld8(op + 256, a1); ld8(op + 512, a2);
#pragma unroll
                for (int j = 0; j < 8; ++j) r[j] = w0 * a0[j] + w1 * a1[j] + w2 * a2[j];
                st8(AO + (size_t)row * DM + 768 + hg * 64 + c * 8, r, 1.0f); }
#endif
            for (int which = 0; which < 2; ++which) {
                const bool naive = which == 0 ? (MK_NAIVE_MLA != 0) : (MK_NAIVE_MOBA != 0);
                if (naive) {
                    for (int u = gw; u < 48 * 32; u += NGW) { const int bh = u >> 5, cp = u & 31, b = bh / 6, h = bh % 6;
                        if (which == 0) { mla_naive_chunk(QM, KN, KR, VM, AO, b, h, cp, lane); mla_naive_chunk(QM, KN, KR, VM, AO, b, h, 63 - cp, lane); }
                        else { moba_naive_chunk(PROJ, kmean, AO, b, h, cp, lane); moba_naive_chunk(PROJ, kmean, AO, b, h, 63 - cp, lane); } }
                } else {
                    gu32* head = F.ctl + CW_QUEUE + 64 * (2 * l + which);
                    for (;;) {
                        if (tid_ == 0) F.MISC[16] = __hip_atomic_fetch_add(head, 1u, RLX_AGENT);
                        __syncthreads();
                        const int u = (int)F.MISC[16];
                        if (u >= 48 * 16) break;
                        const int qb = 15 - u / 48, bh = u % 48, b = bh / 6, h = bh % 6;
                        if (which == 0) fa::flash_unit<96, false>((LAS char*)(F.lds + RING_OFF), tid_, b, qb, QM + h * 96, 576, KN + h * 64, 384, KR, VM + h * 64, 384, AO + h * 64, nullptr, nullptr, 0.f);
                        else fa::flash_unit<64, true>((LAS char*)(F.lds + RING_OFF), tid_, b, qb, PROJ + PC_MQ + h * 64, PP, PROJ + PC_MK + h * 64, PP, nullptr, PROJ + PC_MV + h * 64, PP, AO + 384 + h * 64,
                                                      kmh + (size_t)bh * 1024, kml + (size_t)bh * 1024, exp2f(-8.0f * (float)(12 + h + 1) / 18.0f) * LOG2E);
                    }
                    __syncthreads();
                }
            }
            if (BOTH(pb + 5)) GRID_BAR();
        }
        if (IN(pb + 6)) { PHASE_PTRS();
            pg8::Gemm g{XB, Wg, T, 3072, DM, DM, DM}; pg8::StaticOrder S; S.init(T, 3072, OPQ_S((int)gridDim.x), OPQ_S((int)blockIdx.x));
            pg8::EpiGate E{GT, rs};
            pg8::gemm_phase<pg8::EpiGate, pg8::StaticOrder, true>(F.lds + RING_OFF, g, S, E, MYTID());
            if (BOTH(pb + 6)) GRID_BAR();
        }
        if (IN(pb + 7)) { PHASE_PTRS();
            int first_ = 1;
            if (MK_BRANCH_MASK & 1) { pg8::Gemm g{AO, Wbr, T, DM, 384, DM, DM}; pg8::StaticOrder S; S.init(T, DM, OPQ_S((int)gridDim.x), OPQ_S((int)blockIdx.x)); pg8::EpiMerge E{GT, MG, first_}; first_ = 0;
              pg8::gemm_phase<pg8::EpiMerge, pg8::StaticOrder, true>(F.lds + RING_OFF, g, S, E, MYTID()); }
            if (MK_BRANCH_MASK & 2) { pg8::Gemm g{AO + 384, Wbr + 384, T, DM, 384, DM, DM}; pg8::StaticOrder S; S.init(T, DM, OPQ_S((int)gridDim.x), OPQ_S((int)blockIdx.x)); pg8::EpiMerge E{GT + 1024, MG, first_}; first_ = 0;
              pg8::gemm_phase<pg8::EpiMerge, pg8::StaticOrder, true>(F.lds + RING_OFF, g, S, E, MYTID()); }
            if (MK_BRANCH_MASK & 4) { pg8::Gemm g{AO + 768, Wbr + 768, T, DM, 256, DM, DM}; pg8::StaticOrder S; S.init(T, DM, OPQ_S((int)gridDim.x), OPQ_S((int)blockIdx.x)); pg8::EpiMerge E{GT + 2048, MG, first_}; first_ = 0;
              pg8::gemm_phase<pg8::EpiMerge, pg8::StaticOrder, true>(F.lds + RING_OFF, g, S, E, MYTID()); }
            if (BOTH(pb + 7)) GRID_BAR();
        }
        if (IN(pb + 8)) { PHASE_PTRS();
            pg8::Gemm g{MG, Wout, T, DM, DM, DM, DM}; pg8::StaticOrder S; S.init(T, DM, OPQ_S((int)gridDim.x), OPQ_S((int)blockIdx.x));
            pg8::EpiResid E{out, out, XB, rs, 1.0f};
            pg8::gemm_phase<pg8::EpiResid, pg8::StaticOrder, true>(F.lds + RING_OFF, g, S, E, MYTID());
            if (BOTH(pb + 8)) GRID_BAR();
        }
        if (IN(pb + 9)) { PHASE_PTRS();
            pg8::Gemm g{XB, Wgu2, T, 2 * FF, DM, DM, DM}; pg8::StaticOrder S; S.init(T, 2 * FF, OPQ_S((int)gridDim.x), OPQ_S((int)blockIdx.x));
            pg8::EpiSwiGLU E{ACT, FF, rs};
            pg8::gemm_phase<pg8::EpiSwiGLU, pg8::StaticOrder, true>(F.lds + RING_OFF, g, S, E, MYTID());
            if (BOTH(pb + 9)) GRID_BAR();
        }
        if (IN(pb + 10)) { PHASE_PTRS();
            pg8::Gemm g{ACT, Wd2, T, DM, FF, FF, FF}; pg8::StaticOrder S; S.init(T, DM, OPQ_S((int)gridDim.x), OPQ_S((int)blockIdx.x));
            pg8::EpiResid E{out, out, XB, rs, 0.5f};
            pg8::gemm_phase<pg8::EpiResid, pg8::StaticOrder, true>(F.lds + RING_OFF, g, S, E, MYTID());
            if (BOTH(pb + 10)) GRID_BAR();
        }
    }
    if (IN(N_PHASES - 1)) { PHASE_LANES(); PHASE_PTRS();
        const float* gain = args.in[19];
        for (int m = gw; m < T; m += NGW) { GAS f32x4* xr = (GAS f32x4*)(out + (size_t)m * DM) + lane; f32x4 v[4]; float s = 0.f;
#pragma unroll
            for (int j = 0; j < 4; ++j) { v[j] = xr[64 * j]; s += (v[j].x * v[j].x + v[j].y * v[j].y) + (v[j].z * v[j].z + v[j].w * v[j].w); }
            const float r = 1.0f / sqrtf(wave_sum(s) * (1.0f / DM) + NORM_EPS);
#pragma unroll
            for (int j = 0; j < 4; ++j) { const f32x4 gn = *((const f32x4*)gain + lane + 64 * j); xr[64 * j] = v[j] * r * gn; } }
    }
#undef IN
#undef BOTH
#undef GRID_BAR
}


__global__ void dbg_rowsum(const float* out, float* cs) { const int row = blockIdx.x * 4 + (threadIdx.x >> 6), lane = threadIdx.x & 63; float s = 0.f; for (int c = lane; c < DM; c += 64) s += out[(size_t)row * DM + c]; for (int o = 1; o < 64; o <<= 1) s += __shfl_xor(s, o); if (lane == 0) cs[row] = s; }
__global__ void dbg_cmp(const float* a, const float* b, unsigned* flag) { const int i = blockIdx.x * 256 + threadIdx.x; if (i < T) { const float d = fabsf(a[i] - b[i]); if (!(d <= 1e-5f * fabsf(a[i]) + 1e-6f)) atomicAdd(flag, 1u); } }
__global__ void dbg_scale(float* out, const unsigned* flag) { const size_t i = (size_t)blockIdx.x * 256 + threadIdx.x; if (*flag) out[i] *= 3.0f; }
extern "C" void kernel_launch(void* const* d_in, const int* in_sizes, int n_in, void* d_out, int out_size, void* d_ws, size_t ws_size, hipStream_t stream) {
    static int grid = 0;
    if (grid == 0) {
        if (n_in != 20 || in_sizes[0] != T * DM || out_size != T * DM || ws_size < WS_END) { fprintf(stderr, "kernel_launch: unexpected shapes / workspace (n_in %d, ws %zu, need %zu)\n", n_in, ws_size, (size_t)WS_END); grid = -1; return; }
        int dev = 0, cus = 0, per_cu = 0;
        if (hipGetDevice(&dev) != hipSuccess || hipDeviceGetAttribute(&cus, hipDeviceAttributeMultiprocessorCount, dev) != hipSuccess) { grid = -1; return; }
        if (hipFuncSetAttribute((const void*)mk_fwd, hipFuncAttributeMaxDynamicSharedMemorySize, LDS_BYTES) != hipSuccess) { fprintf(stderr, "kernel_launch: hipFuncSetAttribute failed\n"); grid = -1; return; }
        if (hipOccupancyMaxActiveBlocksPerMultiprocessor(&per_cu, (const void*)mk_fwd, NWAVES * 64, LDS_BYTES) != hipSuccess || per_cu < 1)
            fprintf(stderr, "kernel_launch: note: occupancy query reports %d workgroups per CU\n", per_cu);
        (void)hipGetLastError();
        grid = cus;
    }
    if (grid < 0) return;
    if (hipMemsetAsync((char*)d_ws + WS_CTL, 0, CTL_ZERO_BYTES, stream) != hipSuccess) return;
    Args a{};
    for (int i = 0; i < 20; ++i) a.in[i] = (const float*)d_in[i];
    a.out = (float*)d_out; a.ws = (unsigned char*)d_ws;
#if MK_PER_PHASE
    float* cs = (float*)((char*)d_ws + WS_END); unsigned* flag = (unsigned*)((char*)d_ws + 64);
    for (int rep = 0; rep < 1; ++rep) {
      for (int p = 0; p < N_PHASES; ++p) { if (p > MK_STOP_AFTER && p != N_PHASES - 1) continue; a.ph_lo = p; a.ph_hi = p + 1; hipLaunchKernelGGL(mk_fwd, dim3(grid), dim3(NWAVES * 64), LDS_BYTES, stream, a); }
      hipLaunchKernelGGL(dbg_rowsum, dim3(T / 4), dim3(256), 0, stream, (const float*)d_out, cs + rep * T);
    }
    if (0) hipLaunchKernelGGL(dbg_cmp, dim3(T / 256), dim3(256), 0, stream, (const float*)cs, (const float*)(cs + T), flag);
    if (0) hipLaunchKernelGGL(dbg_scale, dim3(T * DM / 256), dim3(256), 0, stream, (float*)d_out, (const unsigned*)flag);
#else
    a.ph_lo = 0; a.ph_hi = N_PHASES;
    hipLaunchKernelGGL(mk_fwd, dim3(grid), dim3(NWAVES * 64), LDS_BYTES, stream, a);
#endif
}
```

```cpp
#include <hip/hip_runtime.h>
#include <cstdio>
#include <cstdint>

#ifndef MK_PER_PHASE
#define MK_PER_PHASE 0
#endif

#ifndef MK_DOUBLE
#define MK_DOUBLE 0
#endif
#ifndef MK_NAIVE_MLA
#define MK_NAIVE_MLA 0
#endif
#ifndef MK_NAIVE_MOBA
#define MK_NAIVE_MOBA 0
#endif
#ifndef MK_NAIVE_DIL
#define MK_NAIVE_DIL 0
#endif
#ifndef MK_STOP_AFTER
#define MK_STOP_AFTER 999
#endif
#ifndef MK_BRANCH_MASK
#define MK_BRANCH_MASK 7
#endif
constexpr int BATCH = 8, SEQ = 4096, DM = 1024, DEPTH = 4, FF = 2816, T = BATCH * SEQ;
constexpr int PP = 4096;
constexpr int PC_DQ = 0, PC_DK = 768, PC_DV = 1536, PC_MQ = 2304, PC_MK = 2688, PC_MV = 3072, PC_CKV = 3456, PC_CQ = 3584, PC_KR = 3840;
constexpr int IN_COLS = 6944;
constexpr float NORM_EPS = 1e-6f;
constexpr float LOG2E = 1.4426950408889634f, QSCALE64 = 0.125f * LOG2E, QSCALE96 = 0.10206207261596575f * LOG2E;

namespace pg8 {
#define PG8_LAS __attribute__((address_space(3)))
typedef unsigned short bf16_t;
typedef short bf16x8 __attribute__((ext_vector_type(8)));
typedef float f32x4 __attribute__((ext_vector_type(4)));
typedef unsigned u32x4 __attribute__((ext_vector_type(4)));
typedef unsigned u32x2 __attribute__((ext_vector_type(2)));
constexpr int BM = 256, BK = 64, HALF = 128, HTB = HALF * BK * 2, STAGE_BYTES = 8 * HTB, NXCD = 8, WGM = 8;

__host__ __device__ __forceinline__ int lds_byte(int r, int c) { const int st = (r >> 4) * 2 + (c >> 5), rr = r & 15, cc = c & 31, ob = rr * 64 + cc * 2; return st * 1024 + (ob ^ (((ob >> 9) & 1) << 5)); }
__host__ __device__ __forceinline__ void stage_rc(int b, int& R, int& C) { const int st = b / 1024, sb = b % 1024, swz = sb ^ (((sb >> 9) & 1) << 5); R = (st >> 1) * 16 + swz / 64; C = (st & 1) * 32 + (swz % 64) / 2; }
__host__ __device__ __forceinline__ int perm32(int rho) { const int n = rho >> 4, i = rho & 15; return 8 * (i >> 2) + 4 * n + (i & 3); }

struct Unit { int pm, pn; };
struct Gemm { const bf16_t* A; const bf16_t* Bt; int M, N, K, lda, ldb; };

struct StaticOrder {
    int nM, nN, nwg, G, c;
    __host__ __device__ void init(int M, int N, int G_, int c_) { nM = M / BM; nN = N / BM; nwg = nM * nN; G = G_; c = c_; }
    __host__ __device__ bool next(int i, Unit& u) const {
        const long L = (long)i * G + c; if (L >= nwg) return false;
        int wgid = (int)L; { const int q = nwg / NXCD, r = nwg % NXCD, xcd = wgid % NXCD, off = wgid / NXCD; wgid = (xcd < r ? xcd * (q + 1) : r * (q + 1) + (xcd - r) * q) + off; }
        const int nig = WGM * nN, gid = wgid / nig, fm = gid * WGM, gsz = (nM - fm) < WGM ? (nM - fm) : WGM;
        u.pm = fm + ((wgid % nig) % gsz); u.pn = (wgid % nig) / gsz; return true;
    }
    __device__ __forceinline__ void a_ready(const Unit&) const {}
    __device__ __forceinline__ void done(const Unit&) const {}
};

typedef float f32x2_t __attribute__((ext_vector_type(2))); typedef __bf16 bf16x2_t __attribute__((ext_vector_type(2)));
__device__ __forceinline__ unsigned cvt_pk_bf16(float lo, float hi) { f32x2_t v = {lo, hi}; bf16x2_t b = __builtin_convertvector(v, bf16x2_t); return __builtin_bit_cast(unsigned, b); }
__device__ __forceinline__ float bflo(unsigned w) { return __uint_as_float(w << 16); }
__device__ __forceinline__ float bfhi(unsigned w) { return __uint_as_float(w & 0xffff0000u); }

template <int NP> __device__ __forceinline__ float row_scale(const float* p, int row, float invn) {
    float s = 0.f;
#pragma unroll
    for (int i = 0; i < NP / 4; ++i) { const f32x4 a = *(const f32x4*)(p + (size_t)row * NP + 4 * i); s += (a[0] + a[1]) + (a[2] + a[3]); }
    return 1.0f / sqrtf(s * invn + NORM_EPS);
}
typedef unsigned long long u64;
constexpr float RS_FIX = 16777216.0f, RS_UNFIX = 1.0f / 16777216.0f;
__device__ __forceinline__ void row_scales8(const u64* rsu, int row0, float (&sc)[2][4]) {
    u64 v[2][4];
#pragma unroll
    for (int ai = 0; ai < 2; ++ai)
#pragma unroll
        for (int m = 0; m < 4; ++m) v[ai][m] = rsu[row0 + ai * HALF + m * 16];
#pragma unroll
    for (int ai = 0; ai < 2; ++ai)
#pragma unroll
        for (int m = 0; m < 4; ++m) sc[ai][m] = 1.0f / sqrtf((float)v[ai][m] * (RS_UNFIX / DM) + NORM_EPS);
}
__device__ __forceinline__ float silu_f(float a) { return a * __builtin_amdgcn_rcpf(1.0f + __builtin_amdgcn_exp2f(-1.4426950408889634f * a)); }
__device__ __forceinline__ float sigm_f(float a) { return __builtin_amdgcn_rcpf(1.0f + __builtin_amdgcn_exp2f(-1.4426950408889634f * a)); }

struct EpiSwiGLU { static constexpr bool PERM = true, AFTER_DRAIN = false;
    bf16_t* O; int ldc; const u64* rsu;
    __device__ __forceinline__ void operator()(const f32x4 (&acc)[2][2][4][2], const Unit& u, int wr, int wc, int fr, int fq) const {
        const int row0 = u.pm * BM + wr * 64 + fr, col0 = u.pn * HALF + wc * 32 + 8 * fq;
        float sc[2][4]; row_scales8(rsu, row0, sc);
#pragma unroll
        for (int ai = 0; ai < 2; ++ai)
#pragma unroll
            for (int m = 0; m < 4; ++m) { const int row = row0 + ai * HALF + m * 16; const float s = sc[ai][m];
                float y[8];
#pragma unroll
                for (int n = 0; n < 2; ++n)
#pragma unroll
                    for (int j = 0; j < 4; ++j) y[4 * n + j] = silu_f(acc[ai][0][m][n][j] * s) * (acc[ai][1][m][n][j] * s);
                u32x4 w; w.x = cvt_pk_bf16(y[0], y[1]); w.y = cvt_pk_bf16(y[2], y[3]); w.z = cvt_pk_bf16(y[4], y[5]); w.w = cvt_pk_bf16(y[6], y[7]);
                *(u32x4*)(O + (size_t)row * ldc + col0) = w; }
    }
};
struct EpiResid { static constexpr bool PERM = true, AFTER_DRAIN = false;
    bf16_t* xb; u64* rsu; float alpha;
    __device__ __forceinline__ void operator()(const f32x4 (&acc)[2][2][4][2], const Unit& u, int wr, int wc, int fr, int fq) const {
        const int row0 = u.pm * BM + wr * 64 + fr, col0 = u.pn * BM + wc * 32 + 8 * fq;
#pragma unroll
        for (int ai = 0; ai < 2; ++ai) {
            u32x4 b[4][2];
#pragma unroll
            for (int m = 0; m < 4; ++m)
#pragma unroll
                for (int bj = 0; bj < 2; ++bj) b[m][bj] = *(const u32x4*)(xb + (size_t)(row0 + ai * HALF + m * 16) * DM + col0 + bj * HALF);
#pragma unroll
            for (int m = 0; m < 4; ++m) { const int row = row0 + ai * HALF + m * 16; float ss = 0.f;
#pragma unroll
                for (int bj = 0; bj < 2; ++bj) { const u32x4 p = b[m][bj]; const f32x4 a0 = acc[ai][bj][m][0], a1 = acc[ai][bj][m][1]; float o[8];
                    o[0] = bflo(p.x) + alpha * a0[0]; o[1] = bfhi(p.x) + alpha * a0[1]; o[2] = bflo(p.y) + alpha * a0[2]; o[3] = bfhi(p.y) + alpha * a0[3];
                    o[4] = bflo(p.z) + alpha * a1[0]; o[5] = bfhi(p.z) + alpha * a1[1]; o[6] = bflo(p.w) + alpha * a1[2]; o[7] = bfhi(p.w) + alpha * a1[3];
                    u32x4 w; w.x = cvt_pk_bf16(o[0], o[1]); w.y = cvt_pk_bf16(o[2], o[3]); w.z = cvt_pk_bf16(o[4], o[5]); w.w = cvt_pk_bf16(o[6], o[7]);
                    *(u32x4*)(xb + (size_t)row * DM + col0 + bj * HALF) = w;
#pragma unroll
                    for (int j = 0; j < 8; ++j) ss += o[j] * o[j]; }
                ss += __shfl_xor(ss, 16); ss += __shfl_xor(ss, 32);
                if (fq == 0) __hip_atomic_fetch_add(rsu + row, (u64)(ss * RS_FIX), __ATOMIC_RELAXED, __HIP_MEMORY_SCOPE_AGENT); }
        }
    }
};
struct EpiProj { static constexpr bool PERM = true, AFTER_DRAIN = false;
    bf16_t* O; const u64* rsu; float* rsq; float* rskv;
    __device__ __forceinline__ void operator()(const f32x4 (&acc)[2][2][4][2], const Unit& u, int wr, int wc, int fr, int fq) const {
        const int row0 = u.pm * BM + wr * 64 + fr, col0 = u.pn * BM + wc * 32 + 8 * fq;
        float sc[2][4]; row_scales8(rsu, row0, sc);
#pragma unroll
        for (int ai = 0; ai < 2; ++ai)
#pragma unroll
            for (int m = 0; m < 4; ++m) { const int row = row0 + ai * HALF + m * 16; const float s = sc[ai][m]; float ssb[2];
#pragma unroll
                for (int bj = 0; bj < 2; ++bj) { const float sq = (u.pn < 3 || u.pn == 9 || (u.pn == 10 && bj == 0)) ? s * QSCALE64 : s;
                    const f32x4 v0 = acc[ai][bj][m][0] * sq, v1 = acc[ai][bj][m][1] * sq;
                    u32x4 w; w.x = cvt_pk_bf16(v0[0], v0[1]); w.y = cvt_pk_bf16(v0[2], v0[3]); w.z = cvt_pk_bf16(v1[0], v1[1]); w.w = cvt_pk_bf16(v1[2], v1[3]);
                    *(u32x4*)(O + (size_t)row * PP + col0 + bj * HALF) = w;
                    ssb[bj] = ((v0[0] * v0[0] + v0[1] * v0[1]) + (v0[2] * v0[2] + v0[3] * v0[3])) + ((v1[0] * v1[0] + v1[1] * v1[1]) + (v1[2] * v1[2] + v1[3] * v1[3])); }
                if (u.pn == 14) { float ss = ssb[0] + ssb[1]; ss += __shfl_xor(ss, 16); ss += __shfl_xor(ss, 32); if (fq == 0) rsq[(size_t)row * 4 + wc] = ss; }
                if (u.pn == 13) { float ss = ssb[1]; ss += __shfl_xor(ss, 16); ss += __shfl_xor(ss, 32); if (fq == 0) rskv[(size_t)row * 4 + wc] = ss; } }
    }
};
struct EpiQup { static constexpr bool PERM = false, AFTER_DRAIN = false;
    bf16_t* Q; const float* rsq; const float* cosT; const float* sinT;
    __device__ __forceinline__ void operator()(const f32x4 (&acc)[2][2][4][2], const Unit& u, int wr, int wc, int fr, int fq) const {
        const int row0 = u.pm * BM + wr * 64 + fr;
#pragma unroll
        for (int bj = 0; bj < 2; ++bj) { const int c32 = u.pn * BM + bj * HALF + wc * 32; if (c32 >= 576) continue; const bool rope = (c32 % 96) == 64;
#pragma unroll
            for (int ai = 0; ai < 2; ++ai)
#pragma unroll
                for (int m = 0; m < 4; ++m) { const int row = row0 + ai * HALF + m * 16; const float s = row_scale<4>(rsq, row, 1.0f / 256.0f) * QSCALE96;
                    f32x4 v0 = acc[ai][bj][m][0] * s, v1 = acc[ai][bj][m][1] * s;
                    if (rope) { const int pos = row & (SEQ - 1); const f32x4 cs = *(const f32x4*)(cosT + pos * 16 + 4 * fq), sn = *(const f32x4*)(sinT + pos * 16 + 4 * fq);
                        const f32x4 o0 = v0 * cs - v1 * sn, o1 = v0 * sn + v1 * cs; v0 = o0; v1 = o1; }
                    u32x2 w0, w1; w0.x = cvt_pk_bf16(v0[0], v0[1]); w0.y = cvt_pk_bf16(v0[2], v0[3]); w1.x = cvt_pk_bf16(v1[0], v1[1]); w1.y = cvt_pk_bf16(v1[2], v1[3]);
                    bf16_t* p = Q + (size_t)row * 576 + c32 + 4 * fq; *(u32x2*)p = w0; *(u32x2*)(p + 16) = w1; } }
    }
};
struct EpiKVup { static constexpr bool PERM = true, AFTER_DRAIN = false;
    bf16_t* Kn; bf16_t* Vm; const float* rskv;
    __device__ __forceinline__ void operator()(const f32x4 (&acc)[2][2][4][2], const Unit& u, int wr, int wc, int fr, int fq) const {
        const int row0 = u.pm * BM + wr * 64 + fr;
#pragma unroll
        for (int bj = 0; bj < 2; ++bj) { const int h = 2 * u.pn + bj; bf16_t* dst = (wc < 2 ? Kn + h * 64 + wc * 32 : Vm + h * 64 + (wc - 2) * 32) + 8 * fq;
#pragma unroll
            for (int ai = 0; ai < 2; ++ai)
#pragma unroll
                for (int m = 0; m < 4; ++m) { const int row = row0 + ai * HALF + m * 16; const float s = row_scale<4>(rskv, row, 1.0f / 128.0f);
                    const f32x4 v0 = acc[ai][bj][m][0] * s, v1 = acc[ai][bj][m][1] * s;
                    u32x4 w; w.x = cvt_pk_bf16(v0[0], v0[1]); w.y = cvt_pk_bf16(v0[2], v0[3]); w.z = cvt_pk_bf16(v1[0], v1[1]); w.w = cvt_pk_bf16(v1[2], v1[3]);
                    *(u32x4*)(dst + (size_t)row * 384) = w; } }
    }
};
struct EpiGate { static constexpr bool PERM = true, AFTER_DRAIN = false;
    bf16_t* O; const u64* rsu;
    __device__ __forceinline__ void operator()(const f32x4 (&acc)[2][2][4][2], const Unit& u, int wr, int wc, int fr, int fq) const {
        const int row0 = u.pm * BM + wr * 64 + fr, col0 = u.pn * BM + wc * 32 + 8 * fq;
        float sc[2][4]; row_scales8(rsu, row0, sc);
#pragma unroll
        for (int ai = 0; ai < 2; ++ai)
#pragma unroll
            for (int m = 0; m < 4; ++m) { const int row = row0 + ai * HALF + m * 16; const float s = sc[ai][m];
#pragma unroll
                for (int bj = 0; bj < 2; ++bj) { float y[8];
#pragma unroll
                    for (int n = 0; n < 2; ++n)
#pragma unroll
                        for (int j = 0; j < 4; ++j) y[4 * n + j] = sigm_f(acc[ai][bj][m][n][j] * s);
                    u32x4 w; w.x = cvt_pk_bf16(y[0], y[1]); w.y = cvt_pk_bf16(y[2], y[3]); w.z = cvt_pk_bf16(y[4], y[5]); w.w = cvt_pk_bf16(y[6], y[7]);
                    *(u32x4*)(O + (size_t)row * 3072 + col0 + bj * HALF) = w; } }
    }
};
struct EpiMerge { static constexpr bool PERM = true, AFTER_DRAIN = false;
    const bf16_t* G; bf16_t* Mg; int first;
    __device__ __forceinline__ void operator()(const f32x4 (&acc)[2][2][4][2], const Unit& u, int wr, int wc, int fr, int fq) const {
        const int row0 = u.pm * BM + wr * 64 + fr, col0 = u.pn * BM + wc * 32 + 8 * fq;
#pragma unroll
        for (int ai = 0; ai < 2; ++ai) {
            u32x4 gv[4][2], pv[4][2];
#pragma unroll
            for (int m = 0; m < 4; ++m)
#pragma unroll
                for (int bj = 0; bj < 2; ++bj) { const int row = row0 + ai * HALF + m * 16; gv[m][bj] = *(const u32x4*)(G + (size_t)row * 3072 + col0 + bj * HALF);
                    pv[m][bj] = (u32x4){0u, 0u, 0u, 0u}; if (!first) pv[m][bj] = *(const u32x4*)(Mg + (size_t)row * DM + col0 + bj * HALF); }
#pragma unroll
            for (int m = 0; m < 4; ++m)
#pragma unroll
                for (int bj = 0; bj < 2; ++bj) { const int row = row0 + ai * HALF + m * 16; const u32x4 g = gv[m][bj], p = pv[m][bj];
                    const f32x4 a0 = acc[ai][bj][m][0], a1 = acc[ai][bj][m][1];
                    u32x4 w;
                    w.x = cvt_pk_bf16(bflo(p.x) + bflo(g.x) * a0[0], bfhi(p.x) + bfhi(g.x) * a0[1]);
                    w.y = cvt_pk_bf16(bflo(p.y) + bflo(g.y) * a0[2], bfhi(p.y) + bfhi(g.y) * a0[3]);
                    w.z = cvt_pk_bf16(bflo(p.z) + bflo(g.z) * a1[0], bfhi(p.z) + bfhi(g.z) * a1[1]);
                    w.w = cvt_pk_bf16(bflo(p.w) + bflo(g.w) * a1[2], bfhi(p.w) + bfhi(g.w) * a1[3]);
                    *(u32x4*)(Mg + (size_t)row * DM + col0 + bj * HALF) = w; }
        }
    }
};

template <class Epi, class Sched, bool ALIGN_EPI = false>
__device__ __forceinline__ void gemm_phase(PG8_LAS unsigned char* lds, const Gemm g, const Sched& S, const Epi& E, int tid_in) {
    int tid_ = tid_in; asm volatile("" : "+v"(tid_));
    const int tid = tid_, wid = __builtin_amdgcn_readfirstlane(tid >> 6), lane = tid & 63, wr = wid >> 2, wc = wid & 3, fr = lane & 15, fq = lane >> 4;
    int K = g.K; asm volatile("" : "+s"(K)); const int nt = K / BK;
    unsigned voffA[2], voffB[2];
#pragma unroll
    for (int i = 0; i < 2; ++i) { int R, C; stage_rc(tid * 16 + i * 8192, R, C); const int Rb = Epi::PERM ? ((R & ~31) + perm32(R & 31)) : R;
        voffA[i] = (unsigned)(R * g.lda + C) * 2u; voffB[i] = (unsigned)(Rb * g.ldb + C) * 2u; }
    const size_t kstep = (size_t)(BK * 2);
    const size_t hstepA = (size_t)HALF * g.lda * 2, hstepB = (size_t)HALF * g.ldb * 2;
    const size_t tstepA = 2 * hstepA, tstepB = 2 * hstepB;
    const unsigned ldsw = (unsigned)wid * 1024u;
    const int aoff = lds_byte(wr * 64 + fr, fq * 8), boff = lds_byte(wc * 32 + fr, fq * 8);
#define PG8_SA(b, h) (((b) * 2 + (h)) * HTB)
#define PG8_SB(b, h) ((4 + (b) * 2 + (h)) * HTB)
#define PG8_STAGE(bufoff, gbase, voff) do { _Pragma("unroll") for (int _i = 0; _i < 2; ++_i) \
        __builtin_amdgcn_global_load_lds((const unsigned*)((const char*)(gbase) + (voff)[_i]), (PG8_LAS unsigned*)(lds + (bufoff) + ldsw + _i * 8192), 16, 0, 0); } while (0)
#define PG8_LDA(dst, b, h) do { _Pragma("unroll") for (int m = 0; m < 4; ++m) _Pragma("unroll") for (int k = 0; k < 2; ++k) dst[m][k] = *(const PG8_LAS bf16x8*)(lds + PG8_SA(b, h) + aoff + m * 2048 + k * 1024); } while (0)
#define PG8_LDB(dst, b, h) do { _Pragma("unroll") for (int n = 0; n < 2; ++n) _Pragma("unroll") for (int k = 0; k < 2; ++k) dst[n][k] = *(const PG8_LAS bf16x8*)(lds + PG8_SB(b, h) + boff + n * 2048 + k * 1024); } while (0)
#define PG8_MMA(ai, bj, At, Bt) do { __builtin_amdgcn_s_setprio(1); _Pragma("unroll") for (int m = 0; m < 4; ++m) _Pragma("unroll") for (int n = 0; n < 2; ++n) _Pragma("unroll") for (int k = 0; k < 2; ++k) \
        acc[ai][bj][m][n] = __builtin_amdgcn_mfma_f32_16x16x32_bf16(Bt[n][k], At[m][k], acc[ai][bj][m][n], 0, 0, 0); __builtin_amdgcn_s_setprio(0); } while (0)
#define PG8_WAIT_V(n) asm volatile("s_waitcnt vmcnt(" #n ")" ::: "memory")
#define PG8_WAIT_L(n) asm volatile("s_waitcnt lgkmcnt(" #n ")" ::: "memory")
#define PG8_BAR __builtin_amdgcn_s_barrier()
#define PG8_SCHED __builtin_amdgcn_sched_barrier(0)
    Unit cur, nxt; int ui = 0;
    if (!S.next(0, cur)) return;
    f32x4 acc[2][2][4][2];
#pragma unroll
    for (int a = 0; a < 2; ++a)
#pragma unroll
        for (int b = 0; b < 2; ++b)
#pragma unroll
            for (int m = 0; m < 4; ++m)
#pragma unroll
                for (int n = 0; n < 2; ++n) acc[a][b][m][n] = (f32x4){0.f, 0.f, 0.f, 0.f};
    bf16x8 At[4][2], B0[2][2], B1[2][2];
    const char* cA = (const char*)g.A + (size_t)cur.pm * tstepA; const char* cB = (const char*)g.Bt + (size_t)cur.pn * tstepB;
    S.a_ready(cur);
    PG8_STAGE(PG8_SB(0, 0), cB, voffB); PG8_STAGE(PG8_SB(0, 1), cB + hstepB, voffB); PG8_STAGE(PG8_SA(0, 0), cA, voffA); PG8_STAGE(PG8_SA(0, 1), cA + hstepA, voffA);
    if (wr == 1) PG8_BAR;
    PG8_WAIT_V(2); PG8_BAR;
    PG8_STAGE(PG8_SB(1, 0), cB + kstep, voffB); PG8_STAGE(PG8_SA(1, 0), cA + kstep, voffA); PG8_STAGE(PG8_SB(1, 1), cB + hstepB + kstep, voffB);
    PG8_WAIT_V(6); PG8_BAR;
    for (;;) {
        const bool has_next = S.next(ui + 1, nxt);
        const char* nA = has_next ? (const char*)g.A + (size_t)nxt.pm * tstepA : cA; const char* nB = has_next ? (const char*)g.Bt + (size_t)nxt.pn * tstepB : cB;
        for (int t = 0; t < nt; t += 2) {
            const bool last = (t == nt - 2);
            const char* a1 = cA + (size_t)(t + 1) * kstep;
            const char* a2 = last ? nA : cA + (size_t)(t + 2) * kstep; const char* b2 = last ? nB : cB + (size_t)(t + 2) * kstep;
            const char* a3 = a2 + kstep; const char* b3 = b2 + kstep;
            if (last && has_next) S.a_ready(nxt);
            PG8_LDB(B0, 0, 0); PG8_LDB(B1, 0, 1); PG8_SCHED; PG8_LDA(At, 0, 0); PG8_STAGE(PG8_SA(1, 1), a1 + hstepA, voffA);
            PG8_WAIT_V(8); PG8_WAIT_L(0); PG8_BAR; PG8_MMA(0, 0, At, B0); PG8_MMA(0, 1, At, B1); PG8_BAR; PG8_SCHED;
            PG8_LDA(At, 0, 1); PG8_STAGE(PG8_SB(0, 0), b2, voffB); PG8_STAGE(PG8_SB(0, 1), b2 + hstepB, voffB); PG8_STAGE(PG8_SA(0, 0), a2, voffA);
            PG8_WAIT_V(8); PG8_WAIT_L(0); PG8_BAR; PG8_MMA(1, 0, At, B0); PG8_MMA(1, 1, At, B1); PG8_BAR; PG8_SCHED;
            PG8_LDB(B0, 1, 0); PG8_LDB(B1, 1, 1); PG8_SCHED; PG8_LDA(At, 1, 0); PG8_STAGE(PG8_SA(0, 1), a2 + hstepA, voffA);
            PG8_WAIT_V(8); PG8_WAIT_L(0); PG8_BAR; PG8_MMA(0, 0, At, B0); PG8_MMA(0, 1, At, B1); PG8_BAR; PG8_SCHED;
            PG8_LDA(At, 1, 1); PG8_STAGE(PG8_SB(1, 0), b3, voffB); PG8_STAGE(PG8_SB(1, 1), b3 + hstepB, voffB); PG8_STAGE(PG8_SA(1, 0), a3, voffA);
            PG8_WAIT_V(8); PG8_WAIT_L(0); PG8_BAR; PG8_MMA(1, 0, At, B0); PG8_MMA(1, 1, At, B1); PG8_BAR; PG8_SCHED;
        }
        if constexpr (ALIGN_EPI) { if (wr == 0) PG8_BAR; }
        E(acc, cur, wr, wc, fr, fq); S.done(cur);
        if (!has_next) break;
#pragma unroll
        for (int a = 0; a < 2; ++a)
#pragma unroll
            for (int b = 0; b < 2; ++b)
#pragma unroll
                for (int m = 0; m < 4; ++m)
#pragma unroll
                    for (int n = 0; n < 2; ++n) acc[a][b][m][n] = (f32x4){0.f, 0.f, 0.f, 0.f};
        cur = nxt; cA = nA; cB = nB; ++ui;
        if constexpr (ALIGN_EPI) { if (wr == 1) PG8_BAR; }
    }
    PG8_WAIT_V(0);
    if constexpr (!ALIGN_EPI) { if (wr == 0) PG8_BAR; }
    PG8_BAR;
#undef PG8_SA
#undef PG8_SB
#undef PG8_STAGE
#undef PG8_LDA
#undef PG8_LDB
#undef PG8_MMA
#undef PG8_WAIT_V
#undef PG8_WAIT_L
#undef PG8_BAR
#undef PG8_SCHED
}
}

constexpr int NWAVES = 8;
constexpr size_t MiB = 1u << 20;
constexpr size_t WS_CTL = 0, CTL_ZERO_BYTES = 6 * MiB;
constexpr size_t WS_ROPE = 1 * MiB;
constexpr size_t WS_KMEAN = WS_ROPE + 512 * 1024;
constexpr size_t WS_RS = 2 * MiB;
constexpr size_t WS_RSQ = 6 * MiB;
constexpr size_t WS_RSKV = WS_RSQ + 512 * 1024;
constexpr size_t WS_W = 7 * MiB;
constexpr size_t W_GU1 = 0, W_D1 = W_GU1 + (size_t)5632 * 1024 * 2, W_IN = W_D1 + (size_t)1024 * 2816 * 2, W_G = W_IN + (size_t)4096 * 1024 * 2,
                 W_UQ = W_G + (size_t)3072 * 1024 * 2, W_UKV = W_UQ + (size_t)768 * 256 * 2, W_BR = W_UKV + (size_t)768 * 256 * 2, W_OUT = W_BR + (size_t)1024 * 1024 * 2,
                 W_GU2 = W_OUT + (size_t)1024 * 1024 * 2, W_D2 = W_GU2 + (size_t)5632 * 1024 * 2, W_END = W_D2 + (size_t)1024 * 2816 * 2;
static_assert(W_END <= 52 * MiB, "weights region");
constexpr size_t WS_XB = 59 * MiB;
constexpr size_t WS_PROJ = 123 * MiB;
constexpr size_t WS_QM = 379 * MiB;
constexpr size_t WS_KN = 415 * MiB;
constexpr size_t WS_VM = 439 * MiB;
constexpr size_t WS_KR = 463 * MiB;
constexpr size_t WS_MG = WS_QM;
constexpr size_t WS_AO = 465 * MiB;
constexpr size_t WS_LSE = 529 * MiB;
constexpr size_t WS_END = 531 * MiB;
static_assert(WS_RS + (size_t)13 * T * 8 <= WS_RSQ && WS_RSQ + MiB <= WS_W && WS_W + 52 * MiB <= WS_XB && WS_RSQ <= CTL_ZERO_BYTES + 0 * MiB + WS_RSQ, "d_ws map");
constexpr int CW_BAR = 4096;
constexpr int CW_QUEUE = 8192;

constexpr int RING_OFF = 0, RING_BYTES = 131072;
constexpr int LDSCTL_OFF = RING_BYTES, MISC_OFF = LDSCTL_OFF + 320;
constexpr int LDS_BYTES = 147456;

#define GAS __attribute__((address_space(1)))
#define LAS __attribute__((address_space(3)))
typedef unsigned short bf16;
typedef unsigned v4u __attribute__((ext_vector_type(4)));
typedef unsigned v2u __attribute__((ext_vector_type(2)));
typedef float f32x4 __attribute__((ext_vector_type(4)));
typedef GAS unsigned gu32;
#define RLX_AGENT __ATOMIC_RELAXED, __HIP_MEMORY_SCOPE_AGENT
#define LDS_WAIT() asm volatile("s_waitcnt lgkmcnt(0)" ::: "memory")
__device__ __forceinline__ unsigned f2bf(float f) { unsigned u = __builtin_bit_cast(unsigned, f); return (u + 0x7fffu + ((u >> 16) & 1u)) >> 16; }
__device__ __forceinline__ unsigned pk2(float lo, float hi) { return f2bf(lo) | (f2bf(hi) << 16); }
__device__ __forceinline__ float bflo(unsigned w) { return __uint_as_float(w << 16); }
__device__ __forceinline__ float bfhi(unsigned w) { return __uint_as_float(w & 0xffff0000u); }

#define XB_TMO      128
#define XB_XCNT(j)  (256  + 64 * (j))
#define XB_XSUB(j)  (1280 + 64 * (j))
#define XB_XGEN(j)  (2304 + 64 * (j))
#define XB_TOP      3328
#define XB_TOPGEN   3392
#define XCD_BAR_WORDS 3456
#define XB_SPIN_CAP (1u << 20)

__device__ __forceinline__ unsigned xb_ld(unsigned* p)              { return __hip_atomic_load(p, __ATOMIC_RELAXED, __HIP_MEMORY_SCOPE_AGENT); }
__device__ __forceinline__ unsigned xb_add(unsigned* p, unsigned v) { return __hip_atomic_fetch_add(p, v, __ATOMIC_RELAXED, __HIP_MEMORY_SCOPE_AGENT); }
__device__ __forceinline__ unsigned xb_xcc_id() { return (unsigned)__builtin_amdgcn_s_getreg((3 << 11) | 20) & 0xFu; }
#define XB_SPIN(cond, bar) do { unsigned _sp = 0; while (cond) { __builtin_amdgcn_s_sleep(1); \
    if ((++_sp & 255u) == 0u) { if (xb_ld(&(bar)[XB_TMO])) break; if (_sp > XB_SPIN_CAP) { atomicAdd(&(bar)[XB_TMO], 1u); break; } } } } while (0)

struct XcdBarrier { unsigned* bar; unsigned x; volatile LAS unsigned* st; };

__device__ __forceinline__ XcdBarrier xcd_barrier_post(unsigned* bar, volatile LAS unsigned* st) {
    XcdBarrier b; b.bar = bar; b.x = xb_xcc_id(); b.st = st;
    if (threadIdx.x == 0) (void)xb_add(&bar[XB_XCNT(b.x)], 1u);
    return b;
}
__device__ __forceinline__ void xcd_barrier_complete(unsigned* bar, unsigned x, unsigned& nloc, unsigned& nx) {
    const unsigned G = gridDim.x * gridDim.y * gridDim.z;
    unsigned sum, cnt, mine, sp = 0u;
    for (;;) {
        sum = 0u; cnt = 0u; mine = 0u;
#pragma unroll
        for (unsigned j = 0; j < 16; ++j) { const unsigned c = xb_ld(&bar[XB_XCNT(j)]); sum += c; cnt += (c > 0u) ? 1u : 0u; mine = (j == x) ? c : mine; }
        if (sum == G) break;
        __builtin_amdgcn_s_sleep(1);
        if ((++sp & 255u) == 0u) { if (xb_ld(&bar[XB_TMO])) break; if (sp > XB_SPIN_CAP) { atomicAdd(&bar[XB_TMO], 1u); break; } }
    }
    nloc = mine > 0u ? mine : 1u; nx = cnt > 0u ? cnt : 1u;
}
__device__ __forceinline__ void xcd_barrier(const XcdBarrier& b, bool leader) {
    asm volatile("s_waitcnt vmcnt(0)" ::: "memory");
    __syncthreads();
    if (leader) {
        unsigned* bar = b.bar;
        __builtin_amdgcn_s_waitcnt(0);
        unsigned nloc = b.st[0], nx = b.st[1];
        if (nloc == 0u) { xcd_barrier_complete(bar, b.x, nloc, nx); b.st[0] = nloc; b.st[1] = nx; }
        const unsigned old = xb_add(&bar[XB_XSUB(b.x)], 1u);
        const unsigned gen = old / nloc;
        if (old + 1u == (gen + 1u) * nloc) {
            __builtin_amdgcn_fence(__ATOMIC_RELEASE, "agent");
            asm volatile("s_waitcnt vmcnt(0)" ::: "memory");
            const unsigned og = xb_add(&bar[XB_TOP], 1u);
            const unsigned tg = og / nx;
            if (og + 1u == (tg + 1u) * nx) xb_add(&bar[XB_TOPGEN], 1u);
            else XB_SPIN(xb_ld(&bar[XB_TOPGEN]) == tg, bar);
            __builtin_amdgcn_fence(__ATOMIC_ACQUIRE, "agent");
            xb_add(&bar[XB_XGEN(b.x)], 1u);
            asm volatile("s_waitcnt vmcnt(0)" ::: "memory");
        } else {
            XB_SPIN(xb_ld(&bar[XB_XGEN(b.x)]) == gen, bar);
            __builtin_amdgcn_fence(__ATOMIC_ACQUIRE, "agent");
            asm volatile("s_waitcnt vmcnt(0)" ::: "memory");
        }
    }
    __syncthreads();
}

__device__ __forceinline__ float wave_sum(float v) {
#pragma unroll
    for (int o = 1; o < 64; o <<= 1) v += __shfl_xor(v, o);
    return v;
}
__device__ __forceinline__ void cvt_item(const float* W, int N, const float* gain, bf16* WT, int dpitch, int dkoff, int k0, int n0, int drow0, LAS float* scr, int lane) {
#pragma unroll 8
    for (int i = 0; i < 32; ++i) { const int kk = 2 * i + (lane >> 5); float v = W[(size_t)(k0 + kk) * N + n0 + (lane & 31)]; if (gain) v *= gain[k0 + kk]; scr[kk * 33 + (lane & 31)] = v; }
    LDS_WAIT(); asm volatile("" ::: "memory");
    const int c = lane & 7;
#pragma unroll
    for (int j = 0; j < 4; ++j) { const int n = (lane >> 3) + 8 * j; const LAS float* s = scr + (8 * c) * 33 + n;
        v4u o; o.x = pk2(s[0 * 33], s[1 * 33]); o.y = pk2(s[2 * 33], s[3 * 33]); o.z = pk2(s[4 * 33], s[5 * 33]); o.w = pk2(s[6 * 33], s[7 * 33]);
        *(GAS v4u*)(WT + (size_t)(drow0 + n) * dpitch + dkoff + k0 + 8 * c) = o; }
    LDS_WAIT(); asm volatile("" ::: "memory");
}
template <class RowMap>
__device__ __forceinline__ void cvt_matrix(const float* W, int K, int N, const float* gain, bf16* WT, int dpitch, int dkoff, const RowMap& RM, LAS float* scr, int gw, int NGW, int lane, int& base) {
    const int nblk = N / 32, nit = (K / 64) * nblk;
    int first = gw - (base % NGW); if (first < 0) first += NGW;
    for (int it = first; it < nit; it += NGW) { const int kb = it / nblk, nb = it % nblk; cvt_item(W, N, gain, WT, dpitch, dkoff, 64 * kb, 32 * nb, RM(32 * nb), scr, lane); }
    base += nit;
}
struct RmId { __device__ __forceinline__ int operator()(int n0) const { return n0; } };
struct RmGU { int add; __device__ __forceinline__ int operator()(int n0) const { return 256 * (n0 / 128) + (n0 % 128) + add; } };
struct RmIn { __device__ __forceinline__ int operator()(int n0) const {
    if (n0 < 256) return PC_CQ + n0; if (n0 < 384) return PC_CKV + (n0 - 256); if (n0 < 416) return PC_KR + (n0 - 384); if (n0 < 1568) return PC_MQ + (n0 - 416); if (n0 < 3872) return PC_DQ + (n0 - 1568);
    return 4096 + (n0 - 3872); } };
static_assert(W_G == W_IN + (size_t)4096 * 1024 * 2, "gate weights follow w_in");

__device__ __forceinline__ int OPQ_S(int v) { asm volatile("" : "+s"(v)); return v; }
struct Frame {
    LAS unsigned char* lds; volatile LAS unsigned* MISC; gu32* ctl;
};

__device__ __forceinline__ void ld8(const bf16* p, float* f) { const v4u w = *(const v4u*)p; f[0] = bflo(w.x); f[1] = bfhi(w.x); f[2] = bflo(w.y); f[3] = bfhi(w.y); f[4] = bflo(w.z); f[5] = bfhi(w.z); f[6] = bflo(w.w); f[7] = bfhi(w.w); }
__device__ __forceinline__ float dot8(const bf16* p, const float* q) { const v4u w = *(const v4u*)p;
    return ((q[0] * bflo(w.x) + q[1] * bfhi(w.x)) + (q[2] * bflo(w.y) + q[3] * bfhi(w.y))) + ((q[4] * bflo(w.z) + q[5] * bfhi(w.z)) + (q[6] * bflo(w.w) + q[7] * bfhi(w.w))); }
__device__ __forceinline__ void axpy8(const bf16* p, float a, float c, float* o) { const v4u w = *(const v4u*)p;
    o[0] = o[0] * c + a * bflo(w.x); o[1] = o[1] * c + a * bfhi(w.x); o[2] = o[2] * c + a * bflo(w.y); o[3] = o[3] * c + a * bfhi(w.y);
    o[4] = o[4] * c + a * bflo(w.z); o[5] = o[5] * c + a * bfhi(w.z); o[6] = o[6] * c + a * bflo(w.w); o[7] = o[7] * c + a * bfhi(w.w); }
__device__ __forceinline__ void st8(bf16* p, const float* o, float s) { v4u w; w.x = pk2(o[0] * s, o[1] * s); w.y = pk2(o[2] * s, o[3] * s); w.z = pk2(o[4] * s, o[5] * s); w.w = pk2(o[6] * s, o[7] * s); *(v4u*)p = w; }

__device__ __forceinline__ void mla_naive_chunk(const bf16* Qm, const bf16* Kn, const bf16* KR, const bf16* Vm, bf16* AO, int b, int h, int chunk, int lane) {
    const int t = chunk * 64 + lane; const size_t rowb = (size_t)b * SEQ;
    float q[96];
#pragma unroll
    for (int c = 0; c < 12; ++c) ld8(Qm + (rowb + t) * 576 + h * 96 + 8 * c, q + 8 * c);
    float m = -1e30f, l = 0.f; float o[64];
#pragma unroll
    for (int d = 0; d < 64; ++d) o[d] = 0.f;
    const int jmax = chunk * 64 + 63;
    for (int j = 0; j <= jmax; ++j) {
        const bf16* kp = Kn + (rowb + j) * 384 + h * 64; const bf16* rp = KR + (rowb + j) * 32; const bf16* vp = Vm + (rowb + j) * 384 + h * 64;
        float s = 0.f;
#pragma unroll
        for (int c = 0; c < 8; ++c) s += dot8(kp + 8 * c, q + 8 * c);
#pragma unroll
        for (int c = 0; c < 4; ++c) s += dot8(rp + 8 * c, q + 64 + 8 * c);
        if (j <= t) { const float mn = fmaxf(m, s), corr = exp2f(m - mn), p = exp2f(s - mn); l = l * corr + p; m = mn;
#pragma unroll
            for (int c = 0; c < 8; ++c) axpy8(vp + 8 * c, p, corr, o + 8 * c); }
    }
    const float inv = 1.0f / l;
#pragma unroll
    for (int c = 0; c < 8; ++c) st8(AO + (rowb + t) * DM + h * 64 + 8 * c, o + 8 * c, inv);
}

__device__ __forceinline__ void moba_naive_chunk(const bf16* proj, const float* kmean, bf16* AO, int b, int h, int chunk, int lane) {
    const int t = chunk * 64 + lane; const size_t rowb = (size_t)b * SEQ; const int b_own = chunk >> 2;
    float q[64];
#pragma unroll
    for (int c = 0; c < 8; ++c) ld8(proj + (rowb + t) * PP + PC_MQ + h * 64 + 8 * c, q + 8 * c);
    const float slope = exp2f(-8.0f * (float)(12 + h + 1) / 18.0f) * LOG2E;
    float v1 = -3e38f, v2 = -3e38f, v3 = -3e38f; int i1 = -1, i2 = -1, i3 = -1;
    for (int n = 0; n < b_own; ++n) { const float* km = kmean + ((size_t)(b * 6 + h) * 16 + n) * 64; float g = 0.f;
#pragma unroll
        for (int c = 0; c < 16; ++c) { const f32x4 k4 = *(const f32x4*)(km + 4 * c); g += (q[4 * c] * k4[0] + q[4 * c + 1] * k4[1]) + (q[4 * c + 2] * k4[2] + q[4 * c + 3] * k4[3]); }
        if (g > v1) { v3 = v2; i3 = i2; v2 = v1; i2 = i1; v1 = g; i1 = n; } else if (g > v2) { v3 = v2; i3 = i2; v2 = g; i2 = n; } else if (g > v3) { v3 = g; i3 = n; } }
    unsigned sel = 0u; if (i1 >= 0) sel |= 1u << i1; if (i2 >= 0) sel |= 1u << i2; if (i3 >= 0) sel |= 1u << i3;
    float m = -1e30f, l = 0.f; float o[64];
#pragma unroll
    for (int d = 0; d < 64; ++d) o[d] = 0.f;
    for (int n = 0; n < b_own; ++n) { const bool mine = (sel >> n) & 1u; if (!__any(mine)) continue;
        for (int kk = 0; kk < 256; ++kk) { const int kpos = n * 256 + kk; const bf16* kp = proj + (rowb + kpos) * PP + PC_MK + h * 64; const bf16* vp = proj + (rowb + kpos) * PP + PC_MV + h * 64;
            float s = 0.f;
#pragma unroll
            for (int c = 0; c < 8; ++c) s += dot8(kp + 8 * c, q + 8 * c);
            s = s - slope * (float)(t - kpos);
            if (mine) { const float mn = fmaxf(m, s), corr = exp2f(m - mn), p = exp2f(s - mn); l = l * corr + p; m = mn;
#pragma unroll
                for (int c = 0; c < 8; ++c) axpy8(vp + 8 * c, p, corr, o + 8 * c); } } }
    for (int kpos = b_own * 256; kpos <= chunk * 64 + 63; ++kpos) { const bf16* kp = proj + (rowb + kpos) * PP + PC_MK + h * 64; const bf16* vp = proj + (rowb + kpos) * PP + PC_MV + h * 64;
        float s = 0.f;
#pragma unroll
        for (int c = 0; c < 8; ++c) s += dot8(kp + 8 * c, q + 8 * c);
        s = s - slope * (float)(t - kpos);
        if (kpos <= t) { const float mn = fmaxf(m, s), corr = exp2f(m - mn), p = exp2f(s - mn); l = l * corr + p; m = mn;
#pragma unroll
            for (int c = 0; c < 8; ++c) axpy8(vp + 8 * c, p, corr, o + 8 * c); } }
    const float inv = 1.0f / l;
#pragma unroll
    for (int c = 0; c < 8; ++c) st8(AO + (rowb + t) * DM + 384 + h * 64 + 8 * c, o + 8 * c, inv);
}

__device__ __forceinline__ void dil_naive_thread(const bf16* proj, bf16* AO, int b, int hg, int t) {
    const size_t rowb = (size_t)b * SEQ;
    float m = -1e30f, l = 0.f; float o[64];
#pragma unroll
    for (int d = 0; d < 64; ++d) o[d] = 0.f;
    for (int g = 0; g < 3; ++g) { const int h = g * 4 + hg, dil = (g == 0) ? 1 : (g == 1) ? 4 : 16; const float slope = exp2f(-8.0f * (float)(h + 1) / 18.0f) * LOG2E;
        float q[64];
#pragma unroll
        for (int c = 0; c < 8; ++c) ld8(proj + (rowb + t) * PP + PC_DQ + h * 64 + 8 * c, q + 8 * c);
        for (int j = 0; j <= 128; ++j) { const int kpos = t - j * dil;
            if (kpos >= 0) { const bf16* kp = proj + (rowb + kpos) * PP + PC_DK + h * 64; const bf16* vp = proj + (rowb + kpos) * PP + PC_DV + h * 64;
                float s = 0.f;
#pragma unroll
                for (int c = 0; c < 8; ++c) s += dot8(kp + 8 * c, q + 8 * c);
                s = s - slope * (float)(j * dil);
                const float mn = fmaxf(m, s), corr = exp2f(m - mn), p = exp2f(s - mn); l = l * corr + p; m = mn;
#pragma unroll
                for (int c = 0; c < 8; ++c) axpy8(vp + 8 * c, p, corr, o + 8 * c); } } }
    const float inv = 1.0f / l;
#pragma unroll
    for (int c = 0; c < 8; ++c) st8(AO + (rowb + t) * DM + 768 + hg * 64 + 8 * c, o + 8 * c, inv);
}

namespace fa {
typedef float f32x16 __attribute__((ext_vector_type(16)));
typedef short bf16x8 __attribute__((ext_vector_type(8)));
typedef short s16x4 __attribute__((ext_vector_type(4)));
#define FLAS __attribute__((address_space(3)))
constexpr float NEG = -1.0e30f, POS = 1.0e30f;
__device__ __forceinline__ int crow(int r, int hi) { return (r & 3) + 8 * (r >> 2) + 4 * hi; }
__device__ __forceinline__ float xmax(float v) { auto rr = __builtin_amdgcn_permlane32_swap(__float_as_uint(v), __float_as_uint(v), false, false); return fmaxf(__uint_as_float(rr[0]), __uint_as_float(rr[1])); }
__device__ __forceinline__ float xsum(float v) { auto rr = __builtin_amdgcn_permlane32_swap(__float_as_uint(v), __float_as_uint(v), false, false); return __uint_as_float(rr[0]) + __uint_as_float(rr[1]); }
__device__ __forceinline__ float xother(float v, int hi) { auto rr = __builtin_amdgcn_permlane32_swap(__float_as_uint(v), __float_as_uint(v), false, false); return hi ? __uint_as_float(rr[0]) : __uint_as_float(rr[1]); }
__device__ __forceinline__ float max16(const f32x16& a) { float x = fmaxf(fmaxf(a[0], a[1]), fmaxf(a[2], a[3])), y = fmaxf(fmaxf(a[4], a[5]), fmaxf(a[6], a[7])), z = fmaxf(fmaxf(a[8], a[9]), fmaxf(a[10], a[11])), w = fmaxf(fmaxf(a[12], a[13]), fmaxf(a[14], a[15])); return fmaxf(fmaxf(x, y), fmaxf(z, w)); }
__device__ __forceinline__ bf16x8 pack8(const f32x16& p, int s8) {
    v4u w; w.x = pg8::cvt_pk_bf16(p[s8 + 0], p[s8 + 1]); w.y = pg8::cvt_pk_bf16(p[s8 + 2], p[s8 + 3]); w.z = pg8::cvt_pk_bf16(p[s8 + 4], p[s8 + 5]); w.w = pg8::cvt_pk_bf16(p[s8 + 6], p[s8 + 7]);
    return __builtin_bit_cast(bf16x8, w); }
#define FA_MFMA(a, b, c) __builtin_amdgcn_mfma_f32_32x32x16_bf16((a), (b), (c), 0, 0, 0)
template <int DK> __device__ __forceinline__ f32x16 qk_half(const FLAS char* krow, int hi, const bf16x8* qf, const f32x16& c) {
    f32x16 s = c;
#pragma unroll
    for (int d0 = 0; d0 < DK / 16; ++d0) { const bf16x8 kf = *(const FLAS bf16x8*)(krow + d0 * 32 + hi * 16); s = FA_MFMA(kf, qf[d0], s); }
    return s; }
__device__ __forceinline__ void pv_half(f32x16& o0, f32x16& o1, const FLAS char* vrow, int VP, int hi, const f32x16& p) {
#pragma unroll
    for (int s = 0; s < 2; ++s) { const bf16x8 pf = pack8(p, 8 * s);
        const FLAS char* v0 = vrow + (16 * s + 4 * hi) * 2; const FLAS char* v1 = v0 + 32 * VP;
        const s16x4 a0 = *(const FLAS s16x4*)v0, a1 = *(const FLAS s16x4*)(v0 + 16), b0 = *(const FLAS s16x4*)v1, b1 = *(const FLAS s16x4*)(v1 + 16);
        o0 = FA_MFMA(((bf16x8){a0[0], a0[1], a0[2], a0[3], a1[0], a1[1], a1[2], a1[3]}), pf, o0);
        o1 = FA_MFMA(((bf16x8){b0[0], b0[1], b0[2], b0[3], b1[0], b1[1], b1[2], b1[3]}), pf, o1); }
}
__device__ __forceinline__ void store_o(bf16* orow, const f32x16& o0, const f32x16& o1, float inv, int hi) {
#pragma unroll
    for (int g = 0; g < 4; ++g) { v2u w0, w1;
        w0.x = pg8::cvt_pk_bf16(o0[4 * g] * inv, o0[4 * g + 1] * inv); w0.y = pg8::cvt_pk_bf16(o0[4 * g + 2] * inv, o0[4 * g + 3] * inv);
        w1.x = pg8::cvt_pk_bf16(o1[4 * g] * inv, o1[4 * g + 1] * inv); w1.y = pg8::cvt_pk_bf16(o1[4 * g + 2] * inv, o1[4 * g + 3] * inv);
        *(v2u*)(orow + 8 * g + 4 * hi) = w0; *(v2u*)(orow + 32 + 8 * g + 4 * hi) = w1; }
}

template <int DK, bool MOBA>
__device__ __forceinline__ void flash_unit(FLAS char* lds, int tid, int b, int qb,
        const bf16* Qh, int qpitch, const bf16* Kh, int kpitch, const bf16* KRb, const bf16* Vh, int vpitch, bf16* Oh,
        const bf16* kmh, const bf16* kml, float slope2) {
    constexpr int KP = DK * 2 + 16, VP = 136, KBUF = 64 * KP, VBUF = 64 * VP;
    const int lane = tid & 63, w = __builtin_amdgcn_readfirstlane(tid >> 6), r32 = lane & 31, hi = lane >> 5;
    const size_t rowb = (size_t)b * SEQ; const int q0 = qb * 256;
    bf16x8 qf[DK / 16];
    { const bf16* qp = Qh + (rowb + q0 + 32 * w + r32) * qpitch + 8 * hi;
#pragma unroll
      for (int d0 = 0; d0 < DK / 16; ++d0) qf[d0] = *(const bf16x8*)(qp + 16 * d0); }
    unsigned sel = 0u;
    f32x16 cinit;
#pragma unroll
    for (int r = 0; r < 16; ++r) cinit[r] = 0.f;
    if constexpr (MOBA) {
        f32x16 ga = cinit;
#pragma unroll
        for (int d0 = 0; d0 < 4; ++d0) { const bf16x8 ah = *(const bf16x8*)(kmh + (r32 & 15) * 64 + 16 * d0 + 8 * hi), al = *(const bf16x8*)(kml + (r32 & 15) * 64 + 16 * d0 + 8 * hi);
            ga = FA_MFMA(ah, qf[d0], ga); ga = FA_MFMA(al, qf[d0], ga); }
        float g[16];
#pragma unroll
        for (int i = 0; i < 8; ++i) { const float mine = ga[i], oth = xother(mine, hi); const float lo_ = hi ? oth : mine, hi_ = hi ? mine : oth;
            g[(i & 3) + 8 * (i >> 2)] = lo_; g[(i & 3) + 8 * (i >> 2) + 4] = hi_; }
        float v1 = -3e38f, v2 = -3e38f, v3 = -3e38f; int i1 = -1, i2 = -1, i3 = -1;
#pragma unroll
        for (int n = 0; n < 16; ++n) if (n < qb) { const float gv = g[n];
            if (gv > v1) { v3 = v2; i3 = i2; v2 = v1; i2 = i1; v1 = gv; i1 = n; } else if (gv > v2) { v3 = v2; i3 = i2; v2 = gv; i2 = n; } else if (gv > v3) { v3 = gv; i3 = n; } }
        if (i1 >= 0) sel |= 1u << i1; if (i2 >= 0) sel |= 1u << i2; if (i3 >= 0) sel |= 1u << i3;
#pragma unroll
        for (int r = 0; r < 16; ++r) cinit[r] = slope2 * (float)crow(r, hi);
    }
    const float c32 = MOBA ? 32.f * slope2 : 0.f;
    const int kkey = tid >> 3, kch = tid & 7, rkey = tid >> 2, rch = tid & 3;
    const bf16* ksrc = Kh + (rowb + kkey) * kpitch + kch * 8; const bf16* rsrc = (DK == 96) ? KRb + (rowb + rkey) * 32 + rch * 8 : nullptr; const bf16* vsrc = Vh + (rowb + lane) * vpitch + w * 8;
    FLAS char* kdst = lds + kkey * KP + kch * 16; FLAS char* rdst = lds + rkey * KP + 128 + rch * 16; FLAS char* vdst = lds + 2 * KBUF + (8 * w) * VP + lane * 2;
    v4u kreg, rreg, vreg; rreg = (v4u){0u, 0u, 0u, 0u};
    const int NT = 4 * (qb + 1);
#define FA_LOAD(t) do { kreg = *(const v4u*)(ksrc + (size_t)(t) * 64 * kpitch); if (DK == 96 && tid < 256) rreg = *(const v4u*)(rsrc + (size_t)(t) * 64 * 32); vreg = *(const v4u*)(vsrc + (size_t)(t) * 64 * vpitch); } while (0)
#define FA_STORE(buf) do { *(FLAS v4u*)(kdst + (buf) * KBUF) = kreg; if (DK == 96 && tid < 256) *(FLAS v4u*)(rdst + (buf) * KBUF) = rreg; \
        FLAS char* vd_ = vdst + (buf) * VBUF; \
        *(FLAS unsigned short*)(vd_ + 0 * VP) = (unsigned short)(vreg.x & 0xffffu); *(FLAS unsigned short*)(vd_ + 1 * VP) = (unsigned short)(vreg.x >> 16); \
        *(FLAS unsigned short*)(vd_ + 2 * VP) = (unsigned short)(vreg.y & 0xffffu); *(FLAS unsigned short*)(vd_ + 3 * VP) = (unsigned short)(vreg.y >> 16); \
        *(FLAS unsigned short*)(vd_ + 4 * VP) = (unsigned short)(vreg.z & 0xffffu); *(FLAS unsigned short*)(vd_ + 5 * VP) = (unsigned short)(vreg.z >> 16); \
        *(FLAS unsigned short*)(vd_ + 6 * VP) = (unsigned short)(vreg.w & 0xffffu); *(FLAS unsigned short*)(vd_ + 7 * VP) = (unsigned short)(vreg.w >> 16); } while (0)
    FA_LOAD(0); FA_STORE(0); __syncthreads();
    float m = NEG, l = 0.f; f32x16 o0, o1;
#pragma unroll
    for (int r = 0; r < 16; ++r) { o0[r] = 0.f; o1[r] = 0.f; }
    const int rowrel = 32 * w + r32;
    for (int t = 0; t < NT; ++t) {
        const int buf = t & 1;
        if (t + 1 < NT) FA_LOAD(t + 1);
        const int n = t >> 2, jd = t & 3; const bool diag = (n == qb);
        bool lane_on = true; if (MOBA && !diag) lane_on = (sel >> n) & 1u;
        bool wave_on = diag ? (64 * jd <= 32 * w + 31) : (MOBA ? (__any(lane_on) != 0) : true);
        if (wave_on) {
            const FLAS char* kt = lds + buf * KBUF + r32 * KP; const FLAS char* vt = lds + 2 * KBUF + buf * VBUF + r32 * VP;
            f32x16 s0 = qk_half<DK>(kt, hi, qf, cinit), s1 = qk_half<DK>(kt + 32 * KP, hi, qf, cinit);
            if (diag && (64 * jd + 63 > 32 * w)) {
#pragma unroll
                for (int r = 0; r < 16; ++r) { const int kr = 64 * jd + crow(r, hi); if (kr > rowrel) s0[r] = NEG; if (kr + 32 > rowrel) s1[r] = NEG; } }
            const float tb = MOBA ? slope2 * (float)(64 * t) : 0.f;
            float mx = xmax(fmaxf(max16(s0), max16(s1) + c32)) + tb;
            if (!lane_on) mx = NEG;
            const float mn = fmaxf(m, mx);
            if (__any(mn > m)) { const float a = __builtin_amdgcn_exp2f(m - mn); l *= a;
#pragma unroll
                for (int r = 0; r < 16; ++r) { o0[r] *= a; o1[r] *= a; }
                m = mn; }
            const float mref0 = lane_on ? (m - tb) : POS, mref1 = mref0 - c32;
            float ls = 0.f;
#pragma unroll
            for (int r = 0; r < 16; ++r) { s0[r] = __builtin_amdgcn_exp2f(s0[r] - mref0); s1[r] = __builtin_amdgcn_exp2f(s1[r] - mref1); ls += s0[r] + s1[r]; }
            l += ls;
            pv_half(o0, o1, vt, VP, hi, s0); pv_half(o0, o1, vt + 64, VP, hi, s1);
        }
        if (t + 1 < NT) FA_STORE(buf ^ 1);
        __syncthreads();
    }
#undef FA_LOAD
#undef FA_STORE
    const float lt = xsum(l);
    store_o(Oh + (rowb + q0 + 32 * w + r32) * DM, o0, o1, 1.0f / lt, hi);
}

__device__ __forceinline__ void dil_unit(FLAS char* lds, int tid, int b, int h, int dil, int res, int ch, bf16* proj, float* lse, float slope2d) {
    constexpr int KP = 144, VP = 776, VOFF = 384 * KP;
    const int lane = tid & 63, w = __builtin_amdgcn_readfirstlane(tid >> 6), r32 = lane & 31, hi = lane >> 5;
    const size_t rowb = (size_t)b * SEQ; const int m0 = 256 * ch;
#pragma unroll
    for (int i = 0; i < 6; ++i) { const int idx = tid + 512 * i, kk = idx >> 3, kch = idx & 7, mp = m0 - 128 + kk; v4u v = (v4u){0u, 0u, 0u, 0u};
        if (mp >= 0) v = *(const v4u*)(proj + (rowb + (size_t)mp * dil + res) * PP + PC_DK + h * 64 + kch * 8);
        *(FLAS v4u*)(lds + kk * KP + kch * 16) = v; }
#pragma unroll
    for (int i = 0; i < 6; ++i) { const int kk = 64 * i + lane, mp = m0 - 128 + kk; v4u v = (v4u){0u, 0u, 0u, 0u};
        if (mp >= 0) v = *(const v4u*)(proj + (rowb + (size_t)mp * dil + res) * PP + PC_DV + h * 64 + w * 8);
        FLAS char* vd = lds + VOFF + (8 * w) * VP + kk * 2;
        *(FLAS unsigned short*)(vd + 0 * VP) = (unsigned short)(v.x & 0xffffu); *(FLAS unsigned short*)(vd + 1 * VP) = (unsigned short)(v.x >> 16);
        *(FLAS unsigned short*)(vd + 2 * VP) = (unsigned short)(v.y & 0xffffu); *(FLAS unsigned short*)(vd + 3 * VP) = (unsigned short)(v.y >> 16);
        *(FLAS unsigned short*)(vd + 4 * VP) = (unsigned short)(v.z & 0xffffu); *(FLAS unsigned short*)(vd + 5 * VP) = (unsigned short)(v.z >> 16);
        *(FLAS unsigned short*)(vd + 6 * VP) = (unsigned short)(v.w & 0xffffu); *(FLAS unsigned short*)(vd + 7 * VP) = (unsigned short)(v.w >> 16); }
    const size_t qrow = rowb + (size_t)(m0 + 32 * w + r32) * dil + res;
    bf16x8 qf[4];
#pragma unroll
    for (int d0 = 0; d0 < 4; ++d0) qf[d0] = *(const bf16x8*)(proj + qrow * PP + PC_DQ + h * 64 + 16 * d0 + 8 * hi);
    f32x16 cinit;
#pragma unroll
    for (int r = 0; r < 16; ++r) cinit[r] = slope2d * (float)crow(r, hi);
    __syncthreads();
    f32x16 s[5]; float mx = NEG;
#pragma unroll
    for (int i = 0; i < 5; ++i) { s[i] = qk_half<64>(lds + (32 * (w + i) + r32) * KP, hi, qf, cinit);
        const bool dead = (ch == 0) && (w + i < 4);
#pragma unroll
        for (int r = 0; r < 16; ++r) { const int kr = crow(r, hi); bool ok = !dead; if (i == 0) ok = ok && (kr >= r32); if (i == 4) ok = ok && (kr <= r32); if (!ok) s[i][r] = NEG; }
        mx = fmaxf(mx, max16(s[i]) + (float)(32 * i) * slope2d); }
    mx = xmax(mx);
    float ls = 0.f; f32x16 o0, o1;
#pragma unroll
    for (int r = 0; r < 16; ++r) { o0[r] = 0.f; o1[r] = 0.f; }
#pragma unroll
    for (int i = 0; i < 5; ++i) { const float mref = mx - (float)(32 * i) * slope2d;
#pragma unroll
        for (int r = 0; r < 16; ++r) { s[i][r] = __builtin_amdgcn_exp2f(s[i][r] - mref); ls += s[i][r]; }
        pv_half(o0, o1, lds + VOFF + r32 * VP + (32 * (w + i)) * 2, VP, hi, s[i]); }
    const float lt = xsum(ls);
    if (hi == 0) lse[qrow * 12 + h] = mx + __builtin_amdgcn_logf(lt) - slope2d * (float)(r32 + 128);
    __syncthreads();
    store_o(proj + qrow * PP + PC_DQ + h * 64, o0, o1, 1.0f / lt, hi);
}
#undef FA_MFMA
}

struct Args { const float* in[20]; float* out; unsigned char* ws; int ph_lo, ph_hi; };
constexpr int PH_PER_LAYER = 11, N_PHASES = 1 + DEPTH * PH_PER_LAYER + 1;

__global__ void __launch_bounds__(NWAVES * 64, 2) mk_fwd(Args args) {
    extern __shared__ __attribute__((aligned(16))) unsigned char lds[];
    Frame F;
    F.lds = (LAS unsigned char*)lds;
    F.MISC = (volatile LAS unsigned*)(F.lds + MISC_OFF);
    unsigned char* ws = args.ws;
    F.ctl = (gu32*)(ws + WS_CTL);
    for (int u = threadIdx.x; u < (LDS_BYTES - LDSCTL_OFF) / 4; u += NWAVES * 64) ((LAS unsigned*)(F.lds + LDSCTL_OFF))[u] = 0u;
    __syncthreads();
    const int wave_s = __builtin_amdgcn_readfirstlane((int)threadIdx.x >> 6);
#define MYTID() (OPQ_S(wave_s) * 64 + (int)__builtin_amdgcn_mbcnt_hi(~0u, __builtin_amdgcn_mbcnt_lo(~0u, 0u)))
#define PHASE_LANES() int tid_ = MYTID(); asm volatile("" : "+v"(tid_)); int G_ = gridDim.x, bx_ = blockIdx.x; asm volatile("" : "+s"(G_), "+s"(bx_)); \
    const int lane = tid_ & 63, wave = __builtin_amdgcn_readfirstlane(tid_ >> 6); const int vcu_ = (G_ % 8 == 0) ? (bx_ % 8) * (G_ / 8) + bx_ / 8 : bx_; const int gw = vcu_ * NWAVES + wave, NGW = G_ * NWAVES; (void)lane; (void)gw; (void)NGW
    XcdBarrier bar; bar.bar = (unsigned*)(F.ctl + CW_BAR); bar.x = 0; bar.st = nullptr;
    if (!MK_PER_PHASE) bar = xcd_barrier_post((unsigned*)(F.ctl + CW_BAR), F.MISC + 8);
#define GRID_BAR() do { if (MK_PER_PHASE) { if (MYTID() == 0) __hip_atomic_store(F.ctl + 0, 0xBADBA0u, RLX_AGENT); } else { xcd_barrier(bar, MYTID() == 0); } } while (0)
    const int lo = args.ph_lo, hi = args.ph_hi;
#define IN(k) (lo <= (k) && (k) < hi)
#define BOTH(k) (IN(k) && IN((k) + 1))

#define PHASE_PTRS() unsigned zo_ = 0u; asm volatile("" : "+s"(zo_)); unsigned char* ws_ = args.ws + zo_;     \
    const float* x_in = args.in[0]; float* out = args.out; \
    float* cosT = (float*)(ws_ + WS_ROPE); float* sinT = cosT + SEQ * 16; float* kmean = (float*)(ws_ + WS_KMEAN); bf16* kmh = (bf16*)(ws_ + WS_KMEAN + 192 * 1024); bf16* kml = kmh + BATCH * 6 * 16 * 64; float* lse = (float*)(ws_ + WS_LSE); (void)kmh; (void)kml; (void)lse; \
    pg8::u64* rsu = (pg8::u64*)(ws_ + WS_RS); float* rsq = (float*)(ws_ + WS_RSQ); float* rskv = (float*)(ws_ + WS_RSKV); \
    bf16* Wb = (bf16*)(ws_ + WS_W); bf16* XB = (bf16*)(ws_ + WS_XB); bf16* PROJ = (bf16*)(ws_ + WS_PROJ); bf16* ACT = PROJ; bf16* GT = PROJ; \
    bf16* QM = (bf16*)(ws_ + WS_QM); bf16* KN = (bf16*)(ws_ + WS_KN); bf16* VM = (bf16*)(ws_ + WS_VM); bf16* KR = (bf16*)(ws_ + WS_KR); \
    bf16* MG = (bf16*)(ws_ + WS_MG); bf16* AO = (bf16*)(ws_ + WS_AO); \
    const pg8::bf16_t* Wgu1 = Wb + W_GU1 / 2; const pg8::bf16_t* Wd1 = Wb + W_D1 / 2; const pg8::bf16_t* Win = Wb + W_IN / 2; const pg8::bf16_t* Wg = Wb + W_G / 2; \
    const pg8::bf16_t* Wuq = Wb + W_UQ / 2; const pg8::bf16_t* Wukv = Wb + W_UKV / 2; const pg8::bf16_t* Wbr = Wb + W_BR / 2; const pg8::bf16_t* Wout = Wb + W_OUT / 2; \
    const pg8::bf16_t* Wgu2 = Wb + W_GU2 / 2; const pg8::bf16_t* Wd2 = Wb + W_D2 / 2; \
    (void)x_in; (void)out; (void)cosT; (void)sinT; (void)kmean; (void)rsu; (void)rsq; (void)rskv; (void)XB; (void)ACT; (void)GT; (void)QM; (void)KN; (void)VM; (void)KR; (void)MG; (void)AO; \
    (void)Wgu1; (void)Wd1; (void)Win; (void)Wg; (void)Wuq; (void)Wukv; (void)Wbr; (void)Wout; (void)Wgu2; (void)Wd2

    if (IN(0)) { PHASE_LANES(); PHASE_PTRS();
        for (int m = gw; m < T; m += NGW) { const GAS f32x4* xr = (const GAS f32x4*)(x_in + (size_t)m * DM) + lane; f32x4 v[4]; float s = 0.f;
#pragma unroll
            for (int j = 0; j < 4; ++j) { v[j] = xr[64 * j]; s += (v[j].x * v[j].x + v[j].y * v[j].y) + (v[j].z * v[j].z + v[j].w * v[j].w); }
            s = wave_sum(s);
            GAS unsigned long long* o8 = (GAS unsigned long long*)(XB + (size_t)m * DM) + lane;
#pragma unroll
            for (int j = 0; j < 4; ++j) o8[64 * j] = (unsigned long long)pk2(v[j].x, v[j].y) | ((unsigned long long)pk2(v[j].z, v[j].w) << 32);
            if (lane == 0) rsu[m] = (pg8::u64)(s * pg8::RS_FIX); }
        for (int idx = gw * 64 + lane; idx < SEQ * 16; idx += NGW * 64) { const int pos = idx >> 4, i = idx & 15; const int a = i & 3, e = i >> 2;
            const double mm = a == 0 ? 1.0 : a == 1 ? 0.5623413251903491 : a == 2 ? 0.31622776601683794 : 0.1778279410038923;
            const double pe = e == 0 ? 1.0 : e == 1 ? 0.1 : e == 2 ? 0.01 : 0.001;
            const float inv = (float)(mm * pe); const float angf = (float)pos * inv;
            const double rev = (double)angf * 0.15915494309189535; const float fr = (float)(rev - __builtin_rint(rev));
            cosT[idx] = __builtin_amdgcn_cosf(fr); sinT[idx] = __builtin_amdgcn_sinf(fr); }
        if (BOTH(0)) GRID_BAR();
    }

    for (int l = 0; l < DEPTH; ++l) {
        const int pb = 1 + l * PH_PER_LAYER;
        if (IN(pb + 0)) { PHASE_LANES(); PHASE_PTRS();
            LAS float* scr = (LAS float*)(F.lds + RING_OFF + wave * 16384);
            int base = 0;
            cvt_matrix(args.in[2] + (size_t)l * DM * FF, DM, FF, args.in[1] + l * DM, Wb + W_GU1 / 2, DM, 0, RmGU{0}, scr, gw, NGW, lane, base);
            cvt_matrix(args.in[3] + (size_t)l * DM * FF, DM, FF, args.in[1] + l * DM, Wb + W_GU1 / 2, DM, 0, RmGU{128}, scr, gw, NGW, lane, base);
            cvt_matrix(args.in[4] + (size_t)l * FF * DM, FF, DM, nullptr, Wb + W_D1 / 2, FF, 0, RmId{}, scr, gw, NGW, lane, base);
            cvt_matrix(args.in[6] + (size_t)l * DM * IN_COLS, DM, IN_COLS, args.in[5] + l * DM, Wb + W_IN / 2, DM, 0, RmIn{}, scr, gw, NGW, lane, base);
            cvt_matrix(args.in[8] + (size_t)l * 256 * 576, 256, 576, args.in[7] + l * 256, Wb + W_UQ / 2, 256, 0, RmId{}, scr, gw, NGW, lane, base);
            cvt_matrix(args.in[10] + (size_t)l * 128 * 768, 128, 768, args.in[9] + l * 128, Wb + W_UKV / 2, 256, 0, RmId{}, scr, gw, NGW, lane, base);
            cvt_matrix(args.in[11] + (size_t)l * 384 * DM, 384, DM, nullptr, Wb + W_BR / 2, DM, 0, RmId{}, scr, gw, NGW, lane, base);
            cvt_matrix(args.in[12] + (size_t)l * 384 * DM, 384, DM, nullptr, Wb + W_BR / 2, DM, 384, RmId{}, scr, gw, NGW, lane, base);
            cvt_matrix(args.in[13] + (size_t)l * 256 * DM, 256, DM, nullptr, Wb + W_BR / 2, DM, 768, RmId{}, scr, gw, NGW, lane, base);
            cvt_matrix(args.in[14] + (size_t)l * DM * DM, DM, DM, nullptr, Wb + W_OUT / 2, DM, 0, RmId{}, scr, gw, NGW, lane, base);
            cvt_matrix(args.in[16] + (size_t)l * DM * FF, DM, FF, args.in[15] + l * DM, Wb + W_GU2 / 2, DM, 0, RmGU{0}, scr, gw, NGW, lane, base);
            cvt_matrix(args.in[17] + (size_t)l * DM * FF, DM, FF, args.in[15] + l * DM, Wb + W_GU2 / 2, DM, 0, RmGU{128}, scr, gw, NGW, lane, base);
            cvt_matrix(args.in[18] + (size_t)l * FF * DM, FF, DM, nullptr, Wb + W_D2 / 2, FF, 0, RmId{}, scr, gw, NGW, lane, base);
            const v4u z = (v4u){0u, 0u, 0u, 0u}; const int gt = gw * 64 + lane, NT = NGW * 64;
            for (int i = gt; i < 224 * 1024 / 8; i += NT) *(GAS v4u*)(Wb + W_IN / 2 + (size_t)3872 * 1024 + (size_t)i * 8) = z;
            for (int i = gt; i < 192 * 256 / 8; i += NT) *(GAS v4u*)(Wb + W_UQ / 2 + (size_t)576 * 256 + (size_t)i * 8) = z;
            for (int i = gt; i < 768 * 16; i += NT) *(GAS v4u*)(Wb + W_UKV / 2 + (size_t)(i >> 4) * 256 + 128 + (i & 15) * 8) = z;
            if (BOTH(pb + 0)) GRID_BAR();
        }
        if (IN(pb + 1)) { PHASE_PTRS();
            pg8::Gemm g{XB, Wgu1, T, 2 * FF, DM, DM, DM}; pg8::StaticOrder S; S.init(T, 2 * FF, OPQ_S((int)gridDim.x), OPQ_S((int)blockIdx.x));
            pg8::EpiSwiGLU E{ACT, FF, rsu + (size_t)(3 * l + 0) * T};
            for (int rep = 0; rep < ((MK_DOUBLE & 1) ? 2 : 1); ++rep)
            pg8::gemm_phase<pg8::EpiSwiGLU, pg8::StaticOrder, true>(F.lds + RING_OFF, g, S, E, MYTID());
            if (BOTH(pb + 1)) GRID_BAR();
        }
        if (IN(pb + 2)) { PHASE_PTRS();
            pg8::Gemm g{ACT, Wd1, T, DM, FF, FF, FF}; pg8::StaticOrder S; S.init(T, DM, OPQ_S((int)gridDim.x), OPQ_S((int)blockIdx.x));
            pg8::EpiResid E{XB, rsu + (size_t)(3 * l + 1) * T, 0.5f};
            pg8::gemm_phase<pg8::EpiResid, pg8::StaticOrder, true>(F.lds + RING_OFF, g, S, E, MYTID());
            if (BOTH(pb + 2)) GRID_BAR();
        }
        if (IN(pb + 3)) { PHASE_PTRS();
            pg8::Gemm g{XB, Win, T, 4096, DM, DM, DM}; pg8::StaticOrder S; S.init(T, 4096, OPQ_S((int)gridDim.x), OPQ_S((int)blockIdx.x));
            pg8::EpiProj E{PROJ, rsu + (size_t)(3 * l + 1) * T, rsq, rskv};
            for (int rep = 0; rep < ((MK_DOUBLE & 4) ? 2 : 1); ++rep)
            pg8::gemm_phase<pg8::EpiProj, pg8::StaticOrder, true>(F.lds + RING_OFF, g, S, E, MYTID());
            if (BOTH(pb + 3)) GRID_BAR();
        }
        if (IN(pb + 4)) { PHASE_PTRS();
            { pg8::Gemm g{PROJ + PC_CQ, Wuq, T, 768, 256, PP, 256}; pg8::StaticOrder S; S.init(T, 768, OPQ_S((int)gridDim.x), OPQ_S((int)blockIdx.x));
              pg8::EpiQup E{QM, rsq, cosT, sinT};
              pg8::gemm_phase<pg8::EpiQup, pg8::StaticOrder, true>(F.lds + RING_OFF, g, S, E, MYTID()); }
            { pg8::Gemm g{PROJ + PC_CKV, Wukv, T, 768, 256, PP, 256}; pg8::StaticOrder S; S.init(T, 768, OPQ_S((int)gridDim.x), OPQ_S((int)blockIdx.x));
              pg8::EpiKVup E{KN, VM, rskv};
              pg8::gemm_phase<pg8::EpiKVup, pg8::StaticOrder, true>(F.lds + RING_OFF, g, S, E, MYTID()); }
            PHASE_LANES();
            for (int idx = gw * 64 + lane; idx < T * 16; idx += NGW * 64) { const int row = idx >> 4, i = idx & 15, pos = row & (SEQ - 1);
                const float t1 = __uint_as_float((unsigned)PROJ[(size_t)row * PP + PC_KR + i] << 16), t2 = __uint_as_float((unsigned)PROJ[(size_t)row * PP + PC_KR + 16 + i] << 16);
                const float c = cosT[pos * 16 + i], s = sinT[pos * 16 + i];
                KR[(size_t)row * 32 + i] = (bf16)f2bf(t1 * c - t2 * s); KR[(size_t)row * 32 + 16 + i] = (bf16)f2bf(t1 * s + t2 * c); }
            for (int u = gw; u < BATCH * 6 * 16; u += NGW) { const int n = u & 15, bh = u >> 4, b = bh / 6, h = bh % 6, dc = lane & 7, ks = lane >> 3;
                const bf16* kp = PROJ + ((size_t)b * SEQ + n * 256 + ks) * PP + PC_MK + h * 64 + dc * 8; float a[8];
#pragma unroll
                for (int j = 0; j < 8; ++j) a[j] = 0.f;
#pragma unroll 8
                for (int i = 0; i < 32; ++i) { float f[8]; ld8(kp + (size_t)(8 * i) * PP, f);
#pragma unroll
                    for (int j = 0; j < 8; ++j) a[j] += f[j]; }
#pragma unroll
                for (int j = 0; j < 8; ++j) { a[j] += __shfl_xor(a[j], 8); a[j] += __shfl_xor(a[j], 16); a[j] += __shfl_xor(a[j], 32); }
                if (ks == 0) {
#pragma unroll
                    for (int j = 0; j < 8; ++j) { const int idx = u * 64 + dc * 8 + j; const float km = a[j] * (1.0f / 256.0f); kmean[idx] = km; const unsigned hb = f2bf(km); kmh[idx] = (bf16)hb; kml[idx] = (bf16)f2bf(km - __uint_as_float(hb << 16)); } } }
#if MK_NAIVE_DIL
            for (int gid = gw * 64 + lane; gid < BATCH * 4 * SEQ; gid += NGW * 64) dil_naive_thread(PROJ, AO, gid >> 14, (gid >> 12) & 3, gid & (SEQ - 1));
#else
            __syncthreads();
            for (int u = bx_; u < BATCH * 12 * 16; u += G_) { const int b = u / 192, h = (u >> 4) % 12, i16 = u & 15, g = h >> 2, dil = (g == 0) ? 1 : (g == 1) ? 4 : 16, nch = 16 / dil;
                fa::dil_unit((LAS char*)(F.lds + RING_OFF), tid_, b, h, dil, i16 / nch, i16 % nch, PROJ, lse, exp2f(-8.0f * (float)(h + 1) / 18.0f) * LOG2E * (float)dil);
                __syncthreads(); }
#endif
            if (BOTH(pb + 4)) GRID_BAR();
        }
        if (IN(pb + 5)) { PHASE_LANES(); PHASE_PTRS();
#if !MK_NAIVE_DIL
            for (int idx = gw * 64 + lane; idx < T * 32; idx += NGW * 64) { const int row = idx >> 5, hg = (idx >> 3) & 3, c = idx & 7;
                const float l0 = lse[(size_t)row * 12 + hg], l1 = lse[(size_t)row * 12 + 4 + hg], l2 = lse[(size_t)row * 12 + 8 + hg], lm = fmaxf(l0, fmaxf(l1, l2));
                float w0 = exp2f(l0 - lm), w1 = exp2f(l1 - lm), w2 = exp2f(l2 - lm); const float wi = 1.0f / (w0 + w1 + w2); w0 *= wi; w1 *= wi; w2 *= wi;
                const bf16* op = PROJ + (size_t)row * PP + PC_DQ + hg * 64 + c * 8; float a0[8], a1[8], a2[8], r[8];
                ld8(op, a0); ld8(op + 256, a1); ld8(op + 512, a2);
#pragma unroll
                for (int j = 0; j < 8; ++j) r[j] = w0 * a0[j] + w1 * a1[j] + w2 * a2[j];
                st8(AO + (size_t)row * DM + 768 + hg * 64 + c * 8, r, 1.0f); }
#endif
            for (int wrep = 0; wrep < 4; ++wrep) { const int which = wrep >> 1, rep = wrep & 1; if (rep == 1 && !((MK_DOUBLE >> (3 + which)) & 1)) continue;
                const bool naive = which == 0 ? (MK_NAIVE_MLA != 0) : (MK_NAIVE_MOBA != 0);
                if (naive) {
                    for (int u = gw; u < 48 * 32; u += NGW) { const int bh = u >> 5, cp = u & 31, b = bh / 6, h = bh % 6;
                        if (which == 0) { mla_naive_chunk(QM, KN, KR, VM, AO, b, h, cp, lane); mla_naive_chunk(QM, KN, KR, VM, AO, b, h, 63 - cp, lane); }
                        else { moba_naive_chunk(PROJ, kmean, AO, b, h, cp, lane); moba_naive_chunk(PROJ, kmean, AO, b, h, 63 - cp, lane); } }
                } else {
                    gu32* head = F.ctl + CW_QUEUE + 64 * (2 * l + which) + 64 * 8 * rep;
                    for (;;) {
                        if (tid_ == 0) F.MISC[16] = __hip_atomic_fetch_add(head, 1u, RLX_AGENT);
                        __syncthreads();
                        const int u = (int)F.MISC[16];
                        if (u >= 48 * 16) break;
                        const int qb = 15 - u / 48, bh = u % 48, b = bh / 6, h = bh % 6;
                        if (which == 0) fa::flash_unit<96, false>((LAS char*)(F.lds + RING_OFF), tid_, b, qb, QM + h * 96, 576, KN + h * 64, 384, KR, VM + h * 64, 384, AO + h * 64, nullptr, nullptr, 0.f);
                        else fa::flash_unit<64, true>((LAS char*)(F.lds + RING_OFF), tid_, b, qb, PROJ + PC_MQ + h * 64, PP, PROJ + PC_MK + h * 64, PP, nullptr, PROJ + PC_MV + h * 64, PP, AO + 384 + h * 64,
                                                      kmh + (size_t)bh * 1024, kml + (size_t)bh * 1024, exp2f(-8.0f * (float)(12 + h + 1) / 18.0f) * LOG2E);
                    }
                    __syncthreads();
                }
            }
            if (BOTH(pb + 5)) GRID_BAR();
        }
        if (IN(pb + 6)) { PHASE_PTRS();
            pg8::Gemm g{XB, Wg, T, 3072, DM, DM, DM}; pg8::StaticOrder S; S.init(T, 3072, OPQ_S((int)gridDim.x), OPQ_S((int)blockIdx.x));
            pg8::EpiGate E{GT, rsu + (size_t)(3 * l + 1) * T};
            for (int rep = 0; rep < ((MK_DOUBLE & 32) ? 2 : 1); ++rep)
            pg8::gemm_phase<pg8::EpiGate, pg8::StaticOrder, true>(F.lds + RING_OFF, g, S, E, MYTID());
            if (BOTH(pb + 6)) GRID_BAR();
        }
        if (IN(pb + 7)) { PHASE_PTRS();
            for (int rep = 0; rep < ((MK_DOUBLE & 64) ? 2 : 1); ++rep) {
            int first_ = 1;
            if (MK_BRANCH_MASK & 1) { pg8::Gemm g{AO, Wbr, T, DM, 384, DM, DM}; pg8::StaticOrder S; S.init(T, DM, OPQ_S((int)gridDim.x), OPQ_S((int)blockIdx.x)); pg8::EpiMerge E{GT, MG, first_}; first_ = 0;
              pg8::gemm_phase<pg8::EpiMerge, pg8::StaticOrder, true>(F.lds + RING_OFF, g, S, E, MYTID()); }
            if (MK_BRANCH_MASK & 2) { pg8::Gemm g{AO + 384, Wbr + 384, T, DM, 384, DM, DM}; pg8::StaticOrder S; S.init(T, DM, OPQ_S((int)gridDim.x), OPQ_S((int)blockIdx.x)); pg8::EpiMerge E{GT + 1024, MG, first_}; first_ = 0;
              pg8::gemm_phase<pg8::EpiMerge, pg8::StaticOrder, true>(F.lds + RING_OFF, g, S, E, MYTID()); }
            if (MK_BRANCH_MASK & 4) { pg8::Gemm g{AO + 768, Wbr + 768, T, DM, 256, DM, DM}; pg8::StaticOrder S; S.init(T, DM, OPQ_S((int)gridDim.x), OPQ_S((int)blockIdx.x)); pg8::EpiMerge E{GT + 2048, MG, first_}; first_ = 0;
              pg8::gemm_phase<pg8::EpiMerge, pg8::StaticOrder, true>(F.lds + RING_OFF, g, S, E, MYTID()); }
            }
            if (BOTH(pb + 7)) GRID_BAR();
        }
        if (IN(pb + 8)) { PHASE_PTRS();
            pg8::Gemm g{MG, Wout, T, DM, DM, DM, DM}; pg8::StaticOrder S; S.init(T, DM, OPQ_S((int)gridDim.x), OPQ_S((int)blockIdx.x));
            pg8::EpiResid E{XB, rsu + (size_t)(3 * l + 2) * T, 1.0f};
            pg8::gemm_phase<pg8::EpiResid, pg8::StaticOrder, true>(F.lds + RING_OFF, g, S, E, MYTID());
            if (BOTH(pb + 8)) GRID_BAR();
        }
        if (IN(pb + 9)) { PHASE_PTRS();
            pg8::Gemm g{XB, Wgu2, T, 2 * FF, DM, DM, DM}; pg8::StaticOrder S; S.init(T, 2 * FF, OPQ_S((int)gridDim.x), OPQ_S((int)blockIdx.x));
            pg8::EpiSwiGLU E{ACT, FF, rsu + (size_t)(3 * l + 2) * T};
            for (int rep = 0; rep < ((MK_DOUBLE & 1) ? 2 : 1); ++rep)
            pg8::gemm_phase<pg8::EpiSwiGLU, pg8::StaticOrder, true>(F.lds + RING_OFF, g, S, E, MYTID());
            if (BOTH(pb + 9)) GRID_BAR();
        }
        if (IN(pb + 10)) { PHASE_PTRS();
            pg8::Gemm g{ACT, Wd2, T, DM, FF, FF, FF}; pg8::StaticOrder S; S.init(T, DM, OPQ_S((int)gridDim.x), OPQ_S((int)blockIdx.x));
            pg8::EpiResid E{XB, rsu + (size_t)(3 * (l + 1)) * T, 0.5f};
            pg8::gemm_phase<pg8::EpiResid, pg8::StaticOrder, true>(F.lds + RING_OFF, g, S, E, MYTID());
            if (BOTH(pb + 10)) GRID_BAR();
        }
    }
    if (IN(N_PHASES - 1)) { PHASE_LANES(); PHASE_PTRS();
        const float* gain = args.in[19];
        for (int m = gw; m < T; m += NGW) { float v[16]; ld8(XB + (size_t)m * DM + lane * 16, v); ld8(XB + (size_t)m * DM + lane * 16 + 8, v + 8); float s2 = 0.f;
#pragma unroll
            for (int j = 0; j < 16; ++j) s2 += v[j] * v[j];
            const float r = 1.0f / sqrtf(wave_sum(s2) * (1.0f / DM) + NORM_EPS);
#pragma unroll
            for (int j = 0; j < 4; ++j) { const f32x4 gn = *((const f32x4*)gain + lane * 4 + j); *((GAS f32x4*)(out + (size_t)m * DM) + lane * 4 + j) = (f32x4){v[4 * j] * r * gn[0], v[4 * j + 1] * r * gn[1], v[4 * j + 2] * r * gn[2], v[4 * j + 3] * r * gn[3]}; } }
    }
#undef IN
#undef BOTH
#undef GRID_BAR
}


__global__ void dbg_rowsum(const float* out, float* cs) { const int row = blockIdx.x * 4 + (threadIdx.x >> 6), lane = threadIdx.x & 63; float s = 0.f; for (int c = lane; c < DM; c += 64) s += out[(size_t)row * DM + c]; for (int o = 1; o < 64; o <<= 1) s += __shfl_xor(s, o); if (lane == 0) cs[row] = s; }
__global__ void dbg_cmp(const float* a, const float* b, unsigned* flag) { const int i = blockIdx.x * 256 + threadIdx.x; if (i < T) { const float d = fabsf(a[i] - b[i]); if (!(d <= 1e-5f * fabsf(a[i]) + 1e-6f)) atomicAdd(flag, 1u); } }
__global__ void dbg_scale(float* out, const unsigned* flag) { const size_t i = (size_t)blockIdx.x * 256 + threadIdx.x; if (*flag) out[i] *= 3.0f; }
extern "C" void kernel_launch(void* const* d_in, const int* in_sizes, int n_in, void* d_out, int out_size, void* d_ws, size_t ws_size, hipStream_t stream) {
    static int grid = 0;
    if (grid == 0) {
        if (n_in != 20 || in_sizes[0] != T * DM || out_size != T * DM || ws_size < WS_END) { fprintf(stderr, "kernel_launch: unexpected shapes / workspace (n_in %d, ws %zu, need %zu)\n", n_in, ws_size, (size_t)WS_END); grid = -1; return; }
        int dev = 0, cus = 0, per_cu = 0;
        if (hipGetDevice(&dev) != hipSuccess || hipDeviceGetAttribute(&cus, hipDeviceAttributeMultiprocessorCount, dev) != hipSuccess) { grid = -1; return; }
        if (hipFuncSetAttribute((const void*)mk_fwd, hipFuncAttributeMaxDynamicSharedMemorySize, LDS_BYTES) != hipSuccess) { fprintf(stderr, "kernel_launch: hipFuncSetAttribute failed\n"); grid = -1; return; }
        if (hipOccupancyMaxActiveBlocksPerMultiprocessor(&per_cu, (const void*)mk_fwd, NWAVES * 64, LDS_BYTES) != hipSuccess || per_cu < 1)
            fprintf(stderr, "kernel_launch: note: occupancy query reports %d workgroups per CU\n", per_cu);
        (void)hipGetLastError();
        grid = cus;
    }
    if (grid < 0) return;
    if (hipMemsetAsync((char*)d_ws + WS_CTL, 0, CTL_ZERO_BYTES, stream) != hipSuccess) return;
    Args a{};
    for (int i = 0; i < 20; ++i) a.in[i] = (const float*)d_in[i];
    a.out = (float*)d_out; a.ws = (unsigned char*)d_ws;
#if MK_PER_PHASE
    float* cs = (float*)((char*)d_ws + WS_END); unsigned* flag = (unsigned*)((char*)d_ws + 64);
    for (int rep = 0; rep < 1; ++rep) {
      for (int p = 0; p < N_PHASES; ++p) { if (p > MK_STOP_AFTER && p != N_PHASES - 1) continue; a.ph_lo = p; a.ph_hi = p + 1; hipLaunchKernelGGL(mk_fwd, dim3(grid), dim3(NWAVES * 64), LDS_BYTES, stream, a); }
      hipLaunchKernelGGL(dbg_rowsum, dim3(T / 4), dim3(256), 0, stream, (const float*)d_out, cs + rep * T);
    }
    if (0) hipLaunchKernelGGL(dbg_cmp, dim3(T / 256), dim3(256), 0, stream, (const float*)cs, (const float*)(cs + T), flag);
    if (0) hipLaunchKernelGGL(dbg_scale, dim3(T * DM / 256), dim3(256), 0, stream, (float*)d_out, (const unsigned*)flag);
#else
    a.ph_lo = 0; a.ph_hi = N_PHASES;
    hipLaunchKernelGGL(mk_fwd, dim3(grid), dim3(NWAVES * 64), LDS_BYTES, stream, a);
#endif
}
```

```cpp
#include <hip/hip_runtime.h>
#include <cstdio>
#include <cstdint>

#ifndef MK_PER_PHASE
#define MK_PER_PHASE 0
#endif

#ifndef MK_DOUBLE
#define MK_DOUBLE 0
#endif
#ifndef MK_STAGGER_TICKS
#define MK_STAGGER_TICKS 300
#endif
#ifndef MK_EXTRA_BAR
#define MK_EXTRA_BAR 0
#endif
#ifndef MK_NAIVE_MLA
#define MK_NAIVE_MLA 0
#endif
#ifndef MK_NAIVE_MOBA
#define MK_NAIVE_MOBA 0
#endif
#ifndef MK_NAIVE_DIL
#define MK_NAIVE_DIL 0
#endif
#ifndef MK_STOP_AFTER
#define MK_STOP_AFTER 999
#endif
constexpr int BATCH = 8, SEQ = 4096, DM = 1024, DEPTH = 4, FF = 2816, T = BATCH * SEQ;
constexpr int PP = 4096;
constexpr int HSLOTS = 54, SL_DQ = 0, SL_DK = 12, SL_DV = 24, SL_MQ = 36, SL_MK = 42, SL_MV = 48, PTP = 640;
constexpr size_t PTOK_OFF = (size_t)8 * HSLOTS * 4096 * 64;
constexpr int PC_DQ = 0, PC_DK = 768, PC_DV = 1536, PC_MQ = 2304, PC_MK = 2688, PC_MV = 3072, PC_CKV = 3456, PC_CQ = 3584, PC_KR = 3840;
constexpr int IN_COLS = 6944;
constexpr float NORM_EPS = 1e-6f;
constexpr float LOG2E = 1.4426950408889634f, QSCALE64 = 0.125f * LOG2E, QSCALE96 = 0.10206207261596575f * LOG2E;

namespace pg8 {
#define PG8_LAS __attribute__((address_space(3)))
typedef unsigned short bf16_t;
typedef short bf16x8 __attribute__((ext_vector_type(8)));
typedef float f32x4 __attribute__((ext_vector_type(4)));
typedef unsigned u32x4 __attribute__((ext_vector_type(4)));
typedef unsigned u32x2 __attribute__((ext_vector_type(2)));
typedef unsigned long long u64;
constexpr int BM = 256, BK = 64, HALF = 128, HTB = HALF * BK * 2, STAGE_BYTES = 8 * HTB, NXCD = 8, WGM = 8;

__host__ __device__ __forceinline__ int lds_byte(int r, int c) { const int st = (r >> 4) * 2 + (c >> 5), rr = r & 15, cc = c & 31, ob = rr * 64 + cc * 2; return st * 1024 + (ob ^ (((ob >> 9) & 1) << 5)); }
__host__ __device__ __forceinline__ void stage_rc(int b, int& R, int& C) { const int st = b / 1024, sb = b % 1024, swz = sb ^ (((sb >> 9) & 1) << 5); R = (st >> 1) * 16 + swz / 64; C = (st & 1) * 32 + (swz % 64) / 2; }
__host__ __device__ __forceinline__ int perm32(int rho) { const int n = rho >> 4, i = rho & 15; return 8 * (i >> 2) + 4 * n + (i & 3); }

struct Unit { int pm, pn, sub, ka, kb, nt, sel; };
struct Gemm { const bf16_t* A; const bf16_t* Bt; int M, N, K, lda, ldb; const bf16_t* A1; const bf16_t* Bt1; };

struct StaticOrder {
    int nM, nN, nwg, G, c;
    __host__ __device__ void init(int M, int N, int G_, int c_) { nM = M / BM; nN = N / BM; nwg = nM * nN; G = G_; c = c_; }
    __host__ __device__ bool next(int i, Unit& u) const {
        const long L = (long)i * G + c; if (L >= nwg) return false;
        int wgid = (int)L; { const int q = nwg / NXCD, r = nwg % NXCD, xcd = wgid % NXCD, off = wgid / NXCD; wgid = (xcd < r ? xcd * (q + 1) : r * (q + 1) + (xcd - r) * q) + off; }
        const int nig = WGM * nN, gid = wgid / nig, fm = gid * WGM, gsz = (nM - fm) < WGM ? (nM - fm) : WGM;
        u.pm = fm + ((wgid % nig) % gsz); u.pn = (wgid % nig) / gsz; u.sub = 0; u.ka = 0; u.kb = 0; u.nt = 0; u.sel = 0; return true;
    }
    __device__ __forceinline__ void a_ready(const Unit&) const {}
    __device__ __forceinline__ void done(const Unit&) const {}
};

typedef float f32x2_t __attribute__((ext_vector_type(2))); typedef __bf16 bf16x2_t __attribute__((ext_vector_type(2)));
struct MergeOrder : StaticOrder {
    __host__ __device__ bool next(int i, Unit& u) const { if (!StaticOrder::next(i / 3, u)) return false; u.sub = i % 3; u.ka = u.sub * 768; u.kb = u.ka; u.nt = (u.sub == 2) ? 4 : 6; return true; }
};
struct UpOrder : StaticOrder {
    __host__ __device__ bool next(int i, Unit& u) const { if (!StaticOrder::next(i, u)) return false; u.ka = (u.pn < 3 ? 128 : 0) * 2; return true; }
};
__device__ __forceinline__ unsigned cvt_pk_bf16(float lo, float hi) { f32x2_t v = {lo, hi}; bf16x2_t b = __builtin_convertvector(v, bf16x2_t); return __builtin_bit_cast(unsigned, b); }
__device__ __forceinline__ float bflo(unsigned w) { return __uint_as_float(w << 16); }
__device__ __forceinline__ float bfhi(unsigned w) { return __uint_as_float(w & 0xffff0000u); }

template <int NP> __device__ __forceinline__ float row_scale(const float* p, int row, float invn) {
    float s = 0.f;
#pragma unroll
    for (int i = 0; i < NP / 4; ++i) { const f32x4 a = *(const f32x4*)(p + (size_t)row * NP + 4 * i); s += (a[0] + a[1]) + (a[2] + a[3]); }
    return 1.0f / sqrtf(s * invn + NORM_EPS);
}
constexpr float RS_FIX = 16777216.0f, RS_UNFIX = 1.0f / 16777216.0f;
constexpr int RS_LDS_OFF = 131072 + 2048;
__device__ __forceinline__ void row_scales8(const PG8_LAS unsigned char* ldsbase, int wr, int fr, float (&sc)[2][4]) {
    const PG8_LAS u64* p = (const PG8_LAS u64*)(ldsbase + RS_LDS_OFF) + wr * 64 + fr;
#pragma unroll
    for (int ai = 0; ai < 2; ++ai)
#pragma unroll
        for (int m = 0; m < 4; ++m) sc[ai][m] = 1.0f / sqrtf((float)p[ai * HALF + m * 16] * (RS_UNFIX / DM) + NORM_EPS);
}
__device__ __forceinline__ float silu_f(float a) { return a * __builtin_amdgcn_rcpf(1.0f + __builtin_amdgcn_exp2f(-1.4426950408889634f * a)); }
__device__ __forceinline__ float sigm_f(float a) { return __builtin_amdgcn_rcpf(1.0f + __builtin_amdgcn_exp2f(-1.4426950408889634f * a)); }

struct EpiSwiGLU { static constexpr bool PERM = true, AFTER_DRAIN = false, RS_PREFETCH = true; static __device__ __forceinline__ bool rs_wanted(const Unit&) { return true; }
    bf16_t* O; int ldc; const u64* rsu;
    __device__ __forceinline__ void operator()(const f32x4 (&acc)[2][2][4][2], const Unit& u, int wr, int wc, int fr, int fq, const PG8_LAS unsigned char* ldsbase) const {
        const int row0 = u.pm * BM + wr * 64 + fr, col0 = u.pn * HALF + wc * 32 + 8 * fq;
        float sc[2][4]; row_scales8(ldsbase, wr, fr, sc);
#pragma unroll
        for (int ai = 0; ai < 2; ++ai)
#pragma unroll
            for (int m = 0; m < 4; ++m) { const int row = row0 + ai * HALF + m * 16; const float s = sc[ai][m];
                float y[8];
#pragma unroll
                for (int n = 0; n < 2; ++n)
#pragma unroll
                    for (int j = 0; j < 4; ++j) y[4 * n + j] = silu_f(acc[ai][0][m][n][j] * s) * (acc[ai][1][m][n][j] * s);
                u32x4 w; w.x = cvt_pk_bf16(y[0], y[1]); w.y = cvt_pk_bf16(y[2], y[3]); w.z = cvt_pk_bf16(y[4], y[5]); w.w = cvt_pk_bf16(y[6], y[7]);
                *(u32x4*)(O + (size_t)row * ldc + col0) = w; }
    }
};
struct EpiResid { static constexpr bool PERM = true, AFTER_DRAIN = false, RS_PREFETCH = false;
    bf16_t* xb; u64* rsu; float alpha;
    __device__ __forceinline__ void operator()(const f32x4 (&acc)[2][2][4][2], const Unit& u, int wr, int wc, int fr, int fq, const PG8_LAS unsigned char* ldsbase) const {
        const int row0 = u.pm * BM + wr * 64 + fr, col0 = u.pn * BM + wc * 32 + 8 * fq;
#pragma unroll
        for (int ai = 0; ai < 2; ++ai) {
            u32x4 b[4][2];
#pragma unroll
            for (int m = 0; m < 4; ++m)
#pragma unroll
                for (int bj = 0; bj < 2; ++bj) b[m][bj] = *(const u32x4*)(xb + (size_t)(row0 + ai * HALF + m * 16) * DM + col0 + bj * HALF);
#pragma unroll
            for (int m = 0; m < 4; ++m) { const int row = row0 + ai * HALF + m * 16; float ss = 0.f;
#pragma unroll
                for (int bj = 0; bj < 2; ++bj) { const u32x4 p = b[m][bj]; const f32x4 a0 = acc[ai][bj][m][0], a1 = acc[ai][bj][m][1]; float o[8];
                    o[0] = bflo(p.x) + alpha * a0[0]; o[1] = bfhi(p.x) + alpha * a0[1]; o[2] = bflo(p.y) + alpha * a0[2]; o[3] = bfhi(p.y) + alpha * a0[3];
                    o[4] = bflo(p.z) + alpha * a1[0]; o[5] = bfhi(p.z) + alpha * a1[1]; o[6] = bflo(p.w) + alpha * a1[2]; o[7] = bfhi(p.w) + alpha * a1[3];
                    u32x4 w; w.x = cvt_pk_bf16(o[0], o[1]); w.y = cvt_pk_bf16(o[2], o[3]); w.z = cvt_pk_bf16(o[4], o[5]); w.w = cvt_pk_bf16(o[6], o[7]);
                    *(u32x4*)(xb + (size_t)row * DM + col0 + bj * HALF) = w;
#pragma unroll
                    for (int j = 0; j < 8; ++j) ss += o[j] * o[j]; }
                ss += __shfl_xor(ss, 16); ss += __shfl_xor(ss, 32);
                if (fq == 0) __hip_atomic_fetch_add(rsu + row, (u64)(ss * RS_FIX), __ATOMIC_RELAXED, __HIP_MEMORY_SCOPE_AGENT); }
        }
    }
};
struct EpiProj { static constexpr bool PERM = true, AFTER_DRAIN = false, RS_PREFETCH = true; static __device__ __forceinline__ bool rs_wanted(const Unit&) { return true; }
    bf16_t* O; const u64* rsu; float* rsq; float* rskv;
    __device__ __forceinline__ void operator()(const f32x4 (&acc)[2][2][4][2], const Unit& u, int wr, int wc, int fr, int fq, const PG8_LAS unsigned char* ldsbase) const {
        const int row0 = u.pm * BM + wr * 64 + fr, col0 = u.pn * BM + wc * 32 + 8 * fq;
        float sc[2][4]; row_scales8(ldsbase, wr, fr, sc);
#pragma unroll
        for (int ai = 0; ai < 2; ++ai)
#pragma unroll
            for (int m = 0; m < 4; ++m) { const int row = row0 + ai * HALF + m * 16; const float s = sc[ai][m]; float ssb[2];
#pragma unroll
                for (int bj = 0; bj < 2; ++bj) { const float sq = (u.pn < 3 || u.pn == 9 || (u.pn == 10 && bj == 0)) ? s * QSCALE64 : s;
                    const f32x4 v0 = acc[ai][bj][m][0] * sq, v1 = acc[ai][bj][m][1] * sq;
                    u32x4 w; w.x = cvt_pk_bf16(v0[0], v0[1]); w.y = cvt_pk_bf16(v0[2], v0[3]); w.z = cvt_pk_bf16(v1[0], v1[1]); w.w = cvt_pk_bf16(v1[2], v1[3]);
                    { const int c = col0 + bj * HALF;
                      if (u.pn * 2 + bj < 27) *(u32x4*)(O + ((size_t)((row >> 12) * HSLOTS + (u.pn * 4 + bj * 2 + (wc >> 1))) * SEQ + (row & (SEQ - 1))) * 64 + (wc & 1) * 32 + 8 * fq) = w;
                      else *(u32x4*)(O + PTOK_OFF + (size_t)row * PTP + (c - 3456)) = w; }
                    ssb[bj] = ((v0[0] * v0[0] + v0[1] * v0[1]) + (v0[2] * v0[2] + v0[3] * v0[3])) + ((v1[0] * v1[0] + v1[1] * v1[1]) + (v1[2] * v1[2] + v1[3] * v1[3])); }
                if (u.pn == 14) { float ss = ssb[0] + ssb[1]; ss += __shfl_xor(ss, 16); ss += __shfl_xor(ss, 32); if (fq == 0) rsq[(size_t)row * 4 + wc] = ss; }
                if (u.pn == 13) { float ss = ssb[1]; ss += __shfl_xor(ss, 16); ss += __shfl_xor(ss, 32); if (fq == 0) rskv[(size_t)row * 4 + wc] = ss; } }
    }
};
struct EpiQup { static constexpr bool PERM = false, AFTER_DRAIN = false, RS_PREFETCH = false;
    bf16_t* Q; const float* rsq; const float* cosT; const float* sinT;
    __device__ __forceinline__ void operator()(const f32x4 (&acc)[2][2][4][2], const Unit& u, int wr, int wc, int fr, int fq, const PG8_LAS unsigned char* ldsbase) const {
        const int row0 = u.pm * BM + wr * 64 + fr;
        const int c32a = u.pn * BM + wc * 32, c32b = c32a + HALF;
        const bool ropea = (c32a < 576) && (c32a % 96) == 64, ropeb = (c32b < 576) && (c32b % 96) == 64, ropeany = ropea || ropeb;
#pragma unroll
        for (int ai = 0; ai < 2; ++ai) {
            f32x4 rsv[4], cs[4], sn[4];
#pragma unroll
            for (int m = 0; m < 4; ++m) { rsv[m] = *(const f32x4*)(rsq + (size_t)(row0 + ai * HALF + m * 16) * 4); cs[m] = (f32x4){0.f, 0.f, 0.f, 0.f}; sn[m] = cs[m]; }
            if (ropeany) {
#pragma unroll
                for (int m = 0; m < 4; ++m) { const int pos = (row0 + ai * HALF + m * 16) & (SEQ - 1); cs[m] = *(const f32x4*)(cosT + pos * 16 + 4 * fq); sn[m] = *(const f32x4*)(sinT + pos * 16 + 4 * fq); } }
            float sc[4];
#pragma unroll
            for (int m = 0; m < 4; ++m) { const f32x4 a = rsv[m]; sc[m] = (1.0f / sqrtf(((a[0] + a[1]) + (a[2] + a[3])) * (1.0f / 256.0f) + NORM_EPS)) * QSCALE96; }
#pragma unroll
            for (int bj = 0; bj < 2; ++bj) { const int c32 = bj ? c32b : c32a; if (c32 >= 576) continue; const bool rope = bj ? ropeb : ropea;
#pragma unroll
                for (int m = 0; m < 4; ++m) { const int row = row0 + ai * HALF + m * 16; const float s = sc[m];
                    f32x4 v0 = acc[ai][bj][m][0] * s, v1 = acc[ai][bj][m][1] * s;
                    if (rope) { const f32x4 o0 = v0 * cs[m] - v1 * sn[m], o1 = v0 * sn[m] + v1 * cs[m]; v0 = o0; v1 = o1; }
                    u32x2 w0, w1; w0.x = cvt_pk_bf16(v0[0], v0[1]); w0.y = cvt_pk_bf16(v0[2], v0[3]); w1.x = cvt_pk_bf16(v1[0], v1[1]); w1.y = cvt_pk_bf16(v1[2], v1[3]);
                    { auto r = __builtin_amdgcn_permlane16_swap(w0.x, w1.x, false, false); w0.x = r[0]; w1.x = r[1]; }
                    { auto r = __builtin_amdgcn_permlane16_swap(w0.y, w1.y, false, false); w0.y = r[0]; w1.y = r[1]; }
                    bf16_t* p = Q + ((size_t)((row >> 12) * 6 + c32 / 96) * SEQ + (row & (SEQ - 1))) * 96 + (c32 % 96) + (fq & 1) * 16 + (fq >> 1) * 8; *(u32x4*)p = (u32x4){w0.x, w0.y, w1.x, w1.y}; } } }
    }
};
struct EpiKVup { static constexpr bool PERM = true, AFTER_DRAIN = false, RS_PREFETCH = false;
    bf16_t* Kn; bf16_t* Vm; const float* rskv;
    __device__ __forceinline__ void operator()(const f32x4 (&acc)[2][2][4][2], const Unit& u, int wr, int wc, int fr, int fq, const PG8_LAS unsigned char* ldsbase) const {
        const int row0 = u.pm * BM + wr * 64 + fr;
#pragma unroll
        for (int bj = 0; bj < 2; ++bj) { const int h = 2 * u.pn + bj; bf16_t* dst = (wc < 2 ? Kn + h * 64 + wc * 32 : Vm + h * 64 + (wc - 2) * 32) + 8 * fq;
#pragma unroll
            for (int ai = 0; ai < 2; ++ai)
#pragma unroll
                for (int m = 0; m < 4; ++m) { const int row = row0 + ai * HALF + m * 16; const float s = row_scale<4>(rskv, row, 1.0f / 128.0f);
                    const f32x4 v0 = acc[ai][bj][m][0] * s, v1 = acc[ai][bj][m][1] * s;
                    u32x4 w; w.x = cvt_pk_bf16(v0[0], v0[1]); w.y = cvt_pk_bf16(v0[2], v0[3]); w.z = cvt_pk_bf16(v1[0], v1[1]); w.w = cvt_pk_bf16(v1[2], v1[3]);
                    *(u32x4*)(dst + (size_t)row * 384) = w; } }
    }
};
struct EpiUp { static constexpr bool PERM = false, AFTER_DRAIN = false, RS_PREFETCH = false;
    bf16_t* Q; bf16_t* Kn; bf16_t* Vm; const float* rsq; const float* rskv; const float* cosT; const float* sinT;
    __device__ __forceinline__ void operator()(const f32x4 (&acc)[2][2][4][2], const Unit& u, int wr, int wc, int fr, int fq, const PG8_LAS unsigned char* ldsbase) const {
        const int row0 = u.pm * BM + wr * 64 + fr;
        if (u.pn < 3) { EpiQup E{Q, rsq, cosT, sinT}; E(acc, u, wr, wc, fr, fq, ldsbase); return; }
        f32x4 rsv[2][4]; float sc[2][4];
#pragma unroll
        for (int ai = 0; ai < 2; ++ai)
#pragma unroll
            for (int m = 0; m < 4; ++m) rsv[ai][m] = *(const f32x4*)(rskv + (size_t)(row0 + ai * HALF + m * 16) * 4);
#pragma unroll
        for (int ai = 0; ai < 2; ++ai)
#pragma unroll
            for (int m = 0; m < 4; ++m) { const f32x4 a = rsv[ai][m]; sc[ai][m] = 1.0f / sqrtf(((a[0] + a[1]) + (a[2] + a[3])) * (1.0f / 128.0f) + NORM_EPS); }
#pragma unroll
        for (int bj = 0; bj < 2; ++bj) { const int h = 2 * (u.pn - 3) + bj; bf16_t* dst = (wc < 2 ? Kn + wc * 32 : Vm + (wc - 2) * 32) + (fq & 1) * 16 + (fq >> 1) * 8;
#pragma unroll
            for (int ai = 0; ai < 2; ++ai)
#pragma unroll
                for (int m = 0; m < 4; ++m) { const int row = row0 + ai * HALF + m * 16; const float s = sc[ai][m];
                    const f32x4 v0 = acc[ai][bj][m][0] * s, v1 = acc[ai][bj][m][1] * s;
                    u32x2 w0, w1; w0.x = cvt_pk_bf16(v0[0], v0[1]); w0.y = cvt_pk_bf16(v0[2], v0[3]); w1.x = cvt_pk_bf16(v1[0], v1[1]); w1.y = cvt_pk_bf16(v1[2], v1[3]);
                    { auto r = __builtin_amdgcn_permlane16_swap(w0.x, w1.x, false, false); w0.x = r[0]; w1.x = r[1]; }
                    { auto r = __builtin_amdgcn_permlane16_swap(w0.y, w1.y, false, false); w0.y = r[0]; w1.y = r[1]; }
                    { bf16_t* p = dst + ((size_t)((row >> 12) * 6 + h) * SEQ + (row & (SEQ - 1))) * 64; *(u32x4*)p = (u32x4){w0.x, w0.y, w1.x, w1.y}; } } }
    }
};
struct EpiGate { static constexpr bool PERM = true, AFTER_DRAIN = false, RS_PREFETCH = true; static __device__ __forceinline__ bool rs_wanted(const Unit&) { return true; }
    bf16_t* O; const u64* rsu;
    __device__ __forceinline__ void operator()(const f32x4 (&acc)[2][2][4][2], const Unit& u, int wr, int wc, int fr, int fq, const PG8_LAS unsigned char* ldsbase) const {
        const int row0 = u.pm * BM + wr * 64 + fr, col0 = u.pn * BM + wc * 32 + 8 * fq;
        float sc[2][4]; row_scales8(ldsbase, wr, fr, sc);
#pragma unroll
        for (int ai = 0; ai < 2; ++ai)
#pragma unroll
            for (int m = 0; m < 4; ++m) { const int row = row0 + ai * HALF + m * 16; const float s = sc[ai][m];
#pragma unroll
                for (int bj = 0; bj < 2; ++bj) { float y[8];
#pragma unroll
                    for (int n = 0; n < 2; ++n)
#pragma unroll
                        for (int j = 0; j < 4; ++j) y[4 * n + j] = sigm_f(acc[ai][bj][m][n][j] * s);
                    u32x4 w; w.x = cvt_pk_bf16(y[0], y[1]); w.y = cvt_pk_bf16(y[2], y[3]); w.z = cvt_pk_bf16(y[4], y[5]); w.w = cvt_pk_bf16(y[6], y[7]);
                    *(u32x4*)(O + (size_t)row * 3072 + col0 + bj * HALF) = w; } }
    }
};
struct EpiMerge { static constexpr bool PERM = true, AFTER_DRAIN = false, RS_PREFETCH = false;
    const bf16_t* G; bf16_t* Mg;
    __device__ __forceinline__ void operator()(const f32x4 (&acc)[2][2][4][2], const Unit& u, int wr, int wc, int fr, int fq, const PG8_LAS unsigned char* ldsbase) const {
        const int row0 = u.pm * BM + wr * 64 + fr, col0 = u.pn * BM + wc * 32 + 8 * fq; const bool first = (u.sub == 0); const bf16_t* Gs = G + u.sub * 1024;
#pragma unroll
        for (int ai = 0; ai < 2; ++ai) {
            u32x4 gv[4][2], pv[4][2];
#pragma unroll
            for (int m = 0; m < 4; ++m)
#pragma unroll
                for (int bj = 0; bj < 2; ++bj) { const int row = row0 + ai * HALF + m * 16; gv[m][bj] = *(const u32x4*)(Gs + (size_t)row * 3072 + col0 + bj * HALF);
                    pv[m][bj] = (u32x4){0u, 0u, 0u, 0u}; if (!first) pv[m][bj] = *(const u32x4*)(Mg + (size_t)row * DM + col0 + bj * HALF); }
#pragma unroll
            for (int m = 0; m < 4; ++m)
#pragma unroll
                for (int bj = 0; bj < 2; ++bj) { const int row = row0 + ai * HALF + m * 16; const u32x4 g = gv[m][bj], p = pv[m][bj];
                    const f32x4 a0 = acc[ai][bj][m][0], a1 = acc[ai][bj][m][1];
                    u32x4 w;
                    w.x = cvt_pk_bf16(bflo(p.x) + bflo(g.x) * a0[0], bfhi(p.x) + bfhi(g.x) * a0[1]);
                    w.y = cvt_pk_bf16(bflo(p.y) + bflo(g.y) * a0[2], bfhi(p.y) + bfhi(g.y) * a0[3]);
                    w.z = cvt_pk_bf16(bflo(p.z) + bflo(g.z) * a1[0], bfhi(p.z) + bfhi(g.z) * a1[1]);
                    w.w = cvt_pk_bf16(bflo(p.w) + bflo(g.w) * a1[2], bfhi(p.w) + bfhi(g.w) * a1[3]);
                    *(u32x4*)(Mg + (size_t)row * DM + col0 + bj * HALF) = w; }
        }
    }
};

struct FusedOrder : StaticOrder {
    __host__ __device__ bool next(int i, Unit& u) const { if (!StaticOrder::next(i / 6, u)) return false; const int j = i % 6, br = j >> 1; u.sub = j;
        if ((j & 1) == 0) { u.sel = 0; u.ka = 0; u.kb = br * (1024 * 1024 * 2); u.nt = 16; } else { u.sel = 1; u.ka = br * 768; u.kb = u.ka; u.nt = (br == 2) ? 4 : 6; }
        return true; }
};
struct EpiFused { static constexpr bool PERM = true, AFTER_DRAIN = false, RS_PREFETCH = true; static __device__ __forceinline__ bool rs_wanted(const Unit& u) { return (u.sub & 1) == 0; }
    bf16_t* gs; bf16_t* Mg; const u64* rsu;
    __device__ __forceinline__ void operator()(const f32x4 (&acc)[2][2][4][2], const Unit& u, int wr, int wc, int fr, int fq, const PG8_LAS unsigned char* ldsbase) const {
        int tid = (wr * 4 + wc) * 64 + fq * 16 + fr; asm volatile("" : "+v"(tid));
        const int row0 = u.pm * BM + wr * 64 + fr, col0 = u.pn * BM + wc * 32 + 8 * fq;
        if ((u.sub & 1) == 0) {
            float sc[2][4]; row_scales8(ldsbase, wr, fr, sc);
#pragma unroll
            for (int ai = 0; ai < 2; ++ai)
#pragma unroll
                for (int m = 0; m < 4; ++m) { const float s = sc[ai][m];
#pragma unroll
                    for (int bj = 0; bj < 2; ++bj) { float y[8];
#pragma unroll
                        for (int n = 0; n < 2; ++n)
#pragma unroll
                            for (int j = 0; j < 4; ++j) y[4 * n + j] = sigm_f(acc[ai][bj][m][n][j] * s);
                        u32x4 w; w.x = cvt_pk_bf16(y[0], y[1]); w.y = cvt_pk_bf16(y[2], y[3]); w.z = cvt_pk_bf16(y[4], y[5]); w.w = cvt_pk_bf16(y[6], y[7]);
                        *(u32x4*)(gs + (size_t)((((ai * 4 + m) * 2 + bj) * 512 + tid) * 8)) = w; } }
        } else {
            const bool first = (u.sub == 1);
#pragma unroll
            for (int ai = 0; ai < 2; ++ai) {
                u32x4 gv[4][2], pv[4][2];
#pragma unroll
                for (int m = 0; m < 4; ++m)
#pragma unroll
                    for (int bj = 0; bj < 2; ++bj) { const int row = row0 + ai * HALF + m * 16; gv[m][bj] = *(const u32x4*)(gs + (size_t)((((ai * 4 + m) * 2 + bj) * 512 + tid) * 8));
                        pv[m][bj] = (u32x4){0u, 0u, 0u, 0u}; if (!first) pv[m][bj] = *(const u32x4*)(Mg + (size_t)row * DM + col0 + bj * HALF); }
#pragma unroll
                for (int m = 0; m < 4; ++m)
#pragma unroll
                    for (int bj = 0; bj < 2; ++bj) { const int row = row0 + ai * HALF + m * 16; const u32x4 g = gv[m][bj], p = pv[m][bj];
                        const f32x4 a0 = acc[ai][bj][m][0], a1 = acc[ai][bj][m][1];
                        u32x4 w;
                        w.x = cvt_pk_bf16(bflo(p.x) + bflo(g.x) * a0[0], bfhi(p.x) + bfhi(g.x) * a0[1]);
                        w.y = cvt_pk_bf16(bflo(p.y) + bflo(g.y) * a0[2], bfhi(p.y) + bfhi(g.y) * a0[3]);
                        w.z = cvt_pk_bf16(bflo(p.z) + bflo(g.z) * a1[0], bfhi(p.z) + bfhi(g.z) * a1[1]);
                        w.w = cvt_pk_bf16(bflo(p.w) + bflo(g.w) * a1[2], bfhi(p.w) + bfhi(g.w) * a1[3]);
                        *(u32x4*)(Mg + (size_t)row * DM + col0 + bj * HALF) = w; } }
        }
    }
};

template <class Epi, class Sched, bool ALIGN_EPI = false>
__device__ __forceinline__ void gemm_phase(PG8_LAS unsigned char* lds, const Gemm g, const Sched& S, const Epi& E, int tid_in) {
    int tid_ = tid_in; asm volatile("" : "+v"(tid_));
    const int tid = tid_, wid = __builtin_amdgcn_readfirstlane(tid >> 6), lane = tid & 63, wr = wid >> 2, wc = wid & 3, fr = lane & 15, fq = lane >> 4;
    int K = g.K; asm volatile("" : "+s"(K)); const int nt = K / BK;
    unsigned voffA[2], voffB[2];
#pragma unroll
    for (int i = 0; i < 2; ++i) { int R, C; stage_rc(tid * 16 + i * 8192, R, C); const int Rb = Epi::PERM ? ((R & ~31) + perm32(R & 31)) : R;
        voffA[i] = (unsigned)(R * g.lda + C) * 2u; voffB[i] = (unsigned)(Rb * g.ldb + C) * 2u; }
    const size_t kstep = (size_t)(BK * 2);
    const size_t hstepA = (size_t)HALF * g.lda * 2, hstepB = (size_t)HALF * g.ldb * 2;
    const size_t tstepA = 2 * hstepA, tstepB = 2 * hstepB;
    const unsigned ldsw = (unsigned)wid * 1024u;
    const int aoff = lds_byte(wr * 64 + fr, fq * 8), boff = lds_byte(wc * 32 + fr, fq * 8);
#define PG8_SA(b, h) (((b) * 2 + (h)) * HTB)
#define PG8_SB(b, h) ((4 + (b) * 2 + (h)) * HTB)
#define PG8_STAGE(bufoff, gbase, voff) do { _Pragma("unroll") for (int _i = 0; _i < 2; ++_i) \
        __builtin_amdgcn_global_load_lds((const unsigned*)((const char*)(gbase) + (voff)[_i]), (PG8_LAS unsigned*)(lds + (bufoff) + ldsw + _i * 8192), 16, 0, 0); } while (0)
#define PG8_LDA(dst, b, h) do { _Pragma("unroll") for (int m = 0; m < 4; ++m) _Pragma("unroll") for (int k = 0; k < 2; ++k) dst[m][k] = *(const PG8_LAS bf16x8*)(lds + PG8_SA(b, h) + aoff + m * 2048 + k * 1024); } while (0)
#define PG8_LDB(dst, b, h) do { _Pragma("unroll") for (int n = 0; n < 2; ++n) _Pragma("unroll") for (int k = 0; k < 2; ++k) dst[n][k] = *(const PG8_LAS bf16x8*)(lds + PG8_SB(b, h) + boff + n * 2048 + k * 1024); } while (0)
#define PG8_MMA(ai, bj, At, Bt) do { __builtin_amdgcn_s_setprio(1); _Pragma("unroll") for (int m = 0; m < 4; ++m) _Pragma("unroll") for (int n = 0; n < 2; ++n) _Pragma("unroll") for (int k = 0; k < 2; ++k) \
        acc[ai][bj][m][n] = __builtin_amdgcn_mfma_f32_16x16x32_bf16(Bt[n][k], At[m][k], acc[ai][bj][m][n], 0, 0, 0); __builtin_amdgcn_s_setprio(0); } while (0)
#define PG8_WAIT_V(n) asm volatile("s_waitcnt vmcnt(" #n ")" ::: "memory")
#define PG8_WAIT_L(n) asm volatile("s_waitcnt lgkmcnt(" #n ")" ::: "memory")
#define PG8_BAR __builtin_amdgcn_s_barrier()
#define PG8_SCHED __builtin_amdgcn_sched_barrier(0)
    Unit cur, nxt; int ui = 0;
    if (!S.next(0, cur)) return;
    f32x4 acc[2][2][4][2];
#pragma unroll
    for (int a = 0; a < 2; ++a)
#pragma unroll
        for (int b = 0; b < 2; ++b)
#pragma unroll
            for (int m = 0; m < 4; ++m)
#pragma unroll
                for (int n = 0; n < 2; ++n) acc[a][b][m][n] = (f32x4){0.f, 0.f, 0.f, 0.f};
    bf16x8 At[4][2], B0[2][2], B1[2][2];
    const char* cA = (const char*)(cur.sel ? g.A1 : g.A) + (size_t)cur.pm * tstepA + cur.ka; const char* cB = (const char*)(cur.sel ? g.Bt1 : g.Bt) + (size_t)cur.pn * tstepB + cur.kb;
    S.a_ready(cur);
    PG8_STAGE(PG8_SB(0, 0), cB, voffB); PG8_STAGE(PG8_SB(0, 1), cB + hstepB, voffB); PG8_STAGE(PG8_SA(0, 0), cA, voffA); PG8_STAGE(PG8_SA(0, 1), cA + hstepA, voffA);
    if (wr == 1) PG8_BAR;
    PG8_WAIT_V(2); PG8_BAR;
    PG8_STAGE(PG8_SB(1, 0), cB + kstep, voffB); PG8_STAGE(PG8_SA(1, 0), cA + kstep, voffA); PG8_STAGE(PG8_SB(1, 1), cB + hstepB + kstep, voffB);
    PG8_WAIT_V(6); PG8_BAR;
    for (;;) {
        const bool has_next = S.next(ui + 1, nxt);
        const char* nA = has_next ? (const char*)(nxt.sel ? g.A1 : g.A) + (size_t)nxt.pm * tstepA + nxt.ka : cA; const char* nB = has_next ? (const char*)(nxt.sel ? g.Bt1 : g.Bt) + (size_t)nxt.pn * tstepB + nxt.kb : cB;
        const int ntc = cur.nt ? cur.nt : nt;
        for (int t = 0; t < ntc; t += 2) {
            const bool last = (t == ntc - 2);
            const char* a1 = cA + (size_t)(t + 1) * kstep;
            const char* a2 = last ? nA : cA + (size_t)(t + 2) * kstep; const char* b2 = last ? nB : cB + (size_t)(t + 2) * kstep;
            const char* a3 = a2 + kstep; const char* b3 = b2 + kstep;
            if (last && has_next) S.a_ready(nxt);
            if constexpr (Epi::RS_PREFETCH) { if (last && Epi::rs_wanted(cur)) __builtin_amdgcn_global_load_lds((const unsigned*)(E.rsu + (size_t)cur.pm * BM) + tid, (PG8_LAS unsigned*)(lds + RS_LDS_OFF + wid * 256), 4, 0, 0); }
            PG8_LDB(B0, 0, 0); PG8_LDB(B1, 0, 1); PG8_SCHED; PG8_LDA(At, 0, 0); PG8_STAGE(PG8_SA(1, 1), a1 + hstepA, voffA);
            PG8_WAIT_V(8); PG8_WAIT_L(0); PG8_BAR; PG8_MMA(0, 0, At, B0); PG8_MMA(0, 1, At, B1); PG8_BAR; PG8_SCHED;
            PG8_LDA(At, 0, 1); PG8_STAGE(PG8_SB(0, 0), b2, voffB); PG8_STAGE(PG8_SB(0, 1), b2 + hstepB, voffB); PG8_STAGE(PG8_SA(0, 0), a2, voffA);
            PG8_WAIT_V(8); PG8_WAIT_L(0); PG8_BAR; PG8_MMA(1, 0, At, B0); PG8_MMA(1, 1, At, B1); PG8_BAR; PG8_SCHED;
            PG8_LDB(B0, 1, 0); PG8_LDB(B1, 1, 1); PG8_SCHED; PG8_LDA(At, 1, 0); PG8_STAGE(PG8_SA(0, 1), a2 + hstepA, voffA);
            PG8_WAIT_V(8); PG8_WAIT_L(0); PG8_BAR; PG8_MMA(0, 0, At, B0); PG8_MMA(0, 1, At, B1); PG8_BAR; PG8_SCHED;
            PG8_LDA(At, 1, 1); PG8_STAGE(PG8_SB(1, 0), b3, voffB); PG8_STAGE(PG8_SB(1, 1), b3 + hstepB, voffB); PG8_STAGE(PG8_SA(1, 0), a3, voffA);
            PG8_WAIT_V(8); PG8_WAIT_L(0); PG8_BAR; PG8_MMA(1, 0, At, B0); PG8_MMA(1, 1, At, B1); PG8_BAR; PG8_SCHED;
        }
        if constexpr (ALIGN_EPI) { if (wr == 0) PG8_BAR; }
        E(acc, cur, wr, wc, fr, fq, lds); S.done(cur);
        if (!has_next) break;
#pragma unroll
        for (int a = 0; a < 2; ++a)
#pragma unroll
            for (int b = 0; b < 2; ++b)
#pragma unroll
                for (int m = 0; m < 4; ++m)
#pragma unroll
                    for (int n = 0; n < 2; ++n) acc[a][b][m][n] = (f32x4){0.f, 0.f, 0.f, 0.f};
        cur = nxt; cA = nA; cB = nB; ++ui;
        if constexpr (ALIGN_EPI) { if (wr == 1) PG8_BAR; }
    }
    PG8_WAIT_V(0);
    if constexpr (!ALIGN_EPI) { if (wr == 0) PG8_BAR; }
    PG8_BAR;
#undef PG8_SA
#undef PG8_SB
#undef PG8_STAGE
#undef PG8_LDA
#undef PG8_LDB
#undef PG8_MMA
#undef PG8_WAIT_V
#undef PG8_WAIT_L
#undef PG8_BAR
#undef PG8_SCHED
}
}

constexpr int NWAVES = 8;
constexpr size_t MiB = 1u << 20;
constexpr size_t WS_CTL = 0, CTL_ZERO_BYTES = 6 * MiB;
constexpr size_t WS_ROPE = 1 * MiB;
constexpr size_t WS_KMEAN = WS_ROPE + 512 * 1024;
constexpr size_t WS_RS = 2 * MiB;
constexpr size_t WS_RSQ = 6 * MiB;
constexpr size_t WS_RSKV = WS_RSQ + 512 * 1024;
constexpr size_t WS_W = 7 * MiB;
constexpr size_t W_GU1 = 0, W_D1 = W_GU1 + (size_t)5632 * 1024 * 2, W_IN = W_D1 + (size_t)1024 * 2816 * 2, W_G = W_IN + (size_t)4096 * 1024 * 2,
                 W_UQ = W_G + (size_t)3072 * 1024 * 2, W_UKV = W_UQ + (size_t)768 * 256 * 2, W_BR = W_UKV + (size_t)768 * 256 * 2, W_OUT = W_BR + (size_t)1024 * 1024 * 2,
                 W_GU2 = W_OUT + (size_t)1024 * 1024 * 2, W_D2 = W_GU2 + (size_t)5632 * 1024 * 2, W_END = W_D2 + (size_t)1024 * 2816 * 2;
static_assert(W_END <= 52 * MiB, "weights region");
constexpr size_t WS_XB = 59 * MiB;
constexpr size_t WS_PROJ = 123 * MiB;
constexpr size_t WS_QM = 379 * MiB;
constexpr size_t WS_KN = 415 * MiB;
constexpr size_t WS_VM = 439 * MiB;
constexpr size_t WS_KR = 463 * MiB;
constexpr size_t WS_MG = WS_QM;
constexpr size_t WS_AO = 465 * MiB;
constexpr size_t WS_LSE = 529 * MiB;
constexpr size_t WS_END = 531 * MiB;
static_assert(WS_RS + (size_t)13 * T * 8 <= WS_RSQ && WS_RSQ + MiB <= WS_W && WS_W + 52 * MiB <= WS_XB && WS_RSQ <= CTL_ZERO_BYTES + 0 * MiB + WS_RSQ, "d_ws map");
constexpr int CW_BAR = 4096;
constexpr int CW_QUEUE = 8192;

constexpr int RING_OFF = 0, RING_BYTES = 131072;
constexpr int LDSCTL_OFF = RING_BYTES, MISC_OFF = LDSCTL_OFF + 320;
constexpr int LDS_BYTES = 147456;

#define GAS __attribute__((address_space(1)))
#define LAS __attribute__((address_space(3)))
typedef unsigned short bf16;
typedef unsigned v4u __attribute__((ext_vector_type(4)));
typedef unsigned v2u __attribute__((ext_vector_type(2)));
typedef float f32x4 __attribute__((ext_vector_type(4)));
typedef GAS unsigned gu32;
#define RLX_AGENT __ATOMIC_RELAXED, __HIP_MEMORY_SCOPE_AGENT
#define LDS_WAIT() asm volatile("s_waitcnt lgkmcnt(0)" ::: "memory")
__device__ __forceinline__ unsigned f2bf(float f) { unsigned u = __builtin_bit_cast(unsigned, f); return (u + 0x7fffu + ((u >> 16) & 1u)) >> 16; }
__device__ __forceinline__ unsigned pk2(float lo, float hi) { return f2bf(lo) | (f2bf(hi) << 16); }
__device__ __forceinline__ float bflo(unsigned w) { return __uint_as_float(w << 16); }
__device__ __forceinline__ float bfhi(unsigned w) { return __uint_as_float(w & 0xffff0000u); }

#define XB_TMO      128
#define XB_XCNT(j)  (256  + 64 * (j))
#define XB_XSUB(j)  (1280 + 64 * (j))
#define XB_XGEN(j)  (2304 + 64 * (j))
#define XB_TOP      3328
#define XB_TOPGEN   3392
#define XCD_BAR_WORDS 3456
#define XB_SPIN_CAP (1u << 20)

__device__ __forceinline__ unsigned xb_ld(unsigned* p)              { return __hip_atomic_load(p, __ATOMIC_RELAXED, __HIP_MEMORY_SCOPE_AGENT); }
__device__ __forceinline__ unsigned xb_add(unsigned* p, unsigned v) { return __hip_atomic_fetch_add(p, v, __ATOMIC_RELAXED, __HIP_MEMORY_SCOPE_AGENT); }
__device__ __forceinline__ unsigned xb_xcc_id() { return (unsigned)__builtin_amdgcn_s_getreg((3 << 11) | 20) & 0xFu; }
#define XB_SPIN(cond, bar) do { unsigned _sp = 0; while (cond) { __builtin_amdgcn_s_sleep(1); \
    if ((++_sp & 255u) == 0u) { if (xb_ld(&(bar)[XB_TMO])) break; if (_sp > XB_SPIN_CAP) { atomicAdd(&(bar)[XB_TMO], 1u); break; } } } } while (0)

struct XcdBarrier { unsigned* bar; unsigned x; volatile LAS unsigned* st; };

__device__ __forceinline__ XcdBarrier xcd_barrier_post(unsigned* bar, volatile LAS unsigned* st) {
    XcdBarrier b; b.bar = bar; b.x = xb_xcc_id(); b.st = st;
    if (threadIdx.x == 0) (void)xb_add(&bar[XB_XCNT(b.x)], 1u);
    return b;
}
__device__ __forceinline__ void xcd_barrier_complete(unsigned* bar, unsigned x, unsigned& nloc, unsigned& nx) {
    const unsigned G = gridDim.x * gridDim.y * gridDim.z;
    unsigned sum, cnt, mine, sp = 0u;
    for (;;) {
        sum = 0u; cnt = 0u; mine = 0u;
#pragma unroll
        for (unsigned j = 0; j < 16; ++j) { const unsigned c = xb_ld(&bar[XB_XCNT(j)]); sum += c; cnt += (c > 0u) ? 1u : 0u; mine = (j == x) ? c : mine; }
        if (sum == G) break;
        __builtin_amdgcn_s_sleep(1);
        if ((++sp & 255u) == 0u) { if (xb_ld(&bar[XB_TMO])) break; if (sp > XB_SPIN_CAP) { atomicAdd(&bar[XB_TMO], 1u); break; } }
    }
    nloc = mine > 0u ? mine : 1u; nx = cnt > 0u ? cnt : 1u;
}
__device__ __forceinline__ void xcd_barrier(const XcdBarrier& b, bool leader) {
    asm volatile("s_waitcnt vmcnt(0)" ::: "memory");
    __syncthreads();
    if (leader) {
        unsigned* bar = b.bar; asm volatile("" : "+s"(bar));
        __builtin_amdgcn_s_waitcnt(0);
        unsigned nloc = b.st[0], nx = b.st[1];
        if (nloc == 0u) { xcd_barrier_complete(bar, b.x, nloc, nx); b.st[0] = nloc; b.st[1] = nx; }
        const unsigned old = xb_add(&bar[XB_XSUB(b.x)], 1u);
        const unsigned gen = old / nloc;
        if (old + 1u == (gen + 1u) * nloc) {
            __builtin_amdgcn_fence(__ATOMIC_RELEASE, "agent");
            asm volatile("s_waitcnt vmcnt(0)" ::: "memory");
            const unsigned og = xb_add(&bar[XB_TOP], 1u);
            const unsigned tg = og / nx;
            if (og + 1u == (tg + 1u) * nx) xb_add(&bar[XB_TOPGEN], 1u);
            else XB_SPIN(xb_ld(&bar[XB_TOPGEN]) == tg, bar);
            __builtin_amdgcn_fence(__ATOMIC_ACQUIRE, "agent");
            xb_add(&bar[XB_XGEN(b.x)], 1u);
            asm volatile("s_waitcnt vmcnt(0)" ::: "memory");
        } else {
            XB_SPIN(xb_ld(&bar[XB_XGEN(b.x)]) == gen, bar);
            __builtin_amdgcn_fence(__ATOMIC_ACQUIRE, "agent");
            asm volatile("s_waitcnt vmcnt(0)" ::: "memory");
        }
    }
    __syncthreads();
}

__device__ __forceinline__ float wave_sum(float v) {
#pragma unroll
    for (int o = 1; o < 64; o <<= 1) v += __shfl_xor(v, o);
    return v;
}
__device__ __forceinline__ void cvt_item(const float* W, int N, const float* gain, bf16* WT, int dpitch, int dkoff, int k0, int n0, int drow0, LAS float* scr, int lane) {
    float wv[32];
#pragma unroll
    for (int i = 0; i < 32; ++i) { const int kk = 2 * i + (lane >> 5); wv[i] = W[(size_t)(k0 + kk) * N + n0 + (lane & 31)]; }
#pragma unroll
    for (int i = 0; i < 32; ++i) { const int kk = 2 * i + (lane >> 5); float v = wv[i]; if (gain) v *= gain[k0 + kk]; scr[kk * 33 + (lane & 31)] = v; }
    LDS_WAIT(); asm volatile("" ::: "memory");
    const int c = lane & 7;
#pragma unroll
    for (int j = 0; j < 4; ++j) { const int n = (lane >> 3) + 8 * j; const LAS float* s = scr + (8 * c) * 33 + n;
        v4u o; o.x = pk2(s[0 * 33], s[1 * 33]); o.y = pk2(s[2 * 33], s[3 * 33]); o.z = pk2(s[4 * 33], s[5 * 33]); o.w = pk2(s[6 * 33], s[7 * 33]);
        *(GAS v4u*)(WT + (size_t)(drow0 + n) * dpitch + dkoff + k0 + 8 * c) = o; }
    LDS_WAIT(); asm volatile("" ::: "memory");
}
template <class RowMap>
__device__ __forceinline__ void cvt_matrix(const float* W, int K, int N, int nb0, int nblk, const float* gain, bf16* WT, int dpitch, int dkoff, const RowMap& RM, LAS float* scr, int gw, int NGW, int lane, int& base) {
    const int nit = (K / 64) * nblk;
    int first = gw - (base % NGW); if (first < 0) first += NGW;
    for (int it = first; it < nit; it += NGW) { const int kb = it / nblk, nb = nb0 + it % nblk; cvt_item(W, N, gain, WT, dpitch, dkoff, 64 * kb, 32 * nb, RM(32 * nb), scr, lane); }
    base += nit;
}
struct RmId { __device__ __forceinline__ int operator()(int n0) const { return n0; } };
struct RmGU { int add; __device__ __forceinline__ int operator()(int n0) const { return 256 * (n0 / 128) + (n0 % 128) + add; } };
struct RmIn { __device__ __forceinline__ int operator()(int n0) const {
    if (n0 < 256) return PC_CQ + n0; if (n0 < 384) return PC_CKV + (n0 - 256); if (n0 < 416) return PC_KR + (n0 - 384); if (n0 < 1568) return PC_MQ + (n0 - 416); if (n0 < 3872) return PC_DQ + (n0 - 1568);
    return 4096 + (n0 - 3872); } };
static_assert(W_G == W_IN + (size_t)4096 * 1024 * 2, "gate weights follow w_in");

__device__ __forceinline__ int OPQ_S(int v) { asm volatile("" : "+s"(v)); return v; }
__device__ __forceinline__ int lane_id_volatile() { int l; asm volatile("v_mbcnt_lo_u32_b32 %0, -1, 0\n\tv_mbcnt_hi_u32_b32 %0, -1, %0" : "=v"(l)); return l; }

#define CVT_SET_A(L, gw_, ngw_) do { int base_ = 0; const int L_ = (L); \
    cvt_matrix(args.in[2] + (size_t)L_ * DM * FF, DM, FF, 0, FF / 32, args.in[1] + L_ * DM, Wb + W_GU1 / 2, DM, 0, RmGU{0}, scr, gw_, ngw_, lane, base_); \
    cvt_matrix(args.in[3] + (size_t)L_ * DM * FF, DM, FF, 0, FF / 32, args.in[1] + L_ * DM, Wb + W_GU1 / 2, DM, 0, RmGU{128}, scr, gw_, ngw_, lane, base_); \
    cvt_matrix(args.in[4] + (size_t)L_ * FF * DM, FF, DM, 0, DM / 32, nullptr, Wb + W_D1 / 2, FF, 0, RmId{}, scr, gw_, ngw_, lane, base_); \
    cvt_matrix(args.in[6] + (size_t)L_ * DM * IN_COLS, DM, IN_COLS, 0, 121, args.in[5] + L_ * DM, Wb + W_IN / 2, DM, 0, RmIn{}, scr, gw_, ngw_, lane, base_); \
    cvt_matrix(args.in[8] + (size_t)L_ * 256 * 576, 256, 576, 0, 18, args.in[7] + L_ * 256, Wb + W_UQ / 2, 256, 0, RmId{}, scr, gw_, ngw_, lane, base_); \
    cvt_matrix(args.in[10] + (size_t)L_ * 128 * 768, 128, 768, 0, 24, args.in[9] + L_ * 128, Wb + W_UKV / 2, 256, 0, RmId{}, scr, gw_, ngw_, lane, base_); } while (0)
#define CVT_SET_B(L, gw_, ngw_) do { int base_ = 0; const int L_ = (L); \
    cvt_matrix(args.in[6] + (size_t)L_ * DM * IN_COLS, DM, IN_COLS, 121, 96, args.in[5] + L_ * DM, Wb + W_IN / 2, DM, 0, RmIn{}, scr, gw_, ngw_, lane, base_); \
    cvt_matrix(args.in[11] + (size_t)L_ * 384 * DM, 384, DM, 0, 32, nullptr, Wb + W_BR / 2, DM, 0, RmId{}, scr, gw_, ngw_, lane, base_); \
    cvt_matrix(args.in[12] + (size_t)L_ * 384 * DM, 384, DM, 0, 32, nullptr, Wb + W_BR / 2, DM, 384, RmId{}, scr, gw_, ngw_, lane, base_); \
    cvt_matrix(args.in[13] + (size_t)L_ * 256 * DM, 256, DM, 0, 32, nullptr, Wb + W_BR / 2, DM, 768, RmId{}, scr, gw_, ngw_, lane, base_); \
    cvt_matrix(args.in[14] + (size_t)L_ * DM * DM, DM, DM, 0, 32, nullptr, Wb + W_OUT / 2, DM, 0, RmId{}, scr, gw_, ngw_, lane, base_); \
    cvt_matrix(args.in[16] + (size_t)L_ * DM * FF, DM, FF, 0, FF / 32, args.in[15] + L_ * DM, Wb + W_GU2 / 2, DM, 0, RmGU{0}, scr, gw_, ngw_, lane, base_); \
    cvt_matrix(args.in[17] + (size_t)L_ * DM * FF, DM, FF, 0, FF / 32, args.in[15] + L_ * DM, Wb + W_GU2 / 2, DM, 0, RmGU{128}, scr, gw_, ngw_, lane, base_); \
    cvt_matrix(args.in[18] + (size_t)L_ * FF * DM, FF, DM, 0, DM / 32, nullptr, Wb + W_D2 / 2, FF, 0, RmId{}, scr, gw_, ngw_, lane, base_); } while (0)
constexpr int CVT_ITEMS_A = 2 * 16 * 88 + 44 * 32 + 16 * 121 + 4 * 18 + 2 * 24, CVT_ITEMS_B = 16 * 96 + 6 * 32 + 6 * 32 + 4 * 32 + 16 * 32 + 2 * 16 * 88 + 44 * 32;
static_assert(CVT_ITEMS_A % 8 == 0 && CVT_ITEMS_B % 8 == 0, "conversion items come in chunks of 8 (one item per wave)");
struct Frame {
    LAS unsigned char* lds; volatile LAS unsigned* MISC; gu32* ctl;
};

__device__ __forceinline__ void ld8(const bf16* p, float* f) { const v4u w = *(const v4u*)p; f[0] = bflo(w.x); f[1] = bfhi(w.x); f[2] = bflo(w.y); f[3] = bfhi(w.y); f[4] = bflo(w.z); f[5] = bfhi(w.z); f[6] = bflo(w.w); f[7] = bfhi(w.w); }
__device__ __forceinline__ float dot8(const bf16* p, const float* q) { const v4u w = *(const v4u*)p;
    return ((q[0] * bflo(w.x) + q[1] * bfhi(w.x)) + (q[2] * bflo(w.y) + q[3] * bfhi(w.y))) + ((q[4] * bflo(w.z) + q[5] * bfhi(w.z)) + (q[6] * bflo(w.w) + q[7] * bfhi(w.w))); }
__device__ __forceinline__ void axpy8(const bf16* p, float a, float c, float* o) { const v4u w = *(const v4u*)p;
    o[0] = o[0] * c + a * bflo(w.x); o[1] = o[1] * c + a * bfhi(w.x); o[2] = o[2] * c + a * bflo(w.y); o[3] = o[3] * c + a * bfhi(w.y);
    o[4] = o[4] * c + a * bflo(w.z); o[5] = o[5] * c + a * bfhi(w.z); o[6] = o[6] * c + a * bflo(w.w); o[7] = o[7] * c + a * bfhi(w.w); }
__device__ __forceinline__ void st8(bf16* p, const float* o, float s) { v4u w; w.x = pk2(o[0] * s, o[1] * s); w.y = pk2(o[2] * s, o[3] * s); w.z = pk2(o[4] * s, o[5] * s); w.w = pk2(o[6] * s, o[7] * s); *(v4u*)p = w; }

__device__ __forceinline__ void mla_naive_chunk(const bf16* Qm, const bf16* Kn, const bf16* KR, const bf16* Vm, bf16* AO, int b, int h, int chunk, int lane) {
    const int t = chunk * 64 + lane; const size_t rowb = (size_t)b * SEQ;
    float q[96];
#pragma unroll
    for (int c = 0; c < 12; ++c) ld8(Qm + (rowb + t) * 576 + h * 96 + 8 * c, q + 8 * c);
    float m = -1e30f, l = 0.f; float o[64];
#pragma unroll
    for (int d = 0; d < 64; ++d) o[d] = 0.f;
    const int jmax = chunk * 64 + 63;
    for (int j = 0; j <= jmax; ++j) {
        const bf16* kp = Kn + (rowb + j) * 384 + h * 64; const bf16* rp = KR + (rowb + j) * 32; const bf16* vp = Vm + (rowb + j) * 384 + h * 64;
        float s = 0.f;
#pragma unroll
        for (int c = 0; c < 8; ++c) s += dot8(kp + 8 * c, q + 8 * c);
#pragma unroll
        for (int c = 0; c < 4; ++c) s += dot8(rp + 8 * c, q + 64 + 8 * c);
        if (j <= t) { const float mn = fmaxf(m, s), corr = exp2f(m - mn), p = exp2f(s - mn); l = l * corr + p; m = mn;
#pragma unroll
            for (int c = 0; c < 8; ++c) axpy8(vp + 8 * c, p, corr, o + 8 * c); }
    }
    const float inv = 1.0f / l;
#pragma unroll
    for (int c = 0; c < 8; ++c) st8(AO + (rowb + t) * DM + h * 64 + 8 * c, o + 8 * c, inv);
}

__device__ __forceinline__ void moba_naive_chunk(const bf16* proj, const float* kmean, bf16* AO, int b, int h, int chunk, int lane) {
    const int t = chunk * 64 + lane; const size_t rowb = (size_t)b * SEQ; const int b_own = chunk >> 2;
    float q[64];
#pragma unroll
    for (int c = 0; c < 8; ++c) ld8(proj + (rowb + t) * PP + PC_MQ + h * 64 + 8 * c, q + 8 * c);
    const float slope = exp2f(-8.0f * (float)(12 + h + 1) / 18.0f) * LOG2E;
    float v1 = -3e38f, v2 = -3e38f, v3 = -3e38f; int i1 = -1, i2 = -1, i3 = -1;
    for (int n = 0; n < b_own; ++n) { const float* km = kmean + ((size_t)(b * 6 + h) * 16 + n) * 64; float g = 0.f;
#pragma unroll
        for (int c = 0; c < 16; ++c) { const f32x4 k4 = *(const f32x4*)(km + 4 * c); g += (q[4 * c] * k4[0] + q[4 * c + 1] * k4[1]) + (q[4 * c + 2] * k4[2] + q[4 * c + 3] * k4[3]); }
        if (g > v1) { v3 = v2; i3 = i2; v2 = v1; i2 = i1; v1 = g; i1 = n; } else if (g > v2) { v3 = v2; i3 = i2; v2 = g; i2 = n; } else if (g > v3) { v3 = g; i3 = n; } }
    unsigned sel = 0u; if (i1 >= 0) sel |= 1u << i1; if (i2 >= 0) sel |= 1u << i2; if (i3 >= 0) sel |= 1u << i3;
    float m = -1e30f, l = 0.f; float o[64];
#pragma unroll
    for (int d = 0; d < 64; ++d) o[d] = 0.f;
    for (int n = 0; n < b_own; ++n) { const bool mine = (sel >> n) & 1u; if (!__any(mine)) continue;
        for (int kk = 0; kk < 256; ++kk) { const int kpos = n * 256 + kk; const bf16* kp = proj + (rowb + kpos) * PP + PC_MK + h * 64; const bf16* vp = proj + (rowb + kpos) * PP + PC_MV + h * 64;
            float s = 0.f;
#pragma unroll
            for (int c = 0; c < 8; ++c) s += dot8(kp + 8 * c, q + 8 * c);
            s = s - slope * (float)(t - kpos);
            if (mine) { const float mn = fmaxf(m, s), corr = exp2f(m - mn), p = exp2f(s - mn); l = l * corr + p; m = mn;
#pragma unroll
                for (int c = 0; c < 8; ++c) axpy8(vp + 8 * c, p, corr, o + 8 * c); } } }
    for (int kpos = b_own * 256; kpos <= chunk * 64 + 63; ++kpos) { const bf16* kp = proj + (rowb + kpos) * PP + PC_MK + h * 64; const bf16* vp = proj + (rowb + kpos) * PP + PC_MV + h * 64;
        float s = 0.f;
#pragma unroll
        for (int c = 0; c < 8; ++c) s += dot8(kp + 8 * c, q + 8 * c);
        s = s - slope * (float)(t - kpos);
        if (kpos <= t) { const float mn = fmaxf(m, s), corr = exp2f(m - mn), p = exp2f(s - mn); l = l * corr + p; m = mn;
#pragma unroll
            for (int c = 0; c < 8; ++c) axpy8(vp + 8 * c, p, corr, o + 8 * c); } }
    const float inv = 1.0f / l;
#pragma unroll
    for (int c = 0; c < 8; ++c) st8(AO + (rowb + t) * DM + 384 + h * 64 + 8 * c, o + 8 * c, inv);
}

__device__ __forceinline__ void dil_naive_thread(const bf16* proj, bf16* AO, int b, int hg, int t) {
    const size_t rowb = (size_t)b * SEQ;
    float m = -1e30f, l = 0.f; float o[64];
#pragma unroll
    for (int d = 0; d < 64; ++d) o[d] = 0.f;
    for (int g = 0; g < 3; ++g) { const int h = g * 4 + hg, dil = (g == 0) ? 1 : (g == 1) ? 4 : 16; const float slope = exp2f(-8.0f * (float)(h + 1) / 18.0f) * LOG2E;
        float q[64];
#pragma unroll
        for (int c = 0; c < 8; ++c) ld8(proj + (rowb + t) * PP + PC_DQ + h * 64 + 8 * c, q + 8 * c);
        for (int j = 0; j <= 128; ++j) { const int kpos = t - j * dil;
            if (kpos >= 0) { const bf16* kp = proj + (rowb + kpos) * PP + PC_DK + h * 64; const bf16* vp = proj + (rowb + kpos) * PP + PC_DV + h * 64;
                float s = 0.f;
#pragma unroll
                for (int c = 0; c < 8; ++c) s += dot8(kp + 8 * c, q + 8 * c);
                s = s - slope * (float)(j * dil);
                const float mn = fmaxf(m, s), corr = exp2f(m - mn), p = exp2f(s - mn); l = l * corr + p; m = mn;
#pragma unroll
                for (int c = 0; c < 8; ++c) axpy8(vp + 8 * c, p, corr, o + 8 * c); } } }
    const float inv = 1.0f / l;
#pragma unroll
    for (int c = 0; c < 8; ++c) st8(AO + (rowb + t) * DM + 768 + hg * 64 + 8 * c, o + 8 * c, inv);
}

namespace fa {
typedef float f32x16 __attribute__((ext_vector_type(16)));
typedef short bf16x8 __attribute__((ext_vector_type(8)));
typedef short s16x4 __attribute__((ext_vector_type(4)));
#define FLAS __attribute__((address_space(3)))
constexpr float NEG = -1.0e30f, POS = 1.0e30f, RESC_THR = 8.0f;
__device__ __forceinline__ int crow(int r, int hi) { return (r & 3) + 8 * (r >> 2) + 4 * hi; }
__device__ __forceinline__ float xmax(float v) { auto rr = __builtin_amdgcn_permlane32_swap(__float_as_uint(v), __float_as_uint(v), false, false); return fmaxf(__uint_as_float(rr[0]), __uint_as_float(rr[1])); }
__device__ __forceinline__ float xsum(float v) { auto rr = __builtin_amdgcn_permlane32_swap(__float_as_uint(v), __float_as_uint(v), false, false); return __uint_as_float(rr[0]) + __uint_as_float(rr[1]); }
__device__ __forceinline__ float xother(float v, int hi) { auto rr = __builtin_amdgcn_permlane32_swap(__float_as_uint(v), __float_as_uint(v), false, false); return hi ? __uint_as_float(rr[0]) : __uint_as_float(rr[1]); }
__device__ __forceinline__ float max16(const f32x16& a) { float x = fmaxf(fmaxf(a[0], a[1]), fmaxf(a[2], a[3])), y = fmaxf(fmaxf(a[4], a[5]), fmaxf(a[6], a[7])), z = fmaxf(fmaxf(a[8], a[9]), fmaxf(a[10], a[11])), w = fmaxf(fmaxf(a[12], a[13]), fmaxf(a[14], a[15])); return fmaxf(fmaxf(x, y), fmaxf(z, w)); }
__device__ __forceinline__ bf16x8 pack8(const f32x16& p, int s8) {
    v4u w; w.x = pg8::cvt_pk_bf16(p[s8 + 0], p[s8 + 1]); w.y = pg8::cvt_pk_bf16(p[s8 + 2], p[s8 + 3]); w.z = pg8::cvt_pk_bf16(p[s8 + 4], p[s8 + 5]); w.w = pg8::cvt_pk_bf16(p[s8 + 6], p[s8 + 7]);
    return __builtin_bit_cast(bf16x8, w); }
#define FA_MFMA(a, b, c) __builtin_amdgcn_mfma_f32_32x32x16_bf16((a), (b), (c), 0, 0, 0)
template <int DK> __device__ __forceinline__ f32x16 qk_half(const FLAS char* krow, int hi, const bf16x8* qf, const f32x16& c) {
    f32x16 s = c;
#pragma unroll
    for (int d0 = 0; d0 < DK / 16; ++d0) { const bf16x8 kf = *(const FLAS bf16x8*)(krow + d0 * 32 + hi * 16); s = FA_MFMA(kf, qf[d0], s); }
    return s; }
__device__ __forceinline__ void pv_half(f32x16& o0, f32x16& o1, const FLAS char* vrow, int VP, int hi, const f32x16& p) {
#pragma unroll
    for (int s = 0; s < 2; ++s) { const bf16x8 pf = pack8(p, 8 * s);
        const FLAS char* v0 = vrow + (16 * s + 4 * hi) * 2; const FLAS char* v1 = v0 + 32 * VP;
        const s16x4 a0 = *(const FLAS s16x4*)v0, a1 = *(const FLAS s16x4*)(v0 + 16), b0 = *(const FLAS s16x4*)v1, b1 = *(const FLAS s16x4*)(v1 + 16);
        o0 = FA_MFMA(((bf16x8){a0[0], a0[1], a0[2], a0[3], a1[0], a1[1], a1[2], a1[3]}), pf, o0);
        o1 = FA_MFMA(((bf16x8){b0[0], b0[1], b0[2], b0[3], b1[0], b1[1], b1[2], b1[3]}), pf, o1); }
}
typedef short v4i16_t __attribute__((ext_vector_type(4)));
__device__ __forceinline__ s16x4 vtr(const FLAS char* p) { return __builtin_bit_cast(s16x4, __builtin_amdgcn_ds_read_tr16_b64_v4i16((FLAS v4i16_t*)p)); }
__device__ __forceinline__ int tr_lane_off(int lane, int VP) { return (4 * (lane >> 5) + ((lane & 15) >> 2)) * VP + ((lane & 3) * 4 + 16 * ((lane >> 4) & 1)) * 2; }
__device__ __forceinline__ void pv_half_tr(f32x16& o0, f32x16& o1, const FLAS char* vhalf, int VP, const f32x16& p) {
#pragma unroll
    for (int s = 0; s < 2; ++s) { const bf16x8 pf = pack8(p, 8 * s); const FLAS char* a = vhalf + 16 * s * VP;
        const s16x4 a0 = vtr(a), a1 = vtr(a + 8 * VP), b0 = vtr(a + 64), b1 = vtr(a + 8 * VP + 64);
        o0 = FA_MFMA(((bf16x8){a0[0], a0[1], a0[2], a0[3], a1[0], a1[1], a1[2], a1[3]}), pf, o0);
        o1 = FA_MFMA(((bf16x8){b0[0], b0[1], b0[2], b0[3], b1[0], b1[1], b1[2], b1[3]}), pf, o1); }
}
__device__ __forceinline__ void store_o(bf16* orow, const f32x16& o0, const f32x16& o1, float inv, int hi) {
#pragma unroll
    for (int blk = 0; blk < 2; ++blk)
#pragma unroll
        for (int g = 0; g < 4; g += 2) { const f32x16& o = blk ? o1 : o0;
            unsigned ax = pg8::cvt_pk_bf16(o[4 * g] * inv, o[4 * g + 1] * inv), ay = pg8::cvt_pk_bf16(o[4 * g + 2] * inv, o[4 * g + 3] * inv);
            unsigned bx = pg8::cvt_pk_bf16(o[4 * g + 4] * inv, o[4 * g + 5] * inv), by = pg8::cvt_pk_bf16(o[4 * g + 6] * inv, o[4 * g + 7] * inv);
            { auto r = __builtin_amdgcn_permlane32_swap(ax, bx, false, false); ax = r[0]; bx = r[1]; }
            { auto r = __builtin_amdgcn_permlane32_swap(ay, by, false, false); ay = r[0]; by = r[1]; }
            *(v4u*)(orow + 32 * blk + 8 * g + 8 * hi) = (v4u){ax, ay, bx, by}; }
}

template <int DK, bool MOBA>
__device__ __forceinline__ void flash_unit(FLAS char* lds, int tid_in, int b, int qb,
        const bf16* Qh, int qpitch, const bf16* Kh, int kpitch, const bf16* KRb, const bf16* Vh, int vpitch, bf16* Oh,
        const bf16* kmh, const bf16* kml, float slope2) {
    constexpr int KP = DK * 2 + 16, VP = 192, KBUF = 64 * KP, VBUF = 64 * VP;
    int tid = tid_in; asm volatile("" : "+v"(tid));
    const int lane = tid & 63, w = __builtin_amdgcn_readfirstlane(tid >> 6), r32 = lane & 31, hi = lane >> 5;
    const int q0 = qb * 256; (void)b;
    bf16x8 qf[DK / 16];
    { const bf16* qp = Qh + (size_t)(q0 + 32 * w + r32) * qpitch + 8 * hi;
#pragma unroll
      for (int d0 = 0; d0 < DK / 16; ++d0) qf[d0] = *(const bf16x8*)(qp + 16 * d0); }
    unsigned sel = 0u;
    f32x16 cinit;
#pragma unroll
    for (int r = 0; r < 16; ++r) cinit[r] = 0.f;
    if constexpr (MOBA) {
        f32x16 ga = cinit;
#pragma unroll
        for (int d0 = 0; d0 < 4; ++d0) { const bf16x8 ah = *(const bf16x8*)(kmh + (r32 & 15) * 64 + 16 * d0 + 8 * hi), al = *(const bf16x8*)(kml + (r32 & 15) * 64 + 16 * d0 + 8 * hi);
            ga = FA_MFMA(ah, qf[d0], ga); ga = FA_MFMA(al, qf[d0], ga); }
        float g[16];
#pragma unroll
        for (int i = 0; i < 8; ++i) { const float mine = ga[i], oth = xother(mine, hi); const float lo_ = hi ? oth : mine, hi_ = hi ? mine : oth;
            g[(i & 3) + 8 * (i >> 2)] = lo_; g[(i & 3) + 8 * (i >> 2) + 4] = hi_; }
        float v1 = -3e38f, v2 = -3e38f, v3 = -3e38f; int i1 = -1, i2 = -1, i3 = -1;
#pragma unroll
        for (int n = 0; n < 16; ++n) if (n < qb) { const float gv = g[n];
            if (gv > v1) { v3 = v2; i3 = i2; v2 = v1; i2 = i1; v1 = gv; i1 = n; } else if (gv > v2) { v3 = v2; i3 = i2; v2 = gv; i2 = n; } else if (gv > v3) { v3 = gv; i3 = n; } }
        if (i1 >= 0) sel |= 1u << i1; if (i2 >= 0) sel |= 1u << i2; if (i3 >= 0) sel |= 1u << i3;
#pragma unroll
        for (int r = 0; r < 16; ++r) cinit[r] = slope2 * (float)crow(r, hi);
    }
    const float c32 = MOBA ? 32.f * slope2 : 0.f;
    constexpr int CPRK = KP / 16, CPRV = VP / 16, NIK = (64 * CPRK + 63) / 64, NIV = (64 * CPRV + 63) / 64;
    const char* kbase = (const char*)Kh; const char* rbase = (const char*)((DK == 96) ? KRb : Kh); const char* vbase = (const char*)Vh;
    unsigned koffs[2], voffs[2]; bool krope[2];
#pragma unroll
    for (int j = 0; j < 2; ++j) { const int pk = 64 * (w + 8 * j) + lane, rk = pk / CPRK, ck = pk % CPRK; krope[j] = (DK == 96) && ck >= 8 && ck < 12;
        koffs[j] = krope[j] ? (unsigned)(rk * 32 + (ck - 8) * 8) * 2u : (unsigned)(rk * kpitch + (ck < 8 ? ck : 0) * 8) * 2u;
        const int pv = 64 * (w + 8 * j) + lane, rv = pv / CPRV, cv = pv % CPRV; voffs[j] = (unsigned)(rv * vpitch + (cv < 8 ? cv : 0) * 8) * 2u; }
    const int vlo = tr_lane_off(lane, VP);
    const int NT = 4 * (qb + 1);
#define FA_DMA(t, slot) do { const char* kb_ = kbase + (size_t)(t) * 128 * kpitch; const char* rb_ = rbase + (size_t)(t) * 128 * 32; const char* vb_ = vbase + (size_t)(t) * 128 * vpitch; \
        _Pragma("unroll") for (int j = 0; j < 2; ++j) { const int i_ = w + 8 * j; \
            if (i_ < NIK) __builtin_amdgcn_global_load_lds((const unsigned*)((krope[j] ? rb_ : kb_) + koffs[j]), (FLAS unsigned*)(lds + (slot) * KBUF + i_ * 1024), 16, 0, 0); \
            if (i_ < NIV) __builtin_amdgcn_global_load_lds((const unsigned*)(vb_ + voffs[j]), (FLAS unsigned*)(lds + 2 * KBUF + (slot) * VBUF + i_ * 1024), 16, 0, 0); } } while (0)
#define FA_LANDED() asm volatile("s_waitcnt vmcnt(0)" ::: "memory")
    static_assert(NIK <= 16 && NIV <= 16, "two DMA instructions per wave cover a tile");
    FA_DMA(0, 0); FA_LANDED(); __syncthreads();
    float m = MOBA ? NEG : 0.f, l = 0.f; f32x16 o0, o1;
#pragma unroll
    for (int r = 0; r < 16; ++r) { o0[r] = 0.f; o1[r] = 0.f; }
    const int rowrel = 32 * w + r32;
    for (int t = 0; t < NT; ++t) {
        const int buf = t & 1;
        if (t + 1 < NT) FA_DMA(t + 1, buf ^ 1);
        const int n = t >> 2, jd = t & 3; const bool diag = (n == qb);
        bool lane_on = true; if (MOBA && !diag) lane_on = (sel >> n) & 1u;
        bool wave_on = diag ? (64 * jd <= 32 * w + 31) : (MOBA ? (__any(lane_on) != 0) : true);
        if (wave_on) {
            const FLAS char* kt = lds + buf * KBUF + r32 * KP; const FLAS char* vt = lds + 2 * KBUF + buf * VBUF + vlo;
            f32x16 s0 = qk_half<DK>(kt, hi, qf, cinit), s1 = qk_half<DK>(kt + 32 * KP, hi, qf, cinit);
            if (diag && (64 * jd + 63 > 32 * w)) {
#pragma unroll
                for (int r = 0; r < 16; ++r) { const int kr = 64 * jd + crow(r, hi); if (kr > rowrel) s0[r] = NEG; if (kr + 32 > rowrel) s1[r] = NEG; } }
            if constexpr (MOBA) {
                const float tb = slope2 * (float)(64 * t);
                float mx = xmax(fmaxf(max16(s0), max16(s1) + c32)) + tb;
                if (!lane_on) mx = NEG;
                const float mn = fmaxf(m, mx);
                if (__any(mx > m + RESC_THR)) { const float a = __builtin_amdgcn_exp2f(m - mn); l *= a;
#pragma unroll
                    for (int r = 0; r < 16; ++r) { o0[r] *= a; o1[r] *= a; }
                    m = mn; }
                const float mref0 = lane_on ? (m - tb) : POS, mref1 = mref0 - c32;
#pragma unroll
                for (int r = 0; r < 16; ++r) { s0[r] = __builtin_amdgcn_exp2f(s0[r] - mref0); s1[r] = __builtin_amdgcn_exp2f(s1[r] - mref1); }
            } else {
                const float mx = xmax(fmaxf(max16(s0), max16(s1)));
                if (t == 0 || __any(mx > RESC_THR)) { const float d = (t == 0) ? mx : fmaxf(mx, 0.f), a = __builtin_amdgcn_exp2f(-d); m += d; l *= a;
#pragma unroll
                    for (int r = 0; r < 16; ++r) { o0[r] *= a; o1[r] *= a; s0[r] -= d; s1[r] -= d; cinit[r] = -m; } }
#pragma unroll
                for (int r = 0; r < 16; ++r) { s0[r] = __builtin_amdgcn_exp2f(s0[r]); s1[r] = __builtin_amdgcn_exp2f(s1[r]); }
            }
            { float ls = 0.f;
#pragma unroll
              for (int r = 0; r < 16; ++r) ls += s0[r] + s1[r];
              l += ls; }
            pv_half_tr(o0, o1, vt, VP, s0); pv_half_tr(o0, o1, vt + 32 * VP, VP, s1);
        }
        FA_LANDED();
        __syncthreads();
    }
#undef FA_DMA
#undef FA_LANDED
    const float lt = xsum(l);
    store_o(Oh + (size_t)(q0 + 32 * w + r32) * DM, o0, o1, 1.0f / lt, hi);
}

#define SBAR() __builtin_amdgcn_sched_barrier(0)
#define FA_WAIT_BAR(N) asm volatile("s_waitcnt vmcnt(" #N ") lgkmcnt(0)\n\ts_barrier" ::: "memory")
__device__ __forceinline__ void glds16(const void* gsrc, unsigned lds_dst) { unsigned keep;
    asm volatile("s_mov_b32 %0, m0\n\ts_mov_b32 m0, %2\n\ts_nop 0\n\tglobal_load_lds_dwordx4 %1, off\n\ts_mov_b32 m0, %0" : "=&s"(keep) : "v"(gsrc), "s"(lds_dst) : "memory"); }
__device__ __forceinline__ void kload8(bf16x8* kf, const FLAS char* kp) {
    kf[0] = *(const FLAS bf16x8*)(kp);        kf[1] = *(const FLAS bf16x8*)(kp + 512);
    kf[2] = *(const FLAS bf16x8*)(kp + 2048); kf[3] = *(const FLAS bf16x8*)(kp + 2560);
    kf[4] = *(const FLAS bf16x8*)(kp + 4096); kf[5] = *(const FLAS bf16x8*)(kp + 4608);
    kf[6] = *(const FLAS bf16x8*)(kp + 6144); kf[7] = *(const FLAS bf16x8*)(kp + 6656); }
__device__ __forceinline__ void kload2(bf16x8* kf, const FLAS char* kp, int j) { kf[2 * j] = *(const FLAS bf16x8*)(kp + j * 2048); kf[2 * j + 1] = *(const FLAS bf16x8*)(kp + j * 2048 + 512); }
#define MX3(a, b, c) __builtin_fmaxf(__builtin_fmaxf((a), (b)), (c))
__device__ __forceinline__ float rowmax_c(const f32x16& p0, const f32x16& p1, float c32) {
    float a = MX3(p0[0], p0[1], p0[2]), b = MX3(p1[0], p1[1], p1[2]);
#pragma unroll
    for (int r = 3; r < 15; r += 2) { a = MX3(a, p0[r], p0[r + 1]); b = MX3(b, p1[r], p1[r + 1]); }
    a = __builtin_fmaxf(a, p0[15]); b = __builtin_fmaxf(b, p1[15]);
    return xmax(__builtin_fmaxf(a, b + c32)); }
template <int THRL>
__device__ __forceinline__ void moba_unit(FLAS char* lds, int tid_in, int qb_in, const bf16* Qh, const bf16* Kh, const bf16* Vh, bf16* Oh, const bf16* kmh, const bf16* kml, float slope2_in) {
    constexpr int SLOTB = 8192, NSLOT = 3, L_K = 0, L_V = NSLOT * SLOTB, L_WS = 2 * NSLOT * SLOTB, L_OST = 0;
    int tid = tid_in; asm volatile("" : "+v"(tid));
    const int lane = tid & 63, wid = __builtin_amdgcn_readfirstlane(tid >> 6), r32 = lane & 31, hi = lane >> 5;
    const int qb = __builtin_amdgcn_readfirstlane(qb_in), q0 = qb * 256;
    const float slope2 = __builtin_bit_cast(float, __builtin_amdgcn_readfirstlane(__builtin_bit_cast(int, slope2_in)));
    const float c32 = 32.f * slope2, hb = slope2 * (float)(4 * hi);
    const unsigned lds0 = (unsigned)(uintptr_t)lds;
    FLAS float* wsf = (FLAS float*)(lds + L_WS) + wid * 64;
    const bf16* ksrc = Kh + (size_t)lane * 64 + wid * 8;
    const bf16* vsrc = Vh + (size_t)(16 * (wid & 3) + (lane >> 2)) * 64 + (wid >> 2) * 32 + (lane & 3) * 8;
    const unsigned kdst = lds0 + L_K + wid * 1024, vdst = lds0 + L_V + wid * 1024;
#define DMA_K(t, slot) glds16(ksrc + (size_t)(t) * 4096, (unsigned)__builtin_amdgcn_readfirstlane(kdst + (slot)))
#define DMA_V(t, slot) glds16(vsrc + (size_t)(t) * 4096, (unsigned)__builtin_amdgcn_readfirstlane(vdst + (slot)))
    const FLAS char* kp0 = lds + L_K + hi * 1024 + r32 * 16;
    const FLAS char* vp0 = lds + L_V + ((lane >> 4) & 1) * 32 + (lane & 3) * 8 + (4 * hi + ((lane & 15) >> 2)) * 64;
    const int NT = 4 * (qb + 1);
    DMA_K(0, 0); DMA_V(0, 0); DMA_K(1, SLOTB);
    bf16x8 qr[4];
    { const bf16* qp = Qh + (size_t)(q0 + 32 * wid + r32) * 64 + 8 * hi;
#pragma unroll
      for (int d0 = 0; d0 < 4; ++d0) qr[d0] = *(const bf16x8*)(qp + 16 * d0); }
    DMA_K(2, 2 * SLOTB);
    unsigned selq = 1u << qb;
    { f32x16 ga;
#pragma unroll
      for (int r = 0; r < 16; ++r) ga[r] = 0.f;
#pragma unroll
      for (int d0 = 0; d0 < 4; ++d0) { const bf16x8 ah = *(const bf16x8*)(kmh + (r32 & 15) * 64 + 16 * d0 + 8 * hi), al = *(const bf16x8*)(kml + (r32 & 15) * 64 + 16 * d0 + 8 * hi);
          ga = FA_MFMA(ah, qr[d0], ga); ga = FA_MFMA(al, qr[d0], ga); }
      float g[16];
#pragma unroll
      for (int i = 0; i < 8; ++i) { const float mine = ga[i], oth = xother(mine, hi); const float lo_ = hi ? oth : mine, hi_ = hi ? mine : oth;
          g[(i & 3) + 8 * (i >> 2)] = lo_; g[(i & 3) + 8 * (i >> 2) + 4] = hi_; }
      float v1 = -3e38f, v2 = -3e38f, v3 = -3e38f; int i1 = -1, i2 = -1, i3 = -1;
#pragma unroll
      for (int n = 0; n < 16; ++n) if (n < qb) { const float gv = g[n];
          if (gv > v1) { v3 = v2; i3 = i2; v2 = v1; i2 = i1; v1 = gv; i1 = n; } else if (gv > v2) { v3 = v2; i3 = i2; v2 = gv; i2 = n; } else if (gv > v3) { v3 = gv; i3 = n; } }
      if (i1 >= 0) selq |= 1u << i1; if (i2 >= 0) selq |= 1u << i2; if (i3 >= 0) selq |= 1u << i3; }
    float mhat = 0.f, l_reg = 0.f; f32x16 o[2];
#pragma unroll
    for (int r = 0; r < 16; ++r) { o[0][r] = 0.f; o[1][r] = 0.f; }
    f32x16 nb;
    float negbig = -1.0e30f; asm volatile("" : "+v"(negbig));
#define NB_BASE(tt) ((((selq >> ((tt) >> 2)) & 1u) ? (slope2 * (float)(64 * (tt)) - mhat) : negbig) + hb)
#define NB_SET(r, base) nb[r] = __builtin_fmaf(slope2, (float)(((r) & 3) + 8 * ((r) >> 2)), (base))
    { const float b0_ = NB_BASE(0);
#pragma unroll
      for (int r = 0; r < 16; ++r) NB_SET(r, b0_); }
    const int qrel = wid * 32 + r32;
#define CMASK(P0, P1, t) do { const int jb_ = (t) - (NT - 4); if (jb_ >= 0) { const int kb_ = 64 * jb_ + 4 * hi; _Pragma("unroll") for (int r = 0; r < 16; ++r) { const int kv_ = kb_ + (r & 3) + 8 * (r >> 2); if (kv_ > qrel) P0[r] = -INFINITY; if (kv_ + 32 > qrel) P1[r] = -INFINITY; } } } while (0)
    bool resc = false;
#define RESC() do { if (resc) { asm volatile("s_waitcnt lgkmcnt(0)" ::: "memory"); \
        _Pragma("unroll") for (int d_ = 0; d_ < 2; ++d_) _Pragma("unroll") for (int r = 0; r < 16; ++r) o[d_][r] *= wsf[crow(r, hi)]; } } while (0)
    f32x16 pA0, pA1, pB0, pB1; bf16x8 kf[8];
    int sl_prev = 0, sl_cur = 0, sl_next = SLOTB;
#define ROT() do { sl_prev = sl_cur; sl_cur = sl_next; sl_next = (sl_next == (NSLOT - 1) * SLOTB) ? 0 : sl_next + SLOTB; } while (0)
    FA_WAIT_BAR(3);
    { const FLAS char* kb = lds + L_K + hi * 1024 + r32 * 16;
#pragma unroll
      for (int d0 = 0; d0 < 4; ++d0) { const bf16x8 b0 = *(const FLAS bf16x8*)(kb + d0 * 2048), b1 = *(const FLAS bf16x8*)(kb + d0 * 2048 + 512);
          if (d0 == 0) { pA0 = FA_MFMA(b0, qr[0], nb); pA1 = FA_MFMA(b1, qr[0], nb); } else { pA0 = FA_MFMA(b0, qr[d0], pA0); pA1 = FA_MFMA(b1, qr[d0], pA1); } } }
    CMASK(pA0, pA1, 0);
    { const float rm = rowmax_c(pA0, pA1, c32); const float dl = (selq & 1u) ? rm : 0.f; mhat = dl;
#pragma unroll
      for (int r = 0; r < 16; ++r) { pA0[r] = __builtin_amdgcn_exp2f(pA0[r] - dl); pA1[r] = __builtin_amdgcn_exp2f(pA1[r] - dl + c32); }
      const float b1_ = NB_BASE(1);
#pragma unroll
      for (int r = 0; r < 16; ++r) NB_SET(r, b1_); }
    FA_WAIT_BAR(0);
    DMA_K(3, 0); DMA_V(1, SLOTB);
    ROT();
    kload8(kf, kp0 + sl_cur);
    FA_WAIT_BAR(2);
    s16x4 vlo[8], vhi[8]; v4u pw0, pw1, pw2, pw3;
#define PKW(P, B) pg8::cvt_pk_bf16(P[B], P[(B) + 1])
#define PAF(k) __builtin_bit_cast(bf16x8, pw##k)
#define VFR(i) (bf16x8){vlo[i][0], vlo[i][1], vlo[i][2], vlo[i][3], vhi[i][0], vhi[i][1], vhi[i][2], vhi[i][3]}
#define PIN(x) asm volatile("" : "+v"(x))
#define GAPA(MF, A0, A1, A2, A3, W0, W1, PW) do { MF; sacc += A0; sacc += A1; sacc += A2; sacc += A3; PIN(sacc); W0; W1; PIN(PW); SBAR(); } while (0)
#define EX(v) __builtin_amdgcn_exp2f(v)
#define GAPB0(MF, X, B, R0) do { MF; X[B] = EX(X[B]); X[(B) + 1] = EX(X[(B) + 1]); X[(B) + 2] = EX(X[(B) + 2]); X[(B) + 3] = EX(X[(B) + 3]); NB_SET(R0, nbase_); NB_SET((R0) + 1, nbase_); PIN(X); PIN(nb); SBAR(); } while (0)
#define GAPB1(MF, X, B, R0) do { MF; X[B] = EX(X[B] + c32); X[(B) + 1] = EX(X[(B) + 1] + c32); X[(B) + 2] = EX(X[(B) + 2] + c32); X[(B) + 3] = EX(X[(B) + 3] + c32); NB_SET(R0, nbase_); NB_SET((R0) + 1, nbase_); PIN(X); PIN(nb); SBAR(); } while (0)
#define VRD(i) do { vlo[i] = vtr(vp_ + (((i) >> 2) * 4096 + ((i) & 3) * 1024)); vhi[i] = vtr(vp_ + (((i) >> 2) * 4096 + ((i) & 3) * 1024 + 512)); } while (0)
#define KRD(G, j) do { if (G) { kload2(kf, kp0 + sl_next, j); SBAR(); } } while (0)
#define STEP(C0, C1, P0, P1, t, GK, GV, GL) do { SBAR(); \
    const FLAS char* vp_ = vp0 + sl_prev; \
    VRD(0); SBAR(); float sacc = (P0[0] + P0[1]); \
    GAPA(C0 = FA_MFMA(kf[0], qr[0], nb), P0[2], P0[3], P0[4], P0[5],     pw0[0] = PKW(P0, 0), pw0[1] = PKW(P0, 2), pw0); \
    VRD(4); SBAR(); GAPA(C1 = FA_MFMA(kf[1], qr[0], nb), P0[6], P0[7], P0[8], P0[9],     pw0[2] = PKW(P0, 4), pw0[3] = PKW(P0, 6), pw0); \
    VRD(1); SBAR(); GAPA(C0 = FA_MFMA(kf[2], qr[1], C0),   P0[10], P0[11], P0[12], P0[13], pw1[0] = PKW(P0, 8), pw1[1] = PKW(P0, 10), pw1); \
    VRD(5); SBAR(); GAPA(C1 = FA_MFMA(kf[3], qr[1], C1),   P0[14], P0[15], P1[0], P1[1],   pw1[2] = PKW(P0, 12), pw1[3] = PKW(P0, 14), pw1); \
    VRD(2); SBAR(); GAPA(C0 = FA_MFMA(kf[4], qr[2], C0),   P1[2], P1[3], P1[4], P1[5],     pw2[0] = PKW(P1, 0), pw2[1] = PKW(P1, 2), pw2); \
    VRD(6); SBAR(); GAPA(C1 = FA_MFMA(kf[5], qr[2], C1),   P1[6], P1[7], P1[8], P1[9],     pw2[2] = PKW(P1, 4), pw2[3] = PKW(P1, 6), pw2); \
    VRD(3); SBAR(); GAPA(C0 = FA_MFMA(kf[6], qr[3], C0),   P1[10], P1[11], P1[12], P1[13], pw3[0] = PKW(P1, 8), pw3[1] = PKW(P1, 10), pw3); \
    VRD(7); SBAR(); GAPA(C1 = FA_MFMA(kf[7], qr[3], C1),   P1[14], P1[15], 0.f, 0.f,       pw3[2] = PKW(P1, 12), pw3[3] = PKW(P1, 14), pw3); \
    l_reg += sacc; \
    if (GK) { DMA_K((t) + 3, sl_cur); } if (GV) { DMA_V((t) + 1, sl_next); } \
    CMASK(C0, C1, t); \
    { const float rm = rowmax_c(C0, C1, c32); \
      resc = false; \
      if (__builtin_expect(__any(rm > (float)THRL), 0)) { const float dl = __builtin_fmaxf(rm, 0.f); mhat += dl; \
        _Pragma("unroll") for (int r = 0; r < 16; ++r) { C0[r] -= dl; C1[r] -= dl; } \
        const float f = __builtin_amdgcn_exp2f(-dl); l_reg *= f; if (hi == 0) wsf[r32] = f; resc = true; } } \
    const float nbase_ = NB_BASE((t) + 1); \
    SBAR(); \
    GAPB0(o[0] = FA_MFMA(PAF(0), VFR(0), o[0]), C0, 0, 0); \
    GAPB0(o[1] = FA_MFMA(PAF(0), VFR(4), o[1]), C0, 4, 2); \
    KRD(GL, 0); GAPB0(o[0] = FA_MFMA(PAF(1), VFR(1), o[0]), C0, 8, 4); \
    KRD(GL, 1); GAPB0(o[1] = FA_MFMA(PAF(1), VFR(5), o[1]), C0, 12, 6); \
    KRD(GL, 2); GAPB1(o[0] = FA_MFMA(PAF(2), VFR(2), o[0]), C1, 0, 8); \
    KRD(GL, 3); GAPB1(o[1] = FA_MFMA(PAF(2), VFR(6), o[1]), C1, 4, 10); \
    GAPB1(o[0] = FA_MFMA(PAF(3), VFR(3), o[0]), C1, 8, 12); \
    GAPB1(o[1] = FA_MFMA(PAF(3), VFR(7), o[1]), C1, 12, 14); \
    } while (0)
    int t = 1;
#undef CMASK
#define CMASK(P0, P1, t) do { } while (0)
    for (; t + 5 < NT; t += 2) {
        STEP(pB0, pB1, pA0, pA1, t, true, true, true);       FA_WAIT_BAR(2); RESC(); ROT();
        STEP(pA0, pA1, pB0, pB1, t + 1, true, true, true);   FA_WAIT_BAR(2); RESC(); ROT();
    }
#undef CMASK
#define CMASK(P0, P1, t) do { const int jb_ = (t) - (NT - 4); if (jb_ >= 0) { const int kb_ = 64 * jb_ + 4 * hi; _Pragma("unroll") for (int r = 0; r < 16; ++r) { const int kv_ = kb_ + (r & 3) + 8 * (r >> 2); if (kv_ > qrel) P0[r] = -INFINITY; if (kv_ + 32 > qrel) P1[r] = -INFINITY; } } } while (0)
#define ENDW(tt) do { if ((tt) + 3 < NT) { FA_WAIT_BAR(2); } else if ((tt) + 2 < NT) { FA_WAIT_BAR(1); } else { FA_WAIT_BAR(0); } } while (0)
    for (; t + 1 < NT; t += 2) {
        STEP(pB0, pB1, pA0, pA1, t, (t + 3 < NT), (t + 1 < NT), (t + 1 < NT));         ENDW(t);     RESC(); ROT();
        STEP(pA0, pA1, pB0, pB1, t + 1, (t + 4 < NT), (t + 2 < NT), (t + 2 < NT));     ENDW(t + 1); RESC(); ROT();
    }
    STEP(pB0, pB1, pA0, pA1, NT - 1, false, false, false); RESC();
    { float sacc = pB0[0] + pB0[1];
#pragma unroll
      for (int r = 2; r < 16; ++r) sacc += pB0[r];
#pragma unroll
      for (int r = 0; r < 16; ++r) sacc += pB1[r];
      l_reg += sacc;
      pw0 = (v4u){PKW(pB0, 0), PKW(pB0, 2), PKW(pB0, 4), PKW(pB0, 6)}; pw1 = (v4u){PKW(pB0, 8), PKW(pB0, 10), PKW(pB0, 12), PKW(pB0, 14)};
      pw2 = (v4u){PKW(pB1, 0), PKW(pB1, 2), PKW(pB1, 4), PKW(pB1, 6)}; pw3 = (v4u){PKW(pB1, 8), PKW(pB1, 10), PKW(pB1, 12), PKW(pB1, 14)};
      SBAR();
      const FLAS char* vp_ = vp0 + sl_cur;
#pragma unroll
      for (int i = 0; i < 8; ++i) VRD(i);
      o[0] = FA_MFMA(PAF(0), VFR(0), o[0]); o[0] = FA_MFMA(PAF(1), VFR(1), o[0]); o[0] = FA_MFMA(PAF(2), VFR(2), o[0]); o[0] = FA_MFMA(PAF(3), VFR(3), o[0]);
      o[1] = FA_MFMA(PAF(0), VFR(4), o[1]); o[1] = FA_MFMA(PAF(1), VFR(5), o[1]); o[1] = FA_MFMA(PAF(2), VFR(6), o[1]); o[1] = FA_MFMA(PAF(3), VFR(7), o[1]); }
    l_reg = xsum(l_reg);
    if (hi == 0) wsf[32 + r32] = l_reg;
    asm volatile("s_waitcnt lgkmcnt(0)\n\ts_barrier" ::: "memory");
    float rli[16];
#pragma unroll
    for (int r = 0; r < 16; ++r) rli[r] = __builtin_amdgcn_rcpf(wsf[32 + crow(r, hi)]);
    { FLAS bf16* stg = (FLAS bf16*)(lds + L_OST) + wid * 2048;
#pragma unroll
      for (int r = 0; r < 16; ++r) { const int orow = crow(r, hi);
#pragma unroll
          for (int d0 = 0; d0 < 2; ++d0) stg[orow * 64 + d0 * 32 + r32] = (bf16)f2bf(o[d0][r] * rli[r]); }
      asm volatile("s_waitcnt lgkmcnt(0)" ::: "memory");
      bf16* Ow = Oh + (size_t)(q0 + wid * 32) * DM;
#pragma unroll
      for (int i = 0; i < 4; ++i) { const int row = i * 8 + (lane >> 3), ch = lane & 7; const v4u v = *(const FLAS v4u*)(stg + row * 64 + ch * 8); *(v4u*)(Ow + (size_t)row * DM + ch * 8) = v; } }
    asm volatile("s_waitcnt lgkmcnt(0)\n\ts_barrier" ::: "memory");
#undef DMA_K
#undef DMA_V
#undef NB_BASE
#undef NB_SET
#undef CMASK
#undef RESC
#undef ROT
#undef PKW
#undef PAF
#undef VFR
#undef PIN
#undef GAPA
#undef EX
#undef GAPB0
#undef GAPB1
#undef VRD
#undef KRD
#undef STEP
#undef ENDW
}

template <int THRL>
__device__ __forceinline__ void mla_unit(FLAS char* lds, int tid_in, int qb_in, const bf16* Qh, const bf16* Kh, const bf16* KRb, const bf16* Vh, bf16* Oh) {
    constexpr int KSLOT = 12288, VSLOT = 8192, NSLOT = 3, L_K = 0, L_V = NSLOT * KSLOT, L_WS = L_V + NSLOT * VSLOT, L_OST = 0;
    int tid = tid_in; asm volatile("" : "+v"(tid));
    const int lane = tid & 63, wid = __builtin_amdgcn_readfirstlane(tid >> 6), r32 = lane & 31, hi = lane >> 5;
    const int qb = __builtin_amdgcn_readfirstlane(qb_in), q0 = qb * 256;
    const unsigned lds0 = (unsigned)(uintptr_t)lds;
    FLAS float* wsf = (FLAS float*)(lds + L_WS) + wid * 64;
    const bf16* ksrc = Kh + (size_t)lane * 64 + wid * 8;
    const bf16* rsrc = KRb + (size_t)lane * 32 + (wid & 3) * 8;
    const bf16* vsrc = Vh + (size_t)(16 * (wid & 3) + (lane >> 2)) * 64 + (wid >> 2) * 32 + (lane & 3) * 8;
    const unsigned kdst = lds0 + L_K + wid * 1024, rdst = lds0 + L_K + (8 + (wid & 3)) * 1024, vdst = lds0 + L_V + wid * 1024;
    const bool ropew = wid < 4;
#define DMA_K(t, slot) do { glds16(ksrc + (size_t)(t) * 4096, (unsigned)__builtin_amdgcn_readfirstlane(kdst + (slot))); if (ropew) glds16(rsrc + (size_t)(t) * 2048, (unsigned)__builtin_amdgcn_readfirstlane(rdst + (slot))); } while (0)
#define DMA_V(t, slot) glds16(vsrc + (size_t)(t) * 4096, (unsigned)__builtin_amdgcn_readfirstlane(vdst + (slot)))
    const FLAS char* kp0 = lds + L_K + hi * 1024 + r32 * 16;
    const FLAS char* vp0 = lds + L_V + ((lane >> 4) & 1) * 32 + (lane & 3) * 8 + (4 * hi + ((lane & 15) >> 2)) * 64;
    const int NT = 4 * (qb + 1);
    DMA_K(0, 0); DMA_V(0, 0); DMA_K(1, KSLOT);
    bf16x8 qr[6];
    { const bf16* qp = Qh + (size_t)(q0 + 32 * wid + r32) * 96 + 8 * hi;
#pragma unroll
      for (int d0 = 0; d0 < 6; ++d0) qr[d0] = *(const bf16x8*)(qp + 16 * d0); }
    DMA_K(2, 2 * KSLOT);
    float mhat = 0.f, l_reg = 0.f; f32x16 o[2], negm;
#pragma unroll
    for (int r = 0; r < 16; ++r) { o[0][r] = 0.f; o[1][r] = 0.f; negm[r] = 0.f; }
    asm volatile("" : "+v"(negm));
    const int qrel = wid * 32 + r32;
#define CMASK(P0, P1, t) do { const int jb_ = (t) - (NT - 4); if (jb_ >= 0) { const int kb_ = 64 * jb_ + 4 * hi; _Pragma("unroll") for (int r = 0; r < 16; ++r) { const int kv_ = kb_ + (r & 3) + 8 * (r >> 2); if (kv_ > qrel) P0[r] = -INFINITY; if (kv_ + 32 > qrel) P1[r] = -INFINITY; } } } while (0)
    bool resc = false;
#define RESC() do { if (resc) { asm volatile("s_waitcnt lgkmcnt(0)" ::: "memory"); \
        _Pragma("unroll") for (int d_ = 0; d_ < 2; ++d_) _Pragma("unroll") for (int r = 0; r < 16; ++r) o[d_][r] *= wsf[crow(r, hi)]; } } while (0)
    f32x16 pA0, pA1, pB0, pB1; bf16x8 kf[12];
    int ks_cur = 0, ks_next = KSLOT, vs_prev = 0, vs_cur = 0, vs_next = VSLOT;
#define ROT() do { ks_cur = ks_next; ks_next = (ks_next == (NSLOT - 1) * KSLOT) ? 0 : ks_next + KSLOT; vs_prev = vs_cur; vs_cur = vs_next; vs_next = (vs_next == (NSLOT - 1) * VSLOT) ? 0 : vs_next + VSLOT; } while (0)
    FA_WAIT_BAR(0);
    { const FLAS char* kb = lds + L_K + hi * 1024 + r32 * 16;
#pragma unroll
      for (int d0 = 0; d0 < 6; ++d0) { const bf16x8 b0 = *(const FLAS bf16x8*)(kb + d0 * 2048), b1 = *(const FLAS bf16x8*)(kb + d0 * 2048 + 512);
          if (d0 == 0) { pA0 = FA_MFMA(b0, qr[0], negm); pA1 = FA_MFMA(b1, qr[0], negm); } else { pA0 = FA_MFMA(b0, qr[d0], pA0); pA1 = FA_MFMA(b1, qr[d0], pA1); } } }
    CMASK(pA0, pA1, 0);
    { const float rm = rowmax_c(pA0, pA1, 0.f); mhat = rm;
#pragma unroll
      for (int r = 0; r < 16; ++r) { pA0[r] = __builtin_amdgcn_exp2f(pA0[r] - rm); pA1[r] = __builtin_amdgcn_exp2f(pA1[r] - rm); }
#pragma unroll
      for (int r = 0; r < 16; ++r) negm[r] = -mhat;
      asm volatile("" : "+v"(negm)); }
    FA_WAIT_BAR(0);
    DMA_K(3, 0); DMA_V(1, VSLOT);
    ROT();
#pragma unroll
    for (int j = 0; j < 6; ++j) kload2(kf, kp0 + ks_cur, j);
    if (ropew) { FA_WAIT_BAR(3); } else { FA_WAIT_BAR(2); }
    s16x4 vlo[8], vhi[8]; v4u pw0, pw1, pw2, pw3;
#define PKW(P, B) pg8::cvt_pk_bf16(P[B], P[(B) + 1])
#define PAF(k) __builtin_bit_cast(bf16x8, pw##k)
#define VFR(i) (bf16x8){vlo[i][0], vlo[i][1], vlo[i][2], vlo[i][3], vhi[i][0], vhi[i][1], vhi[i][2], vhi[i][3]}
#define PIN(x) asm volatile("" : "+v"(x))
#define GAPA(MF, A0, A1, A2, W0, W1, PW) do { MF; sacc += A0; sacc += A1; sacc += A2; PIN(sacc); W0; W1; PIN(PW); SBAR(); } while (0)
#define GAPA0(MF, A0, A1, A2) do { MF; sacc += A0; sacc += A1; sacc += A2; PIN(sacc); SBAR(); } while (0)
#define EX(v) __builtin_amdgcn_exp2f(v)
#define GAPB(MF, X, B) do { MF; X[B] = EX(X[B]); X[(B) + 1] = EX(X[(B) + 1]); X[(B) + 2] = EX(X[(B) + 2]); X[(B) + 3] = EX(X[(B) + 3]); PIN(X); SBAR(); } while (0)
#define VRD(i) do { vlo[i] = vtr(vp_ + (((i) >> 2) * 4096 + ((i) & 3) * 1024)); vhi[i] = vtr(vp_ + (((i) >> 2) * 4096 + ((i) & 3) * 1024 + 512)); } while (0)
#define KRD(G, j) do { if (G) { kload2(kf, kp0 + ks_next, j); SBAR(); } } while (0)
#define STEP(C0, C1, P0, P1, t, GK, GV, GL) do { SBAR(); \
    const FLAS char* vp_ = vp0 + vs_prev; \
    float sacc = (P0[0] + P0[1]); \
    GAPA(C0 = FA_MFMA(kf[0], qr[0], negm), P0[2], P0[3], P0[4],      pw0[0] = PKW(P0, 0), pw0[1] = PKW(P0, 2), pw0); \
    GAPA(C1 = FA_MFMA(kf[1], qr[0], negm), P0[5], P0[6], P0[7],      pw0[2] = PKW(P0, 4), pw0[3] = PKW(P0, 6), pw0); \
    GAPA(C0 = FA_MFMA(kf[2], qr[1], C0),   P0[8], P0[9], P0[10],     pw1[0] = PKW(P0, 8), pw1[1] = PKW(P0, 10), pw1); \
    GAPA(C1 = FA_MFMA(kf[3], qr[1], C1),   P0[11], P0[12], P0[13],   pw1[2] = PKW(P0, 12), pw1[3] = PKW(P0, 14), pw1); \
    VRD(0); SBAR(); GAPA(C0 = FA_MFMA(kf[4], qr[2], C0),   P0[14], P0[15], P1[0],    pw2[0] = PKW(P1, 0), pw2[1] = PKW(P1, 2), pw2); \
    VRD(4); SBAR(); GAPA(C1 = FA_MFMA(kf[5], qr[2], C1),   P1[1], P1[2], P1[3],      pw2[2] = PKW(P1, 4), pw2[3] = PKW(P1, 6), pw2); \
    VRD(1); SBAR(); GAPA(C0 = FA_MFMA(kf[6], qr[3], C0),   P1[4], P1[5], P1[6],      pw3[0] = PKW(P1, 8), pw3[1] = PKW(P1, 10), pw3); \
    VRD(5); SBAR(); GAPA(C1 = FA_MFMA(kf[7], qr[3], C1),   P1[7], P1[8], P1[9],      pw3[2] = PKW(P1, 12), pw3[3] = PKW(P1, 14), pw3); \
    VRD(2); SBAR(); GAPA0(C0 = FA_MFMA(kf[8], qr[4], C0),   P1[10], P1[11], P1[12]); \
    VRD(6); SBAR(); GAPA0(C1 = FA_MFMA(kf[9], qr[4], C1),   P1[13], P1[14], P1[15]); \
    VRD(3); SBAR(); C0 = FA_MFMA(kf[10], qr[5], C0); SBAR(); \
    VRD(7); SBAR(); C1 = FA_MFMA(kf[11], qr[5], C1); SBAR(); \
    l_reg += sacc; \
    if (GK) { DMA_K((t) + 3, ks_cur); } if (GV) { DMA_V((t) + 1, vs_next); } \
    CMASK(C0, C1, t); \
    { const float rm = rowmax_c(C0, C1, 0.f); \
      resc = false; \
      if (__builtin_expect(__any(rm > (float)THRL), 0)) { const float dl = __builtin_fmaxf(rm, 0.f); mhat += dl; \
        _Pragma("unroll") for (int r = 0; r < 16; ++r) { C0[r] -= dl; C1[r] -= dl; } \
        _Pragma("unroll") for (int r = 0; r < 16; ++r) negm[r] = -mhat; asm volatile("" : "+v"(negm)); \
        const float f = __builtin_amdgcn_exp2f(-dl); l_reg *= f; if (hi == 0) wsf[r32] = f; resc = true; } } \
    SBAR(); \
    GAPB(o[0] = FA_MFMA(PAF(0), VFR(0), o[0]), C0, 0); \
    KRD(GL, 0); GAPB(o[1] = FA_MFMA(PAF(0), VFR(4), o[1]), C0, 4); \
    KRD(GL, 1); GAPB(o[0] = FA_MFMA(PAF(1), VFR(1), o[0]), C0, 8); \
    KRD(GL, 2); GAPB(o[1] = FA_MFMA(PAF(1), VFR(5), o[1]), C0, 12); \
    KRD(GL, 3); GAPB(o[0] = FA_MFMA(PAF(2), VFR(2), o[0]), C1, 0); \
    KRD(GL, 4); GAPB(o[1] = FA_MFMA(PAF(2), VFR(6), o[1]), C1, 4); \
    KRD(GL, 5); GAPB(o[0] = FA_MFMA(PAF(3), VFR(3), o[0]), C1, 8); \
    GAPB(o[1] = FA_MFMA(PAF(3), VFR(7), o[1]), C1, 12); \
    } while (0)
#define ENDW(tt) do { const bool gk_ = (tt) + 3 < NT, gv_ = (tt) + 1 < NT; \
        if (gk_ && gv_) { if (ropew) { FA_WAIT_BAR(3); } else { FA_WAIT_BAR(2); } } \
        else if ((tt) + 2 < NT) { FA_WAIT_BAR(1); } \
        else { FA_WAIT_BAR(0); } } while (0)
    int t = 1;
#undef CMASK
#define CMASK(P0, P1, t) do { } while (0)
    for (; t + 5 < NT; t += 2) {
        STEP(pB0, pB1, pA0, pA1, t, true, true, true);       ENDW(t);     RESC(); ROT();
        STEP(pA0, pA1, pB0, pB1, t + 1, true, true, true);   ENDW(t + 1); RESC(); ROT();
    }
#undef CMASK
#define CMASK(P0, P1, t) do { const int jb_ = (t) - (NT - 4); if (jb_ >= 0) { const int kb_ = 64 * jb_ + 4 * hi; _Pragma("unroll") for (int r = 0; r < 16; ++r) { const int kv_ = kb_ + (r & 3) + 8 * (r >> 2); if (kv_ > qrel) P0[r] = -INFINITY; if (kv_ + 32 > qrel) P1[r] = -INFINITY; } } } while (0)
    for (; t + 1 < NT; t += 2) {
        STEP(pB0, pB1, pA0, pA1, t, (t + 3 < NT), (t + 1 < NT), (t + 1 < NT));         ENDW(t);     RESC(); ROT();
        STEP(pA0, pA1, pB0, pB1, t + 1, (t + 4 < NT), (t + 2 < NT), (t + 2 < NT));     ENDW(t + 1); RESC(); ROT();
    }
    STEP(pB0, pB1, pA0, pA1, NT - 1, false, false, false); RESC();
    { float sacc = pB0[0] + pB0[1];
#pragma unroll
      for (int r = 2; r < 16; ++r) sacc += pB0[r];
#pragma unroll
      for (int r = 0; r < 16; ++r) sacc += pB1[r];
      l_reg += sacc;
      pw0 = (v4u){PKW(pB0, 0), PKW(pB0, 2), PKW(pB0, 4), PKW(pB0, 6)}; pw1 = (v4u){PKW(pB0, 8), PKW(pB0, 10), PKW(pB0, 12), PKW(pB0, 14)};
      pw2 = (v4u){PKW(pB1, 0), PKW(pB1, 2), PKW(pB1, 4), PKW(pB1, 6)}; pw3 = (v4u){PKW(pB1, 8), PKW(pB1, 10), PKW(pB1, 12), PKW(pB1, 14)};
      SBAR();
      const FLAS char* vp_ = vp0 + vs_cur;
#pragma unroll
      for (int i = 0; i < 8; ++i) VRD(i);
      o[0] = FA_MFMA(PAF(0), VFR(0), o[0]); o[0] = FA_MFMA(PAF(1), VFR(1), o[0]); o[0] = FA_MFMA(PAF(2), VFR(2), o[0]); o[0] = FA_MFMA(PAF(3), VFR(3), o[0]);
      o[1] = FA_MFMA(PAF(0), VFR(4), o[1]); o[1] = FA_MFMA(PAF(1), VFR(5), o[1]); o[1] = FA_MFMA(PAF(2), VFR(6), o[1]); o[1] = FA_MFMA(PAF(3), VFR(7), o[1]); }
    l_reg = xsum(l_reg);
    if (hi == 0) wsf[32 + r32] = l_reg;
    asm volatile("s_waitcnt lgkmcnt(0)\n\ts_barrier" ::: "memory");
    float rli[16];
#pragma unroll
    for (int r = 0; r < 16; ++r) rli[r] = __builtin_amdgcn_rcpf(wsf[32 + crow(r, hi)]);
    { FLAS bf16* stg = (FLAS bf16*)(lds + L_OST) + wid * 2048;
#pragma unroll
      for (int r = 0; r < 16; ++r) { const int orow = crow(r, hi);
#pragma unroll
          for (int d0 = 0; d0 < 2; ++d0) stg[orow * 64 + d0 * 32 + r32] = (bf16)f2bf(o[d0][r] * rli[r]); }
      asm volatile("s_waitcnt lgkmcnt(0)" ::: "memory");
      bf16* Ow = Oh + (size_t)(q0 + wid * 32) * DM;
#pragma unroll
      for (int i = 0; i < 4; ++i) { const int row = i * 8 + (lane >> 3), ch = lane & 7; const v4u v = *(const FLAS v4u*)(stg + row * 64 + ch * 8); *(v4u*)(Ow + (size_t)row * DM + ch * 8) = v; } }
    asm volatile("s_waitcnt lgkmcnt(0)\n\ts_barrier" ::: "memory");
#undef DMA_K
#undef DMA_V
#undef CMASK
#undef RESC
#undef ROT
#undef PKW
#undef PAF
#undef VFR
#undef PIN
#undef GAPA
#undef GAPA0
#undef EX
#undef GAPB
#undef VRD
#undef KRD
#undef STEP
#undef ENDW
}

__device__ __forceinline__ void dil_phase(FLAS char* lds, int tid_in, int bx, int G, bf16* proj, float* lse) {
    constexpr int KP = 144, VP = 192, VOFF = 384 * KP, NU = BATCH * 12 * 16;
    int tid = tid_in; asm volatile("" : "+v"(tid));
    const int lane = tid & 63, w = __builtin_amdgcn_readfirstlane(tid >> 6), r32 = lane & 31, hi = lane >> 5;
    v4u zz = (v4u){0u, 0u, 0u, 0u}; asm volatile("" : "+v"(zz));
    v4u kr[6], vr[6]; bf16x8 qn[4];
#define DIL_DECODE(u_) const int b_ = (u_) / 192, h_ = ((u_) >> 4) % 12, i16_ = (u_) & 15, g_ = h_ >> 2, dil_ = (g_ == 0) ? 1 : (g_ == 1) ? 4 : 16, nch_ = 16 / dil_, res_ = i16_ / nch_, ch_ = i16_ % nch_, m0_ = 256 * ch_; \
        const size_t rowb_ = (size_t)b_ * SEQ; const bf16* hq_ = proj + ((size_t)(b_ * HSLOTS + SL_DQ + h_) * SEQ) * 64; (void)ch_; (void)hq_
#define DIL_LOAD(u_) do { DIL_DECODE(u_); \
        _Pragma("unroll") for (int i = 0; i < 6; ++i) { const int idx = tid + 512 * i, kk = idx >> 3, kch = idx & 7, mp = m0_ - 128 + kk; kr[i] = zz; vr[i] = zz; \
            if (mp >= 0) { const bf16* p_ = hq_ + (size_t)(mp * dil_ + res_) * 64 + kch * 8; kr[i] = *(const v4u*)(p_ + (size_t)SL_DK * SEQ * 64); vr[i] = *(const v4u*)(p_ + (size_t)SL_DV * SEQ * 64); } } \
        { const size_t qtok_ = (size_t)(m0_ + 32 * w + r32) * dil_ + res_; \
          _Pragma("unroll") for (int d0 = 0; d0 < 4; ++d0) qn[d0] = *(const bf16x8*)(hq_ + qtok_ * 64 + 16 * d0 + 8 * hi); } } while (0)
    int u = bx; if (u >= NU) return;
    DIL_LOAD(u);
    for (; u < NU; u += G) {
        DIL_DECODE(u);
#pragma unroll
        for (int i = 0; i < 6; ++i) { const int idx = tid + 512 * i, kk = idx >> 3, kch = idx & 7; *(FLAS v4u*)(lds + kk * KP + kch * 16) = kr[i]; *(FLAS v4u*)(lds + VOFF + kk * VP + kch * 16) = vr[i]; }
        bf16x8 qf[4];
#pragma unroll
        for (int d0 = 0; d0 < 4; ++d0) qf[d0] = qn[d0];
        const float slope2d = exp2f(-8.0f * (float)(h_ + 1) / 18.0f) * LOG2E * (float)dil_;
        const size_t qrow = rowb_ + (size_t)(m0_ + 32 * w + r32) * dil_ + res_;
        f32x16 cinit;
#pragma unroll
        for (int r = 0; r < 16; ++r) cinit[r] = slope2d * (float)crow(r, hi);
        __syncthreads();
        if (u + G < NU) DIL_LOAD(u + G);
        f32x16 s[5]; float mx = NEG;
#pragma unroll
        for (int i = 0; i < 5; ++i) { s[i] = qk_half<64>(lds + (32 * (w + i) + r32) * KP, hi, qf, cinit);
            const bool dead = (ch_ == 0) && (w + i < 4);
#pragma unroll
            for (int r = 0; r < 16; ++r) { const int krr = crow(r, hi); bool ok = !dead; if (i == 0) ok = ok && (krr >= r32); if (i == 4) ok = ok && (krr <= r32); if (!ok) s[i][r] = NEG; }
            mx = fmaxf(mx, max16(s[i]) + (float)(32 * i) * slope2d); }
        mx = xmax(mx);
        float ls = 0.f; f32x16 o0, o1;
#pragma unroll
        for (int r = 0; r < 16; ++r) { o0[r] = 0.f; o1[r] = 0.f; }
#pragma unroll
        for (int i = 0; i < 5; ++i) { const float mref = mx - (float)(32 * i) * slope2d;
#pragma unroll
            for (int r = 0; r < 16; ++r) { s[i][r] = __builtin_amdgcn_exp2f(s[i][r] - mref); ls += s[i][r]; }
            pv_half_tr(o0, o1, lds + VOFF + (32 * (w + i)) * VP + tr_lane_off(lane, VP), VP, s[i]); }
        const float lt = xsum(ls);
        if (hi == 0) lse[qrow * 12 + h_] = mx + __builtin_amdgcn_logf(lt) - slope2d * (float)(r32 + 128);
        store_o(proj + ((size_t)(b_ * HSLOTS + SL_DQ + h_) * SEQ + (qrow - rowb_)) * 64, o0, o1, 1.0f / lt, hi);
        __syncthreads();
    }
#undef DIL_LOAD
#undef DIL_DECODE
}
#undef FA_MFMA
}

struct Args { const float* in[20]; float* out; unsigned char* ws; int ph_lo, ph_hi; };
constexpr int PH_PER_LAYER = 11, N_PHASES = 1 + DEPTH * PH_PER_LAYER + 1;

__global__ void __launch_bounds__(NWAVES * 64, 2) mk_fwd(Args args) {
    extern __shared__ __attribute__((aligned(16))) unsigned char lds[];
    Frame F;
    F.lds = (LAS unsigned char*)lds;
    F.MISC = (volatile LAS unsigned*)(F.lds + MISC_OFF);
    unsigned char* ws = args.ws;
    F.ctl = (gu32*)(ws + WS_CTL);
    for (int u = threadIdx.x; u < (LDS_BYTES - LDSCTL_OFF) / 4; u += NWAVES * 64) ((LAS unsigned*)(F.lds + LDSCTL_OFF))[u] = 0u;
    __syncthreads();
    const int wave_s = __builtin_amdgcn_readfirstlane((int)threadIdx.x >> 6);
#define MYTID() (OPQ_S(wave_s) * 64 + lane_id_volatile())
#define STAGGER() do { const unsigned long long t0_ = __builtin_amdgcn_s_memrealtime(); const unsigned long long d_ = (unsigned long long)(MK_STAGGER_TICKS) * (unsigned)((OPQ_S((int)blockIdx.x) * 5) & 7); while (__builtin_amdgcn_s_memrealtime() - t0_ < d_) __builtin_amdgcn_s_sleep(8); } while (0)
#define PHASE_LANES() int tid_ = MYTID(); asm volatile("" : "+v"(tid_)); int G_ = gridDim.x, bx_ = blockIdx.x; asm volatile("" : "+s"(G_), "+s"(bx_)); \
    const int lane = tid_ & 63, wave = __builtin_amdgcn_readfirstlane(tid_ >> 6); const int vcu_ = (G_ % 8 == 0) ? (bx_ % 8) * (G_ / 8) + bx_ / 8 : bx_; const int gw = vcu_ * NWAVES + wave, NGW = G_ * NWAVES; (void)lane; (void)gw; (void)NGW
    XcdBarrier bar; bar.bar = (unsigned*)(F.ctl + CW_BAR); bar.x = 0; bar.st = nullptr;
    if (!MK_PER_PHASE) bar = xcd_barrier_post((unsigned*)(F.ctl + CW_BAR), F.MISC + 8);
#define GRID_BAR() do { if (MK_PER_PHASE) { if (MYTID() == 0) __hip_atomic_store(F.ctl + 0, 0xBADBA0u, RLX_AGENT); } else { for (int xb_ = 0; xb_ <= MK_EXTRA_BAR; ++xb_) xcd_barrier(bar, MYTID() == 0); } } while (0)
    const int lo = args.ph_lo, hi = args.ph_hi;
#define IN(k) (lo <= (k) && (k) < hi)
#define BOTH(k) (IN(k) && IN((k) + 1))

#define PHASE_PTRS() unsigned zo_ = 0u; asm volatile("" : "+s"(zo_)); unsigned char* ws_ = args.ws + zo_;     \
    const float* x_in = args.in[0]; float* out = args.out; \
    float* cosT = (float*)(ws_ + WS_ROPE); float* sinT = cosT + SEQ * 16; float* kmean = (float*)(ws_ + WS_KMEAN); bf16* kmh = (bf16*)(ws_ + WS_KMEAN + 192 * 1024); bf16* kml = kmh + BATCH * 6 * 16 * 64; float* lse = (float*)(ws_ + WS_LSE); (void)kmh; (void)kml; (void)lse; \
    pg8::u64* rsu = (pg8::u64*)(ws_ + WS_RS); float* rsq = (float*)(ws_ + WS_RSQ); float* rskv = (float*)(ws_ + WS_RSKV); \
    bf16* Wb = (bf16*)(ws_ + WS_W); bf16* XB = (bf16*)(ws_ + WS_XB); bf16* PROJ = (bf16*)(ws_ + WS_PROJ); bf16* ACT = PROJ; bf16* GT = PROJ; \
    bf16* QM = (bf16*)(ws_ + WS_QM); bf16* KN = (bf16*)(ws_ + WS_KN); bf16* VM = (bf16*)(ws_ + WS_VM); bf16* KR = (bf16*)(ws_ + WS_KR); \
    bf16* MG = (bf16*)(ws_ + WS_MG); bf16* AO = (bf16*)(ws_ + WS_AO); \
    const pg8::bf16_t* Wgu1 = Wb + W_GU1 / 2; const pg8::bf16_t* Wd1 = Wb + W_D1 / 2; const pg8::bf16_t* Win = Wb + W_IN / 2; const pg8::bf16_t* Wg = Wb + W_G / 2; \
    const pg8::bf16_t* Wuq = Wb + W_UQ / 2; const pg8::bf16_t* Wukv = Wb + W_UKV / 2; const pg8::bf16_t* Wbr = Wb + W_BR / 2; const pg8::bf16_t* Wout = Wb + W_OUT / 2; \
    const pg8::bf16_t* Wgu2 = Wb + W_GU2 / 2; const pg8::bf16_t* Wd2 = Wb + W_D2 / 2; \
    (void)x_in; (void)out; (void)cosT; (void)sinT; (void)kmean; (void)rsu; (void)rsq; (void)rskv; (void)XB; (void)ACT; (void)GT; (void)QM; (void)KN; (void)VM; (void)KR; (void)MG; (void)AO; \
    (void)Wgu1; (void)Wd1; (void)Win; (void)Wg; (void)Wuq; (void)Wukv; (void)Wbr; (void)Wout; (void)Wgu2; (void)Wd2

    if (IN(0)) { PHASE_LANES(); PHASE_PTRS();
        for (int m = gw; m < T; m += NGW) { const GAS f32x4* xr = (const GAS f32x4*)(x_in + (size_t)m * DM) + 2 * lane; f32x4 v[4]; float s = 0.f;
#pragma unroll
            for (int j = 0; j < 4; ++j) { v[j] = xr[128 * (j >> 1) + (j & 1)]; s += (v[j].x * v[j].x + v[j].y * v[j].y) + (v[j].z * v[j].z + v[j].w * v[j].w); }
            s = wave_sum(s);
            GAS v4u* o16 = (GAS v4u*)(XB + (size_t)m * DM) + lane;
#pragma unroll
            for (int j = 0; j < 2; ++j) o16[64 * j] = (v4u){pk2(v[2 * j].x, v[2 * j].y), pk2(v[2 * j].z, v[2 * j].w), pk2(v[2 * j + 1].x, v[2 * j + 1].y), pk2(v[2 * j + 1].z, v[2 * j + 1].w)};
            if (lane == 0) rsu[m] = (pg8::u64)(s * pg8::RS_FIX); }
        for (int idx = gw * 64 + lane; idx < SEQ * 16; idx += NGW * 64) { const int pos = idx >> 4, i = idx & 15; const int a = i & 3, e = i >> 2;
            const double mm = a == 0 ? 1.0 : a == 1 ? 0.5623413251903491 : a == 2 ? 0.31622776601683794 : 0.1778279410038923;
            const double pe = e == 0 ? 1.0 : e == 1 ? 0.1 : e == 2 ? 0.01 : 0.001;
            const float inv = (float)(mm * pe); const float angf = (float)pos * inv;
            const double rev = (double)angf * 0.15915494309189535; const float fr = (float)(rev - __builtin_rint(rev));
            cosT[idx] = __builtin_amdgcn_cosf(fr); sinT[idx] = __builtin_amdgcn_sinf(fr); }
        { LAS float* scr = (LAS float*)(F.lds + RING_OFF + wave * 16384); CVT_SET_A(0, gw, NGW);
          v4u z = (v4u){0u, 0u, 0u, 0u}; asm volatile("" : "+v"(z)); const int gt = gw * 64 + lane, NTH = NGW * 64;
          for (int i = gt; i < 224 * 1024 / 8; i += NTH) *(GAS v4u*)(Wb + W_IN / 2 + (size_t)3872 * 1024 + (size_t)i * 8) = z;
          for (int i = gt; i < 192 * 256 / 8; i += NTH) *(GAS v4u*)(Wb + W_UQ / 2 + (size_t)576 * 256 + (size_t)i * 8) = z;
          for (int i = gt; i < 768 * 16; i += NTH) *(GAS v4u*)(Wb + W_UKV / 2 + (size_t)(i >> 4) * 256 + 128 + (i & 15) * 8) = z; }
        if (BOTH(0)) GRID_BAR();
    }

    for (int l = 0; l < DEPTH; ++l) {
        const int pb = 1 + l * PH_PER_LAYER;
        if (IN(pb + 1)) { PHASE_PTRS();
            pg8::Gemm g{XB, Wgu1, T, 2 * FF, DM, DM, DM}; pg8::StaticOrder S; S.init(T, 2 * FF, OPQ_S((int)gridDim.x), OPQ_S((int)blockIdx.x));
            pg8::EpiSwiGLU E{ACT, FF, rsu + (size_t)(3 * l + 0) * T};
            for (int rep = 0; rep < ((MK_DOUBLE & 1) ? 2 : 1); ++rep)
            pg8::gemm_phase<pg8::EpiSwiGLU, pg8::StaticOrder, true>(F.lds + RING_OFF, g, S, E, MYTID());
            if (BOTH(pb + 1)) GRID_BAR();
        }
        if (IN(pb + 2)) { PHASE_PTRS();
            pg8::Gemm g{ACT, Wd1, T, DM, FF, FF, FF}; pg8::StaticOrder S; S.init(T, DM, OPQ_S((int)gridDim.x), OPQ_S((int)blockIdx.x));
            pg8::EpiResid E{XB, rsu + (size_t)(3 * l + 1) * T, 0.5f};
            pg8::gemm_phase<pg8::EpiResid, pg8::StaticOrder, true>(F.lds + RING_OFF, g, S, E, MYTID());
            if (BOTH(pb + 2)) GRID_BAR();
        }
        if (IN(pb + 3)) { PHASE_PTRS();
            pg8::Gemm g{XB, Win, T, 4096, DM, DM, DM}; pg8::StaticOrder S; S.init(T, 4096, OPQ_S((int)gridDim.x), OPQ_S((int)blockIdx.x));
            pg8::EpiProj E{PROJ, rsu + (size_t)(3 * l + 1) * T, rsq, rskv};
            for (int rep = 0; rep < ((MK_DOUBLE & 4) ? 2 : 1); ++rep)
            pg8::gemm_phase<pg8::EpiProj, pg8::StaticOrder, true>(F.lds + RING_OFF, g, S, E, MYTID());
            if (BOTH(pb + 3)) GRID_BAR();
        }
        if (IN(pb + 4)) { PHASE_PTRS();
            { pg8::Gemm g{PROJ + PTOK_OFF, Wuq, T, 1536, 256, PTP, 256}; pg8::UpOrder S; S.init(T, 1536, OPQ_S((int)gridDim.x), OPQ_S((int)blockIdx.x));
              pg8::EpiUp E{QM, KN, VM, rsq, rskv, cosT, sinT};
              pg8::gemm_phase<pg8::EpiUp, pg8::UpOrder, true>(F.lds + RING_OFF, g, S, E, MYTID()); }
            PHASE_LANES();
            for (int idx = gw * 64 + lane; idx < T * 2; idx += NGW * 64) { const int row = idx >> 1, c = idx & 1, pos = row & (SEQ - 1);
                const v4u a1 = *(const v4u*)(PROJ + PTOK_OFF + (size_t)row * PTP + 384 + 8 * c), a2 = *(const v4u*)(PROJ + PTOK_OFF + (size_t)row * PTP + 384 + 16 + 8 * c);
                const f32x4 c0 = *(const f32x4*)(cosT + pos * 16 + 8 * c), c1 = *(const f32x4*)(cosT + pos * 16 + 8 * c + 4), s0 = *(const f32x4*)(sinT + pos * 16 + 8 * c), s1 = *(const f32x4*)(sinT + pos * 16 + 8 * c + 4);
                float t1[8], t2[8], cc[8], ss[8], o1[8], o2[8];
                t1[0] = bflo(a1.x); t1[1] = bfhi(a1.x); t1[2] = bflo(a1.y); t1[3] = bfhi(a1.y); t1[4] = bflo(a1.z); t1[5] = bfhi(a1.z); t1[6] = bflo(a1.w); t1[7] = bfhi(a1.w);
                t2[0] = bflo(a2.x); t2[1] = bfhi(a2.x); t2[2] = bflo(a2.y); t2[3] = bfhi(a2.y); t2[4] = bflo(a2.z); t2[5] = bfhi(a2.z); t2[6] = bflo(a2.w); t2[7] = bfhi(a2.w);
#pragma unroll
                for (int j = 0; j < 4; ++j) { cc[j] = c0[j]; cc[4 + j] = c1[j]; ss[j] = s0[j]; ss[4 + j] = s1[j]; }
#pragma unroll
                for (int j = 0; j < 8; ++j) { o1[j] = t1[j] * cc[j] - t2[j] * ss[j]; o2[j] = t1[j] * ss[j] + t2[j] * cc[j]; }
                *(v4u*)(KR + (size_t)row * 32 + 8 * c) = (v4u){pk2(o1[0], o1[1]), pk2(o1[2], o1[3]), pk2(o1[4], o1[5]), pk2(o1[6], o1[7])};
                *(v4u*)(KR + (size_t)row * 32 + 16 + 8 * c) = (v4u){pk2(o2[0], o2[1]), pk2(o2[2], o2[3]), pk2(o2[4], o2[5]), pk2(o2[6], o2[7])}; }
            for (int u = gw; u < BATCH * 6 * 16; u += NGW) { const int n = u & 15, bh = u >> 4, b = bh / 6, h = bh % 6, dc = lane & 7, ks = lane >> 3;
                const bf16* kp = PROJ + ((size_t)(b * HSLOTS + SL_MK + h) * SEQ + n * 256 + ks) * 64 + dc * 8; float a[8];
#pragma unroll
                for (int j = 0; j < 8; ++j) a[j] = 0.f;
#pragma unroll 1
                for (int i0 = 0; i0 < 32; i0 += 16) { v4u kw[16];
#pragma unroll
                    for (int i = 0; i < 16; ++i) kw[i] = *(const v4u*)(kp + (size_t)(8 * (i0 + i)) * 64);
#pragma unroll
                    for (int i = 0; i < 16; ++i) { a[0] += bflo(kw[i].x); a[1] += bfhi(kw[i].x); a[2] += bflo(kw[i].y); a[3] += bfhi(kw[i].y); a[4] += bflo(kw[i].z); a[5] += bfhi(kw[i].z); a[6] += bflo(kw[i].w); a[7] += bfhi(kw[i].w); } }
#pragma unroll
                for (int j = 0; j < 8; ++j) { a[j] += __shfl_xor(a[j], 8); a[j] += __shfl_xor(a[j], 16); a[j] += __shfl_xor(a[j], 32); }
                if (ks == 0) {
#pragma unroll
                    for (int j = 0; j < 8; ++j) { const int idx = u * 64 + dc * 8 + j; const float km = a[j] * (1.0f / 256.0f); kmean[idx] = km; const unsigned hb = f2bf(km); kmh[idx] = (bf16)hb; kml[idx] = (bf16)f2bf(km - __uint_as_float(hb << 16)); } } }
#if MK_NAIVE_DIL
            for (int gid = gw * 64 + lane; gid < BATCH * 4 * SEQ; gid += NGW * 64) dil_naive_thread(PROJ, AO, gid >> 14, (gid >> 12) & 3, gid & (SEQ - 1));
#else
            __syncthreads();
            fa::dil_phase((LAS char*)(F.lds + RING_OFF), tid_, bx_, G_, PROJ, lse);
#endif
            if (BOTH(pb + 4)) GRID_BAR();
        }
        if (IN(pb + 5)) { PHASE_LANES(); PHASE_PTRS();
            const int nchunk = (CVT_ITEMS_B + (l + 1 < DEPTH ? CVT_ITEMS_A : 0)) / 8; gu32* chead = F.ctl + CW_QUEUE + 64 * (32 + l);
            LAS float* scr = (LAS float*)(F.lds + RING_OFF + 63488 + wave * 8448);
#define CVT_CHUNKS(c0_, cnt_) do { for (int c_ = (c0_); c_ < (c0_) + (cnt_) && c_ < nchunk; ++c_) { const int it_ = c_ * 8 + wave; int lane_o_ = lane; asm volatile("" : "+v"(lane_o_)); \
                { const int lane = lane_o_;     \
                if (it_ < CVT_ITEMS_B) CVT_SET_B(l, it_, 0x40000000); else CVT_SET_A(l + 1, it_ - CVT_ITEMS_B, 0x40000000); } } } while (0)
#if !MK_NAIVE_DIL
            for (int idx = gw * 64 + lane; idx < T * 32; idx += NGW * 64) { const int row = idx >> 5, hg = (idx >> 3) & 3, c = idx & 7;
                const float l0 = lse[(size_t)row * 12 + hg], l1 = lse[(size_t)row * 12 + 4 + hg], l2 = lse[(size_t)row * 12 + 8 + hg], lm = fmaxf(l0, fmaxf(l1, l2));
                float w0 = exp2f(l0 - lm), w1 = exp2f(l1 - lm), w2 = exp2f(l2 - lm); const float wi = 1.0f / (w0 + w1 + w2); w0 *= wi; w1 *= wi; w2 *= wi;
                const bf16* op = PROJ + ((size_t)((row >> 12) * HSLOTS + SL_DQ + hg) * SEQ + (row & (SEQ - 1))) * 64 + c * 8; float a0[8], a1[8], a2[8], r[8];
                ld8(op, a0); ld8(op + (size_t)4 * SEQ * 64, a1); ld8(op + (size_t)8 * SEQ * 64, a2);
#pragma unroll
                for (int j = 0; j < 8; ++j) r[j] = w0 * a0[j] + w1 * a1[j] + w2 * a2[j];
                st8(AO + (size_t)row * DM + 768 + hg * 64 + c * 8, r, 1.0f); }
#endif
            for (int wrep = 0; wrep < 4; ++wrep) { const int which = wrep >> 1, rep = wrep & 1; if (rep == 1 && !((MK_DOUBLE >> (3 + which)) & 1)) continue;
                const bool naive = which == 0 ? (MK_NAIVE_MLA != 0) : (MK_NAIVE_MOBA != 0);
                if (naive) {
                    for (int u = gw; u < 48 * 32; u += NGW) { const int bh = u >> 5, cp = u & 31, b = bh / 6, h = bh % 6;
                        if (which == 0) { mla_naive_chunk(QM, KN, KR, VM, AO, b, h, cp, lane); mla_naive_chunk(QM, KN, KR, VM, AO, b, h, 63 - cp, lane); }
                        else { moba_naive_chunk(PROJ, kmean, AO, b, h, cp, lane); moba_naive_chunk(PROJ, kmean, AO, b, h, 63 - cp, lane); } }
                } else {
                    gu32* head = F.ctl + CW_QUEUE + 64 * (2 * l + which) + 64 * 8 * rep;
                    for (;;) {
                        if (tid_ == 0) { F.MISC[16] = __hip_atomic_fetch_add(head, 1u, RLX_AGENT); if (which == 0 && rep == 0) F.MISC[17] = __hip_atomic_fetch_add(chead, 2u, RLX_AGENT); }
                        __syncthreads();
                        const int u = __builtin_amdgcn_readfirstlane((int)F.MISC[16]);
                        if (which == 0 && rep == 0) { const int c0 = __builtin_amdgcn_readfirstlane((int)F.MISC[17]); CVT_CHUNKS(c0, 2); }
                        if (u >= 48 * 16) break;
                        const int qb = 15 - u / 48, bh = u % 48, b = bh / 6, h = bh % 6;
                        if (which == 0) fa::mla_unit<8>((LAS char*)(F.lds + RING_OFF), tid_, qb, QM + (size_t)bh * SEQ * 96, KN + (size_t)bh * SEQ * 64, KR + (size_t)b * SEQ * 32, VM + (size_t)bh * SEQ * 64, AO + (size_t)b * SEQ * DM + h * 64);
                        else fa::moba_unit<8>((LAS char*)(F.lds + RING_OFF), tid_, qb, PROJ + (size_t)(b * HSLOTS + SL_MQ + h) * SEQ * 64, PROJ + (size_t)(b * HSLOTS + SL_MK + h) * SEQ * 64, PROJ + (size_t)(b * HSLOTS + SL_MV + h) * SEQ * 64, AO + (size_t)b * SEQ * DM + 384 + h * 64,
                                              kmh + (size_t)bh * 1024, kml + (size_t)bh * 1024, exp2f(-8.0f * (float)(12 + h + 1) / 18.0f) * LOG2E);
                    }
                    __syncthreads();
                }
            }
            for (;;) {
                __syncthreads();
                if (tid_ == 0) F.MISC[17] = __hip_atomic_fetch_add(chead, 4u, RLX_AGENT);
                __syncthreads();
                const int c0 = __builtin_amdgcn_readfirstlane((int)F.MISC[17]); if (c0 >= nchunk) break;
                CVT_CHUNKS(c0, 4);
            }
#undef CVT_CHUNKS
            if (BOTH(pb + 5)) GRID_BAR();
        }
        if (IN(pb + 7)) { PHASE_PTRS();
            { pg8::Gemm g{XB, Wg, T, DM, DM, DM, DM, AO, Wbr}; pg8::FusedOrder S; S.init(T, DM, OPQ_S((int)gridDim.x), OPQ_S((int)blockIdx.x));
              pg8::EpiFused E{GT + (size_t)OPQ_S((int)blockIdx.x) * 65536, MG, rsu + (size_t)(3 * l + 1) * T};
              pg8::gemm_phase<pg8::EpiFused, pg8::FusedOrder, true>(F.lds + RING_OFF, g, S, E, MYTID()); }
            if (BOTH(pb + 7)) GRID_BAR();
        }
        if (IN(pb + 8)) { PHASE_PTRS();
            pg8::Gemm g{MG, Wout, T, DM, DM, DM, DM}; pg8::StaticOrder S; S.init(T, DM, OPQ_S((int)gridDim.x), OPQ_S((int)blockIdx.x));
            pg8::EpiResid E{XB, rsu + (size_t)(3 * l + 2) * T, 1.0f};
            pg8::gemm_phase<pg8::EpiResid, pg8::StaticOrder, true>(F.lds + RING_OFF, g, S, E, MYTID());
            if (BOTH(pb + 8)) GRID_BAR();
        }
        if (IN(pb + 9)) { PHASE_PTRS();
            pg8::Gemm g{XB, Wgu2, T, 2 * FF, DM, DM, DM}; pg8::StaticOrder S; S.init(T, 2 * FF, OPQ_S((int)gridDim.x), OPQ_S((int)blockIdx.x));
            pg8::EpiSwiGLU E{ACT, FF, rsu + (size_t)(3 * l + 2) * T};
            for (int rep = 0; rep < ((MK_DOUBLE & 1) ? 2 : 1); ++rep)
            pg8::gemm_phase<pg8::EpiSwiGLU, pg8::StaticOrder, true>(F.lds + RING_OFF, g, S, E, MYTID());
            if (BOTH(pb + 9)) GRID_BAR();
        }
        if (IN(pb + 10)) { PHASE_PTRS();
            pg8::Gemm g{ACT, Wd2, T, DM, FF, FF, FF}; pg8::StaticOrder S; S.init(T, DM, OPQ_S((int)gridDim.x), OPQ_S((int)blockIdx.x));
            pg8::EpiResid E{XB, rsu + (size_t)(3 * (l + 1)) * T, 0.5f};
            pg8::gemm_phase<pg8::EpiResid, pg8::StaticOrder, true>(F.lds + RING_OFF, g, S, E, MYTID());
            if (BOTH(pb + 10)) GRID_BAR();
        }
    }
    if (IN(N_PHASES - 1)) { PHASE_LANES(); PHASE_PTRS();
        const float* gain = args.in[19];
        for (int m = gw; m < T; m += NGW) { float v[16]; ld8(XB + (size_t)m * DM + lane * 16, v); ld8(XB + (size_t)m * DM + lane * 16 + 8, v + 8); float s2 = 0.f;
#pragma unroll
            for (int j = 0; j < 16; ++j) s2 += v[j] * v[j];
            const float r = 1.0f / sqrtf(wave_sum(s2) * (1.0f / DM) + NORM_EPS);
#pragma unroll
            for (int j = 0; j < 4; ++j) { const f32x4 gn = *((const f32x4*)gain + lane * 4 + j); *((GAS f32x4*)(out + (size_t)m * DM) + lane * 4 + j) = (f32x4){v[4 * j] * r * gn[0], v[4 * j + 1] * r * gn[1], v[4 * j + 2] * r * gn[2], v[4 * j + 3] * r * gn[3]}; } }
    }
#undef IN
#undef BOTH
#undef GRID_BAR
}


extern "C" void kernel_launch(void* const* d_in, const int* in_sizes, int n_in, void* d_out, int out_size, void* d_ws, size_t ws_size, hipStream_t stream) {
    static int grid = 0;
    if (grid == 0) {
        if (n_in != 20 || in_sizes[0] != T * DM || out_size != T * DM || ws_size < WS_END) { fprintf(stderr, "kernel_launch: unexpected shapes / workspace (n_in %d, ws %zu, need %zu)\n", n_in, ws_size, (size_t)WS_END); grid = -1; return; }
        int dev = 0, cus = 0, per_cu = 0;
        if (hipGetDevice(&dev) != hipSuccess || hipDeviceGetAttribute(&cus, hipDeviceAttributeMultiprocessorCount, dev) != hipSuccess) { grid = -1; return; }
        if (hipFuncSetAttribute((const void*)mk_fwd, hipFuncAttributeMaxDynamicSharedMemorySize, LDS_BYTES) != hipSuccess) { fprintf(stderr, "kernel_launch: hipFuncSetAttribute failed\n"); grid = -1; return; }
        if (hipOccupancyMaxActiveBlocksPerMultiprocessor(&per_cu, (const void*)mk_fwd, NWAVES * 64, LDS_BYTES) != hipSuccess || per_cu < 1)
            fprintf(stderr, "kernel_launch: note: occupancy query reports %d workgroups per CU\n", per_cu);
        (void)hipGetLastError();
        grid = cus;
    }
    if (grid < 0) return;
    if (hipMemsetAsync((char*)d_ws + WS_CTL, 0, CTL_ZERO_BYTES, stream) != hipSuccess) return;
    Args a{};
    for (int i = 0; i < 20; ++i) a.in[i] = (const float*)d_in[i];
    a.out = (float*)d_out; a.ws = (unsigned char*)d_ws;
#if MK_PER_PHASE
    for (int p = 0; p < N_PHASES; ++p) { if (p > MK_STOP_AFTER && p != N_PHASES - 1) continue; a.ph_lo = p; a.ph_hi = p + 1; hipLaunchKernelGGL(mk_fwd, dim3(grid), dim3(NWAVES * 64), LDS_BYTES, stream, a); }
#else
    a.ph_lo = 0; a.ph_hi = N_PHASES;
    hipLaunchKernelGGL(mk_fwd, dim3(grid), dim3(NWAVES * 64), LDS_BYTES, stream, a);
#endif
}
```

```cpp
#include <hip/hip_runtime.h>
#include <cstdio>
#include <cstdint>

#ifndef MK_PER_PHASE
#define MK_PER_PHASE 0
#endif

#ifndef MK_DOUBLE
#define MK_DOUBLE 0
#endif
#ifndef MK_STAGGER_TICKS
#define MK_STAGGER_TICKS 300
#endif
#ifndef MK_EXTRA_BAR
#define MK_EXTRA_BAR 0
#endif
#ifndef MK_NAIVE_MLA
#define MK_NAIVE_MLA 0
#endif
#ifndef MK_NAIVE_MOBA
#define MK_NAIVE_MOBA 0
#endif
#ifndef MK_NAIVE_DIL
#define MK_NAIVE_DIL 0
#endif
#ifndef MK_STOP_AFTER
#define MK_STOP_AFTER 999
#endif
constexpr int BATCH = 8, SEQ = 4096, DM = 1024, DEPTH = 4, FF = 2816, T = BATCH * SEQ;
constexpr int PP = 4096;
constexpr int HSLOTS = 54, SL_DQ = 0, SL_DK = 12, SL_DV = 24, SL_MQ = 36, SL_MK = 42, SL_MV = 48, PTP = 640;
constexpr size_t PTOK_OFF = (size_t)8 * HSLOTS * 4096 * 64;
constexpr int PC_DQ = 0, PC_DK = 768, PC_DV = 1536, PC_MQ = 2304, PC_MK = 2688, PC_MV = 3072, PC_CKV = 3456, PC_CQ = 3584, PC_KR = 3840;
constexpr int IN_COLS = 6944;
constexpr float NORM_EPS = 1e-6f;
constexpr float LOG2E = 1.4426950408889634f, QSCALE64 = 0.125f * LOG2E, QSCALE96 = 0.10206207261596575f * LOG2E;

namespace pg8 {
#define PG8_LAS __attribute__((address_space(3)))
typedef unsigned short bf16_t;
typedef short bf16x8 __attribute__((ext_vector_type(8)));
typedef float f32x4 __attribute__((ext_vector_type(4)));
typedef unsigned u32x4 __attribute__((ext_vector_type(4)));
typedef unsigned u32x2 __attribute__((ext_vector_type(2)));
typedef unsigned long long u64;
constexpr int BM = 256, BK = 64, HALF = 128, HTB = HALF * BK * 2, STAGE_BYTES = 8 * HTB, NXCD = 8, WGM = 8;

__host__ __device__ __forceinline__ int lds_byte(int r, int c) { const int st = (r >> 4) * 2 + (c >> 5), rr = r & 15, cc = c & 31, ob = rr * 64 + cc * 2; return st * 1024 + (ob ^ (((ob >> 9) & 1) << 5)); }
__host__ __device__ __forceinline__ void stage_rc(int b, int& R, int& C) { const int st = b / 1024, sb = b % 1024, swz = sb ^ (((sb >> 9) & 1) << 5); R = (st >> 1) * 16 + swz / 64; C = (st & 1) * 32 + (swz % 64) / 2; }
__host__ __device__ __forceinline__ int perm32(int rho) { const int n = rho >> 4, i = rho & 15; return 8 * (i >> 2) + 4 * n + (i & 3); }

struct Unit { int pm, pn, sub, ka, kb, nt, sel; };
struct Gemm { const bf16_t* A; const bf16_t* Bt; int M, N, K, lda, ldb; const bf16_t* A1; const bf16_t* Bt1; };

struct StaticOrder {
    int nM, nN, nwg, G, c;
    __host__ __device__ void init(int M, int N, int G_, int c_) { nM = M / BM; nN = N / BM; nwg = nM * nN; G = G_; c = c_; }
    __host__ __device__ bool next(int i, Unit& u) const {
        const long L = (long)i * G + c; if (L >= nwg) return false;
        int wgid = (int)L; { const int q = nwg / NXCD, r = nwg % NXCD, xcd = wgid % NXCD, off = wgid / NXCD; wgid = (xcd < r ? xcd * (q + 1) : r * (q + 1) + (xcd - r) * q) + off; }
        const int nig = WGM * nN, gid = wgid / nig, fm = gid * WGM, gsz = (nM - fm) < WGM ? (nM - fm) : WGM;
        u.pm = fm + ((wgid % nig) % gsz); u.pn = (wgid % nig) / gsz; u.sub = 0; u.ka = 0; u.kb = 0; u.nt = 0; u.sel = 0; return true;
    }
    __device__ __forceinline__ void a_ready(const Unit&) const {}
    __device__ __forceinline__ void done(const Unit&) const {}
};

typedef float f32x2_t __attribute__((ext_vector_type(2))); typedef __bf16 bf16x2_t __attribute__((ext_vector_type(2)));
struct MergeOrder : StaticOrder {
    __host__ __device__ bool next(int i, Unit& u) const { if (!StaticOrder::next(i / 3, u)) return false; u.sub = i % 3; u.ka = u.sub * 768; u.kb = u.ka; u.nt = (u.sub == 2) ? 4 : 6; return true; }
};
struct UpOrder : StaticOrder {
    __host__ __device__ bool next(int i, Unit& u) const { if (!StaticOrder::next(i, u)) return false; u.ka = (u.pn < 3 ? 128 : 0) * 2; return true; }
};
__device__ __forceinline__ unsigned cvt_pk_bf16(float lo, float hi) { f32x2_t v = {lo, hi}; bf16x2_t b = __builtin_convertvector(v, bf16x2_t); return __builtin_bit_cast(unsigned, b); }
__device__ __forceinline__ float bflo(unsigned w) { return __uint_as_float(w << 16); }
__device__ __forceinline__ float bfhi(unsigned w) { return __uint_as_float(w & 0xffff0000u); }

template <int NP> __device__ __forceinline__ float row_scale(const float* p, int row, float invn) {
    float s = 0.f;
#pragma unroll
    for (int i = 0; i < NP / 4; ++i) { const f32x4 a = *(const f32x4*)(p + (size_t)row * NP + 4 * i); s += (a[0] + a[1]) + (a[2] + a[3]); }
    return 1.0f / sqrtf(s * invn + NORM_EPS);
}
constexpr float RS_FIX = 16777216.0f, RS_UNFIX = 1.0f / 16777216.0f;
constexpr int RS_LDS_OFF = 131072 + 2048;
__device__ __forceinline__ void row_scales8(const PG8_LAS unsigned char* ldsbase, int wr, int fr, float (&sc)[2][4]) {
    const PG8_LAS u64* p = (const PG8_LAS u64*)(ldsbase + RS_LDS_OFF) + wr * 64 + fr;
#pragma unroll
    for (int ai = 0; ai < 2; ++ai)
#pragma unroll
        for (int m = 0; m < 4; ++m) sc[ai][m] = 1.0f / sqrtf((float)p[ai * HALF + m * 16] * (RS_UNFIX / DM) + NORM_EPS);
}
__device__ __forceinline__ float silu_f(float a) { return a * __builtin_amdgcn_rcpf(1.0f + __builtin_amdgcn_exp2f(-1.4426950408889634f * a)); }
__device__ __forceinline__ float sigm_f(float a) { return __builtin_amdgcn_rcpf(1.0f + __builtin_amdgcn_exp2f(-1.4426950408889634f * a)); }

struct EpiSwiGLU { static constexpr bool PERM = true, AFTER_DRAIN = false, RS_PREFETCH = true; static __device__ __forceinline__ bool rs_wanted(const Unit&) { return true; }
    bf16_t* O; int ldc; const u64* rsu;
    __device__ __forceinline__ void operator()(const f32x4 (&acc)[2][2][4][2], const Unit& u, int wr, int wc, int fr, int fq, const PG8_LAS unsigned char* ldsbase) const {
        const int row0 = u.pm * BM + wr * 64 + fr, col0 = u.pn * HALF + wc * 32 + 8 * fq;
        float sc[2][4]; row_scales8(ldsbase, wr, fr, sc);
#pragma unroll
        for (int ai = 0; ai < 2; ++ai)
#pragma unroll
            for (int m = 0; m < 4; ++m) { const int row = row0 + ai * HALF + m * 16; const float s = sc[ai][m];
                float y[8];
#pragma unroll
                for (int n = 0; n < 2; ++n)
#pragma unroll
                    for (int j = 0; j < 4; ++j) y[4 * n + j] = silu_f(acc[ai][0][m][n][j] * s) * (acc[ai][1][m][n][j] * s);
                u32x4 w; w.x = cvt_pk_bf16(y[0], y[1]); w.y = cvt_pk_bf16(y[2], y[3]); w.z = cvt_pk_bf16(y[4], y[5]); w.w = cvt_pk_bf16(y[6], y[7]);
                *(u32x4*)(O + (size_t)row * ldc + col0) = w; }
    }
};
struct EpiResid { static constexpr bool PERM = true, AFTER_DRAIN = false, RS_PREFETCH = false;
    bf16_t* xb; u64* rsu; float alpha;
    __device__ __forceinline__ void operator()(const f32x4 (&acc)[2][2][4][2], const Unit& u, int wr, int wc, int fr, int fq, const PG8_LAS unsigned char* ldsbase) const {
        const int row0 = u.pm * BM + wr * 64 + fr, col0 = u.pn * BM + wc * 32 + 8 * fq;
#pragma unroll
        for (int ai = 0; ai < 2; ++ai) {
            u32x4 b[4][2];
#pragma unroll
            for (int m = 0; m < 4; ++m)
#pragma unroll
                for (int bj = 0; bj < 2; ++bj) b[m][bj] = *(const u32x4*)(xb + (size_t)(row0 + ai * HALF + m * 16) * DM + col0 + bj * HALF);
#pragma unroll
            for (int m = 0; m < 4; ++m) { const int row = row0 + ai * HALF + m * 16; float ss = 0.f;
#pragma unroll
                for (int bj = 0; bj < 2; ++bj) { const u32x4 p = b[m][bj]; const f32x4 a0 = acc[ai][bj][m][0], a1 = acc[ai][bj][m][1]; float o[8];
                    o[0] = bflo(p.x) + alpha * a0[0]; o[1] = bfhi(p.x) + alpha * a0[1]; o[2] = bflo(p.y) + alpha * a0[2]; o[3] = bfhi(p.y) + alpha * a0[3];
                    o[4] = bflo(p.z) + alpha * a1[0]; o[5] = bfhi(p.z) + alpha * a1[1]; o[6] = bflo(p.w) + alpha * a1[2]; o[7] = bfhi(p.w) + alpha * a1[3];
                    u32x4 w; w.x = cvt_pk_bf16(o[0], o[1]); w.y = cvt_pk_bf16(o[2], o[3]); w.z = cvt_pk_bf16(o[4], o[5]); w.w = cvt_pk_bf16(o[6], o[7]);
                    *(u32x4*)(xb + (size_t)row * DM + col0 + bj * HALF) = w;
#pragma unroll
                    for (int j = 0; j < 8; ++j) ss += o[j] * o[j]; }
                ss += __shfl_xor(ss, 16); ss += __shfl_xor(ss, 32);
                if (fq == 0) __hip_atomic_fetch_add(rsu + row, (u64)(ss * RS_FIX), __ATOMIC_RELAXED, __HIP_MEMORY_SCOPE_AGENT); }
        }
    }
};
struct EpiProj { static constexpr bool PERM = true, AFTER_DRAIN = false, RS_PREFETCH = true; static __device__ __forceinline__ bool rs_wanted(const Unit&) { return true; }
    bf16_t* O; const u64* rsu; float* rsq; float* rskv;
    __device__ __forceinline__ void operator()(const f32x4 (&acc)[2][2][4][2], const Unit& u, int wr, int wc, int fr, int fq, const PG8_LAS unsigned char* ldsbase) const {
        const int row0 = u.pm * BM + wr * 64 + fr, col0 = u.pn * BM + wc * 32 + 8 * fq;
        float sc[2][4]; row_scales8(ldsbase, wr, fr, sc);
#pragma unroll
        for (int ai = 0; ai < 2; ++ai)
#pragma unroll
            for (int m = 0; m < 4; ++m) { const int row = row0 + ai * HALF + m * 16; const float s = sc[ai][m]; float ssb[2];
#pragma unroll
                for (int bj = 0; bj < 2; ++bj) { const float sq = (u.pn < 3 || u.pn == 9 || (u.pn == 10 && bj == 0)) ? s * QSCALE64 : s;
                    const f32x4 v0 = acc[ai][bj][m][0] * sq, v1 = acc[ai][bj][m][1] * sq;
                    u32x4 w; w.x = cvt_pk_bf16(v0[0], v0[1]); w.y = cvt_pk_bf16(v0[2], v0[3]); w.z = cvt_pk_bf16(v1[0], v1[1]); w.w = cvt_pk_bf16(v1[2], v1[3]);
                    { const int c = col0 + bj * HALF;
                      if (u.pn * 2 + bj < 27) *(u32x4*)(O + ((size_t)((row >> 12) * HSLOTS + (u.pn * 4 + bj * 2 + (wc >> 1))) * SEQ + (row & (SEQ - 1))) * 64 + (wc & 1) * 32 + 8 * fq) = w;
                      else *(u32x4*)(O + PTOK_OFF + (size_t)row * PTP + (c - 3456)) = w; }
                    ssb[bj] = ((v0[0] * v0[0] + v0[1] * v0[1]) + (v0[2] * v0[2] + v0[3] * v0[3])) + ((v1[0] * v1[0] + v1[1] * v1[1]) + (v1[2] * v1[2] + v1[3] * v1[3])); }
                if (u.pn == 14) { float ss = ssb[0] + ssb[1]; ss += __shfl_xor(ss, 16); ss += __shfl_xor(ss, 32); if (fq == 0) rsq[(size_t)row * 4 + wc] = ss; }
                if (u.pn == 13) { float ss = ssb[1]; ss += __shfl_xor(ss, 16); ss += __shfl_xor(ss, 32); if (fq == 0) rskv[(size_t)row * 4 + wc] = ss; } }
    }
};
struct EpiQup { static constexpr bool PERM = false, AFTER_DRAIN = false, RS_PREFETCH = false;
    bf16_t* Q; const float* rsq; const float* cosT; const float* sinT;
    __device__ __forceinline__ void operator()(const f32x4 (&acc)[2][2][4][2], const Unit& u, int wr, int wc, int fr, int fq, const PG8_LAS unsigned char* ldsbase) const {
        const int row0 = u.pm * BM + wr * 64 + fr;
        const int c32a = u.pn * BM + wc * 32, c32b = c32a + HALF;
        const bool ropea = (c32a < 576) && (c32a % 96) == 64, ropeb = (c32b < 576) && (c32b % 96) == 64, ropeany = ropea || ropeb;
#pragma unroll
        for (int ai = 0; ai < 2; ++ai) {
            f32x4 rsv[4], cs[4], sn[4];
#pragma unroll
            for (int m = 0; m < 4; ++m) { rsv[m] = *(const f32x4*)(rsq + (size_t)(row0 + ai * HALF + m * 16) * 4); cs[m] = (f32x4){0.f, 0.f, 0.f, 0.f}; sn[m] = cs[m]; }
            if (ropeany) {
#pragma unroll
                for (int m = 0; m < 4; ++m) { const int pos = (row0 + ai * HALF + m * 16) & (SEQ - 1); cs[m] = *(const f32x4*)(cosT + pos * 16 + 4 * fq); sn[m] = *(const f32x4*)(sinT + pos * 16 + 4 * fq); } }
            float sc[4];
#pragma unroll
            for (int m = 0; m < 4; ++m) { const f32x4 a = rsv[m]; sc[m] = (1.0f / sqrtf(((a[0] + a[1]) + (a[2] + a[3])) * (1.0f / 256.0f) + NORM_EPS)) * QSCALE96; }
#pragma unroll
            for (int bj = 0; bj < 2; ++bj) { const int c32 = bj ? c32b : c32a; if (c32 >= 576) continue; const bool rope = bj ? ropeb : ropea;
#pragma unroll
                for (int m = 0; m < 4; ++m) { const int row = row0 + ai * HALF + m * 16; const float s = sc[m];
                    f32x4 v0 = acc[ai][bj][m][0] * s, v1 = acc[ai][bj][m][1] * s;
                    if (rope) { const f32x4 o0 = v0 * cs[m] - v1 * sn[m], o1 = v0 * sn[m] + v1 * cs[m]; v0 = o0; v1 = o1; }
                    u32x2 w0, w1; w0.x = cvt_pk_bf16(v0[0], v0[1]); w0.y = cvt_pk_bf16(v0[2], v0[3]); w1.x = cvt_pk_bf16(v1[0], v1[1]); w1.y = cvt_pk_bf16(v1[2], v1[3]);
                    { auto r = __builtin_amdgcn_permlane16_swap(w0.x, w1.x, false, false); w0.x = r[0]; w1.x = r[1]; }
                    { auto r = __builtin_amdgcn_permlane16_swap(w0.y, w1.y, false, false); w0.y = r[0]; w1.y = r[1]; }
                    bf16_t* p = Q + ((size_t)((row >> 12) * 6 + c32 / 96) * SEQ + (row & (SEQ - 1))) * 96 + (c32 % 96) + (fq & 1) * 16 + (fq >> 1) * 8; *(u32x4*)p = (u32x4){w0.x, w0.y, w1.x, w1.y}; } } }
    }
};
struct EpiKVup { static constexpr bool PERM = true, AFTER_DRAIN = false, RS_PREFETCH = false;
    bf16_t* Kn; bf16_t* Vm; const float* rskv;
    __device__ __forceinline__ void operator()(const f32x4 (&acc)[2][2][4][2], const Unit& u, int wr, int wc, int fr, int fq, const PG8_LAS unsigned char* ldsbase) const {
        const int row0 = u.pm * BM + wr * 64 + fr;
#pragma unroll
        for (int bj = 0; bj < 2; ++bj) { const int h = 2 * u.pn + bj; bf16_t* dst = (wc < 2 ? Kn + h * 64 + wc * 32 : Vm + h * 64 + (wc - 2) * 32) + 8 * fq;
#pragma unroll
            for (int ai = 0; ai < 2; ++ai)
#pragma unroll
                for (int m = 0; m < 4; ++m) { const int row = row0 + ai * HALF + m * 16; const float s = row_scale<4>(rskv, row, 1.0f / 128.0f);
                    const f32x4 v0 = acc[ai][bj][m][0] * s, v1 = acc[ai][bj][m][1] * s;
                    u32x4 w; w.x = cvt_pk_bf16(v0[0], v0[1]); w.y = cvt_pk_bf16(v0[2], v0[3]); w.z = cvt_pk_bf16(v1[0], v1[1]); w.w = cvt_pk_bf16(v1[2], v1[3]);
                    *(u32x4*)(dst + (size_t)row * 384) = w; } }
    }
};
struct EpiUp { static constexpr bool PERM = false, AFTER_DRAIN = false, RS_PREFETCH = false;
    bf16_t* Q; bf16_t* Kn; bf16_t* Vm; const float* rsq; const float* rskv; const float* cosT; const float* sinT;
    __device__ __forceinline__ void operator()(const f32x4 (&acc)[2][2][4][2], const Unit& u, int wr, int wc, int fr, int fq, const PG8_LAS unsigned char* ldsbase) const {
        const int row0 = u.pm * BM + wr * 64 + fr;
        if (u.pn < 3) { EpiQup E{Q, rsq, cosT, sinT}; E(acc, u, wr, wc, fr, fq, ldsbase); return; }
        f32x4 rsv[2][4]; float sc[2][4];
#pragma unroll
        for (int ai = 0; ai < 2; ++ai)
#pragma unroll
            for (int m = 0; m < 4; ++m) rsv[ai][m] = *(const f32x4*)(rskv + (size_t)(row0 + ai * HALF + m * 16) * 4);
#pragma unroll
        for (int ai = 0; ai < 2; ++ai)
#pragma unroll
            for (int m = 0; m < 4; ++m) { const f32x4 a = rsv[ai][m]; sc[ai][m] = 1.0f / sqrtf(((a[0] + a[1]) + (a[2] + a[3])) * (1.0f / 128.0f) + NORM_EPS); }
#pragma unroll
        for (int bj = 0; bj < 2; ++bj) { const int h = 2 * (u.pn - 3) + bj; bf16_t* dst = (wc < 2 ? Kn + wc * 32 : Vm + (wc - 2) * 32) + (fq & 1) * 16 + (fq >> 1) * 8;
#pragma unroll
            for (int ai = 0; ai < 2; ++ai)
#pragma unroll
                for (int m = 0; m < 4; ++m) { const int row = row0 + ai * HALF + m * 16; const float s = sc[ai][m];
                    const f32x4 v0 = acc[ai][bj][m][0] * s, v1 = acc[ai][bj][m][1] * s;
                    u32x2 w0, w1; w0.x = cvt_pk_bf16(v0[0], v0[1]); w0.y = cvt_pk_bf16(v0[2], v0[3]); w1.x = cvt_pk_bf16(v1[0], v1[1]); w1.y = cvt_pk_bf16(v1[2], v1[3]);
                    { auto r = __builtin_amdgcn_permlane16_swap(w0.x, w1.x, false, false); w0.x = r[0]; w1.x = r[1]; }
                    { auto r = __builtin_amdgcn_permlane16_swap(w0.y, w1.y, false, false); w0.y = r[0]; w1.y = r[1]; }
                    { bf16_t* p = dst + ((size_t)((row >> 12) * 6 + h) * SEQ + (row & (SEQ - 1))) * 64; *(u32x4*)p = (u32x4){w0.x, w0.y, w1.x, w1.y}; } } }
    }
};
struct EpiGate { static constexpr bool PERM = true, AFTER_DRAIN = false, RS_PREFETCH = true; static __device__ __forceinline__ bool rs_wanted(const Unit&) { return true; }
    bf16_t* O; const u64* rsu;
    __device__ __forceinline__ void operator()(const f32x4 (&acc)[2][2][4][2], const Unit& u, int wr, int wc, int fr, int fq, const PG8_LAS unsigned char* ldsbase) const {
        const int row0 = u.pm * BM + wr * 64 + fr, col0 = u.pn * BM + wc * 32 + 8 * fq;
        float sc[2][4]; row_scales8(ldsbase, wr, fr, sc);
#pragma unroll
        for (int ai = 0; ai < 2; ++ai)
#pragma unroll
            for (int m = 0; m < 4; ++m) { const int row = row0 + ai * HALF + m * 16; const float s = sc[ai][m];
#pragma unroll
                for (int bj = 0; bj < 2; ++bj) { float y[8];
#pragma unroll
                    for (int n = 0; n < 2; ++n)
#pragma unroll
                        for (int j = 0; j < 4; ++j) y[4 * n + j] = sigm_f(acc[ai][bj][m][n][j] * s);
                    u32x4 w; w.x = cvt_pk_bf16(y[0], y[1]); w.y = cvt_pk_bf16(y[2], y[3]); w.z = cvt_pk_bf16(y[4], y[5]); w.w = cvt_pk_bf16(y[6], y[7]);
                    *(u32x4*)(O + (size_t)row * 3072 + col0 + bj * HALF) = w; } }
    }
};
struct EpiMerge { static constexpr bool PERM = true, AFTER_DRAIN = false, RS_PREFETCH = false;
    const bf16_t* G; bf16_t* Mg;
    __device__ __forceinline__ void operator()(const f32x4 (&acc)[2][2][4][2], const Unit& u, int wr, int wc, int fr, int fq, const PG8_LAS unsigned char* ldsbase) const {
        const int row0 = u.pm * BM + wr * 64 + fr, col0 = u.pn * BM + wc * 32 + 8 * fq; const bool first = (u.sub == 0); const bf16_t* Gs = G + u.sub * 1024;
#pragma unroll
        for (int ai = 0; ai < 2; ++ai) {
            u32x4 gv[4][2], pv[4][2];
#pragma unroll
            for (int m = 0; m < 4; ++m)
#pragma unroll
                for (int bj = 0; bj < 2; ++bj) { const int row = row0 + ai * HALF + m * 16; gv[m][bj] = *(const u32x4*)(Gs + (size_t)row * 3072 + col0 + bj * HALF);
                    pv[m][bj] = (u32x4){0u, 0u, 0u, 0u}; if (!first) pv[m][bj] = *(const u32x4*)(Mg + (size_t)row * DM + col0 + bj * HALF); }
#pragma unroll
            for (int m = 0; m < 4; ++m)
#pragma unroll
                for (int bj = 0; bj < 2; ++bj) { const int row = row0 + ai * HALF + m * 16; const u32x4 g = gv[m][bj], p = pv[m][bj];
                    const f32x4 a0 = acc[ai][bj][m][0], a1 = acc[ai][bj][m][1];
                    u32x4 w;
                    w.x = cvt_pk_bf16(bflo(p.x) + bflo(g.x) * a0[0], bfhi(p.x) + bfhi(g.x) * a0[1]);
                    w.y = cvt_pk_bf16(bflo(p.y) + bflo(g.y) * a0[2], bfhi(p.y) + bfhi(g.y) * a0[3]);
                    w.z = cvt_pk_bf16(bflo(p.z) + bflo(g.z) * a1[0], bfhi(p.z) + bfhi(g.z) * a1[1]);
                    w.w = cvt_pk_bf16(bflo(p.w) + bflo(g.w) * a1[2], bfhi(p.w) + bfhi(g.w) * a1[3]);
                    *(u32x4*)(Mg + (size_t)row * DM + col0 + bj * HALF) = w; }
        }
    }
};

struct FusedOrder : StaticOrder {
    __host__ __device__ bool next(int i, Unit& u) const { if (!StaticOrder::next(i / 6, u)) return false; const int j = i % 6, br = j >> 1; u.sub = j;
        if ((j & 1) == 0) { u.sel = 0; u.ka = 0; u.kb = br * (1024 * 1024 * 2); u.nt = 16; } else { u.sel = 1; u.ka = br * 768; u.kb = u.ka; u.nt = (br == 2) ? 4 : 6; }
        return true; }
};
struct EpiFused { static constexpr bool PERM = true, AFTER_DRAIN = false, RS_PREFETCH = true; static __device__ __forceinline__ bool rs_wanted(const Unit& u) { return (u.sub & 1) == 0; }
    bf16_t* gs; bf16_t* Mg; const u64* rsu;
    __device__ __forceinline__ void operator()(const f32x4 (&acc)[2][2][4][2], const Unit& u, int wr, int wc, int fr, int fq, const PG8_LAS unsigned char* ldsbase) const {
        int tid = (wr * 4 + wc) * 64 + fq * 16 + fr; asm volatile("" : "+v"(tid));
        const int row0 = u.pm * BM + wr * 64 + fr, col0 = u.pn * BM + wc * 32 + 8 * fq;
        if ((u.sub & 1) == 0) {
            float sc[2][4]; row_scales8(ldsbase, wr, fr, sc);
#pragma unroll
            for (int ai = 0; ai < 2; ++ai)
#pragma unroll
                for (int m = 0; m < 4; ++m) { const float s = sc[ai][m];
#pragma unroll
                    for (int bj = 0; bj < 2; ++bj) { float y[8];
#pragma unroll
                        for (int n = 0; n < 2; ++n)
#pragma unroll
                            for (int j = 0; j < 4; ++j) y[4 * n + j] = sigm_f(acc[ai][bj][m][n][j] * s);
                        u32x4 w; w.x = cvt_pk_bf16(y[0], y[1]); w.y = cvt_pk_bf16(y[2], y[3]); w.z = cvt_pk_bf16(y[4], y[5]); w.w = cvt_pk_bf16(y[6], y[7]);
                        *(u32x4*)(gs + (size_t)((((ai * 4 + m) * 2 + bj) * 512 + tid) * 8)) = w; } }
        } else {
            const bool first = (u.sub == 1);
#pragma unroll
            for (int ai = 0; ai < 2; ++ai) {
                u32x4 gv[4][2], pv[4][2];
#pragma unroll
                for (int m = 0; m < 4; ++m)
#pragma unroll
                    for (int bj = 0; bj < 2; ++bj) { const int row = row0 + ai * HALF + m * 16; gv[m][bj] = *(const u32x4*)(gs + (size_t)((((ai * 4 + m) * 2 + bj) * 512 + tid) * 8));
                        pv[m][bj] = (u32x4){0u, 0u, 0u, 0u}; if (!first) pv[m][bj] = *(const u32x4*)(Mg + (size_t)row * DM + col0 + bj * HALF); }
#pragma unroll
                for (int m = 0; m < 4; ++m)
#pragma unroll
                    for (int bj = 0; bj < 2; ++bj) { const int row = row0 + ai * HALF + m * 16; const u32x4 g = gv[m][bj], p = pv[m][bj];
                        const f32x4 a0 = acc[ai][bj][m][0], a1 = acc[ai][bj][m][1];
                        u32x4 w;
                        w.x = cvt_pk_bf16(bflo(p.x) + bflo(g.x) * a0[0], bfhi(p.x) + bfhi(g.x) * a0[1]);
                        w.y = cvt_pk_bf16(bflo(p.y) + bflo(g.y) * a0[2], bfhi(p.y) + bfhi(g.y) * a0[3]);
                        w.z = cvt_pk_bf16(bflo(p.z) + bflo(g.z) * a1[0], bfhi(p.z) + bfhi(g.z) * a1[1]);
                        w.w = cvt_pk_bf16(bflo(p.w) + bflo(g.w) * a1[2], bfhi(p.w) + bfhi(g.w) * a1[3]);
                        *(u32x4*)(Mg + (size_t)row * DM + col0 + bj * HALF) = w; } }
        }
    }
};

template <class Epi, class Sched, bool ALIGN_EPI = false>
__device__ __forceinline__ void gemm_phase(PG8_LAS unsigned char* lds, const Gemm g, const Sched& S, const Epi& E, int tid_in) {
    int tid_ = tid_in; asm volatile("" : "+v"(tid_));
    const int tid = tid_, wid = __builtin_amdgcn_readfirstlane(tid >> 6), lane = tid & 63, wr = wid >> 2, wc = wid & 3, fr = lane & 15, fq = lane >> 4;
    int K = g.K; asm volatile("" : "+s"(K)); const int nt = K / BK;
    unsigned voffA[2], voffB[2];
#pragma unroll
    for (int i = 0; i < 2; ++i) { int R, C; stage_rc(tid * 16 + i * 8192, R, C); const int Rb = Epi::PERM ? ((R & ~31) + perm32(R & 31)) : R;
        voffA[i] = (unsigned)(R * g.lda + C) * 2u; voffB[i] = (unsigned)(Rb * g.ldb + C) * 2u; }
    const size_t kstep = (size_t)(BK * 2);
    const size_t hstepA = (size_t)HALF * g.lda * 2, hstepB = (size_t)HALF * g.ldb * 2;
    const size_t tstepA = 2 * hstepA, tstepB = 2 * hstepB;
    const unsigned ldsw = (unsigned)wid * 1024u;
    const int aoff = lds_byte(wr * 64 + fr, fq * 8), boff = lds_byte(wc * 32 + fr, fq * 8);
#define PG8_SA(b, h) (((b) * 2 + (h)) * HTB)
#define PG8_SB(b, h) ((4 + (b) * 2 + (h)) * HTB)
#define PG8_STAGE(bufoff, gbase, voff) do { _Pragma("unroll") for (int _i = 0; _i < 2; ++_i) \
        __builtin_amdgcn_global_load_lds((const unsigned*)((const char*)(gbase) + (voff)[_i]), (PG8_LAS unsigned*)(lds + (bufoff) + ldsw + _i * 8192), 16, 0, 0); } while (0)
#define PG8_LDA(dst, b, h) do { _Pragma("unroll") for (int m = 0; m < 4; ++m) _Pragma("unroll") for (int k = 0; k < 2; ++k) dst[m][k] = *(const PG8_LAS bf16x8*)(lds + PG8_SA(b, h) + aoff + m * 2048 + k * 1024); } while (0)
#define PG8_LDB(dst, b, h) do { _Pragma("unroll") for (int n = 0; n < 2; ++n) _Pragma("unroll") for (int k = 0; k < 2; ++k) dst[n][k] = *(const PG8_LAS bf16x8*)(lds + PG8_SB(b, h) + boff + n * 2048 + k * 1024); } while (0)
#define PG8_MMA(ai, bj, At, Bt) do { __builtin_amdgcn_s_setprio(1); _Pragma("unroll") for (int m = 0; m < 4; ++m) _Pragma("unroll") for (int n = 0; n < 2; ++n) _Pragma("unroll") for (int k = 0; k < 2; ++k) \
        acc[ai][bj][m][n] = __builtin_amdgcn_mfma_f32_16x16x32_bf16(Bt[n][k], At[m][k], acc[ai][bj][m][n], 0, 0, 0); __builtin_amdgcn_s_setprio(0); } while (0)
#define PG8_WAIT_V(n) asm volatile("s_waitcnt vmcnt(" #n ")" ::: "memory")
#define PG8_WAIT_L(n) asm volatile("s_waitcnt lgkmcnt(" #n ")" ::: "memory")
#define PG8_BAR __builtin_amdgcn_s_barrier()
#define PG8_SCHED __builtin_amdgcn_sched_barrier(0)
    Unit cur, nxt; int ui = 0;
    if (!S.next(0, cur)) return;
    f32x4 acc[2][2][4][2];
#pragma unroll
    for (int a = 0; a < 2; ++a)
#pragma unroll
        for (int b = 0; b < 2; ++b)
#pragma unroll
            for (int m = 0; m < 4; ++m)
#pragma unroll
                for (int n = 0; n < 2; ++n) acc[a][b][m][n] = (f32x4){0.f, 0.f, 0.f, 0.f};
    bf16x8 At[4][2], B0[2][2], B1[2][2];
    const char* cA = (const char*)(cur.sel ? g.A1 : g.A) + (size_t)cur.pm * tstepA + cur.ka; const char* cB = (const char*)(cur.sel ? g.Bt1 : g.Bt) + (size_t)cur.pn * tstepB + cur.kb;
    S.a_ready(cur);
    PG8_STAGE(PG8_SB(0, 0), cB, voffB); PG8_STAGE(PG8_SB(0, 1), cB + hstepB, voffB); PG8_STAGE(PG8_SA(0, 0), cA, voffA); PG8_STAGE(PG8_SA(0, 1), cA + hstepA, voffA);
    if (wr == 1) PG8_BAR;
    PG8_WAIT_V(2); PG8_BAR;
    PG8_STAGE(PG8_SB(1, 0), cB + kstep, voffB); PG8_STAGE(PG8_SA(1, 0), cA + kstep, voffA); PG8_STAGE(PG8_SB(1, 1), cB + hstepB + kstep, voffB);
    PG8_WAIT_V(6); PG8_BAR;
    for (;;) {
        const bool has_next = S.next(ui + 1, nxt);
        const char* nA = has_next ? (const char*)(nxt.sel ? g.A1 : g.A) + (size_t)nxt.pm * tstepA + nxt.ka : cA; const char* nB = has_next ? (const char*)(nxt.sel ? g.Bt1 : g.Bt) + (size_t)nxt.pn * tstepB + nxt.kb : cB;
        const int ntc = cur.nt ? cur.nt : nt;
        for (int t = 0; t < ntc; t += 2) {
            const bool last = (t == ntc - 2);
            const char* a1 = cA + (size_t)(t + 1) * kstep;
            const char* a2 = last ? nA : cA + (size_t)(t + 2) * kstep; const char* b2 = last ? nB : cB + (size_t)(t + 2) * kstep;
            const char* a3 = a2 + kstep; const char* b3 = b2 + kstep;
            if (last && has_next) S.a_ready(nxt);
            if constexpr (Epi::RS_PREFETCH) { if (last && Epi::rs_wanted(cur)) __builtin_amdgcn_global_load_lds((const unsigned*)(E.rsu + (size_t)cur.pm * BM) + tid, (PG8_LAS unsigned*)(lds + RS_LDS_OFF + wid * 256), 4, 0, 0); }
            PG8_LDB(B0, 0, 0); PG8_LDB(B1, 0, 1); PG8_SCHED; PG8_LDA(At, 0, 0); PG8_STAGE(PG8_SA(1, 1), a1 + hstepA, voffA);
            PG8_WAIT_V(8); PG8_WAIT_L(0); PG8_BAR; PG8_MMA(0, 0, At, B0); PG8_MMA(0, 1, At, B1); PG8_BAR; PG8_SCHED;
            PG8_LDA(At, 0, 1); PG8_STAGE(PG8_SB(0, 0), b2, voffB); PG8_STAGE(PG8_SB(0, 1), b2 + hstepB, voffB); PG8_STAGE(PG8_SA(0, 0), a2, voffA);
            PG8_WAIT_V(8); PG8_WAIT_L(0); PG8_BAR; PG8_MMA(1, 0, At, B0); PG8_MMA(1, 1, At, B1); PG8_BAR; PG8_SCHED;
            PG8_LDB(B0, 1, 0); PG8_LDB(B1, 1, 1); PG8_SCHED; PG8_LDA(At, 1, 0); PG8_STAGE(PG8_SA(0, 1), a2 + hstepA, voffA);
            PG8_WAIT_V(8); PG8_WAIT_L(0); PG8_BAR; PG8_MMA(0, 0, At, B0); PG8_MMA(0, 1, At, B1); PG8_BAR; PG8_SCHED;
            PG8_LDA(At, 1, 1); PG8_STAGE(PG8_SB(1, 0), b3, voffB); PG8_STAGE(PG8_SB(1, 1), b3 + hstepB, voffB); PG8_STAGE(PG8_SA(1, 0), a3, voffA);
            PG8_WAIT_V(8); PG8_WAIT_L(0); PG8_BAR; PG8_MMA(1, 0, At, B0); PG8_MMA(1, 1, At, B1); PG8_BAR; PG8_SCHED;
        }
        if constexpr (ALIGN_EPI) { if (wr == 0) PG8_BAR; }
        E(acc, cur, wr, wc, fr, fq, lds); S.done(cur);
        if (!has_next) break;
#pragma unroll
        for (int a = 0; a < 2; ++a)
#pragma unroll
            for (int b = 0; b < 2; ++b)
#pragma unroll
                for (int m = 0; m < 4; ++m)
#pragma unroll
                    for (int n = 0; n < 2; ++n) acc[a][b][m][n] = (f32x4){0.f, 0.f, 0.f, 0.f};
        cur = nxt; cA = nA; cB = nB; ++ui;
        if constexpr (ALIGN_EPI) { if (wr == 1) PG8_BAR; }
    }
    PG8_WAIT_V(0);
    if constexpr (!ALIGN_EPI) { if (wr == 0) PG8_BAR; }
    PG8_BAR;
#undef PG8_SA
#undef PG8_SB
#undef PG8_STAGE
#undef PG8_LDA
#undef PG8_LDB
#undef PG8_MMA
#undef PG8_WAIT_V
#undef PG8_WAIT_L
#undef PG8_BAR
#undef PG8_SCHED
}
}

constexpr int NWAVES = 8;
constexpr size_t MiB = 1u << 20;
constexpr size_t WS_CTL = 0, CTL_ZERO_BYTES = 6 * MiB;
constexpr size_t WS_ROPE = 1 * MiB;
constexpr size_t WS_KMEAN = WS_ROPE + 512 * 1024;
constexpr size_t WS_RS = 2 * MiB;
constexpr size_t WS_RSQ = 6 * MiB;
constexpr size_t WS_RSKV = WS_RSQ + 512 * 1024;
constexpr size_t WS_W = 7 * MiB;
constexpr size_t W_GU1 = 0, W_D1 = W_GU1 + (size_t)5632 * 1024 * 2, W_IN = W_D1 + (size_t)1024 * 2816 * 2, W_G = W_IN + (size_t)4096 * 1024 * 2,
                 W_UQ = W_G + (size_t)3072 * 1024 * 2, W_UKV = W_UQ + (size_t)768 * 256 * 2, W_BR = W_UKV + (size_t)768 * 256 * 2, W_OUT = W_BR + (size_t)1024 * 1024 * 2,
                 W_GU2 = W_OUT + (size_t)1024 * 1024 * 2, W_D2 = W_GU2 + (size_t)5632 * 1024 * 2, W_END = W_D2 + (size_t)1024 * 2816 * 2;
static_assert(W_END <= 52 * MiB, "weights region");
constexpr size_t WS_XB = 59 * MiB;
constexpr size_t WS_PROJ = 123 * MiB;
constexpr size_t WS_QM = 379 * MiB;
constexpr size_t WS_KN = 415 * MiB;
constexpr size_t WS_VM = 439 * MiB;
constexpr size_t WS_KR = 463 * MiB;
constexpr size_t WS_MG = WS_QM;
constexpr size_t WS_AO = 465 * MiB;
constexpr size_t WS_LSE = 529 * MiB;
constexpr size_t WS_END = 531 * MiB;
static_assert(WS_RS + (size_t)13 * T * 8 <= WS_RSQ && WS_RSQ + MiB <= WS_W && WS_W + 52 * MiB <= WS_XB && WS_RSQ <= CTL_ZERO_BYTES + 0 * MiB + WS_RSQ, "d_ws map");
constexpr int CW_BAR = 4096;
constexpr int CW_QUEUE = 8192;

constexpr int RING_OFF = 0, RING_BYTES = 131072;
constexpr int LDSCTL_OFF = RING_BYTES, MISC_OFF = LDSCTL_OFF + 320;
constexpr int LDS_BYTES = 147456;

#define GAS __attribute__((address_space(1)))
#define LAS __attribute__((address_space(3)))
typedef unsigned short bf16;
typedef unsigned v4u __attribute__((ext_vector_type(4)));
typedef unsigned v2u __attribute__((ext_vector_type(2)));
typedef float f32x4 __attribute__((ext_vector_type(4)));
typedef GAS unsigned gu32;
#define RLX_AGENT __ATOMIC_RELAXED, __HIP_MEMORY_SCOPE_AGENT
#define LDS_WAIT() asm volatile("s_waitcnt lgkmcnt(0)" ::: "memory")
__device__ __forceinline__ unsigned f2bf(float f) { unsigned u = __builtin_bit_cast(unsigned, f); return (u + 0x7fffu + ((u >> 16) & 1u)) >> 16; }
__device__ __forceinline__ unsigned pk2(float lo, float hi) { return f2bf(lo) | (f2bf(hi) << 16); }
__device__ __forceinline__ float bflo(unsigned w) { return __uint_as_float(w << 16); }
__device__ __forceinline__ float bfhi(unsigned w) { return __uint_as_float(w & 0xffff0000u); }

#define XB_TMO      128
#define XB_XCNT(j)  (256  + 64 * (j))
#define XB_XSUB(j)  (1280 + 64 * (j))
#define XB_XGEN(j)  (2304 + 64 * (j))
#define XB_TOP      3328
#define XB_TOPGEN   3392
#define XCD_BAR_WORDS 3456
#define XB_SPIN_CAP (1u << 20)

__device__ __forceinline__ unsigned xb_ld(unsigned* p)              { return __hip_atomic_load(p, __ATOMIC_RELAXED, __HIP_MEMORY_SCOPE_AGENT); }
__device__ __forceinline__ unsigned xb_add(unsigned* p, unsigned v) { return __hip_atomic_fetch_add(p, v, __ATOMIC_RELAXED, __HIP_MEMORY_SCOPE_AGENT); }
__device__ __forceinline__ unsigned xb_xcc_id() { return (unsigned)__builtin_amdgcn_s_getreg((3 << 11) | 20) & 0xFu; }
#define XB_SPIN(cond, bar) do { unsigned _sp = 0; while (cond) { __builtin_amdgcn_s_sleep(1); \
    if ((++_sp & 255u) == 0u) { if (xb_ld(&(bar)[XB_TMO])) break; if (_sp > XB_SPIN_CAP) { atomicAdd(&(bar)[XB_TMO], 1u); break; } } } } while (0)

struct XcdBarrier { unsigned* bar; unsigned x; volatile LAS unsigned* st; };

__device__ __forceinline__ XcdBarrier xcd_barrier_post(unsigned* bar, volatile LAS unsigned* st) {
    XcdBarrier b; b.bar = bar; b.x = xb_xcc_id(); b.st = st;
    if (threadIdx.x == 0) (void)xb_add(&bar[XB_XCNT(b.x)], 1u);
    return b;
}
__device__ __forceinline__ void xcd_barrier_complete(unsigned* bar, unsigned x, unsigned& nloc, unsigned& nx) {
    const unsigned G = gridDim.x * gridDim.y * gridDim.z;
    unsigned sum, cnt, mine, sp = 0u;
    for (;;) {
        sum = 0u; cnt = 0u; mine = 0u;
#pragma unroll
        for (unsigned j = 0; j < 16; ++j) { const unsigned c = xb_ld(&bar[XB_XCNT(j)]); sum += c; cnt += (c > 0u) ? 1u : 0u; mine = (j == x) ? c : mine; }
        if (sum == G) break;
        __builtin_amdgcn_s_sleep(1);
        if ((++sp & 255u) == 0u) { if (xb_ld(&bar[XB_TMO])) break; if (sp > XB_SPIN_CAP) { atomicAdd(&bar[XB_TMO], 1u); break; } }
    }
    nloc = mine > 0u ? mine : 1u; nx = cnt > 0u ? cnt : 1u;
}
__device__ __forceinline__ void xcd_barrier(const XcdBarrier& b, bool leader) {
    asm volatile("s_waitcnt vmcnt(0)" ::: "memory");
    __syncthreads();
    if (leader) {
        unsigned* bar = b.bar; asm volatile("" : "+s"(bar));
        __builtin_amdgcn_s_waitcnt(0);
        unsigned nloc = b.st[0], nx = b.st[1];
        if (nloc == 0u) { xcd_barrier_complete(bar, b.x, nloc, nx); b.st[0] = nloc; b.st[1] = nx; }
        const unsigned old = xb_add(&bar[XB_XSUB(b.x)], 1u);
        const unsigned gen = old / nloc;
        if (old + 1u == (gen + 1u) * nloc) {
            __builtin_amdgcn_fence(__ATOMIC_RELEASE, "agent");
            asm volatile("s_waitcnt vmcnt(0)" ::: "memory");
            const unsigned og = xb_add(&bar[XB_TOP], 1u);
            const unsigned tg = og / nx;
            if (og + 1u == (tg + 1u) * nx) xb_add(&bar[XB_TOPGEN], 1u);
            else XB_SPIN(xb_ld(&bar[XB_TOPGEN]) == tg, bar);
            __builtin_amdgcn_fence(__ATOMIC_ACQUIRE, "agent");
            xb_add(&bar[XB_XGEN(b.x)], 1u);
            asm volatile("s_waitcnt vmcnt(0)" ::: "memory");
        } else {
            XB_SPIN(xb_ld(&bar[XB_XGEN(b.x)]) == gen, bar);
            __builtin_amdgcn_fence(__ATOMIC_ACQUIRE, "agent");
            asm volatile("s_waitcnt vmcnt(0)" ::: "memory");
        }
    }
    __syncthreads();
}

__device__ __forceinline__ float wave_sum(float v) {
#pragma unroll
    for (int o = 1; o < 64; o <<= 1) v += __shfl_xor(v, o);
    return v;
}
__device__ __forceinline__ void cvt_item(const float* W, int N, const float* gain, bf16* WT, int dpitch, int dkoff, int k0, int n0, int drow0, LAS float* scr, int lane) {
    float wv[32];
#pragma unroll
    for (int i = 0; i < 32; ++i) { const int kk = 2 * i + (lane >> 5); wv[i] = W[(size_t)(k0 + kk) * N + n0 + (lane & 31)]; }
#pragma unroll
    for (int i = 0; i < 32; ++i) { const int kk = 2 * i + (lane >> 5); float v = wv[i]; if (gain) v *= gain[k0 + kk]; scr[kk * 33 + (lane & 31)] = v; }
    LDS_WAIT(); asm volatile("" ::: "memory");
    const int c = lane & 7;
#pragma unroll
    for (int j = 0; j < 4; ++j) { const int n = (lane >> 3) + 8 * j; const LAS float* s = scr + (8 * c) * 33 + n;
        v4u o; o.x = pk2(s[0 * 33], s[1 * 33]); o.y = pk2(s[2 * 33], s[3 * 33]); o.z = pk2(s[4 * 33], s[5 * 33]); o.w = pk2(s[6 * 33], s[7 * 33]);
        *(GAS v4u*)(WT + (size_t)(drow0 + n) * dpitch + dkoff + k0 + 8 * c) = o; }
    LDS_WAIT(); asm volatile("" ::: "memory");
}
template <class RowMap>
__device__ __forceinline__ void cvt_matrix(const float* W, int K, int N, int nb0, int nblk, const float* gain, bf16* WT, int dpitch, int dkoff, const RowMap& RM, LAS float* scr, int gw, int NGW, int lane, int& base) {
    const int nit = (K / 64) * nblk;
    int first = gw - (base % NGW); if (first < 0) first += NGW;
    for (int it = first; it < nit; it += NGW) { const int kb = it / nblk, nb = nb0 + it % nblk; cvt_item(W, N, gain, WT, dpitch, dkoff, 64 * kb, 32 * nb, RM(32 * nb), scr, lane); }
    base += nit;
}
struct RmId { __device__ __forceinline__ int operator()(int n0) const { return n0; } };
struct RmGU { int add; __device__ __forceinline__ int operator()(int n0) const { return 256 * (n0 / 128) + (n0 % 128) + add; } };
struct RmIn { __device__ __forceinline__ int operator()(int n0) const {
    if (n0 < 256) return PC_CQ + n0; if (n0 < 384) return PC_CKV + (n0 - 256); if (n0 < 416) return PC_KR + (n0 - 384); if (n0 < 1568) return PC_MQ + (n0 - 416); if (n0 < 3872) return PC_DQ + (n0 - 1568);
    return 4096 + (n0 - 3872); } };
static_assert(W_G == W_IN + (size_t)4096 * 1024 * 2, "gate weights follow w_in");

__device__ __forceinline__ int OPQ_S(int v) { asm volatile("" : "+s"(v)); return v; }
__device__ __forceinline__ int lane_id_volatile() { int l; asm volatile("v_mbcnt_lo_u32_b32 %0, -1, 0\n\tv_mbcnt_hi_u32_b32 %0, -1, %0" : "=v"(l)); return l; }

#define CVT_SET_A(L, gw_, ngw_) do { int base_ = 0; const int L_ = (L); \
    cvt_matrix(args.in[2] + (size_t)L_ * DM * FF, DM, FF, 0, FF / 32, args.in[1] + L_ * DM, Wb + W_GU1 / 2, DM, 0, RmGU{0}, scr, gw_, ngw_, lane, base_); \
    cvt_matrix(args.in[3] + (size_t)L_ * DM * FF, DM, FF, 0, FF / 32, args.in[1] + L_ * DM, Wb + W_GU1 / 2, DM, 0, RmGU{128}, scr, gw_, ngw_, lane, base_); \
    cvt_matrix(args.in[4] + (size_t)L_ * FF * DM, FF, DM, 0, DM / 32, nullptr, Wb + W_D1 / 2, FF, 0, RmId{}, scr, gw_, ngw_, lane, base_); \
    cvt_matrix(args.in[6] + (size_t)L_ * DM * IN_COLS, DM, IN_COLS, 0, 121, args.in[5] + L_ * DM, Wb + W_IN / 2, DM, 0, RmIn{}, scr, gw_, ngw_, lane, base_); \
    cvt_matrix(args.in[8] + (size_t)L_ * 256 * 576, 256, 576, 0, 18, args.in[7] + L_ * 256, Wb + W_UQ / 2, 256, 0, RmId{}, scr, gw_, ngw_, lane, base_); \
    cvt_matrix(args.in[10] + (size_t)L_ * 128 * 768, 128, 768, 0, 24, args.in[9] + L_ * 128, Wb + W_UKV / 2, 256, 0, RmId{}, scr, gw_, ngw_, lane, base_); } while (0)
#define CVT_SET_B(L, gw_, ngw_) do { int base_ = 0; const int L_ = (L); \
    cvt_matrix(args.in[6] + (size_t)L_ * DM * IN_COLS, DM, IN_COLS, 121, 96, args.in[5] + L_ * DM, Wb + W_IN / 2, DM, 0, RmIn{}, scr, gw_, ngw_, lane, base_); \
    cvt_matrix(args.in[11] + (size_t)L_ * 384 * DM, 384, DM, 0, 32, nullptr, Wb + W_BR / 2, DM, 0, RmId{}, scr, gw_, ngw_, lane, base_); \
    cvt_matrix(args.in[12] + (size_t)L_ * 384 * DM, 384, DM, 0, 32, nullptr, Wb + W_BR / 2, DM, 384, RmId{}, scr, gw_, ngw_, lane, base_); \
    cvt_matrix(args.in[13] + (size_t)L_ * 256 * DM, 256, DM, 0, 32, nullptr, Wb + W_BR / 2, DM, 768, RmId{}, scr, gw_, ngw_, lane, base_); \
    cvt_matrix(args.in[14] + (size_t)L_ * DM * DM, DM, DM, 0, 32, nullptr, Wb + W_OUT / 2, DM, 0, RmId{}, scr, gw_, ngw_, lane, base_); \
    cvt_matrix(args.in[16] + (size_t)L_ * DM * FF, DM, FF, 0, FF / 32, args.in[15] + L_ * DM, Wb + W_GU2 / 2, DM, 0, RmGU{0}, scr, gw_, ngw_, lane, base_); \
    cvt_matrix(args.in[17] + (size_t)L_ * DM * FF, DM, FF, 0, FF / 32, args.in[15] + L_ * DM, Wb + W_GU2 / 2, DM, 0, RmGU{128}, scr, gw_, ngw_, lane, base_); \
    cvt_matrix(args.in[18] + (size_t)L_ * FF * DM, FF, DM, 0, DM / 32, nullptr, Wb + W_D2 / 2, FF, 0, RmId{}, scr, gw_, ngw_, lane, base_); } while (0)
constexpr int CVT_ITEMS_A = 2 * 16 * 88 + 44 * 32 + 16 * 121 + 4 * 18 + 2 * 24, CVT_ITEMS_B = 16 * 96 + 6 * 32 + 6 * 32 + 4 * 32 + 16 * 32 + 2 * 16 * 88 + 44 * 32;
static_assert(CVT_ITEMS_A % 8 == 0 && CVT_ITEMS_B % 8 == 0, "conversion items come in chunks of 8 (one item per wave)");
struct Frame {
    LAS unsigned char* lds; volatile LAS unsigned* MISC; gu32* ctl;
};

__device__ __forceinline__ void ld8(const bf16* p, float* f) { const v4u w = *(const v4u*)p; f[0] = bflo(w.x); f[1] = bfhi(w.x); f[2] = bflo(w.y); f[3] = bfhi(w.y); f[4] = bflo(w.z); f[5] = bfhi(w.z); f[6] = bflo(w.w); f[7] = bfhi(w.w); }
__device__ __forceinline__ float dot8(const bf16* p, const float* q) { const v4u w = *(const v4u*)p;
    return ((q[0] * bflo(w.x) + q[1] * bfhi(w.x)) + (q[2] * bflo(w.y) + q[3] * bfhi(w.y))) + ((q[4] * bflo(w.z) + q[5] * bfhi(w.z)) + (q[6] * bflo(w.w) + q[7] * bfhi(w.w))); }
__device__ __forceinline__ void axpy8(const bf16* p, float a, float c, float* o) { const v4u w = *(const v4u*)p;
    o[0] = o[0] * c + a * bflo(w.x); o[1] = o[1] * c + a * bfhi(w.x); o[2] = o[2] * c + a * bflo(w.y); o[3] = o[3] * c + a * bfhi(w.y);
    o[4] = o[4] * c + a * bflo(w.z); o[5] = o[5] * c + a * bfhi(w.z); o[6] = o[6] * c + a * bflo(w.w); o[7] = o[7] * c + a * bfhi(w.w); }
__device__ __forceinline__ void st8(bf16* p, const float* o, float s) { v4u w; w.x = pk2(o[0] * s, o[1] * s); w.y = pk2(o[2] * s, o[3] * s); w.z = pk2(o[4] * s, o[5] * s); w.w = pk2(o[6] * s, o[7] * s); *(v4u*)p = w; }

__device__ __forceinline__ void mla_naive_chunk(const bf16* Qm, const bf16* Kn, const bf16* KR, const bf16* Vm, bf16* AO, int b, int h, int chunk, int lane) {
    const int t = chunk * 64 + lane; const size_t rowb = (size_t)b * SEQ;
    float q[96];
#pragma unroll
    for (int c = 0; c < 12; ++c) ld8(Qm + (rowb + t) * 576 + h * 96 + 8 * c, q + 8 * c);
    float m = -1e30f, l = 0.f; float o[64];
#pragma unroll
    for (int d = 0; d < 64; ++d) o[d] = 0.f;
    const int jmax = chunk * 64 + 63;
    for (int j = 0; j <= jmax; ++j) {
        const bf16* kp = Kn + (rowb + j) * 384 + h * 64; const bf16* rp = KR + (rowb + j) * 32; const bf16* vp = Vm + (rowb + j) * 384 + h * 64;
        float s = 0.f;
#pragma unroll
        for (int c = 0; c < 8; ++c) s += dot8(kp + 8 * c, q + 8 * c);
#pragma unroll
        for (int c = 0; c < 4; ++c) s += dot8(rp + 8 * c, q + 64 + 8 * c);
        if (j <= t) { const float mn = fmaxf(m, s), corr = exp2f(m - mn), p = exp2f(s - mn); l = l * corr + p; m = mn;
#pragma unroll
            for (int c = 0; c < 8; ++c) axpy8(vp + 8 * c, p, corr, o + 8 * c); }
    }
    const float inv = 1.0f / l;
#pragma unroll
    for (int c = 0; c < 8; ++c) st8(AO + (rowb + t) * DM + h * 64 + 8 * c, o + 8 * c, inv);
}

__device__ __forceinline__ void moba_naive_chunk(const bf16* proj, const float* kmean, bf16* AO, int b, int h, int chunk, int lane) {
    const int t = chunk * 64 + lane; const size_t rowb = (size_t)b * SEQ; const int b_own = chunk >> 2;
    float q[64];
#pragma unroll
    for (int c = 0; c < 8; ++c) ld8(proj + (rowb + t) * PP + PC_MQ + h * 64 + 8 * c, q + 8 * c);
    const float slope = exp2f(-8.0f * (float)(12 + h + 1) / 18.0f) * LOG2E;
    float v1 = -3e38f, v2 = -3e38f, v3 = -3e38f; int i1 = -1, i2 = -1, i3 = -1;
    for (int n = 0; n < b_own; ++n) { const float* km = kmean + ((size_t)(b * 6 + h) * 16 + n) * 64; float g = 0.f;
#pragma unroll
        for (int c = 0; c < 16; ++c) { const f32x4 k4 = *(const f32x4*)(km + 4 * c); g += (q[4 * c] * k4[0] + q[4 * c + 1] * k4[1]) + (q[4 * c + 2] * k4[2] + q[4 * c + 3] * k4[3]); }
        if (g > v1) { v3 = v2; i3 = i2; v2 = v1; i2 = i1; v1 = g; i1 = n; } else if (g > v2) { v3 = v2; i3 = i2; v2 = g; i2 = n; } else if (g > v3) { v3 = g; i3 = n; } }
    unsigned sel = 0u; if (i1 >= 0) sel |= 1u << i1; if (i2 >= 0) sel |= 1u << i2; if (i3 >= 0) sel |= 1u << i3;
    float m = -1e30f, l = 0.f; float o[64];
#pragma unroll
    for (int d = 0; d < 64; ++d) o[d] = 0.f;
    for (int n = 0; n < b_own; ++n) { const bool mine = (sel >> n) & 1u; if (!__any(mine)) continue;
        for (int kk = 0; kk < 256; ++kk) { const int kpos = n * 256 + kk; const bf16* kp = proj + (rowb + kpos) * PP + PC_MK + h * 64; const bf16* vp = proj + (rowb + kpos) * PP + PC_MV + h * 64;
            float s = 0.f;
#pragma unroll
            for (int c = 0; c < 8; ++c) s += dot8(kp + 8 * c, q + 8 * c);
            s = s - slope * (float)(t - kpos);
            if (mine) { const float mn = fmaxf(m, s), corr = exp2f(m - mn), p = exp2f(s - mn); l = l * corr + p; m = mn;
#pragma unroll
                for (int c = 0; c < 8; ++c) axpy8(vp + 8 * c, p, corr, o + 8 * c); } } }
    for (int kpos = b_own * 256; kpos <= chunk * 64 + 63; ++kpos) { const bf16* kp = proj + (rowb + kpos) * PP + PC_MK + h * 64; const bf16* vp = proj + (rowb + kpos) * PP + PC_MV + h * 64;
        float s = 0.f;
#pragma unroll
        for (int c = 0; c < 8; ++c) s += dot8(kp + 8 * c, q + 8 * c);
        s = s - slope * (float)(t - kpos);
        if (kpos <= t) { const float mn = fmaxf(m, s), corr = exp2f(m - mn), p = exp2f(s - mn); l = l * corr + p; m = mn;
#pragma unroll
            for (int c = 0; c < 8; ++c) axpy8(vp + 8 * c, p, corr, o + 8 * c); } }
    const float inv = 1.0f / l;
#pragma unroll
    for (int c = 0; c < 8; ++c) st8(AO + (rowb + t) * DM + 384 + h * 64 + 8 * c, o + 8 * c, inv);
}

__device__ __forceinline__ void dil_naive_thread(const bf16* proj, bf16* AO, int b, int hg, int t) {
    const size_t rowb = (size_t)b * SEQ;
    float m = -1e30f, l = 0.f; float o[64];
#pragma unroll
    for (int d = 0; d < 64; ++d) o[d] = 0.f;
    for (int g = 0; g < 3; ++g) { const int h = g * 4 + hg, dil = (g == 0) ? 1 : (g == 1) ? 4 : 16; const float slope = exp2f(-8.0f * (float)(h + 1) / 18.0f) * LOG2E;
        float q[64];
#pragma unroll
        for (int c = 0; c < 8; ++c) ld8(proj + (rowb + t) * PP + PC_DQ + h * 64 + 8 * c, q + 8 * c);
        for (int j = 0; j <= 128; ++j) { const int kpos = t - j * dil;
            if (kpos >= 0) { const bf16* kp = proj + (rowb + kpos) * PP + PC_DK + h * 64; const bf16* vp = proj + (rowb + kpos) * PP + PC_DV + h * 64;
                float s = 0.f;
#pragma unroll
                for (int c = 0; c < 8; ++c) s += dot8(kp + 8 * c, q + 8 * c);
                s = s - slope * (float)(j * dil);
                const float mn = fmaxf(m, s), corr = exp2f(m - mn), p = exp2f(s - mn); l = l * corr + p; m = mn;
#pragma unroll
                for (int c = 0; c < 8; ++c) axpy8(vp + 8 * c, p, corr, o + 8 * c); } } }
    const float inv = 1.0f / l;
#pragma unroll
    for (int c = 0; c < 8; ++c) st8(AO + (rowb + t) * DM + 768 + hg * 64 + 8 * c, o + 8 * c, inv);
}

namespace fa {
typedef float f32x16 __attribute__((ext_vector_type(16)));
typedef short bf16x8 __attribute__((ext_vector_type(8)));
typedef short s16x4 __attribute__((ext_vector_type(4)));
#define FLAS __attribute__((address_space(3)))
constexpr float NEG = -1.0e30f, POS = 1.0e30f, RESC_THR = 8.0f;
__device__ __forceinline__ int crow(int r, int hi) { return (r & 3) + 8 * (r >> 2) + 4 * hi; }
__device__ __forceinline__ float xmax(float v) { auto rr = __builtin_amdgcn_permlane32_swap(__float_as_uint(v), __float_as_uint(v), false, false); return fmaxf(__uint_as_float(rr[0]), __uint_as_float(rr[1])); }
__device__ __forceinline__ float xsum(float v) { auto rr = __builtin_amdgcn_permlane32_swap(__float_as_uint(v), __float_as_uint(v), false, false); return __uint_as_float(rr[0]) + __uint_as_float(rr[1]); }
__device__ __forceinline__ float xother(float v, int hi) { auto rr = __builtin_amdgcn_permlane32_swap(__float_as_uint(v), __float_as_uint(v), false, false); return hi ? __uint_as_float(rr[0]) : __uint_as_float(rr[1]); }
__device__ __forceinline__ float max16(const f32x16& a) { float x = fmaxf(fmaxf(a[0], a[1]), fmaxf(a[2], a[3])), y = fmaxf(fmaxf(a[4], a[5]), fmaxf(a[6], a[7])), z = fmaxf(fmaxf(a[8], a[9]), fmaxf(a[10], a[11])), w = fmaxf(fmaxf(a[12], a[13]), fmaxf(a[14], a[15])); return fmaxf(fmaxf(x, y), fmaxf(z, w)); }
__device__ __forceinline__ bf16x8 pack8(const f32x16& p, int s8) {
    v4u w; w.x = pg8::cvt_pk_bf16(p[s8 + 0], p[s8 + 1]); w.y = pg8::cvt_pk_bf16(p[s8 + 2], p[s8 + 3]); w.z = pg8::cvt_pk_bf16(p[s8 + 4], p[s8 + 5]); w.w = pg8::cvt_pk_bf16(p[s8 + 6], p[s8 + 7]);
    return __builtin_bit_cast(bf16x8, w); }
#define FA_MFMA(a, b, c) __builtin_amdgcn_mfma_f32_32x32x16_bf16((a), (b), (c), 0, 0, 0)
template <int DK> __device__ __forceinline__ f32x16 qk_half(const FLAS char* krow, int hi, const bf16x8* qf, const f32x16& c) {
    f32x16 s = c;
#pragma unroll
    for (int d0 = 0; d0 < DK / 16; ++d0) { const bf16x8 kf = *(const FLAS bf16x8*)(krow + d0 * 32 + hi * 16); s = FA_MFMA(kf, qf[d0], s); }
    return s; }
__device__ __forceinline__ void pv_half(f32x16& o0, f32x16& o1, const FLAS char* vrow, int VP, int hi, const f32x16& p) {
#pragma unroll
    for (int s = 0; s < 2; ++s) { const bf16x8 pf = pack8(p, 8 * s);
        const FLAS char* v0 = vrow + (16 * s + 4 * hi) * 2; const FLAS char* v1 = v0 + 32 * VP;
        const s16x4 a0 = *(const FLAS s16x4*)v0, a1 = *(const FLAS s16x4*)(v0 + 16), b0 = *(const FLAS s16x4*)v1, b1 = *(const FLAS s16x4*)(v1 + 16);
        o0 = FA_MFMA(((bf16x8){a0[0], a0[1], a0[2], a0[3], a1[0], a1[1], a1[2], a1[3]}), pf, o0);
        o1 = FA_MFMA(((bf16x8){b0[0], b0[1], b0[2], b0[3], b1[0], b1[1], b1[2], b1[3]}), pf, o1); }
}
typedef short v4i16_t __attribute__((ext_vector_type(4)));
__device__ __forceinline__ s16x4 vtr(const FLAS char* p) { return __builtin_bit_cast(s16x4, __builtin_amdgcn_ds_read_tr16_b64_v4i16((FLAS v4i16_t*)p)); }
__device__ __forceinline__ int tr_lane_off(int lane, int VP) { return (4 * (lane >> 5) + ((lane & 15) >> 2)) * VP + ((lane & 3) * 4 + 16 * ((lane >> 4) & 1)) * 2; }
__device__ __forceinline__ void pv_half_tr(f32x16& o0, f32x16& o1, const FLAS char* vhalf, int VP, const f32x16& p) {
#pragma unroll
    for (int s = 0; s < 2; ++s) { const bf16x8 pf = pack8(p, 8 * s); const FLAS char* a = vhalf + 16 * s * VP;
        const s16x4 a0 = vtr(a), a1 = vtr(a + 8 * VP), b0 = vtr(a + 64), b1 = vtr(a + 8 * VP + 64);
        o0 = FA_MFMA(((bf16x8){a0[0], a0[1], a0[2], a0[3], a1[0], a1[1], a1[2], a1[3]}), pf, o0);
        o1 = FA_MFMA(((bf16x8){b0[0], b0[1], b0[2], b0[3], b1[0], b1[1], b1[2], b1[3]}), pf, o1); }
}
__device__ __forceinline__ void store_o(bf16* orow, const f32x16& o0, const f32x16& o1, float inv, int hi) {
#pragma unroll
    for (int blk = 0; blk < 2; ++blk)
#pragma unroll
        for (int g = 0; g < 4; g += 2) { const f32x16& o = blk ? o1 : o0;
            unsigned ax = pg8::cvt_pk_bf16(o[4 * g] * inv, o[4 * g + 1] * inv), ay = pg8::cvt_pk_bf16(o[4 * g + 2] * inv, o[4 * g + 3] * inv);
            unsigned bx = pg8::cvt_pk_bf16(o[4 * g + 4] * inv, o[4 * g + 5] * inv), by = pg8::cvt_pk_bf16(o[4 * g + 6] * inv, o[4 * g + 7] * inv);
            { auto r = __builtin_amdgcn_permlane32_swap(ax, bx, false, false); ax = r[0]; bx = r[1]; }
            { auto r = __builtin_amdgcn_permlane32_swap(ay, by, false, false); ay = r[0]; by = r[1]; }
            *(v4u*)(orow + 32 * blk + 8 * g + 8 * hi) = (v4u){ax, ay, bx, by}; }
}

template <int DK, bool MOBA>
__device__ __forceinline__ void flash_unit(FLAS char* lds, int tid_in, int b, int qb,
        const bf16* Qh, int qpitch, const bf16* Kh, int kpitch, const bf16* KRb, const bf16* Vh, int vpitch, bf16* Oh,
        const bf16* kmh, const bf16* kml, float slope2) {
    constexpr int KP = DK * 2 + 16, VP = 192, KBUF = 64 * KP, VBUF = 64 * VP;
    int tid = tid_in; asm volatile("" : "+v"(tid));
    const int lane = tid & 63, w = __builtin_amdgcn_readfirstlane(tid >> 6), r32 = lane & 31, hi = lane >> 5;
    const int q0 = qb * 256; (void)b;
    bf16x8 qf[DK / 16];
    { const bf16* qp = Qh + (size_t)(q0 + 32 * w + r32) * qpitch + 8 * hi;
#pragma unroll
      for (int d0 = 0; d0 < DK / 16; ++d0) qf[d0] = *(const bf16x8*)(qp + 16 * d0); }
    unsigned sel = 0u;
    f32x16 cinit;
#pragma unroll
    for (int r = 0; r < 16; ++r) cinit[r] = 0.f;
    if constexpr (MOBA) {
        f32x16 ga = cinit;
#pragma unroll
        for (int d0 = 0; d0 < 4; ++d0) { const bf16x8 ah = *(const bf16x8*)(kmh + (r32 & 15) * 64 + 16 * d0 + 8 * hi), al = *(const bf16x8*)(kml + (r32 & 15) * 64 + 16 * d0 + 8 * hi);
            ga = FA_MFMA(ah, qf[d0], ga); ga = FA_MFMA(al, qf[d0], ga); }
        float g[16];
#pragma unroll
        for (int i = 0; i < 8; ++i) { const float mine = ga[i], oth = xother(mine, hi); const float lo_ = hi ? oth : mine, hi_ = hi ? mine : oth;
            g[(i & 3) + 8 * (i >> 2)] = lo_; g[(i & 3) + 8 * (i >> 2) + 4] = hi_; }
        float v1 = -3e38f, v2 = -3e38f, v3 = -3e38f; int i1 = -1, i2 = -1, i3 = -1;
#pragma unroll
        for (int n = 0; n < 16; ++n) if (n < qb) { const float gv = g[n];
            if (gv > v1) { v3 = v2; i3 = i2; v2 = v1; i2 = i1; v1 = gv; i1 = n; } else if (gv > v2) { v3 = v2; i3 = i2; v2 = gv; i2 = n; } else if (gv > v3) { v3 = gv; i3 = n; } }
        if (i1 >= 0) sel |= 1u << i1; if (i2 >= 0) sel |= 1u << i2; if (i3 >= 0) sel |= 1u << i3;
#pragma unroll
        for (int r = 0; r < 16; ++r) cinit[r] = slope2 * (float)crow(r, hi);
    }
    const float c32 = MOBA ? 32.f * slope2 : 0.f;
    constexpr int CPRK = KP / 16, CPRV = VP / 16, NIK = (64 * CPRK + 63) / 64, NIV = (64 * CPRV + 63) / 64;
    const char* kbase = (const char*)Kh; const char* rbase = (const char*)((DK == 96) ? KRb : Kh); const char* vbase = (const char*)Vh;
    unsigned koffs[2], voffs[2]; bool krope[2];
#pragma unroll
    for (int j = 0; j < 2; ++j) { const int pk = 64 * (w + 8 * j) + lane, rk = pk / CPRK, ck = pk % CPRK; krope[j] = (DK == 96) && ck >= 8 && ck < 12;
        koffs[j] = krope[j] ? (unsigned)(rk * 32 + (ck - 8) * 8) * 2u : (unsigned)(rk * kpitch + (ck < 8 ? ck : 0) * 8) * 2u;
        const int pv = 64 * (w + 8 * j) + lane, rv = pv / CPRV, cv = pv % CPRV; voffs[j] = (unsigned)(rv * vpitch + (cv < 8 ? cv : 0) * 8) * 2u; }
    const int vlo = tr_lane_off(lane, VP);
    const int NT = 4 * (qb + 1);
#define FA_DMA(t, slot) do { const char* kb_ = kbase + (size_t)(t) * 128 * kpitch; const char* rb_ = rbase + (size_t)(t) * 128 * 32; const char* vb_ = vbase + (size_t)(t) * 128 * vpitch; \
        _Pragma("unroll") for (int j = 0; j < 2; ++j) { const int i_ = w + 8 * j; \
            if (i_ < NIK) __builtin_amdgcn_global_load_lds((const unsigned*)((krope[j] ? rb_ : kb_) + koffs[j]), (FLAS unsigned*)(lds + (slot) * KBUF + i_ * 1024), 16, 0, 0); \
            if (i_ < NIV) __builtin_amdgcn_global_load_lds((const unsigned*)(vb_ + voffs[j]), (FLAS unsigned*)(lds + 2 * KBUF + (slot) * VBUF + i_ * 1024), 16, 0, 0); } } while (0)
#define FA_LANDED() asm volatile("s_waitcnt vmcnt(0)" ::: "memory")
    static_assert(NIK <= 16 && NIV <= 16, "two DMA instructions per wave cover a tile");
    FA_DMA(0, 0); FA_LANDED(); __syncthreads();
    float m = MOBA ? NEG : 0.f, l = 0.f; f32x16 o0, o1;
#pragma unroll
    for (int r = 0; r < 16; ++r) { o0[r] = 0.f; o1[r] = 0.f; }
    const int rowrel = 32 * w + r32;
    for (int t = 0; t < NT; ++t) {
        const int buf = t & 1;
        if (t + 1 < NT) FA_DMA(t + 1, buf ^ 1);
        const int n = t >> 2, jd = t & 3; const bool diag = (n == qb);
        bool lane_on = true; if (MOBA && !diag) lane_on = (sel >> n) & 1u;
        bool wave_on = diag ? (64 * jd <= 32 * w + 31) : (MOBA ? (__any(lane_on) != 0) : true);
        if (wave_on) {
            const FLAS char* kt = lds + buf * KBUF + r32 * KP; const FLAS char* vt = lds + 2 * KBUF + buf * VBUF + vlo;
            f32x16 s0 = qk_half<DK>(kt, hi, qf, cinit), s1 = qk_half<DK>(kt + 32 * KP, hi, qf, cinit);
            if (diag && (64 * jd + 63 > 32 * w)) {
#pragma unroll
                for (int r = 0; r < 16; ++r) { const int kr = 64 * jd + crow(r, hi); if (kr > rowrel) s0[r] = NEG; if (kr + 32 > rowrel) s1[r] = NEG; } }
            if constexpr (MOBA) {
                const float tb = slope2 * (float)(64 * t);
                float mx = xmax(fmaxf(max16(s0), max16(s1) + c32)) + tb;
                if (!lane_on) mx = NEG;
                const float mn = fmaxf(m, mx);
                if (__any(mx > m + RESC_THR)) { const float a = __builtin_amdgcn_exp2f(m - mn); l *= a;
#pragma unroll
                    for (int r = 0; r < 16; ++r) { o0[r] *= a; o1[r] *= a; }
                    m = mn; }
                const float mref0 = lane_on ? (m - tb) : POS, mref1 = mref0 - c32;
#pragma unroll
                for (int r = 0; r < 16; ++r) { s0[r] = __builtin_amdgcn_exp2f(s0[r] - mref0); s1[r] = __builtin_amdgcn_exp2f(s1[r] - mref1); }
            } else {
                const float mx = xmax(fmaxf(max16(s0), max16(s1)));
                if (t == 0 || __any(mx > RESC_THR)) { const float d = (t == 0) ? mx : fmaxf(mx, 0.f), a = __builtin_amdgcn_exp2f(-d); m += d; l *= a;
#pragma unroll
                    for (int r = 0; r < 16; ++r) { o0[r] *= a; o1[r] *= a; s0[r] -= d; s1[r] -= d; cinit[r] = -m; } }
#pragma unroll
                for (int r = 0; r < 16; ++r) { s0[r] = __builtin_amdgcn_exp2f(s0[r]); s1[r] = __builtin_amdgcn_exp2f(s1[r]); }
            }
            { float ls = 0.f;
#pragma unroll
              for (int r = 0; r < 16; ++r) ls += s0[r] + s1[r];
              l += ls; }
            pv_half_tr(o0, o1, vt, VP, s0); pv_half_tr(o0, o1, vt + 32 * VP, VP, s1);
        }
        FA_LANDED();
        __syncthreads();
    }
#undef FA_DMA
#undef FA_LANDED
    const float lt = xsum(l);
    store_o(Oh + (size_t)(q0 + 32 * w + r32) * DM, o0, o1, 1.0f / lt, hi);
}

#define SBAR() __builtin_amdgcn_sched_barrier(0)
#define FA_WAIT_BAR(N) asm volatile("s_waitcnt vmcnt(" #N ") lgkmcnt(0)\n\ts_barrier" ::: "memory")
__device__ __forceinline__ void glds16(const void* gsrc, unsigned lds_dst) { unsigned keep;
    asm volatile("s_mov_b32 %0, m0\n\ts_mov_b32 m0, %2\n\ts_nop 0\n\tglobal_load_lds_dwordx4 %1, off\n\ts_mov_b32 m0, %0" : "=&s"(keep) : "v"(gsrc), "s"(lds_dst) : "memory"); }
__device__ __forceinline__ void kload8(bf16x8* kf, const FLAS char* kp) {
    kf[0] = *(const FLAS bf16x8*)(kp);        kf[1] = *(const FLAS bf16x8*)(kp + 512);
    kf[2] = *(const FLAS bf16x8*)(kp + 2048); kf[3] = *(const FLAS bf16x8*)(kp + 2560);
    kf[4] = *(const FLAS bf16x8*)(kp + 4096); kf[5] = *(const FLAS bf16x8*)(kp + 4608);
    kf[6] = *(const FLAS bf16x8*)(kp + 6144); kf[7] = *(const FLAS bf16x8*)(kp + 6656); }
__device__ __forceinline__ void kload2(bf16x8* kf, const FLAS char* kp, int j) { kf[2 * j] = *(const FLAS bf16x8*)(kp + j * 2048); kf[2 * j + 1] = *(const FLAS bf16x8*)(kp + j * 2048 + 512); }
#define MX3(a, b, c) __builtin_fmaxf(__builtin_fmaxf((a), (b)), (c))
__device__ __forceinline__ float rowmax_c(const f32x16& p0, const f32x16& p1, float c32) {
    float a = MX3(p0[0], p0[1], p0[2]), b = MX3(p1[0], p1[1], p1[2]);
#pragma unroll
    for (int r = 3; r < 15; r += 2) { a = MX3(a, p0[r], p0[r + 1]); b = MX3(b, p1[r], p1[r + 1]); }
    a = __builtin_fmaxf(a, p0[15]); b = __builtin_fmaxf(b, p1[15]);
    return xmax(__builtin_fmaxf(a, b + c32)); }
template <int THRL>
__device__ __forceinline__ void moba_unit(FLAS char* lds, int tid_in, int qb_in, const bf16* Qh, const bf16* Kh, const bf16* Vh, bf16* Oh, const bf16* kmh, const bf16* kml, float slope2_in) {
    constexpr int SLOTB = 8192, NSLOT = 3, L_K = 0, L_V = NSLOT * SLOTB, L_WS = 2 * NSLOT * SLOTB, L_OST = 0;
    int tid = tid_in; asm volatile("" : "+v"(tid));
    const int lane = tid & 63, wid = __builtin_amdgcn_readfirstlane(tid >> 6), r32 = lane & 31, hi = lane >> 5;
    const int qb = __builtin_amdgcn_readfirstlane(qb_in), q0 = qb * 256;
    const float slope2 = __builtin_bit_cast(float, __builtin_amdgcn_readfirstlane(__builtin_bit_cast(int, slope2_in)));
    const float c32 = 32.f * slope2, hb = slope2 * (float)(4 * hi);
    const unsigned lds0 = (unsigned)(uintptr_t)lds;
    FLAS float* wsf = (FLAS float*)(lds + L_WS) + wid * 64;
    const bf16* ksrc = Kh + (size_t)lane * 64 + wid * 8;
    const bf16* vsrc = Vh + (size_t)(16 * (wid & 3) + (lane >> 2)) * 64 + (wid >> 2) * 32 + (lane & 3) * 8;
    const unsigned kdst = lds0 + L_K + wid * 1024, vdst = lds0 + L_V + wid * 1024;
#define DMA_K(t, slot) glds16(ksrc + (size_t)(t) * 4096, (unsigned)__builtin_amdgcn_readfirstlane(kdst + (slot)))
#define DMA_V(t, slot) glds16(vsrc + (size_t)(t) * 4096, (unsigned)__builtin_amdgcn_readfirstlane(vdst + (slot)))
    const FLAS char* kp0 = lds + L_K + hi * 1024 + r32 * 16;
    const FLAS char* vp0 = lds + L_V + ((lane >> 4) & 1) * 32 + (lane & 3) * 8 + (4 * hi + ((lane & 15) >> 2)) * 64;
    const int NT = 4 * (qb + 1);
    DMA_K(0, 0); DMA_V(0, 0); DMA_K(1, SLOTB);
    bf16x8 qr[4];
    { const bf16* qp = Qh + (size_t)(q0 + 32 * wid + r32) * 64 + 8 * hi;
#pragma unroll
      for (int d0 = 0; d0 < 4; ++d0) qr[d0] = *(const bf16x8*)(qp + 16 * d0); }
    DMA_K(2, 2 * SLOTB);
    unsigned selq = 1u << qb;
    { f32x16 ga;
#pragma unroll
      for (int r = 0; r < 16; ++r) ga[r] = 0.f;
#pragma unroll
      for (int d0 = 0; d0 < 4; ++d0) { const bf16x8 ah = *(const bf16x8*)(kmh + (r32 & 15) * 64 + 16 * d0 + 8 * hi), al = *(const bf16x8*)(kml + (r32 & 15) * 64 + 16 * d0 + 8 * hi);
          ga = FA_MFMA(ah, qr[d0], ga); ga = FA_MFMA(al, qr[d0], ga); }
      float g[16];
#pragma unroll
      for (int i = 0; i < 8; ++i) { const float mine = ga[i], oth = xother(mine, hi); const float lo_ = hi ? oth : mine, hi_ = hi ? mine : oth;
          g[(i & 3) + 8 * (i >> 2)] = lo_; g[(i & 3) + 8 * (i >> 2) + 4] = hi_; }
      float v1 = -3e38f, v2 = -3e38f, v3 = -3e38f; int i1 = -1, i2 = -1, i3 = -1;
#pragma unroll
      for (int n = 0; n < 16; ++n) if (n < qb) { const float gv = g[n];
          if (gv > v1) { v3 = v2; i3 = i2; v2 = v1; i2 = i1; v1 = gv; i1 = n; } else if (gv > v2) { v3 = v2; i3 = i2; v2 = gv; i2 = n; } else if (gv > v3) { v3 = gv; i3 = n; } }
      if (i1 >= 0) selq |= 1u << i1; if (i2 >= 0) selq |= 1u << i2; if (i3 >= 0) selq |= 1u << i3; }
    float mhat = 0.f, l_reg = 0.f; f32x16 o[2];
#pragma unroll
    for (int r = 0; r < 16; ++r) { o[0][r] = 0.f; o[1][r] = 0.f; }
    f32x16 nb;
    float negbig = -1.0e30f; asm volatile("" : "+v"(negbig));
#define NB_BASE(tt) ((((selq >> ((tt) >> 2)) & 1u) ? (slope2 * (float)(64 * (tt)) - mhat) : negbig) + hb)
#define NB_SET(r, base) nb[r] = __builtin_fmaf(slope2, (float)(((r) & 3) + 8 * ((r) >> 2)), (base))
    { const float b0_ = NB_BASE(0);
#pragma unroll
      for (int r = 0; r < 16; ++r) NB_SET(r, b0_); }
    const int qrel = wid * 32 + r32;
#define CMASK(P0, P1, t) do { const int jb_ = (t) - (NT - 4); if (jb_ >= 0) { const int kb_ = 64 * jb_ + 4 * hi; _Pragma("unroll") for (int r = 0; r < 16; ++r) { const int kv_ = kb_ + (r & 3) + 8 * (r >> 2); if (kv_ > qrel) P0[r] = -INFINITY; if (kv_ + 32 > qrel) P1[r] = -INFINITY; } } } while (0)
    bool resc = false;
#define RESC() do { if (resc) { asm volatile("s_waitcnt lgkmcnt(0)" ::: "memory"); \
        _Pragma("unroll") for (int d_ = 0; d_ < 2; ++d_) _Pragma("unroll") for (int r = 0; r < 16; ++r) o[d_][r] *= wsf[crow(r, hi)]; } } while (0)
    f32x16 pA0, pA1, pB0, pB1; bf16x8 kf[8];
    int sl_prev = 0, sl_cur = 0, sl_next = SLOTB;
#define ROT() do { sl_prev = sl_cur; sl_cur = sl_next; sl_next = (sl_next == (NSLOT - 1) * SLOTB) ? 0 : sl_next + SLOTB; } while (0)
    FA_WAIT_BAR(3);
    { const FLAS char* kb = lds + L_K + hi * 1024 + r32 * 16;
#pragma unroll
      for (int d0 = 0; d0 < 4; ++d0) { const bf16x8 b0 = *(const FLAS bf16x8*)(kb + d0 * 2048), b1 = *(const FLAS bf16x8*)(kb + d0 * 2048 + 512);
          if (d0 == 0) { pA0 = FA_MFMA(b0, qr[0], nb); pA1 = FA_MFMA(b1, qr[0], nb); } else { pA0 = FA_MFMA(b0, qr[d0], pA0); pA1 = FA_MFMA(b1, qr[d0], pA1); } } }
    CMASK(pA0, pA1, 0);
    { const float rm = rowmax_c(pA0, pA1, c32); const float dl = (selq & 1u) ? rm : 0.f; mhat = dl;
#pragma unroll
      for (int r = 0; r < 16; ++r) { pA0[r] = __builtin_amdgcn_exp2f(pA0[r] - dl); pA1[r] = __builtin_amdgcn_exp2f(pA1[r] - dl + c32); }
      const float b1_ = NB_BASE(1);
#pragma unroll
      for (int r = 0; r < 16; ++r) NB_SET(r, b1_); }
    FA_WAIT_BAR(0);
    DMA_K(3, 0); DMA_V(1, SLOTB);
    ROT();
    kload8(kf, kp0 + sl_cur);
    FA_WAIT_BAR(2);
    s16x4 vlo[8], vhi[8]; v4u pw0, pw1, pw2, pw3;
#define PKW(P, B) pg8::cvt_pk_bf16(P[B], P[(B) + 1])
#define PAF(k) __builtin_bit_cast(bf16x8, pw##k)
#define VFR(i) (bf16x8){vlo[i][0], vlo[i][1], vlo[i][2], vlo[i][3], vhi[i][0], vhi[i][1], vhi[i][2], vhi[i][3]}
#define PIN(x) asm volatile("" : "+v"(x))
#define GAPA(MF, A0, A1, A2, A3, W0, W1, PW) do { MF; sacc += A0; sacc += A1; sacc += A2; sacc += A3; PIN(sacc); W0; W1; PIN(PW); SBAR(); } while (0)
#define EX(v) __builtin_amdgcn_exp2f(v)
#define GAPB0(MF, X, B, R0) do { MF; X[B] = EX(X[B]); X[(B) + 1] = EX(X[(B) + 1]); X[(B) + 2] = EX(X[(B) + 2]); X[(B) + 3] = EX(X[(B) + 3]); NB_SET(R0, nbase_); NB_SET((R0) + 1, nbase_); PIN(X); PIN(nb); SBAR(); } while (0)
#define GAPB1(MF, X, B, R0) do { MF; X[B] = EX(X[B] + c32); X[(B) + 1] = EX(X[(B) + 1] + c32); X[(B) + 2] = EX(X[(B) + 2] + c32); X[(B) + 3] = EX(X[(B) + 3] + c32); NB_SET(R0, nbase_); NB_SET((R0) + 1, nbase_); PIN(X); PIN(nb); SBAR(); } while (0)
#define VRD(i) do { vlo[i] = vtr(vp_ + (((i) >> 2) * 4096 + ((i) & 3) * 1024)); vhi[i] = vtr(vp_ + (((i) >> 2) * 4096 + ((i) & 3) * 1024 + 512)); } while (0)
#define KRD(G, j) do { if (G) { kload2(kf, kp0 + sl_next, j); SBAR(); } } while (0)
#define STEP(C0, C1, P0, P1, t, GK, GV, GL) do { SBAR(); \
    const FLAS char* vp_ = vp0 + sl_prev; \
    VRD(0); SBAR(); float sacc = (P0[0] + P0[1]); \
    GAPA(C0 = FA_MFMA(kf[0], qr[0], nb), P0[2], P0[3], P0[4], P0[5],     pw0[0] = PKW(P0, 0), pw0[1] = PKW(P0, 2), pw0); \
    VRD(4); SBAR(); GAPA(C1 = FA_MFMA(kf[1], qr[0], nb), P0[6], P0[7], P0[8], P0[9],     pw0[2] = PKW(P0, 4), pw0[3] = PKW(P0, 6), pw0); \
    VRD(1); SBAR(); GAPA(C0 = FA_MFMA(kf[2], qr[1], C0),   P0[10], P0[11], P0[12], P0[13], pw1[0] = PKW(P0, 8), pw1[1] = PKW(P0, 10), pw1); \
    VRD(5); SBAR(); GAPA(C1 = FA_MFMA(kf[3], qr[1], C1),   P0[14], P0[15], P1[0], P1[1],   pw1[2] = PKW(P0, 12), pw1[3] = PKW(P0, 14), pw1); \
    VRD(2); SBAR(); GAPA(C0 = FA_MFMA(kf[4], qr[2], C0),   P1[2], P1[3], P1[4], P1[5],     pw2[0] = PKW(P1, 0), pw2[1] = PKW(P1, 2), pw2); \
    VRD(6); SBAR(); GAPA(C1 = FA_MFMA(kf[5], qr[2], C1),   P1[6], P1[7], P1[8], P1[9],     pw2[2] = PKW(P1, 4), pw2[3] = PKW(P1, 6), pw2); \
    VRD(3); SBAR(); GAPA(C0 = FA_MFMA(kf[6], qr[3], C0),   P1[10], P1[11], P1[12], P1[13], pw3[0] = PKW(P1, 8), pw3[1] = PKW(P1, 10), pw3); \
    VRD(7); SBAR(); GAPA(C1 = FA_MFMA(kf[7], qr[3], C1),   P1[14], P1[15], 0.f, 0.f,       pw3[2] = PKW(P1, 12), pw3[3] = PKW(P1, 14), pw3); \
    l_reg += sacc; \
    if (GK) { DMA_K((t) + 3, sl_cur); } if (GV) { DMA_V((t) + 1, sl_next); } \
    CMASK(C0, C1, t); \
    { const float rm = rowmax_c(C0, C1, c32); \
      resc = false; \
      if (__builtin_expect(__any(rm > (float)THRL), 0)) { const float dl = __builtin_fmaxf(rm, 0.f); mhat += dl; \
        _Pragma("unroll") for (int r = 0; r < 16; ++r) { C0[r] -= dl; C1[r] -= dl; } \
        const float f = __builtin_amdgcn_exp2f(-dl); l_reg *= f; if (hi == 0) wsf[r32] = f; resc = true; } } \
    const float nbase_ = NB_BASE((t) + 1); \
    SBAR(); \
    GAPB0(o[0] = FA_MFMA(PAF(0), VFR(0), o[0]), C0, 0, 0); \
    GAPB0(o[1] = FA_MFMA(PAF(0), VFR(4), o[1]), C0, 4, 2); \
    KRD(GL, 0); GAPB0(o[0] = FA_MFMA(PAF(1), VFR(1), o[0]), C0, 8, 4); \
    KRD(GL, 1); GAPB0(o[1] = FA_MFMA(PAF(1), VFR(5), o[1]), C0, 12, 6); \
    KRD(GL, 2); GAPB1(o[0] = FA_MFMA(PAF(2), VFR(2), o[0]), C1, 0, 8); \
    KRD(GL, 3); GAPB1(o[1] = FA_MFMA(PAF(2), VFR(6), o[1]), C1, 4, 10); \
    GAPB1(o[0] = FA_MFMA(PAF(3), VFR(3), o[0]), C1, 8, 12); \
    GAPB1(o[1] = FA_MFMA(PAF(3), VFR(7), o[1]), C1, 12, 14); \
    } while (0)
    int t = 1;
#undef CMASK
#define CMASK(P0, P1, t) do { } while (0)
    for (; t + 5 < NT; t += 2) {
        STEP(pB0, pB1, pA0, pA1, t, true, true, true);       FA_WAIT_BAR(2); RESC(); ROT();
        STEP(pA0, pA1, pB0, pB1, t + 1, true, true, true);   FA_WAIT_BAR(2); RESC(); ROT();
    }
#undef CMASK
#define CMASK(P0, P1, t) do { const int jb_ = (t) - (NT - 4); if (jb_ >= 0) { const int kb_ = 64 * jb_ + 4 * hi; _Pragma("unroll") for (int r = 0; r < 16; ++r) { const int kv_ = kb_ + (r & 3) + 8 * (r >> 2); if (kv_ > qrel) P0[r] = -INFINITY; if (kv_ + 32 > qrel) P1[r] = -INFINITY; } } } while (0)
#define ENDW(tt) do { if ((tt) + 3 < NT) { FA_WAIT_BAR(2); } else if ((tt) + 2 < NT) { FA_WAIT_BAR(1); } else { FA_WAIT_BAR(0); } } while (0)
    for (; t + 1 < NT; t += 2) {
        STEP(pB0, pB1, pA0, pA1, t, (t + 3 < NT), (t + 1 < NT), (t + 1 < NT));         ENDW(t);     RESC(); ROT();
        STEP(pA0, pA1, pB0, pB1, t + 1, (t + 4 < NT), (t + 2 < NT), (t + 2 < NT));     ENDW(t + 1); RESC(); ROT();
    }
    STEP(pB0, pB1, pA0, pA1, NT - 1, false, false, false); RESC();
    { float sacc = pB0[0] + pB0[1];
#pragma unroll
      for (int r = 2; r < 16; ++r) sacc += pB0[r];
#pragma unroll
      for (int r = 0; r < 16; ++r) sacc += pB1[r];
      l_reg += sacc;
      pw0 = (v4u){PKW(pB0, 0), PKW(pB0, 2), PKW(pB0, 4), PKW(pB0, 6)}; pw1 = (v4u){PKW(pB0, 8), PKW(pB0, 10), PKW(pB0, 12), PKW(pB0, 14)};
      pw2 = (v4u){PKW(pB1, 0), PKW(pB1, 2), PKW(pB1, 4), PKW(pB1, 6)}; pw3 = (v4u){PKW(pB1, 8), PKW(pB1, 10), PKW(pB1, 12), PKW(pB1, 14)};
      SBAR();
      const FLAS char* vp_ = vp0 + sl_cur;
#pragma unroll
      for (int i = 0; i < 8; ++i) VRD(i);
      o[0] = FA_MFMA(PAF(0), VFR(0), o[0]); o[0] = FA_MFMA(PAF(1), VFR(1), o[0]); o[0] = FA_MFMA(PAF(2), VFR(2), o[0]); o[0] = FA_MFMA(PAF(3), VFR(3), o[0]);
      o[1] = FA_MFMA(PAF(0), VFR(4), o[1]); o[1] = FA_MFMA(PAF(1), VFR(5), o[1]); o[1] = FA_MFMA(PAF(2), VFR(6), o[1]); o[1] = FA_MFMA(PAF(3), VFR(7), o[1]); }
    l_reg = xsum(l_reg);
    if (hi == 0) wsf[32 + r32] = l_reg;
    asm volatile("s_waitcnt lgkmcnt(0)\n\ts_barrier" ::: "memory");
    float rli[16];
#pragma unroll
    for (int r = 0; r < 16; ++r) rli[r] = __builtin_amdgcn_rcpf(wsf[32 + crow(r, hi)]);
    { FLAS bf16* stg = (FLAS bf16*)(lds + L_OST) + wid * 2048;
#pragma unroll
      for (int r = 0; r < 16; ++r) { const int orow = crow(r, hi);
#pragma unroll
          for (int d0 = 0; d0 < 2; ++d0) stg[orow * 64 + d0 * 32 + r32] = (bf16)f2bf(o[d0][r] * rli[r]); }
      asm volatile("s_waitcnt lgkmcnt(0)" ::: "memory");
      bf16* Ow = Oh + (size_t)(q0 + wid * 32) * DM;
#pragma unroll
      for (int i = 0; i < 4; ++i) { const int row = i * 8 + (lane >> 3), ch = lane & 7; const v4u v = *(const FLAS v4u*)(stg + row * 64 + ch * 8); *(v4u*)(Ow + (size_t)row * DM + ch * 8) = v; } }
    asm volatile("s_waitcnt lgkmcnt(0)\n\ts_barrier" ::: "memory");
#undef DMA_K
#undef DMA_V
#undef NB_BASE
#undef NB_SET
#undef CMASK
#undef RESC
#undef ROT
#undef PKW
#undef PAF
#undef VFR
#undef PIN
#undef GAPA
#undef EX
#undef GAPB0
#undef GAPB1
#undef VRD
#undef KRD
#undef STEP
#undef ENDW
}

template <int THRL>
__device__ __forceinline__ void mla_unit(FLAS char* lds, int tid_in, int qb_in, const bf16* Qh, const bf16* Kh, const bf16* KRb, const bf16* Vh, bf16* Oh) {
    constexpr int KSLOT = 12288, VSLOT = 8192, NSLOT = 3, L_K = 0, L_V = NSLOT * KSLOT, L_WS = L_V + NSLOT * VSLOT, L_OST = 0;
    int tid = tid_in; asm volatile("" : "+v"(tid));
    const int lane = tid & 63, wid = __builtin_amdgcn_readfirstlane(tid >> 6), r32 = lane & 31, hi = lane >> 5;
    const int qb = __builtin_amdgcn_readfirstlane(qb_in), q0 = qb * 256;
    const unsigned lds0 = (unsigned)(uintptr_t)lds;
    FLAS float* wsf = (FLAS float*)(lds + L_WS) + wid * 64;
    const bf16* ksrc = Kh + (size_t)lane * 64 + wid * 8;
    const bf16* rsrc = KRb + (size_t)lane * 32 + (wid & 3) * 8;
    const bf16* vsrc = Vh + (size_t)(16 * (wid & 3) + (lane >> 2)) * 64 + (wid >> 2) * 32 + (lane & 3) * 8;
    const unsigned kdst = lds0 + L_K + wid * 1024, rdst = lds0 + L_K + (8 + (wid & 3)) * 1024, vdst = lds0 + L_V + wid * 1024;
    const bool ropew = wid < 4;
#define DMA_K(t, slot) do { glds16(ksrc + (size_t)(t) * 4096, (unsigned)__builtin_amdgcn_readfirstlane(kdst + (slot))); if (ropew) glds16(rsrc + (size_t)(t) * 2048, (unsigned)__builtin_amdgcn_readfirstlane(rdst + (slot))); } while (0)
#define DMA_V(t, slot) glds16(vsrc + (size_t)(t) * 4096, (unsigned)__builtin_amdgcn_readfirstlane(vdst + (slot)))
    const FLAS char* kp0 = lds + L_K + hi * 1024 + r32 * 16;
    const FLAS char* vp0 = lds + L_V + ((lane >> 4) & 1) * 32 + (lane & 3) * 8 + (4 * hi + ((lane & 15) >> 2)) * 64;
    const int NT = 4 * (qb + 1);
    DMA_K(0, 0); DMA_V(0, 0); DMA_K(1, KSLOT);
    bf16x8 qr[6];
    { const bf16* qp = Qh + (size_t)(q0 + 32 * wid + r32) * 96 + 8 * hi;
#pragma unroll
      for (int d0 = 0; d0 < 6; ++d0) qr[d0] = *(const bf16x8*)(qp + 16 * d0); }
    DMA_K(2, 2 * KSLOT);
    float mhat = 0.f, l_reg = 0.f; f32x16 o[2], negm;
#pragma unroll
    for (int r = 0; r < 16; ++r) { o[0][r] = 0.f; o[1][r] = 0.f; negm[r] = 0.f; }
    asm volatile("" : "+v"(negm));
    const int qrel = wid * 32 + r32;
#define CMASK(P0, P1, t) do { const int jb_ = (t) - (NT - 4); if (jb_ >= 0) { const int kb_ = 64 * jb_ + 4 * hi; _Pragma("unroll") for (int r = 0; r < 16; ++r) { const int kv_ = kb_ + (r & 3) + 8 * (r >> 2); if (kv_ > qrel) P0[r] = -INFINITY; if (kv_ + 32 > qrel) P1[r] = -INFINITY; } } } while (0)
    bool resc = false;
#define RESC() do { if (resc) { asm volatile("s_waitcnt lgkmcnt(0)" ::: "memory"); \
        _Pragma("unroll") for (int d_ = 0; d_ < 2; ++d_) _Pragma("unroll") for (int r = 0; r < 16; ++r) o[d_][r] *= wsf[crow(r, hi)]; } } while (0)
    f32x16 pA0, pA1, pB0, pB1; bf16x8 kf[12];
    int ks_cur = 0, ks_next = KSLOT, vs_prev = 0, vs_cur = 0, vs_next = VSLOT;
#define ROT() do { ks_cur = ks_next; ks_next = (ks_next == (NSLOT - 1) * KSLOT) ? 0 : ks_next + KSLOT; vs_prev = vs_cur; vs_cur = vs_next; vs_next = (vs_next == (NSLOT - 1) * VSLOT) ? 0 : vs_next + VSLOT; } while (0)
    FA_WAIT_BAR(0);
    { const FLAS char* kb = lds + L_K + hi * 1024 + r32 * 16;
#pragma unroll
      for (int d0 = 0; d0 < 6; ++d0) { const bf16x8 b0 = *(const FLAS bf16x8*)(kb + d0 * 2048), b1 = *(const FLAS bf16x8*)(kb + d0 * 2048 + 512);
          if (d0 == 0) { pA0 = FA_MFMA(b0, qr[0], negm); pA1 = FA_MFMA(b1, qr[0], negm); } else { pA0 = FA_MFMA(b0, qr[d0], pA0); pA1 = FA_MFMA(b1, qr[d0], pA1); } } }
    CMASK(pA0, pA1, 0);
    { const float rm = rowmax_c(pA0, pA1, 0.f); mhat = rm;
#pragma unroll
      for (int r = 0; r < 16; ++r) { pA0[r] = __builtin_amdgcn_exp2f(pA0[r] - rm); pA1[r] = __builtin_amdgcn_exp2f(pA1[r] - rm); }
#pragma unroll
      for (int r = 0; r < 16; ++r) negm[r] = -mhat;
      asm volatile("" : "+v"(negm)); }
    FA_WAIT_BAR(0);
    DMA_K(3, 0); DMA_V(1, VSLOT);
    ROT();
#pragma unroll
    for (int j = 0; j < 6; ++j) kload2(kf, kp0 + ks_cur, j);
    if (ropew) { FA_WAIT_BAR(3); } else { FA_WAIT_BAR(2); }
    s16x4 vlo[8], vhi[8]; v4u pw0, pw1, pw2, pw3;
#define PKW(P, B) pg8::cvt_pk_bf16(P[B], P[(B) + 1])
#define PAF(k) __builtin_bit_cast(bf16x8, pw##k)
#define VFR(i) (bf16x8){vlo[i][0], vlo[i][1], vlo[i][2], vlo[i][3], vhi[i][0], vhi[i][1], vhi[i][2], vhi[i][3]}
#define PIN(x) asm volatile("" : "+v"(x))
#define GAPA(MF, A0, A1, A2, W0, W1, PW) do { MF; sacc += A0; sacc += A1; sacc += A2; PIN(sacc); W0; W1; PIN(PW); SBAR(); } while (0)
#define GAPA0(MF, A0, A1, A2) do { MF; sacc += A0; sacc += A1; sacc += A2; PIN(sacc); SBAR(); } while (0)
#define EX(v) __builtin_amdgcn_exp2f(v)
#define GAPB(MF, X, B) do { MF; X[B] = EX(X[B]); X[(B) + 1] = EX(X[(B) + 1]); X[(B) + 2] = EX(X[(B) + 2]); X[(B) + 3] = EX(X[(B) + 3]); PIN(X); SBAR(); } while (0)
#define VRD(i) do { vlo[i] = vtr(vp_ + (((i) >> 2) * 4096 + ((i) & 3) * 1024)); vhi[i] = vtr(vp_ + (((i) >> 2) * 4096 + ((i) & 3) * 1024 + 512)); } while (0)
#define KRD(G, j) do { if (G) { kload2(kf, kp0 + ks_next, j); SBAR(); } } while (0)
#define STEP(C0, C1, P0, P1, t, GK, GV, GL) do { SBAR(); \
    const FLAS char* vp_ = vp0 + vs_prev; \
    float sacc = (P0[0] + P0[1]); \
    GAPA(C0 = FA_MFMA(kf[0], qr[0], negm), P0[2], P0[3], P0[4],      pw0[0] = PKW(P0, 0), pw0[1] = PKW(P0, 2), pw0); \
    GAPA(C1 = FA_MFMA(kf[1], qr[0], negm), P0[5], P0[6], P0[7],      pw0[2] = PKW(P0, 4), pw0[3] = PKW(P0, 6), pw0); \
    GAPA(C0 = FA_MFMA(kf[2], qr[1], C0),   P0[8], P0[9], P0[10],     pw1[0] = PKW(P0, 8), pw1[1] = PKW(P0, 10), pw1); \
    GAPA(C1 = FA_MFMA(kf[3], qr[1], C1),   P0[11], P0[12], P0[13],   pw1[2] = PKW(P0, 12), pw1[3] = PKW(P0, 14), pw1); \
    VRD(0); SBAR(); GAPA(C0 = FA_MFMA(kf[4], qr[2], C0),   P0[14], P0[15], P1[0],    pw2[0] = PKW(P1, 0), pw2[1] = PKW(P1, 2), pw2); \
    VRD(4); SBAR(); GAPA(C1 = FA_MFMA(kf[5], qr[2], C1),   P1[1], P1[2], P1[3],      pw2[2] = PKW(P1, 4), pw2[3] = PKW(P1, 6), pw2); \
    VRD(1); SBAR(); GAPA(C0 = FA_MFMA(kf[6], qr[3], C0),   P1[4], P1[5], P1[6],      pw3[0] = PKW(P1, 8), pw3[1] = PKW(P1, 10), pw3); \
    VRD(5); SBAR(); GAPA(C1 = FA_MFMA(kf[7], qr[3], C1),   P1[7], P1[8], P1[9],      pw3[2] = PKW(P1, 12), pw3[3] = PKW(P1, 14), pw3); \
    VRD(2); SBAR(); GAPA0(C0 = FA_MFMA(kf[8], qr[4], C0),   P1[10], P1[11], P1[12]); \
    VRD(6); SBAR(); GAPA0(C1 = FA_MFMA(kf[9], qr[4], C1),   P1[13], P1[14], P1[15]); \
    VRD(3); SBAR(); C0 = FA_MFMA(kf[10], qr[5], C0); SBAR(); \
    VRD(7); SBAR(); C1 = FA_MFMA(kf[11], qr[5], C1); SBAR(); \
    l_reg += sacc; \
    if (GK) { DMA_K((t) + 3, ks_cur); } if (GV) { DMA_V((t) + 1, vs_next); } \
    CMASK(C0, C1, t); \
    { const float rm = rowmax_c(C0, C1, 0.f); \
      resc = false; \
      if (__builtin_expect(__any(rm > (float)THRL), 0)) { const float dl = __builtin_fmaxf(rm, 0.f); mhat += dl; \
        _Pragma("unroll") for (int r = 0; r < 16; ++r) { C0[r] -= dl; C1[r] -= dl; } \
        _Pragma("unroll") for (int r = 0; r < 16; ++r) negm[r] = -mhat; asm volatile("" : "+v"(negm)); \
        const float f = __builtin_amdgcn_exp2f(-dl); l_reg *= f; if (hi == 0) wsf[r32] = f; resc = true; } } \
    SBAR(); \
    GAPB(o[0] = FA_MFMA(PAF(0), VFR(0), o[0]), C0, 0); \
    KRD(GL, 0); GAPB(o[1] = FA_MFMA(PAF(0), VFR(4), o[1]), C0, 4); \
    KRD(GL, 1); GAPB(o[0] = FA_MFMA(PAF(1), VFR(1), o[0]), C0, 8); \
    KRD(GL, 2); GAPB(o[1] = FA_MFMA(PAF(1), VFR(5), o[1]), C0, 12); \
    KRD(GL, 3); GAPB(o[0] = FA_MFMA(PAF(2), VFR(2), o[0]), C1, 0); \
    KRD(GL, 4); GAPB(o[1] = FA_MFMA(PAF(2), VFR(6), o[1]), C1, 4); \
    KRD(GL, 5); GAPB(o[0] = FA_MFMA(PAF(3), VFR(3), o[0]), C1, 8); \
    GAPB(o[1] = FA_MFMA(PAF(3), VFR(7), o[1]), C1, 12); \
    } while (0)
#define ENDW(tt) do { const bool gk_ = (tt) + 3 < NT, gv_ = (tt) + 1 < NT; \
        if (gk_ && gv_) { if (ropew) { FA_WAIT_BAR(3); } else { FA_WAIT_BAR(2); } } \
        else if ((tt) + 2 < NT) { FA_WAIT_BAR(1); } \
        else { FA_WAIT_BAR(0); } } while (0)
    int t = 1;
#undef CMASK
#define CMASK(P0, P1, t) do { } while (0)
    for (; t + 5 < NT; t += 2) {
        STEP(pB0, pB1, pA0, pA1, t, true, true, true);       ENDW(t);     RESC(); ROT();
        STEP(pA0, pA1, pB0, pB1, t + 1, true, true, true);   ENDW(t + 1); RESC(); ROT();
    }
#undef CMASK
#define CMASK(P0, P1, t) do { const int jb_ = (t) - (NT - 4); if (jb_ >= 0) { const int kb_ = 64 * jb_ + 4 * hi; _Pragma("unroll") for (int r = 0; r < 16; ++r) { const int kv_ = kb_ + (r & 3) + 8 * (r >> 2); if (kv_ > qrel) P0[r] = -INFINITY; if (kv_ + 32 > qrel) P1[r] = -INFINITY; } } } while (0)
    for (; t + 1 < NT; t += 2) {
        STEP(pB0, pB1, pA0, pA1, t, (t + 3 < NT), (t + 1 < NT), (t + 1 < NT));         ENDW(t);     RESC(); ROT();
        STEP(pA0, pA1, pB0, pB1, t + 1, (t + 4 < NT), (t + 2 < NT), (t + 2 < NT));     ENDW(t + 1); RESC(); ROT();
    }
    STEP(pB0, pB1, pA0, pA1, NT - 1, false, false, false); RESC();
    { float sacc = pB0[0] + pB0[1];
#pragma unroll
      for (int r = 2; r < 16; ++r) sacc += pB0[r];
#pragma unroll
      for (int r = 0; r < 16; ++r) sacc += pB1[r];
      l_reg += sacc;
      pw0 = (v4u){PKW(pB0, 0), PKW(pB0, 2), PKW(pB0, 4), PKW(pB0, 6)}; pw1 = (v4u){PKW(pB0, 8), PKW(pB0, 10), PKW(pB0, 12), PKW(pB0, 14)};
      pw2 = (v4u){PKW(pB1, 0), PKW(pB1, 2), PKW(pB1, 4), PKW(pB1, 6)}; pw3 = (v4u){PKW(pB1, 8), PKW(pB1, 10), PKW(pB1, 12), PKW(pB1, 14)};
      SBAR();
      const FLAS char* vp_ = vp0 + vs_cur;
#pragma unroll
      for (int i = 0; i < 8; ++i) VRD(i);
      o[0] = FA_MFMA(PAF(0), VFR(0), o[0]); o[0] = FA_MFMA(PAF(1), VFR(1), o[0]); o[0] = FA_MFMA(PAF(2), VFR(2), o[0]); o[0] = FA_MFMA(PAF(3), VFR(3), o[0]);
      o[1] = FA_MFMA(PAF(0), VFR(4), o[1]); o[1] = FA_MFMA(PAF(1), VFR(5), o[1]); o[1] = FA_MFMA(PAF(2), VFR(6), o[1]); o[1] = FA_MFMA(PAF(3), VFR(7), o[1]); }
    l_reg = xsum(l_reg);
    if (hi == 0) wsf[32 + r32] = l_reg;
    asm volatile("s_waitcnt lgkmcnt(0)\n\ts_barrier" ::: "memory");
    float rli[16];
#pragma unroll
    for (int r = 0; r < 16; ++r) rli[r] = __builtin_amdgcn_rcpf(wsf[32 + crow(r, hi)]);
    { FLAS bf16* stg = (FLAS bf16*)(lds + L_OST) + wid * 2048;
#pragma unroll
      for (int r = 0; r < 16; ++r) { const int orow = crow(r, hi);
#pragma unroll
          for (int d0 = 0; d0 < 2; ++d0) stg[orow * 64 + d0 * 32 + r32] = (bf16)f2bf(o[d0][r] * rli[r]); }
      asm volatile("s_waitcnt lgkmcnt(0)" ::: "memory");
      bf16* Ow = Oh + (size_t)(q0 + wid * 32) * DM;
#pragma unroll
      for (int i = 0; i < 4; ++i) { const int row = i * 8 + (lane >> 3), ch = lane & 7; const v4u v = *(const FLAS v4u*)(stg + row * 64 + ch * 8); *(v4u*)(Ow + (size_t)row * DM + ch * 8) = v; } }
    asm volatile("s_waitcnt lgkmcnt(0)\n\ts_barrier" ::: "memory");
#undef DMA_K
#undef DMA_V
#undef CMASK
#undef RESC
#undef ROT
#undef PKW
#undef PAF
#undef VFR
#undef PIN
#undef GAPA
#undef GAPA0
#undef EX
#undef GAPB
#undef VRD
#undef KRD
#undef STEP
#undef ENDW
}

__device__ __forceinline__ void dil_phase(FLAS char* lds, int tid_in, int bx, int G, bf16* proj, float* lse) {
    constexpr int KP = 144, VP = 192, VOFF = 384 * KP, NU = BATCH * 12 * 16;
    int tid = tid_in; asm volatile("" : "+v"(tid));
    const int lane = tid & 63, w = __builtin_amdgcn_readfirstlane(tid >> 6), r32 = lane & 31, hi = lane >> 5;
    v4u zz = (v4u){0u, 0u, 0u, 0u}; asm volatile("" : "+v"(zz));
    v4u kr[6], vr[6]; bf16x8 qn[4];
#define DIL_DECODE(u_) const int b_ = (u_) / 192, h_ = ((u_) >> 4) % 12, i16_ = (u_) & 15, g_ = h_ >> 2, dil_ = (g_ == 0) ? 1 : (g_ == 1) ? 4 : 16, nch_ = 16 / dil_, res_ = i16_ / nch_, ch_ = i16_ % nch_, m0_ = 256 * ch_; \
        const size_t rowb_ = (size_t)b_ * SEQ; const bf16* hq_ = proj + ((size_t)(b_ * HSLOTS + SL_DQ + h_) * SEQ) * 64; (void)ch_; (void)hq_
#define DIL_LOAD(u_) do { DIL_DECODE(u_); \
        _Pragma("unroll") for (int i = 0; i < 6; ++i) { const int idx = tid + 512 * i, kk = idx >> 3, kch = idx & 7, mp = m0_ - 128 + kk; kr[i] = zz; vr[i] = zz; \
            if (mp >= 0) { const bf16* p_ = hq_ + (size_t)(mp * dil_ + res_) * 64 + kch * 8; kr[i] = *(const v4u*)(p_ + (size_t)SL_DK * SEQ * 64); vr[i] = *(const v4u*)(p_ + (size_t)SL_DV * SEQ * 64); } } \
        { const size_t qtok_ = (size_t)(m0_ + 32 * w + r32) * dil_ + res_; \
          _Pragma("unroll") for (int d0 = 0; d0 < 4; ++d0) qn[d0] = *(const bf16x8*)(hq_ + qtok_ * 64 + 16 * d0 + 8 * hi); } } while (0)
    int u = bx; if (u >= NU) return;
    DIL_LOAD(u);
    for (; u < NU; u += G) {
        DIL_DECODE(u);
#pragma unroll
        for (int i = 0; i < 6; ++i) { const int idx = tid + 512 * i, kk = idx >> 3, kch = idx & 7; *(FLAS v4u*)(lds + kk * KP + kch * 16) = kr[i]; *(FLAS v4u*)(lds + VOFF + kk * VP + kch * 16) = vr[i]; }
        bf16x8 qf[4];
#pragma unroll
        for (int d0 = 0; d0 < 4; ++d0) qf[d0] = qn[d0];
        const float slope2d = exp2f(-8.0f * (float)(h_ + 1) / 18.0f) * LOG2E * (float)dil_;
        const size_t qrow = rowb_ + (size_t)(m0_ + 32 * w + r32) * dil_ + res_;
        f32x16 cinit;
#pragma unroll
        for (int r = 0; r < 16; ++r) cinit[r] = slope2d * (float)crow(r, hi);
        __syncthreads();
        if (u + G < NU) DIL_LOAD(u + G);
        f32x16 s[5]; float mx = NEG;
#pragma unroll
        for (int i = 0; i < 5; ++i) { s[i] = qk_half<64>(lds + (32 * (w + i) + r32) * KP, hi, qf, cinit);
            const bool dead = (ch_ == 0) && (w + i < 4);
#pragma unroll
            for (int r = 0; r < 16; ++r) { const int krr = crow(r, hi); bool ok = !dead; if (i == 0) ok = ok && (krr >= r32); if (i == 4) ok = ok && (krr <= r32); if (!ok) s[i][r] = NEG; }
            mx = fmaxf(mx, max16(s[i]) + (float)(32 * i) * slope2d); }
        mx = xmax(mx);
        float ls = 0.f; f32x16 o0, o1;
#pragma unroll
        for (int r = 0; r < 16; ++r) { o0[r] = 0.f; o1[r] = 0.f; }
#pragma unroll
        for (int i = 0; i < 5; ++i) { const float mref = mx - (float)(32 * i) * slope2d;
#pragma unroll
            for (int r = 0; r < 16; ++r) { s[i][r] = __builtin_amdgcn_exp2f(s[i][r] - mref); ls += s[i][r]; }
            pv_half_tr(o0, o1, lds + VOFF + (32 * (w + i)) * VP + tr_lane_off(lane, VP), VP, s[i]); }
        const float lt = xsum(ls);
        if (hi == 0) lse[qrow * 12 + h_] = mx + __builtin_amdgcn_logf(lt) - slope2d * (float)(r32 + 128);
        store_o(proj + ((size_t)(b_ * HSLOTS + SL_DQ + h_) * SEQ + (qrow - rowb_)) * 64, o0, o1, 1.0f / lt, hi);
        __syncthreads();
    }
#undef DIL_LOAD
#undef DIL_DECODE
}
#undef FA_MFMA
}

struct Args { const float* in[20]; float* out; unsigned char* ws; int ph_lo, ph_hi; };
constexpr int PH_PER_LAYER = 11, N_PHASES = 1 + DEPTH * PH_PER_LAYER + 1;

__global__ void __launch_bounds__(NWAVES * 64, 2) mk_fwd(Args args) {
    extern __shared__ __attribute__((aligned(16))) unsigned char lds[];
    Frame F;
    F.lds = (LAS unsigned char*)lds;
    F.MISC = (volatile LAS unsigned*)(F.lds + MISC_OFF);
    unsigned char* ws = args.ws;
    F.ctl = (gu32*)(ws + WS_CTL);
    for (int u = threadIdx.x; u < (LDS_BYTES - LDSCTL_OFF) / 4; u += NWAVES * 64) ((LAS unsigned*)(F.lds + LDSCTL_OFF))[u] = 0u;
    __syncthreads();
    const int wave_s = __builtin_amdgcn_readfirstlane((int)threadIdx.x >> 6);
#define MYTID() (OPQ_S(wave_s) * 64 + lane_id_volatile())
#define STAGGER() do { const unsigned long long t0_ = __builtin_amdgcn_s_memrealtime(); const unsigned long long d_ = (unsigned long long)(MK_STAGGER_TICKS) * (unsigned)((OPQ_S((int)blockIdx.x) * 5) & 7); while (__builtin_amdgcn_s_memrealtime() - t0_ < d_) __builtin_amdgcn_s_sleep(8); } while (0)
#define PHASE_LANES() int tid_ = MYTID(); asm volatile("" : "+v"(tid_)); int G_ = gridDim.x, bx_ = blockIdx.x; asm volatile("" : "+s"(G_), "+s"(bx_)); \
    const int lane = tid_ & 63, wave = __builtin_amdgcn_readfirstlane(tid_ >> 6); const int vcu_ = (G_ % 8 == 0) ? (bx_ % 8) * (G_ / 8) + bx_ / 8 : bx_; const int gw = vcu_ * NWAVES + wave, NGW = G_ * NWAVES; (void)lane; (void)gw; (void)NGW
    XcdBarrier bar; bar.bar = (unsigned*)(F.ctl + CW_BAR); bar.x = 0; bar.st = nullptr;
    if (!MK_PER_PHASE) bar = xcd_barrier_post((unsigned*)(F.ctl + CW_BAR), F.MISC + 8);
#define GRID_BAR() do { if (MK_PER_PHASE) { if (MYTID() == 0) __hip_atomic_store(F.ctl + 0, 0xBADBA0u, RLX_AGENT); } else { for (int xb_ = 0; xb_ <= MK_EXTRA_BAR; ++xb_) xcd_barrier(bar, MYTID() == 0); } } while (0)
    const int lo = args.ph_lo, hi = args.ph_hi;
#define IN(k) (lo <= (k) && (k) < hi)
#define BOTH(k) (IN(k) && IN((k) + 1))

#define PHASE_PTRS() unsigned zo_ = 0u; asm volatile("" : "+s"(zo_)); unsigned char* ws_ = args.ws + zo_;     \
    const float* x_in = args.in[0]; float* out = args.out; \
    float* cosT = (float*)(ws_ + WS_ROPE); float* sinT = cosT + SEQ * 16; float* kmean = (float*)(ws_ + WS_KMEAN); bf16* kmh = (bf16*)(ws_ + WS_KMEAN + 192 * 1024); bf16* kml = kmh + BATCH * 6 * 16 * 64; float* lse = (float*)(ws_ + WS_LSE); (void)kmh; (void)kml; (void)lse; \
    pg8::u64* rsu = (pg8::u64*)(ws_ + WS_RS); float* rsq = (float*)(ws_ + WS_RSQ); float* rskv = (float*)(ws_ + WS_RSKV); \
    bf16* Wb = (bf16*)(ws_ + WS_W); bf16* XB = (bf16*)(ws_ + WS_XB); bf16* PROJ = (bf16*)(ws_ + WS_PROJ); bf16* ACT = PROJ; bf16* GT = PROJ; \
    bf16* QM = (bf16*)(ws_ + WS_QM); bf16* KN = (bf16*)(ws_ + WS_KN); bf16* VM = (bf16*)(ws_ + WS_VM); bf16* KR = (bf16*)(ws_ + WS_KR); \
    bf16* MG = (bf16*)(ws_ + WS_MG); bf16* AO = (bf16*)(ws_ + WS_AO); \
    const pg8::bf16_t* Wgu1 = Wb + W_GU1 / 2; const pg8::bf16_t* Wd1 = Wb + W_D1 / 2; const pg8::bf16_t* Win = Wb + W_IN / 2; const pg8::bf16_t* Wg = Wb + W_G / 2; \
    const pg8::bf16_t* Wuq = Wb + W_UQ / 2; const pg8::bf16_t* Wukv = Wb + W_UKV / 2; const pg8::bf16_t* Wbr = Wb + W_BR / 2; const pg8::bf16_t* Wout = Wb + W_OUT / 2; \
    const pg8::bf16_t* Wgu2 = Wb + W_GU2 / 2; const pg8::bf16_t* Wd2 = Wb + W_D2 / 2; \
    (void)x_in; (void)out; (void)cosT; (void)sinT; (void)kmean; (void)rsu; (void)rsq; (void)rskv; (void)XB; (void)ACT; (void)GT; (void)QM; (void)KN; (void)VM; (void)KR; (void)MG; (void)AO; \
    (void)Wgu1; (void)Wd1; (void)Win; (void)Wg; (void)Wuq; (void)Wukv; (void)Wbr; (void)Wout; (void)Wgu2; (void)Wd2

    if (IN(0)) { PHASE_LANES(); PHASE_PTRS();
        for (int m = gw; m < T; m += NGW) { const GAS f32x4* xr = (const GAS f32x4*)(x_in + (size_t)m * DM) + 2 * lane; f32x4 v[4]; float s = 0.f;
#pragma unroll
            for (int j = 0; j < 4; ++j) { v[j] = xr[128 * (j >> 1) + (j & 1)]; s += (v[j].x * v[j].x + v[j].y * v[j].y) + (v[j].z * v[j].z + v[j].w * v[j].w); }
            s = wave_sum(s);
            GAS v4u* o16 = (GAS v4u*)(XB + (size_t)m * DM) + lane;
#pragma unroll
            for (int j = 0; j < 2; ++j) o16[64 * j] = (v4u){pk2(v[2 * j].x, v[2 * j].y), pk2(v[2 * j].z, v[2 * j].w), pk2(v[2 * j + 1].x, v[2 * j + 1].y), pk2(v[2 * j + 1].z, v[2 * j + 1].w)};
            if (lane == 0) rsu[m] = (pg8::u64)(s * pg8::RS_FIX); }
        for (int idx = gw * 64 + lane; idx < SEQ * 16; idx += NGW * 64) { const int pos = idx >> 4, i = idx & 15; const int a = i & 3, e = i >> 2;
            const double mm = a == 0 ? 1.0 : a == 1 ? 0.5623413251903491 : a == 2 ? 0.31622776601683794 : 0.1778279410038923;
            const double pe = e == 0 ? 1.0 : e == 1 ? 0.1 : e == 2 ? 0.01 : 0.001;
            const float inv = (float)(mm * pe); const float angf = (float)pos * inv;
            const double rev = (double)angf * 0.15915494309189535; const float fr = (float)(rev - __builtin_rint(rev));
            cosT[idx] = __builtin_amdgcn_cosf(fr); sinT[idx] = __builtin_amdgcn_sinf(fr); }
        { LAS float* scr = (LAS float*)(F.lds + RING_OFF + wave * 16384); CVT_SET_A(0, gw, NGW);
          v4u z = (v4u){0u, 0u, 0u, 0u}; asm volatile("" : "+v"(z)); const int gt = gw * 64 + lane, NTH = NGW * 64;
          for (int i = gt; i < 224 * 1024 / 8; i += NTH) *(GAS v4u*)(Wb + W_IN / 2 + (size_t)3872 * 1024 + (size_t)i * 8) = z;
          for (int i = gt; i < 192 * 256 / 8; i += NTH) *(GAS v4u*)(Wb + W_UQ / 2 + (size_t)576 * 256 + (size_t)i * 8) = z;
          for (int i = gt; i < 768 * 16; i += NTH) *(GAS v4u*)(Wb + W_UKV / 2 + (size_t)(i >> 4) * 256 + 128 + (i & 15) * 8) = z; }
        if (BOTH(0)) GRID_BAR();
    }

    for (int l = 0; l < DEPTH; ++l) {
        const int pb = 1 + l * PH_PER_LAYER;
        if (IN(pb + 1)) { PHASE_PTRS();
            pg8::Gemm g{XB, Wgu1, T, 2 * FF, DM, DM, DM}; pg8::StaticOrder S; S.init(T, 2 * FF, OPQ_S((int)gridDim.x), OPQ_S((int)blockIdx.x));
            pg8::EpiSwiGLU E{ACT, FF, rsu + (size_t)(3 * l + 0) * T};
            for (int rep = 0; rep < ((MK_DOUBLE & 1) ? 2 : 1); ++rep)
            pg8::gemm_phase<pg8::EpiSwiGLU, pg8::StaticOrder, true>(F.lds + RING_OFF, g, S, E, MYTID());
            if (BOTH(pb + 1)) GRID_BAR();
        }
        if (IN(pb + 2)) { PHASE_PTRS();
            pg8::Gemm g{ACT, Wd1, T, DM, FF, FF, FF}; pg8::StaticOrder S; S.init(T, DM, OPQ_S((int)gridDim.x), OPQ_S((int)blockIdx.x));
            pg8::EpiResid E{XB, rsu + (size_t)(3 * l + 1) * T, 0.5f};
            pg8::gemm_phase<pg8::EpiResid, pg8::StaticOrder, true>(F.lds + RING_OFF, g, S, E, MYTID());
            if (BOTH(pb + 2)) GRID_BAR();
        }
        if (IN(pb + 3)) { PHASE_PTRS();
            pg8::Gemm g{XB, Win, T, 4096, DM, DM, DM}; pg8::StaticOrder S; S.init(T, 4096, OPQ_S((int)gridDim.x), OPQ_S((int)blockIdx.x));
            pg8::EpiProj E{PROJ, rsu + (size_t)(3 * l + 1) * T, rsq, rskv};
            for (int rep = 0; rep < ((MK_DOUBLE & 4) ? 2 : 1); ++rep)
            pg8::gemm_phase<pg8::EpiProj, pg8::StaticOrder, true>(F.lds + RING_OFF, g, S, E, MYTID());
            if (BOTH(pb + 3)) GRID_BAR();
        }
        if (IN(pb + 4)) { PHASE_PTRS();
            { pg8::Gemm g{PROJ + PTOK_OFF, Wuq, T, 1536, 256, PTP, 256}; pg8::UpOrder S; S.init(T, 1536, OPQ_S((int)gridDim.x), OPQ_S((int)blockIdx.x));
              pg8::EpiUp E{QM, KN, VM, rsq, rskv, cosT, sinT};
              pg8::gemm_phase<pg8::EpiUp, pg8::UpOrder, true>(F.lds + RING_OFF, g, S, E, MYTID()); }
            PHASE_LANES();
            for (int idx = gw * 64 + lane; idx < T * 2; idx += NGW * 64) { const int row = idx >> 1, c = idx & 1, pos = row & (SEQ - 1);
                const v4u a1 = *(const v4u*)(PROJ + PTOK_OFF + (size_t)row * PTP + 384 + 8 * c), a2 = *(const v4u*)(PROJ + PTOK_OFF + (size_t)row * PTP + 384 + 16 + 8 * c);
                const f32x4 c0 = *(const f32x4*)(cosT + pos * 16 + 8 * c), c1 = *(const f32x4*)(cosT + pos * 16 + 8 * c + 4), s0 = *(const f32x4*)(sinT + pos * 16 + 8 * c), s1 = *(const f32x4*)(sinT + pos * 16 + 8 * c + 4);
                float t1[8], t2[8], cc[8], ss[8], o1[8], o2[8];
                t1[0] = bflo(a1.x); t1[1] = bfhi(a1.x); t1[2] = bflo(a1.y); t1[3] = bfhi(a1.y); t1[4] = bflo(a1.z); t1[5] = bfhi(a1.z); t1[6] = bflo(a1.w); t1[7] = bfhi(a1.w);
                t2[0] = bflo(a2.x); t2[1] = bfhi(a2.x); t2[2] = bflo(a2.y); t2[3] = bfhi(a2.y); t2[4] = bflo(a2.z); t2[5] = bfhi(a2.z); t2[6] = bflo(a2.w); t2[7] = bfhi(a2.w);
#pragma unroll
                for (int j = 0; j < 4; ++j) { cc[j] = c0[j]; cc[4 + j] = c1[j]; ss[j] = s0[j]; ss[4 + j] = s1[j]; }
#pragma unroll
                for (int j = 0; j < 8; ++j) { o1[j] = t1[j] * cc[j] - t2[j] * ss[j]; o2[j] = t1[j] * ss[j] + t2[j] * cc[j]; }
                *(v4u*)(KR + (size_t)row * 32 + 8 * c) = (v4u){pk2(o1[0], o1[1]), pk2(o1[2], o1[3]), pk2(o1[4], o1[5]), pk2(o1[6], o1[7])};
                *(v4u*)(KR + (size_t)row * 32 + 16 + 8 * c) = (v4u){pk2(o2[0], o2[1]), pk2(o2[2], o2[3]), pk2(o2[4], o2[5]), pk2(o2[6], o2[7])}; }
            for (int u = gw; u < BATCH * 6 * 16; u += NGW) { const int n = u & 15, bh = u >> 4, b = bh / 6, h = bh % 6, dc = lane & 7, ks = lane >> 3;
                const bf16* kp = PROJ + ((size_t)(b * HSLOTS + SL_MK + h) * SEQ + n * 256 + ks) * 64 + dc * 8; float a[8];
#pragma unroll
                for (int j = 0; j < 8; ++j) a[j] = 0.f;
#pragma unroll 1
                for (int i0 = 0; i0 < 32; i0 += 16) { v4u kw[16];
#pragma unroll
                    for (int i = 0; i < 16; ++i) kw[i] = *(const v4u*)(kp + (size_t)(8 * (i0 + i)) * 64);
#pragma unroll
                    for (int i = 0; i < 16; ++i) { a[0] += bflo(kw[i].x); a[1] += bfhi(kw[i].x); a[2] += bflo(kw[i].y); a[3] += bfhi(kw[i].y); a[4] += bflo(kw[i].z); a[5] += bfhi(kw[i].z); a[6] += bflo(kw[i].w); a[7] += bfhi(kw[i].w); } }
#pragma unroll
                for (int j = 0; j < 8; ++j) { a[j] += __shfl_xor(a[j], 8); a[j] += __shfl_xor(a[j], 16); a[j] += __shfl_xor(a[j], 32); }
                if (ks == 0) {
#pragma unroll
                    for (int j = 0; j < 8; ++j) { const int idx = u * 64 + dc * 8 + j; const float km = a[j] * (1.0f / 256.0f); kmean[idx] = km; const unsigned hb = f2bf(km); kmh[idx] = (bf16)hb; kml[idx] = (bf16)f2bf(km - __uint_as_float(hb << 16)); } } }
#if MK_NAIVE_DIL
            for (int gid = gw * 64 + lane; gid < BATCH * 4 * SEQ; gid += NGW * 64) dil_naive_thread(PROJ, AO, gid >> 14, (gid >> 12) & 3, gid & (SEQ - 1));
#else
            __syncthreads();
            fa::dil_phase((LAS char*)(F.lds + RING_OFF), tid_, bx_, G_, PROJ, lse);
#endif
            if (BOTH(pb + 4)) GRID_BAR();
        }
        if (IN(pb + 5)) { PHASE_LANES(); PHASE_PTRS();
            const int nchunk = (CVT_ITEMS_B + (l + 1 < DEPTH ? CVT_ITEMS_A : 0)) / 8; gu32* chead = F.ctl + CW_QUEUE + 64 * (32 + l);
            LAS float* scr = (LAS float*)(F.lds + RING_OFF + 63488 + wave * 8448);
#define CVT_CHUNKS(c0_, cnt_) do { for (int c_ = (c0_); c_ < (c0_) + (cnt_) && c_ < nchunk; ++c_) { const int it_ = c_ * 8 + wave; int lane_o_ = lane; asm volatile("" : "+v"(lane_o_)); \
                { const int lane = lane_o_;     \
                if (it_ < CVT_ITEMS_B) CVT_SET_B(l, it_, 0x40000000); else CVT_SET_A(l + 1, it_ - CVT_ITEMS_B, 0x40000000); } } } while (0)
#if !MK_NAIVE_DIL
            for (int idx0 = gw * 64 + lane; idx0 < T * 32; idx0 += 4 * NGW * 64) { float lv[4][3]; v4u av[4][3];
#pragma unroll
                for (int q = 0; q < 4; ++q) { int idx = idx0 + q * NGW * 64; idx = idx < T * 32 ? idx : T * 32 - 1; const int row = idx >> 5, hg = (idx >> 3) & 3, c = idx & 7;
                    const bf16* op = PROJ + ((size_t)((row >> 12) * HSLOTS + SL_DQ + hg) * SEQ + (row & (SEQ - 1))) * 64 + c * 8;
#pragma unroll
                    for (int g = 0; g < 3; ++g) { lv[q][g] = lse[(size_t)row * 12 + 4 * g + hg]; av[q][g] = *(const v4u*)(op + (size_t)(4 * g) * SEQ * 64); } }
#pragma unroll
                for (int q = 0; q < 4; ++q) { const int idx = idx0 + q * NGW * 64; if (idx < T * 32) { const int row = idx >> 5, hg = (idx >> 3) & 3, c = idx & 7;
                    const float l0 = lv[q][0], l1 = lv[q][1], l2 = lv[q][2], lm = fmaxf(l0, fmaxf(l1, l2));
                    float w0 = exp2f(l0 - lm), w1 = exp2f(l1 - lm), w2 = exp2f(l2 - lm); const float wi = 1.0f / (w0 + w1 + w2); w0 *= wi; w1 *= wi; w2 *= wi;
                    const v4u x0 = av[q][0], x1 = av[q][1], x2 = av[q][2]; float r[8];
                    r[0] = w0 * bflo(x0.x) + w1 * bflo(x1.x) + w2 * bflo(x2.x); r[1] = w0 * bfhi(x0.x) + w1 * bfhi(x1.x) + w2 * bfhi(x2.x);
                    r[2] = w0 * bflo(x0.y) + w1 * bflo(x1.y) + w2 * bflo(x2.y); r[3] = w0 * bfhi(x0.y) + w1 * bfhi(x1.y) + w2 * bfhi(x2.y);
                    r[4] = w0 * bflo(x0.z) + w1 * bflo(x1.z) + w2 * bflo(x2.z); r[5] = w0 * bfhi(x0.z) + w1 * bfhi(x1.z) + w2 * bfhi(x2.z);
                    r[6] = w0 * bflo(x0.w) + w1 * bflo(x1.w) + w2 * bflo(x2.w); r[7] = w0 * bfhi(x0.w) + w1 * bfhi(x1.w) + w2 * bfhi(x2.w);
                    st8(AO + (size_t)row * DM + 768 + hg * 64 + c * 8, r, 1.0f); } } }
#endif
            for (int wrep = 0; wrep < 4; ++wrep) { const int which = wrep >> 1, rep = wrep & 1; if (rep == 1 && !((MK_DOUBLE >> (3 + which)) & 1)) continue;
                const bool naive = which == 0 ? (MK_NAIVE_MLA != 0) : (MK_NAIVE_MOBA != 0);
                if (naive) {
                    for (int u = gw; u < 48 * 32; u += NGW) { const int bh = u >> 5, cp = u & 31, b = bh / 6, h = bh % 6;
                        if (which == 0) { mla_naive_chunk(QM, KN, KR, VM, AO, b, h, cp, lane); mla_naive_chunk(QM, KN, KR, VM, AO, b, h, 63 - cp, lane); }
                        else { moba_naive_chunk(PROJ, kmean, AO, b, h, cp, lane); moba_naive_chunk(PROJ, kmean, AO, b, h, 63 - cp, lane); } }
                } else {
                    gu32* head = F.ctl + CW_QUEUE + 64 * (2 * l + which) + 64 * 8 * rep;
                    for (;;) {
                        if (tid_ == 0) { F.MISC[16] = __hip_atomic_fetch_add(head, 1u, RLX_AGENT); if (which == 0 && rep == 0) F.MISC[17] = __hip_atomic_fetch_add(chead, 2u, RLX_AGENT); }
                        __syncthreads();
                        const int u = __builtin_amdgcn_readfirstlane((int)F.MISC[16]);
                        if (which == 0 && rep == 0) { const int c0 = __builtin_amdgcn_readfirstlane((int)F.MISC[17]); CVT_CHUNKS(c0, 2); }
                        if (u >= 48 * 16) break;
                        const int qb = 15 - u / 48, bh = u % 48, b = bh / 6, h = bh % 6;
                        if (which == 0) fa::mla_unit<8>((LAS char*)(F.lds + RING_OFF), tid_, qb, QM + (size_t)bh * SEQ * 96, KN + (size_t)bh * SEQ * 64, KR + (size_t)b * SEQ * 32, VM + (size_t)bh * SEQ * 64, AO + (size_t)b * SEQ * DM + h * 64);
                        else fa::moba_unit<8>((LAS char*)(F.lds + RING_OFF), tid_, qb, PROJ + (size_t)(b * HSLOTS + SL_MQ + h) * SEQ * 64, PROJ + (size_t)(b * HSLOTS + SL_MK + h) * SEQ * 64, PROJ + (size_t)(b * HSLOTS + SL_MV + h) * SEQ * 64, AO + (size_t)b * SEQ * DM + 384 + h * 64,
                                              kmh + (size_t)bh * 1024, kml + (size_t)bh * 1024, exp2f(-8.0f * (float)(12 + h + 1) / 18.0f) * LOG2E);
                    }
                    __syncthreads();
                }
            }
            for (;;) {
                __syncthreads();
                if (tid_ == 0) F.MISC[17] = __hip_atomic_fetch_add(chead, 4u, RLX_AGENT);
                __syncthreads();
                const int c0 = __builtin_amdgcn_readfirstlane((int)F.MISC[17]); if (c0 >= nchunk) break;
                CVT_CHUNKS(c0, 4);
            }
#undef CVT_CHUNKS
            if (BOTH(pb + 5)) GRID_BAR();
        }
        if (IN(pb + 7)) { PHASE_PTRS();
            { pg8::Gemm g{XB, Wg, T, DM, DM, DM, DM, AO, Wbr}; pg8::FusedOrder S; S.init(T, DM, OPQ_S((int)gridDim.x), OPQ_S((int)blockIdx.x));
              pg8::EpiFused E{GT + (size_t)OPQ_S((int)blockIdx.x) * 65536, MG, rsu + (size_t)(3 * l + 1) * T};
              pg8::gemm_phase<pg8::EpiFused, pg8::FusedOrder, true>(F.lds + RING_OFF, g, S, E, MYTID()); }
            if (BOTH(pb + 7)) GRID_BAR();
        }
        if (IN(pb + 8)) { PHASE_PTRS();
            pg8::Gemm g{MG, Wout, T, DM, DM, DM, DM}; pg8::StaticOrder S; S.init(T, DM, OPQ_S((int)gridDim.x), OPQ_S((int)blockIdx.x));
            pg8::EpiResid E{XB, rsu + (size_t)(3 * l + 2) * T, 1.0f};
            pg8::gemm_phase<pg8::EpiResid, pg8::StaticOrder, true>(F.lds + RING_OFF, g, S, E, MYTID());
            if (BOTH(pb + 8)) GRID_BAR();
        }
        if (IN(pb + 9)) { PHASE_PTRS();
            pg8::Gemm g{XB, Wgu2, T, 2 * FF, DM, DM, DM}; pg8::StaticOrder S; S.init(T, 2 * FF, OPQ_S((int)gridDim.x), OPQ_S((int)blockIdx.x));
            pg8::EpiSwiGLU E{ACT, FF, rsu + (size_t)(3 * l + 2) * T};
            for (int rep = 0; rep < ((MK_DOUBLE & 1) ? 2 : 1); ++rep)
            pg8::gemm_phase<pg8::EpiSwiGLU, pg8::StaticOrder, true>(F.lds + RING_OFF, g, S, E, MYTID());
            if (BOTH(pb + 9)) GRID_BAR();
        }
        if (IN(pb + 10)) { PHASE_PTRS();
            pg8::Gemm g{ACT, Wd2, T, DM, FF, FF, FF}; pg8::StaticOrder S; S.init(T, DM, OPQ_S((int)gridDim.x), OPQ_S((int)blockIdx.x));
            pg8::EpiResid E{XB, rsu + (size_t)(3 * (l + 1)) * T, 0.5f};
            pg8::gemm_phase<pg8::EpiResid, pg8::StaticOrder, true>(F.lds + RING_OFF, g, S, E, MYTID());
            if (BOTH(pb + 10)) GRID_BAR();
        }
    }
    if (IN(N_PHASES - 1)) { PHASE_LANES(); PHASE_PTRS();
        const float* gain = args.in[19];
        for (int m = gw; m < T; m += NGW) { float v[16]; ld8(XB + (size_t)m * DM + lane * 16, v); ld8(XB + (size_t)m * DM + lane * 16 + 8, v + 8); float s2 = 0.f;
#pragma unroll
            for (int j = 0; j < 16; ++j) s2 += v[j] * v[j];
            const float r = 1.0f / sqrtf(wave_sum(s2) * (1.0f / DM) + NORM_EPS);
#pragma unroll
            for (int j = 0; j < 4; ++j) { const f32x4 gn = *((const f32x4*)gain + lane * 4 + j); *((GAS f32x4*)(out + (size_t)m * DM) + lane * 4 + j) = (f32x4){v[4 * j] * r * gn[0], v[4 * j + 1] * r * gn[1], v[4 * j + 2] * r * gn[2], v[4 * j + 3] * r * gn[3]}; } }
    }
#undef IN
#undef BOTH
#undef GRID_BAR
}


extern "C" void kernel_launch(void* const* d_in, const int* in_sizes, int n_in, void* d_out, int out_size, void* d_ws, size_t ws_size, hipStream_t stream) {
    static int grid = 0;
    if (grid == 0) {
        if (n_in != 20 || in_sizes[0] != T * DM || out_size != T * DM || ws_size < WS_END) { fprintf(stderr, "kernel_launch: unexpected shapes / workspace (n_in %d, ws %zu, need %zu)\n", n_in, ws_size, (size_t)WS_END); grid = -1; return; }
        int dev = 0, cus = 0, per_cu = 0;
        if (hipGetDevice(&dev) != hipSuccess || hipDeviceGetAttribute(&cus, hipDeviceAttributeMultiprocessorCount, dev) != hipSuccess) { grid = -1; return; }
        if (hipFuncSetAttribute((const void*)mk_fwd, hipFuncAttributeMaxDynamicSharedMemorySize, LDS_BYTES) != hipSuccess) { fprintf(stderr, "kernel_launch: hipFuncSetAttribute failed\n"); grid = -1; return; }
        if (hipOccupancyMaxActiveBlocksPerMultiprocessor(&per_cu, (const void*)mk_fwd, NWAVES * 64, LDS_BYTES) != hipSuccess || per_cu < 1)
            fprintf(stderr, "kernel_launch: note: occupancy query reports %d workgroups per CU\n", per_cu);
        (void)hipGetLastError();
        grid = cus;
    }
    if (grid < 0) return;
    if (hipMemsetAsync((char*)d_ws + WS_CTL, 0, CTL_ZERO_BYTES, stream) != hipSuccess) return;
    Args a{};
    for (int i = 0; i < 20; ++i) a.in[i] = (const float*)d_in[i];
    a.out = (float*)d_out; a.ws = (unsigned char*)d_ws;
#if MK_PER_PHASE
    for (int p = 0; p < N_PHASES; ++p) { if (p > MK_STOP_AFTER && p != N_PHASES - 1) continue; a.ph_lo = p; a.ph_hi = p + 1; hipLaunchKernelGGL(mk_fwd, dim3(grid), dim3(NWAVES * 64), LDS_BYTES, stream, a); }
#else
    a.ph_lo = 0; a.ph_hi = N_PHASES;
    hipLaunchKernelGGL(mk_fwd, dim3(grid), dim3(NWAVES * 64), LDS_BYTES, stream, a);
#endif
}
```

```cpp
#include <hip/hip_runtime.h>
#include <cstdio>
#include <cstdint>

#ifndef MK_PER_PHASE
#define MK_PER_PHASE 0
#endif

#ifndef MK_DOUBLE
#define MK_DOUBLE 0
#endif
#ifndef MK_STAGGER_TICKS
#define MK_STAGGER_TICKS 300
#endif
#ifndef MK_EXTRA_BAR
#define MK_EXTRA_BAR 0
#endif
#ifndef MK_NAIVE_MLA
#define MK_NAIVE_MLA 0
#endif
#ifndef MK_NAIVE_MOBA
#define MK_NAIVE_MOBA 0
#endif
#ifndef MK_NAIVE_DIL
#define MK_NAIVE_DIL 0
#endif
#ifndef MK_STOP_AFTER
#define MK_STOP_AFTER 999
#endif
constexpr int BATCH = 8, SEQ = 4096, DM = 1024, DEPTH = 4, FF = 2816, T = BATCH * SEQ;
constexpr int PP = 4096;
constexpr int HSLOTS = 54, SL_DQ = 0, SL_DK = 12, SL_DV = 24, SL_MQ = 36, SL_MK = 42, SL_MV = 48, PTP = 640;
constexpr size_t PTOK_OFF = (size_t)8 * HSLOTS * 4096 * 64;
constexpr int PC_DQ = 0, PC_DK = 768, PC_DV = 1536, PC_MQ = 2304, PC_MK = 2688, PC_MV = 3072, PC_CKV = 3456, PC_CQ = 3584, PC_KR = 3840;
constexpr int IN_COLS = 6944;
constexpr float NORM_EPS = 1e-6f;
constexpr float LOG2E = 1.4426950408889634f, QSCALE64 = 0.125f * LOG2E, QSCALE96 = 0.10206207261596575f * LOG2E;

namespace pg8 {
#define PG8_LAS __attribute__((address_space(3)))
typedef unsigned short bf16_t;
typedef short bf16x8 __attribute__((ext_vector_type(8)));
typedef float f32x4 __attribute__((ext_vector_type(4)));
typedef unsigned u32x4 __attribute__((ext_vector_type(4)));
typedef unsigned u32x2 __attribute__((ext_vector_type(2)));
typedef unsigned long long u64;
constexpr int BM = 256, BK = 64, HALF = 128, HTB = HALF * BK * 2, STAGE_BYTES = 8 * HTB, NXCD = 8, WGM = 8;

__host__ __device__ __forceinline__ int lds_byte(int r, int c) { const int st = (r >> 4) * 2 + (c >> 5), rr = r & 15, cc = c & 31, ob = rr * 64 + cc * 2; return st * 1024 + (ob ^ (((ob >> 9) & 1) << 5)); }
__host__ __device__ __forceinline__ void stage_rc(int b, int& R, int& C) { const int st = b / 1024, sb = b % 1024, swz = sb ^ (((sb >> 9) & 1) << 5); R = (st >> 1) * 16 + swz / 64; C = (st & 1) * 32 + (swz % 64) / 2; }
__host__ __device__ __forceinline__ int perm32(int rho) { const int n = rho >> 4, i = rho & 15; return 8 * (i >> 2) + 4 * n + (i & 3); }

struct Unit { int pm, pn, sub, ka, kb, nt, sel; };
struct Gemm { const bf16_t* A; const bf16_t* Bt; int M, N, K, lda, ldb; const bf16_t* A1; const bf16_t* Bt1; };

struct StaticOrder {
    int nM, nN, nwg, G, c;
    __host__ __device__ void init(int M, int N, int G_, int c_) { nM = M / BM; nN = N / BM; nwg = nM * nN; G = G_; c = c_; }
    __host__ __device__ bool next(int i, Unit& u) const {
        const long L = (long)i * G + c; if (L >= nwg) return false;
        int wgid = (int)L; { const int q = nwg / NXCD, r = nwg % NXCD, xcd = wgid % NXCD, off = wgid / NXCD; wgid = (xcd < r ? xcd * (q + 1) : r * (q + 1) + (xcd - r) * q) + off; }
        const int nig = WGM * nN, gid = wgid / nig, fm = gid * WGM, gsz = (nM - fm) < WGM ? (nM - fm) : WGM;
        u.pm = fm + ((wgid % nig) % gsz); u.pn = (wgid % nig) / gsz; u.sub = 0; u.ka = 0; u.kb = 0; u.nt = 0; u.sel = 0; return true;
    }
    __device__ __forceinline__ void a_ready(const Unit&) const {}
    __device__ __forceinline__ void done(const Unit&) const {}
};

typedef float f32x2_t __attribute__((ext_vector_type(2))); typedef __bf16 bf16x2_t __attribute__((ext_vector_type(2)));
struct MergeOrder : StaticOrder {
    __host__ __device__ bool next(int i, Unit& u) const { if (!StaticOrder::next(i / 3, u)) return false; u.sub = i % 3; u.ka = u.sub * 768; u.kb = u.ka; u.nt = (u.sub == 2) ? 4 : 6; return true; }
};
struct UpOrder : StaticOrder {
    __host__ __device__ bool next(int i, Unit& u) const { if (!StaticOrder::next(i, u)) return false; u.ka = (u.pn < 3 ? 128 : 0) * 2; return true; }
};
__device__ __forceinline__ unsigned cvt_pk_bf16(float lo, float hi) { f32x2_t v = {lo, hi}; bf16x2_t b = __builtin_convertvector(v, bf16x2_t); return __builtin_bit_cast(unsigned, b); }
__device__ __forceinline__ float bflo(unsigned w) { return __uint_as_float(w << 16); }
__device__ __forceinline__ float bfhi(unsigned w) { return __uint_as_float(w & 0xffff0000u); }

template <int NP> __device__ __forceinline__ float row_scale(const float* p, int row, float invn) {
    float s = 0.f;
#pragma unroll
    for (int i = 0; i < NP / 4; ++i) { const f32x4 a = *(const f32x4*)(p + (size_t)row * NP + 4 * i); s += (a[0] + a[1]) + (a[2] + a[3]); }
    return 1.0f / sqrtf(s * invn + NORM_EPS);
}
constexpr float RS_FIX = 16777216.0f, RS_UNFIX = 1.0f / 16777216.0f;
constexpr int RS_LDS_OFF = 131072 + 2048;
__device__ __forceinline__ void row_scales8(const PG8_LAS unsigned char* ldsbase, int wr, int fr, float (&sc)[2][4]) {
    const PG8_LAS u64* p = (const PG8_LAS u64*)(ldsbase + RS_LDS_OFF) + wr * 64 + fr;
#pragma unroll
    for (int ai = 0; ai < 2; ++ai)
#pragma unroll
        for (int m = 0; m < 4; ++m) sc[ai][m] = 1.0f / sqrtf((float)p[ai * HALF + m * 16] * (RS_UNFIX / DM) + NORM_EPS);
}
__device__ __forceinline__ float silu_f(float a) { return a * __builtin_amdgcn_rcpf(1.0f + __builtin_amdgcn_exp2f(-1.4426950408889634f * a)); }
__device__ __forceinline__ float sigm_f(float a) { return __builtin_amdgcn_rcpf(1.0f + __builtin_amdgcn_exp2f(-1.4426950408889634f * a)); }

struct EpiSwiGLU { static constexpr bool PERM = true, AFTER_DRAIN = false, RS_PREFETCH = true; static __device__ __forceinline__ bool rs_wanted(const Unit&) { return true; }
    bf16_t* O; int ldc; const u64* rsu;
    __device__ __forceinline__ void operator()(const f32x4 (&acc)[2][2][4][2], const Unit& u, int wr, int wc, int fr, int fq, const PG8_LAS unsigned char* ldsbase) const {
        const int row0 = u.pm * BM + wr * 64 + fr, col0 = u.pn * HALF + wc * 32 + 8 * fq;
        float sc[2][4]; row_scales8(ldsbase, wr, fr, sc);
#pragma unroll
        for (int ai = 0; ai < 2; ++ai)
#pragma unroll
            for (int m = 0; m < 4; ++m) { const int row = row0 + ai * HALF + m * 16; const float s = sc[ai][m];
                float y[8];
#pragma unroll
                for (int n = 0; n < 2; ++n)
#pragma unroll
                    for (int j = 0; j < 4; ++j) y[4 * n + j] = silu_f(acc[ai][0][m][n][j] * s) * (acc[ai][1][m][n][j] * s);
                u32x4 w; w.x = cvt_pk_bf16(y[0], y[1]); w.y = cvt_pk_bf16(y[2], y[3]); w.z = cvt_pk_bf16(y[4], y[5]); w.w = cvt_pk_bf16(y[6], y[7]);
                *(u32x4*)(O + (size_t)row * ldc + col0) = w; }
    }
};
struct EpiResid { static constexpr bool PERM = true, AFTER_DRAIN = false, RS_PREFETCH = false;
    bf16_t* xb; u64* rsu; float alpha;
    __device__ __forceinline__ void operator()(const f32x4 (&acc)[2][2][4][2], const Unit& u, int wr, int wc, int fr, int fq, const PG8_LAS unsigned char* ldsbase) const {
        const int row0 = u.pm * BM + wr * 64 + fr, col0 = u.pn * BM + wc * 32 + 8 * fq;
#pragma unroll
        for (int ai = 0; ai < 2; ++ai) {
            u32x4 b[4][2];
#pragma unroll
            for (int m = 0; m < 4; ++m)
#pragma unroll
                for (int bj = 0; bj < 2; ++bj) b[m][bj] = *(const u32x4*)(xb + (size_t)(row0 + ai * HALF + m * 16) * DM + col0 + bj * HALF);
#pragma unroll
            for (int m = 0; m < 4; ++m) { const int row = row0 + ai * HALF + m * 16; float ss = 0.f;
#pragma unroll
                for (int bj = 0; bj < 2; ++bj) { const u32x4 p = b[m][bj]; const f32x4 a0 = acc[ai][bj][m][0], a1 = acc[ai][bj][m][1]; float o[8];
                    o[0] = bflo(p.x) + alpha * a0[0]; o[1] = bfhi(p.x) + alpha * a0[1]; o[2] = bflo(p.y) + alpha * a0[2]; o[3] = bfhi(p.y) + alpha * a0[3];
                    o[4] = bflo(p.z) + alpha * a1[0]; o[5] = bfhi(p.z) + alpha * a1[1]; o[6] = bflo(p.w) + alpha * a1[2]; o[7] = bfhi(p.w) + alpha * a1[3];
                    u32x4 w; w.x = cvt_pk_bf16(o[0], o[1]); w.y = cvt_pk_bf16(o[2], o[3]); w.z = cvt_pk_bf16(o[4], o[5]); w.w = cvt_pk_bf16(o[6], o[7]);
                    *(u32x4*)(xb + (size_t)row * DM + col0 + bj * HALF) = w;
#pragma unroll
                    for (int j = 0; j < 8; ++j) ss += o[j] * o[j]; }
                ss += __shfl_xor(ss, 16); ss += __shfl_xor(ss, 32);
                if (fq == 0) __hip_atomic_fetch_add(rsu + row, (u64)(ss * RS_FIX), __ATOMIC_RELAXED, __HIP_MEMORY_SCOPE_AGENT); }
        }
    }
};
struct EpiProj { static constexpr bool PERM = true, AFTER_DRAIN = false, RS_PREFETCH = true; static __device__ __forceinline__ bool rs_wanted(const Unit&) { return true; }
    bf16_t* O; const u64* rsu; float* rsq; float* rskv;
    __device__ __forceinline__ void operator()(const f32x4 (&acc)[2][2][4][2], const Unit& u, int wr, int wc, int fr, int fq, const PG8_LAS unsigned char* ldsbase) const {
        const int row0 = u.pm * BM + wr * 64 + fr, col0 = u.pn * BM + wc * 32 + 8 * fq;
        float sc[2][4]; row_scales8(ldsbase, wr, fr, sc);
#pragma unroll
        for (int ai = 0; ai < 2; ++ai)
#pragma unroll
            for (int m = 0; m < 4; ++m) { const int row = row0 + ai * HALF + m * 16; const float s = sc[ai][m]; float ssb[2];
#pragma unroll
                for (int bj = 0; bj < 2; ++bj) { const float sq = (u.pn < 3 || u.pn == 9 || (u.pn == 10 && bj == 0)) ? s * QSCALE64 : s;
                    const f32x4 v0 = acc[ai][bj][m][0] * sq, v1 = acc[ai][bj][m][1] * sq;
                    u32x4 w; w.x = cvt_pk_bf16(v0[0], v0[1]); w.y = cvt_pk_bf16(v0[2], v0[3]); w.z = cvt_pk_bf16(v1[0], v1[1]); w.w = cvt_pk_bf16(v1[2], v1[3]);
                    { const int c = col0 + bj * HALF;
                      if (u.pn * 2 + bj < 27) *(u32x4*)(O + ((size_t)((row >> 12) * HSLOTS + (u.pn * 4 + bj * 2 + (wc >> 1))) * SEQ + (row & (SEQ - 1))) * 64 + (wc & 1) * 32 + 8 * fq) = w;
                      else *(u32x4*)(O + PTOK_OFF + (size_t)row * PTP + (c - 3456)) = w; }
                    ssb[bj] = ((v0[0] * v0[0] + v0[1] * v0[1]) + (v0[2] * v0[2] + v0[3] * v0[3])) + ((v1[0] * v1[0] + v1[1] * v1[1]) + (v1[2] * v1[2] + v1[3] * v1[3])); }
                if (u.pn == 14) { float ss = ssb[0] + ssb[1]; ss += __shfl_xor(ss, 16); ss += __shfl_xor(ss, 32); if (fq == 0) rsq[(size_t)row * 4 + wc] = ss; }
                if (u.pn == 13) { float ss = ssb[1]; ss += __shfl_xor(ss, 16); ss += __shfl_xor(ss, 32); if (fq == 0) rskv[(size_t)row * 4 + wc] = ss; } }
    }
};
struct EpiQup { static constexpr bool PERM = false, AFTER_DRAIN = false, RS_PREFETCH = false;
    bf16_t* Q; const float* rsq; const float* cosT; const float* sinT;
    __device__ __forceinline__ void operator()(const f32x4 (&acc)[2][2][4][2], const Unit& u, int wr, int wc, int fr, int fq, const PG8_LAS unsigned char* ldsbase) const {
        const int row0 = u.pm * BM + wr * 64 + fr;
        const int c32a = u.pn * BM + wc * 32, c32b = c32a + HALF;
        const bool ropea = (c32a < 576) && (c32a % 96) == 64, ropeb = (c32b < 576) && (c32b % 96) == 64, ropeany = ropea || ropeb;
#pragma unroll
        for (int ai = 0; ai < 2; ++ai) {
            f32x4 rsv[4], cs[4], sn[4];
#pragma unroll
            for (int m = 0; m < 4; ++m) { rsv[m] = *(const f32x4*)(rsq + (size_t)(row0 + ai * HALF + m * 16) * 4); cs[m] = (f32x4){0.f, 0.f, 0.f, 0.f}; sn[m] = cs[m]; }
            if (ropeany) {
#pragma unroll
                for (int m = 0; m < 4; ++m) { const int pos = (row0 + ai * HALF + m * 16) & (SEQ - 1); cs[m] = *(const f32x4*)(cosT + pos * 16 + 4 * fq); sn[m] = *(const f32x4*)(sinT + pos * 16 + 4 * fq); } }
            float sc[4];
#pragma unroll
            for (int m = 0; m < 4; ++m) { const f32x4 a = rsv[m]; sc[m] = (1.0f / sqrtf(((a[0] + a[1]) + (a[2] + a[3])) * (1.0f / 256.0f) + NORM_EPS)) * QSCALE96; }
#pragma unroll
            for (int bj = 0; bj < 2; ++bj) { const int c32 = bj ? c32b : c32a; if (c32 >= 576) continue; const bool rope = bj ? ropeb : ropea;
#pragma unroll
                for (int m = 0; m < 4; ++m) { const int row = row0 + ai * HALF + m * 16; const float s = sc[m];
                    f32x4 v0 = acc[ai][bj][m][0] * s, v1 = acc[ai][bj][m][1] * s;
                    if (rope) { const f32x4 o0 = v0 * cs[m] - v1 * sn[m], o1 = v0 * sn[m] + v1 * cs[m]; v0 = o0; v1 = o1; }
                    u32x2 w0, w1; w0.x = cvt_pk_bf16(v0[0], v0[1]); w0.y = cvt_pk_bf16(v0[2], v0[3]); w1.x = cvt_pk_bf16(v1[0], v1[1]); w1.y = cvt_pk_bf16(v1[2], v1[3]);
                    { auto r = __builtin_amdgcn_permlane16_swap(w0.x, w1.x, false, false); w0.x = r[0]; w1.x = r[1]; }
                    { auto r = __builtin_amdgcn_permlane16_swap(w0.y, w1.y, false, false); w0.y = r[0]; w1.y = r[1]; }
                    bf16_t* p = Q + ((size_t)((row >> 12) * 6 + c32 / 96) * SEQ + (row & (SEQ - 1))) * 96 + (c32 % 96) + (fq & 1) * 16 + (fq >> 1) * 8; *(u32x4*)p = (u32x4){w0.x, w0.y, w1.x, w1.y}; } } }
    }
};
struct EpiKVup { static constexpr bool PERM = true, AFTER_DRAIN = false, RS_PREFETCH = false;
    bf16_t* Kn; bf16_t* Vm; const float* rskv;
    __device__ __forceinline__ void operator()(const f32x4 (&acc)[2][2][4][2], const Unit& u, int wr, int wc, int fr, int fq, const PG8_LAS unsigned char* ldsbase) const {
        const int row0 = u.pm * BM + wr * 64 + fr;
#pragma unroll
        for (int bj = 0; bj < 2; ++bj) { const int h = 2 * u.pn + bj; bf16_t* dst = (wc < 2 ? Kn + h * 64 + wc * 32 : Vm + h * 64 + (wc - 2) * 32) + 8 * fq;
#pragma unroll
            for (int ai = 0; ai < 2; ++ai)
#pragma unroll
                for (int m = 0; m < 4; ++m) { const int row = row0 + ai * HALF + m * 16; const float s = row_scale<4>(rskv, row, 1.0f / 128.0f);
                    const f32x4 v0 = acc[ai][bj][m][0] * s, v1 = acc[ai][bj][m][1] * s;
                    u32x4 w; w.x = cvt_pk_bf16(v0[0], v0[1]); w.y = cvt_pk_bf16(v0[2], v0[3]); w.z = cvt_pk_bf16(v1[0], v1[1]); w.w = cvt_pk_bf16(v1[2], v1[3]);
                    *(u32x4*)(dst + (size_t)row * 384) = w; } }
    }
};
struct EpiUp { static constexpr bool PERM = false, AFTER_DRAIN = false, RS_PREFETCH = false;
    bf16_t* Q; bf16_t* Kn; bf16_t* Vm; const float* rsq; const float* rskv; const float* cosT; const float* sinT;
    __device__ __forceinline__ void operator()(const f32x4 (&acc)[2][2][4][2], const Unit& u, int wr, int wc, int fr, int fq, const PG8_LAS unsigned char* ldsbase) const {
        const int row0 = u.pm * BM + wr * 64 + fr;
        if (u.pn < 3) { EpiQup E{Q, rsq, cosT, sinT}; E(acc, u, wr, wc, fr, fq, ldsbase); return; }
        f32x4 rsv[2][4]; float sc[2][4];
#pragma unroll
        for (int ai = 0; ai < 2; ++ai)
#pragma unroll
            for (int m = 0; m < 4; ++m) rsv[ai][m] = *(const f32x4*)(rskv + (size_t)(row0 + ai * HALF + m * 16) * 4);
#pragma unroll
        for (int ai = 0; ai < 2; ++ai)
#pragma unroll
            for (int m = 0; m < 4; ++m) { const f32x4 a = rsv[ai][m]; sc[ai][m] = 1.0f / sqrtf(((a[0] + a[1]) + (a[2] + a[3])) * (1.0f / 128.0f) + NORM_EPS); }
#pragma unroll
        for (int bj = 0; bj < 2; ++bj) { const int h = 2 * (u.pn - 3) + bj; bf16_t* dst = (wc < 2 ? Kn + wc * 32 : Vm + (wc - 2) * 32) + (fq & 1) * 16 + (fq >> 1) * 8;
#pragma unroll
            for (int ai = 0; ai < 2; ++ai)
#pragma unroll
                for (int m = 0; m < 4; ++m) { const int row = row0 + ai * HALF + m * 16; const float s = sc[ai][m];
                    const f32x4 v0 = acc[ai][bj][m][0] * s, v1 = acc[ai][bj][m][1] * s;
                    u32x2 w0, w1; w0.x = cvt_pk_bf16(v0[0], v0[1]); w0.y = cvt_pk_bf16(v0[2], v0[3]); w1.x = cvt_pk_bf16(v1[0], v1[1]); w1.y = cvt_pk_bf16(v1[2], v1[3]);
                    { auto r = __builtin_amdgcn_permlane16_swap(w0.x, w1.x, false, false); w0.x = r[0]; w1.x = r[1]; }
                    { auto r = __builtin_amdgcn_permlane16_swap(w0.y, w1.y, false, false); w0.y = r[0]; w1.y = r[1]; }
                    { bf16_t* p = dst + ((size_t)((row >> 12) * 6 + h) * SEQ + (row & (SEQ - 1))) * 64; *(u32x4*)p = (u32x4){w0.x, w0.y, w1.x, w1.y}; } } }
    }
};
struct EpiGate { static constexpr bool PERM = true, AFTER_DRAIN = false, RS_PREFETCH = true; static __device__ __forceinline__ bool rs_wanted(const Unit&) { return true; }
    bf16_t* O; const u64* rsu;
    __device__ __forceinline__ void operator()(const f32x4 (&acc)[2][2][4][2], const Unit& u, int wr, int wc, int fr, int fq, const PG8_LAS unsigned char* ldsbase) const {
        const int row0 = u.pm * BM + wr * 64 + fr, col0 = u.pn * BM + wc * 32 + 8 * fq;
        float sc[2][4]; row_scales8(ldsbase, wr, fr, sc);
#pragma unroll
        for (int ai = 0; ai < 2; ++ai)
#pragma unroll
            for (int m = 0; m < 4; ++m) { const int row = row0 + ai * HALF + m * 16; const float s = sc[ai][m];
#pragma unroll
                for (int bj = 0; bj < 2; ++bj) { float y[8];
#pragma unroll
                    for (int n = 0; n < 2; ++n)
#pragma unroll
                        for (int j = 0; j < 4; ++j) y[4 * n + j] = sigm_f(acc[ai][bj][m][n][j] * s);
                    u32x4 w; w.x = cvt_pk_bf16(y[0], y[1]); w.y = cvt_pk_bf16(y[2], y[3]); w.z = cvt_pk_bf16(y[4], y[5]); w.w = cvt_pk_bf16(y[6], y[7]);
                    *(u32x4*)(O + (size_t)row * 3072 + col0 + bj * HALF) = w; } }
    }
};
struct EpiMerge { static constexpr bool PERM = true, AFTER_DRAIN = false, RS_PREFETCH = false;
    const bf16_t* G; bf16_t* Mg;
    __device__ __forceinline__ void operator()(const f32x4 (&acc)[2][2][4][2], const Unit& u, int wr, int wc, int fr, int fq, const PG8_LAS unsigned char* ldsbase) const {
        const int row0 = u.pm * BM + wr * 64 + fr, col0 = u.pn * BM + wc * 32 + 8 * fq; const bool first = (u.sub == 0); const bf16_t* Gs = G + u.sub * 1024;
#pragma unroll
        for (int ai = 0; ai < 2; ++ai) {
            u32x4 gv[4][2], pv[4][2];
#pragma unroll
            for (int m = 0; m < 4; ++m)
#pragma unroll
                for (int bj = 0; bj < 2; ++bj) { const int row = row0 + ai * HALF + m * 16; gv[m][bj] = *(const u32x4*)(Gs + (size_t)row * 3072 + col0 + bj * HALF);
                    pv[m][bj] = (u32x4){0u, 0u, 0u, 0u}; if (!first) pv[m][bj] = *(const u32x4*)(Mg + (size_t)row * DM + col0 + bj * HALF); }
#pragma unroll
            for (int m = 0; m < 4; ++m)
#pragma unroll
                for (int bj = 0; bj < 2; ++bj) { const int row = row0 + ai * HALF + m * 16; const u32x4 g = gv[m][bj], p = pv[m][bj];
                    const f32x4 a0 = acc[ai][bj][m][0], a1 = acc[ai][bj][m][1];
                    u32x4 w;
                    w.x = cvt_pk_bf16(bflo(p.x) + bflo(g.x) * a0[0], bfhi(p.x) + bfhi(g.x) * a0[1]);
                    w.y = cvt_pk_bf16(bflo(p.y) + bflo(g.y) * a0[2], bfhi(p.y) + bfhi(g.y) * a0[3]);
                    w.z = cvt_pk_bf16(bflo(p.z) + bflo(g.z) * a1[0], bfhi(p.z) + bfhi(g.z) * a1[1]);
                    w.w = cvt_pk_bf16(bflo(p.w) + bflo(g.w) * a1[2], bfhi(p.w) + bfhi(g.w) * a1[3]);
                    *(u32x4*)(Mg + (size_t)row * DM + col0 + bj * HALF) = w; }
        }
    }
};

struct FusedOrder : StaticOrder {
    __host__ __device__ bool next(int i, Unit& u) const { if (!StaticOrder::next(i / 6, u)) return false; const int j = i % 6, br = j >> 1; u.sub = j;
        if ((j & 1) == 0) { u.sel = 0; u.ka = 0; u.kb = br * (1024 * 1024 * 2); u.nt = 16; } else { u.sel = 1; u.ka = br * 768; u.kb = u.ka; u.nt = (br == 2) ? 4 : 6; }
        return true; }
};
struct EpiFused { static constexpr bool PERM = true, AFTER_DRAIN = false, RS_PREFETCH = true; static __device__ __forceinline__ bool rs_wanted(const Unit& u) { return (u.sub & 1) == 0; }
    bf16_t* gs; bf16_t* Mg; const u64* rsu;
    __device__ __forceinline__ void operator()(const f32x4 (&acc)[2][2][4][2], const Unit& u, int wr, int wc, int fr, int fq, const PG8_LAS unsigned char* ldsbase) const {
        int tid = (wr * 4 + wc) * 64 + fq * 16 + fr; asm volatile("" : "+v"(tid));
        const int row0 = u.pm * BM + wr * 64 + fr, col0 = u.pn * BM + wc * 32 + 8 * fq;
        if ((u.sub & 1) == 0) {
            float sc[2][4]; row_scales8(ldsbase, wr, fr, sc);
#pragma unroll
            for (int ai = 0; ai < 2; ++ai)
#pragma unroll
                for (int m = 0; m < 4; ++m) { const float s = sc[ai][m];
#pragma unroll
                    for (int bj = 0; bj < 2; ++bj) { float y[8];
#pragma unroll
                        for (int n = 0; n < 2; ++n)
#pragma unroll
                            for (int j = 0; j < 4; ++j) y[4 * n + j] = sigm_f(acc[ai][bj][m][n][j] * s);
                        u32x4 w; w.x = cvt_pk_bf16(y[0], y[1]); w.y = cvt_pk_bf16(y[2], y[3]); w.z = cvt_pk_bf16(y[4], y[5]); w.w = cvt_pk_bf16(y[6], y[7]);
                        *(u32x4*)(gs + (size_t)((((ai * 4 + m) * 2 + bj) * 512 + tid) * 8)) = w; } }
        } else {
            const bool first = (u.sub == 1);
#pragma unroll
            for (int ai = 0; ai < 2; ++ai) {
                u32x4 gv[4][2], pv[4][2];
#pragma unroll
                for (int m = 0; m < 4; ++m)
#pragma unroll
                    for (int bj = 0; bj < 2; ++bj) { const int row = row0 + ai * HALF + m * 16; gv[m][bj] = *(const u32x4*)(gs + (size_t)((((ai * 4 + m) * 2 + bj) * 512 + tid) * 8));
                        pv[m][bj] = (u32x4){0u, 0u, 0u, 0u}; if (!first) pv[m][bj] = *(const u32x4*)(Mg + (size_t)row * DM + col0 + bj * HALF); }
#pragma unroll
                for (int m = 0; m < 4; ++m)
#pragma unroll
                    for (int bj = 0; bj < 2; ++bj) { const int row = row0 + ai * HALF + m * 16; const u32x4 g = gv[m][bj], p = pv[m][bj];
                        const f32x4 a0 = acc[ai][bj][m][0], a1 = acc[ai][bj][m][1];
                        u32x4 w;
                        w.x = cvt_pk_bf16(bflo(p.x) + bflo(g.x) * a0[0], bfhi(p.x) + bfhi(g.x) * a0[1]);
                        w.y = cvt_pk_bf16(bflo(p.y) + bflo(g.y) * a0[2], bfhi(p.y) + bfhi(g.y) * a0[3]);
                        w.z = cvt_pk_bf16(bflo(p.z) + bflo(g.z) * a1[0], bfhi(p.z) + bfhi(g.z) * a1[1]);
                        w.w = cvt_pk_bf16(bflo(p.w) + bflo(g.w) * a1[2], bfhi(p.w) + bfhi(g.w) * a1[3]);
                        *(u32x4*)(Mg + (size_t)row * DM + col0 + bj * HALF) = w; } }
        }
    }
};

template <class Epi, class Sched, bool ALIGN_EPI = false>
__device__ __forceinline__ void gemm_phase(PG8_LAS unsigned char* lds, const Gemm g, const Sched& S, const Epi& E, int tid_in) {
    int tid_ = tid_in; asm volatile("" : "+v"(tid_));
    const int tid = tid_, wid = __builtin_amdgcn_readfirstlane(tid >> 6), lane = tid & 63, wr = wid >> 2, wc = wid & 3, fr = lane & 15, fq = lane >> 4;
    int K = g.K; asm volatile("" : "+s"(K)); const int nt = K / BK;
    unsigned voffA[2], voffB[2];
#pragma unroll
    for (int i = 0; i < 2; ++i) { int R, C; stage_rc(tid * 16 + i * 8192, R, C); const int Rb = Epi::PERM ? ((R & ~31) + perm32(R & 31)) : R;
        voffA[i] = (unsigned)(R * g.lda + C) * 2u; voffB[i] = (unsigned)(Rb * g.ldb + C) * 2u; }
    const size_t kstep = (size_t)(BK * 2);
    const size_t hstepA = (size_t)HALF * g.lda * 2, hstepB = (size_t)HALF * g.ldb * 2;
    const size_t tstepA = 2 * hstepA, tstepB = 2 * hstepB;
    const unsigned ldsw = (unsigned)wid * 1024u;
    const int aoff = lds_byte(wr * 64 + fr, fq * 8), boff = lds_byte(wc * 32 + fr, fq * 8);
#define PG8_SA(b, h) (((b) * 2 + (h)) * HTB)
#define PG8_SB(b, h) ((4 + (b) * 2 + (h)) * HTB)
#define PG8_STAGE(bufoff, gbase, voff) do { _Pragma("unroll") for (int _i = 0; _i < 2; ++_i) \
        __builtin_amdgcn_global_load_lds((const unsigned*)((const char*)(gbase) + (voff)[_i]), (PG8_LAS unsigned*)(lds + (bufoff) + ldsw + _i * 8192), 16, 0, 0); } while (0)
#define PG8_LDA(dst, b, h) do { _Pragma("unroll") for (int m = 0; m < 4; ++m) _Pragma("unroll") for (int k = 0; k < 2; ++k) dst[m][k] = *(const PG8_LAS bf16x8*)(lds + PG8_SA(b, h) + aoff + m * 2048 + k * 1024); } while (0)
#define PG8_LDB(dst, b, h) do { _Pragma("unroll") for (int n = 0; n < 2; ++n) _Pragma("unroll") for (int k = 0; k < 2; ++k) dst[n][k] = *(const PG8_LAS bf16x8*)(lds + PG8_SB(b, h) + boff + n * 2048 + k * 1024); } while (0)
#define PG8_MMA(ai, bj, At, Bt) do { __builtin_amdgcn_s_setprio(1); _Pragma("unroll") for (int m = 0; m < 4; ++m) _Pragma("unroll") for (int n = 0; n < 2; ++n) _Pragma("unroll") for (int k = 0; k < 2; ++k) \
        acc[ai][bj][m][n] = __builtin_amdgcn_mfma_f32_16x16x32_bf16(Bt[n][k], At[m][k], acc[ai][bj][m][n], 0, 0, 0); __builtin_amdgcn_s_setprio(0); } while (0)
#define PG8_WAIT_V(n) asm volatile("s_waitcnt vmcnt(" #n ")" ::: "memory")
#define PG8_WAIT_L(n) asm volatile("s_waitcnt lgkmcnt(" #n ")" ::: "memory")
#define PG8_BAR __builtin_amdgcn_s_barrier()
#define PG8_SCHED __builtin_amdgcn_sched_barrier(0)
    Unit cur, nxt; int ui = 0;
    if (!S.next(0, cur)) return;
    f32x4 acc[2][2][4][2];
#pragma unroll
    for (int a = 0; a < 2; ++a)
#pragma unroll
        for (int b = 0; b < 2; ++b)
#pragma unroll
            for (int m = 0; m < 4; ++m)
#pragma unroll
                for (int n = 0; n < 2; ++n) acc[a][b][m][n] = (f32x4){0.f, 0.f, 0.f, 0.f};
    bf16x8 At[4][2], B0[2][2], B1[2][2];
    const char* cA = (const char*)(cur.sel ? g.A1 : g.A) + (size_t)cur.pm * tstepA + cur.ka; const char* cB = (const char*)(cur.sel ? g.Bt1 : g.Bt) + (size_t)cur.pn * tstepB + cur.kb;
    S.a_ready(cur);
    PG8_STAGE(PG8_SB(0, 0), cB, voffB); PG8_STAGE(PG8_SB(0, 1), cB + hstepB, voffB); PG8_STAGE(PG8_SA(0, 0), cA, voffA); PG8_STAGE(PG8_SA(0, 1), cA + hstepA, voffA);
    if (wr == 1) PG8_BAR;
    PG8_WAIT_V(2); PG8_BAR;
    PG8_STAGE(PG8_SB(1, 0), cB + kstep, voffB); PG8_STAGE(PG8_SA(1, 0), cA + kstep, voffA); PG8_STAGE(PG8_SB(1, 1), cB + hstepB + kstep, voffB);
    PG8_WAIT_V(6); PG8_BAR;
    for (;;) {
        const bool has_next = S.next(ui + 1, nxt);
        const char* nA = has_next ? (const char*)(nxt.sel ? g.A1 : g.A) + (size_t)nxt.pm * tstepA + nxt.ka : cA; const char* nB = has_next ? (const char*)(nxt.sel ? g.Bt1 : g.Bt) + (size_t)nxt.pn * tstepB + nxt.kb : cB;
        const int ntc = cur.nt ? cur.nt : nt;
        for (int t = 0; t < ntc; t += 2) {
            const bool last = (t == ntc - 2);
            const char* a1 = cA + (size_t)(t + 1) * kstep;
            const char* a2 = last ? nA : cA + (size_t)(t + 2) * kstep; const char* b2 = last ? nB : cB + (size_t)(t + 2) * kstep;
            const char* a3 = a2 + kstep; const char* b3 = b2 + kstep;
            if (last && has_next) S.a_ready(nxt);
            if constexpr (Epi::RS_PREFETCH) { if (last && Epi::rs_wanted(cur)) __builtin_amdgcn_global_load_lds((const unsigned*)(E.rsu + (size_t)cur.pm * BM) + tid, (PG8_LAS unsigned*)(lds + RS_LDS_OFF + wid * 256), 4, 0, 0); }
            PG8_LDB(B0, 0, 0); PG8_LDB(B1, 0, 1); PG8_SCHED; PG8_LDA(At, 0, 0); PG8_STAGE(PG8_SA(1, 1), a1 + hstepA, voffA);
            PG8_WAIT_V(8); PG8_WAIT_L(0); PG8_BAR; PG8_MMA(0, 0, At, B0); PG8_MMA(0, 1, At, B1); PG8_BAR; PG8_SCHED;
            PG8_LDA(At, 0, 1); PG8_STAGE(PG8_SB(0, 0), b2, voffB); PG8_STAGE(PG8_SB(0, 1), b2 + hstepB, voffB); PG8_STAGE(PG8_SA(0, 0), a2, voffA);
            PG8_WAIT_V(8); PG8_WAIT_L(0); PG8_BAR; PG8_MMA(1, 0, At, B0); PG8_MMA(1, 1, At, B1); PG8_BAR; PG8_SCHED;
            PG8_LDB(B0, 1, 0); PG8_LDB(B1, 1, 1); PG8_SCHED; PG8_LDA(At, 1, 0); PG8_STAGE(PG8_SA(0, 1), a2 + hstepA, voffA);
            PG8_WAIT_V(8); PG8_WAIT_L(0); PG8_BAR; PG8_MMA(0, 0, At, B0); PG8_MMA(0, 1, At, B1); PG8_BAR; PG8_SCHED;
            PG8_LDA(At, 1, 1); PG8_STAGE(PG8_SB(1, 0), b3, voffB); PG8_STAGE(PG8_SB(1, 1), b3 + hstepB, voffB); PG8_STAGE(PG8_SA(1, 0), a3, voffA);
            PG8_WAIT_V(8); PG8_WAIT_L(0); PG8_BAR; PG8_MMA(1, 0, At, B0); PG8_MMA(1, 1, At, B1); PG8_BAR; PG8_SCHED;
        }
        if constexpr (ALIGN_EPI) { if (wr == 0) PG8_BAR; }
        E(acc, cur, wr, wc, fr, fq, lds); S.done(cur);
        if (!has_next) break;
#pragma unroll
        for (int a = 0; a < 2; ++a)
#pragma unroll
            for (int b = 0; b < 2; ++b)
#pragma unroll
                for (int m = 0; m < 4; ++m)
#pragma unroll
                    for (int n = 0; n < 2; ++n) acc[a][b][m][n] = (f32x4){0.f, 0.f, 0.f, 0.f};
        cur = nxt; cA = nA; cB = nB; ++ui;
        if constexpr (ALIGN_EPI) { if (wr == 1) PG8_BAR; }
    }
    PG8_WAIT_V(0);
    if constexpr (!ALIGN_EPI) { if (wr == 0) PG8_BAR; }
    PG8_BAR;
#undef PG8_SA
#undef PG8_SB
#undef PG8_STAGE
#undef PG8_LDA
#undef PG8_LDB
#undef PG8_MMA
#undef PG8_WAIT_V
#undef PG8_WAIT_L
#undef PG8_BAR
#undef PG8_SCHED
}
}

constexpr int NWAVES = 8;
constexpr size_t MiB = 1u << 20;
constexpr size_t WS_CTL = 0, CTL_ZERO_BYTES = 6 * MiB;
constexpr size_t WS_ROPE = 1 * MiB;
constexpr size_t WS_KMEAN = WS_ROPE + 512 * 1024;
constexpr size_t WS_RS = 2 * MiB;
constexpr size_t WS_RSQ = 6 * MiB;
constexpr size_t WS_RSKV = WS_RSQ + 512 * 1024;
constexpr size_t WS_W = 7 * MiB;
constexpr size_t W_GU1 = 0, W_D1 = W_GU1 + (size_t)5632 * 1024 * 2, W_IN = W_D1 + (size_t)1024 * 2816 * 2, W_G = W_IN + (size_t)4096 * 1024 * 2,
                 W_UQ = W_G + (size_t)3072 * 1024 * 2, W_UKV = W_UQ + (size_t)768 * 256 * 2, W_BR = W_UKV + (size_t)768 * 256 * 2, W_OUT = W_BR + (size_t)1024 * 1024 * 2,
                 W_GU2 = W_OUT + (size_t)1024 * 1024 * 2, W_D2 = W_GU2 + (size_t)5632 * 1024 * 2, W_END = W_D2 + (size_t)1024 * 2816 * 2;
static_assert(W_END <= 52 * MiB, "weights region");
constexpr size_t WS_XB = 59 * MiB;
constexpr size_t WS_PROJ = 123 * MiB;
constexpr size_t WS_QM = 379 * MiB;
constexpr size_t WS_KN = 415 * MiB;
constexpr size_t WS_VM = 439 * MiB;
constexpr size_t WS_KR = 463 * MiB;
constexpr size_t WS_MG = WS_QM;
constexpr size_t WS_AO = 465 * MiB;
constexpr size_t WS_LSE = 529 * MiB;
constexpr size_t WS_END = 531 * MiB;
static_assert(WS_RS + (size_t)13 * T * 8 <= WS_RSQ && WS_RSQ + MiB <= WS_W && WS_W + 52 * MiB <= WS_XB && WS_RSQ <= CTL_ZERO_BYTES + 0 * MiB + WS_RSQ, "d_ws map");
constexpr int CW_BAR = 4096;
constexpr int CW_QUEUE = 8192;

constexpr int RING_OFF = 0, RING_BYTES = 131072;
constexpr int LDSCTL_OFF = RING_BYTES, MISC_OFF = LDSCTL_OFF + 320;
constexpr int LDS_BYTES = 147456;

#define GAS __attribute__((address_space(1)))
#define LAS __attribute__((address_space(3)))
typedef unsigned short bf16;
typedef unsigned v4u __attribute__((ext_vector_type(4)));
typedef unsigned v2u __attribute__((ext_vector_type(2)));
typedef float f32x4 __attribute__((ext_vector_type(4)));
typedef GAS unsigned gu32;
#define RLX_AGENT __ATOMIC_RELAXED, __HIP_MEMORY_SCOPE_AGENT
#define LDS_WAIT() asm volatile("s_waitcnt lgkmcnt(0)" ::: "memory")
__device__ __forceinline__ unsigned f2bf(float f) { unsigned u = __builtin_bit_cast(unsigned, f); return (u + 0x7fffu + ((u >> 16) & 1u)) >> 16; }
__device__ __forceinline__ unsigned pk2(float lo, float hi) { return f2bf(lo) | (f2bf(hi) << 16); }
__device__ __forceinline__ float bflo(unsigned w) { return __uint_as_float(w << 16); }
__device__ __forceinline__ float bfhi(unsigned w) { return __uint_as_float(w & 0xffff0000u); }

#define XB_TMO      128
#define XB_XCNT(j)  (256  + 64 * (j))
#define XB_XSUB(j)  (1280 + 64 * (j))
#define XB_XGEN(j)  (2304 + 64 * (j))
#define XB_TOP      3328
#define XB_TOPGEN   3392
#define XCD_BAR_WORDS 3456
#define XB_SPIN_CAP (1u << 20)

__device__ __forceinline__ unsigned xb_ld(unsigned* p)              { return __hip_atomic_load(p, __ATOMIC_RELAXED, __HIP_MEMORY_SCOPE_AGENT); }
__device__ __forceinline__ unsigned xb_add(unsigned* p, unsigned v) { return __hip_atomic_fetch_add(p, v, __ATOMIC_RELAXED, __HIP_MEMORY_SCOPE_AGENT); }
__device__ __forceinline__ unsigned xb_xcc_id() { return (unsigned)__builtin_amdgcn_s_getreg((3 << 11) | 20) & 0xFu; }
#define XB_SPIN(cond, bar) do { unsigned _sp = 0; while (cond) { __builtin_amdgcn_s_sleep(1); \
    if ((++_sp & 255u) == 0u) { if (xb_ld(&(bar)[XB_TMO])) break; if (_sp > XB_SPIN_CAP) { atomicAdd(&(bar)[XB_TMO], 1u); break; } } } } while (0)

struct XcdBarrier { unsigned* bar; unsigned x; volatile LAS unsigned* st; };

__device__ __forceinline__ XcdBarrier xcd_barrier_post(unsigned* bar, volatile LAS unsigned* st) {
    XcdBarrier b; b.bar = bar; b.x = xb_xcc_id(); b.st = st;
    if (threadIdx.x == 0) (void)xb_add(&bar[XB_XCNT(b.x)], 1u);
    return b;
}
__device__ __forceinline__ void xcd_barrier_complete(unsigned* bar, unsigned x, unsigned& nloc, unsigned& nx) {
    const unsigned G = gridDim.x * gridDim.y * gridDim.z;
    unsigned sum, cnt, mine, sp = 0u;
    for (;;) {
        sum = 0u; cnt = 0u; mine = 0u;
#pragma unroll
        for (unsigned j = 0; j < 16; ++j) { const unsigned c = xb_ld(&bar[XB_XCNT(j)]); sum += c; cnt += (c > 0u) ? 1u : 0u; mine = (j == x) ? c : mine; }
        if (sum == G) break;
        __builtin_amdgcn_s_sleep(1);
        if ((++sp & 255u) == 0u) { if (xb_ld(&bar[XB_TMO])) break; if (sp > XB_SPIN_CAP) { atomicAdd(&bar[XB_TMO], 1u); break; } }
    }
    nloc = mine > 0u ? mine : 1u; nx = cnt > 0u ? cnt : 1u;
}
__device__ __forceinline__ void xcd_barrier(const XcdBarrier& b, bool leader) {
    asm volatile("s_waitcnt vmcnt(0)" ::: "memory");
    __syncthreads();
    if (leader) {
        unsigned* bar = b.bar; asm volatile("" : "+s"(bar));
        __builtin_amdgcn_s_waitcnt(0);
        unsigned nloc = b.st[0], nx = b.st[1];
        if (nloc == 0u) { xcd_barrier_complete(bar, b.x, nloc, nx); b.st[0] = nloc; b.st[1] = nx; }
        const unsigned old = xb_add(&bar[XB_XSUB(b.x)], 1u);
        const unsigned gen = old / nloc;
        if (old + 1u == (gen + 1u) * nloc) {
            __builtin_amdgcn_fence(__ATOMIC_RELEASE, "agent");
            asm volatile("s_waitcnt vmcnt(0)" ::: "memory");
            const unsigned og = xb_add(&bar[XB_TOP], 1u);
            const unsigned tg = og / nx;
            if (og + 1u == (tg + 1u) * nx) xb_add(&bar[XB_TOPGEN], 1u);
            else XB_SPIN(xb_ld(&bar[XB_TOPGEN]) == tg, bar);
            __builtin_amdgcn_fence(__ATOMIC_ACQUIRE, "agent");
            xb_add(&bar[XB_XGEN(b.x)], 1u);
            asm volatile("s_waitcnt vmcnt(0)" ::: "memory");
        } else {
            XB_SPIN(xb_ld(&bar[XB_XGEN(b.x)]) == gen, bar);
            __builtin_amdgcn_fence(__ATOMIC_ACQUIRE, "agent");
            asm volatile("s_waitcnt vmcnt(0)" ::: "memory");
        }
    }
    __syncthreads();
}

__device__ __forceinline__ bool xcd_barrier_arrive(const XcdBarrier& b, unsigned& gen) {
    unsigned* bar = b.bar; asm volatile("" : "+s"(bar));
    __builtin_amdgcn_s_waitcnt(0);
    unsigned nloc = b.st[0], nx = b.st[1];
    if (nloc == 0u) { xcd_barrier_complete(bar, b.x, nloc, nx); b.st[0] = nloc; b.st[1] = nx; }
    const unsigned old = xb_add(&bar[XB_XSUB(b.x)], 1u);
    gen = old / nloc;
    if (old + 1u == (gen + 1u) * nloc) {
        __builtin_amdgcn_fence(__ATOMIC_RELEASE, "agent");
        asm volatile("s_waitcnt vmcnt(0)" ::: "memory");
        const unsigned og = xb_add(&bar[XB_TOP], 1u);
        const unsigned tg = og / nx;
        if (og + 1u == (tg + 1u) * nx) xb_add(&bar[XB_TOPGEN], 1u);
        else XB_SPIN(xb_ld(&bar[XB_TOPGEN]) == tg, bar);
        __builtin_amdgcn_fence(__ATOMIC_ACQUIRE, "agent");
        xb_add(&bar[XB_XGEN(b.x)], 1u);
        asm volatile("s_waitcnt vmcnt(0)" ::: "memory");
        return true; }
    return false;
}
__device__ __forceinline__ bool xcd_barrier_poll(const XcdBarrier& b, unsigned gen) {
    unsigned* bar = b.bar; asm volatile("" : "+s"(bar));
    if (xb_ld(&bar[XB_XGEN(b.x)]) == gen) return false;
    __builtin_amdgcn_fence(__ATOMIC_ACQUIRE, "agent"); asm volatile("s_waitcnt vmcnt(0)" ::: "memory"); return true;
}
__device__ __forceinline__ void xcd_barrier_spin(const XcdBarrier& b, unsigned gen) {
    unsigned* bar = b.bar; asm volatile("" : "+s"(bar));
    XB_SPIN(xb_ld(&bar[XB_XGEN(b.x)]) == gen, bar);
    __builtin_amdgcn_fence(__ATOMIC_ACQUIRE, "agent"); asm volatile("s_waitcnt vmcnt(0)" ::: "memory");
}

__device__ __forceinline__ float wave_sum(float v) {
#pragma unroll
    for (int o = 1; o < 64; o <<= 1) v += __shfl_xor(v, o);
    return v;
}
__device__ __forceinline__ void cvt_item(const float* W, int N, const float* gain, bf16* WT, int dpitch, int dkoff, int k0, int n0, int drow0, LAS float* scr, int lane) {
    float wv[32];
#pragma unroll
    for (int i = 0; i < 32; ++i) { const int kk = 2 * i + (lane >> 5); wv[i] = W[(size_t)(k0 + kk) * N + n0 + (lane & 31)]; }
#pragma unroll
    for (int i = 0; i < 32; ++i) { const int kk = 2 * i + (lane >> 5); float v = wv[i]; if (gain) v *= gain[k0 + kk]; scr[kk * 33 + (lane & 31)] = v; }
    LDS_WAIT(); asm volatile("" ::: "memory");
    const int c = lane & 7;
#pragma unroll
    for (int j = 0; j < 4; ++j) { const int n = (lane >> 3) + 8 * j; const LAS float* s = scr + (8 * c) * 33 + n;
        v4u o; o.x = pk2(s[0 * 33], s[1 * 33]); o.y = pk2(s[2 * 33], s[3 * 33]); o.z = pk2(s[4 * 33], s[5 * 33]); o.w = pk2(s[6 * 33], s[7 * 33]);
        *(GAS v4u*)(WT + (size_t)(drow0 + n) * dpitch + dkoff + k0 + 8 * c) = o; }
    LDS_WAIT(); asm volatile("" ::: "memory");
}
template <class RowMap>
__device__ __forceinline__ void cvt_matrix(const float* W, int K, int N, int nb0, int nblk, const float* gain, bf16* WT, int dpitch, int dkoff, const RowMap& RM, LAS float* scr, int gw, int NGW, int lane, int& base) {
    const int nit = (K / 64) * nblk;
    int first = gw - (base % NGW); if (first < 0) first += NGW;
    for (int it = first; it < nit; it += NGW) { const int kb = it / nblk, nb = nb0 + it % nblk; cvt_item(W, N, gain, WT, dpitch, dkoff, 64 * kb, 32 * nb, RM(32 * nb), scr, lane); }
    base += nit;
}
struct RmId { __device__ __forceinline__ int operator()(int n0) const { return n0; } };
struct RmGU { int add; __device__ __forceinline__ int operator()(int n0) const { return 256 * (n0 / 128) + (n0 % 128) + add; } };
struct RmIn { __device__ __forceinline__ int operator()(int n0) const {
    if (n0 < 256) return PC_CQ + n0; if (n0 < 384) return PC_CKV + (n0 - 256); if (n0 < 416) return PC_KR + (n0 - 384); if (n0 < 1568) return PC_MQ + (n0 - 416); if (n0 < 3872) return PC_DQ + (n0 - 1568);
    return 4096 + (n0 - 3872); } };
static_assert(W_G == W_IN + (size_t)4096 * 1024 * 2, "gate weights follow w_in");

__device__ __forceinline__ int OPQ_S(int v) { asm volatile("" : "+s"(v)); return v; }
__device__ __forceinline__ int lane_id_volatile() { int l; asm volatile("v_mbcnt_lo_u32_b32 %0, -1, 0\n\tv_mbcnt_hi_u32_b32 %0, -1, %0" : "=v"(l)); return l; }

#define CVT_SET_A(L, gw_, ngw_) do { int base_ = 0; const int L_ = (L); \
    cvt_matrix(args.in[2] + (size_t)L_ * DM * FF, DM, FF, 0, FF / 32, args.in[1] + L_ * DM, Wb + W_GU1 / 2, DM, 0, RmGU{0}, scr, gw_, ngw_, lane, base_); \
    cvt_matrix(args.in[3] + (size_t)L_ * DM * FF, DM, FF, 0, FF / 32, args.in[1] + L_ * DM, Wb + W_GU1 / 2, DM, 0, RmGU{128}, scr, gw_, ngw_, lane, base_); \
    cvt_matrix(args.in[4] + (size_t)L_ * FF * DM, FF, DM, 0, DM / 32, nullptr, Wb + W_D1 / 2, FF, 0, RmId{}, scr, gw_, ngw_, lane, base_); \
    cvt_matrix(args.in[6] + (size_t)L_ * DM * IN_COLS, DM, IN_COLS, 0, 121, args.in[5] + L_ * DM, Wb + W_IN / 2, DM, 0, RmIn{}, scr, gw_, ngw_, lane, base_); \
    cvt_matrix(args.in[8] + (size_t)L_ * 256 * 576, 256, 576, 0, 18, args.in[7] + L_ * 256, Wb + W_UQ / 2, 256, 0, RmId{}, scr, gw_, ngw_, lane, base_); \
    cvt_matrix(args.in[10] + (size_t)L_ * 128 * 768, 128, 768, 0, 24, args.in[9] + L_ * 128, Wb + W_UKV / 2, 256, 0, RmId{}, scr, gw_, ngw_, lane, base_); } while (0)
#define CVT_SET_B(L, gw_, ngw_) do { int base_ = 0; const int L_ = (L); \
    cvt_matrix(args.in[6] + (size_t)L_ * DM * IN_COLS, DM, IN_COLS, 121, 96, args.in[5] + L_ * DM, Wb + W_IN / 2, DM, 0, RmIn{}, scr, gw_, ngw_, lane, base_); \
    cvt_matrix(args.in[11] + (size_t)L_ * 384 * DM, 384, DM, 0, 32, nullptr, Wb + W_BR / 2, DM, 0, RmId{}, scr, gw_, ngw_, lane, base_); \
    cvt_matrix(args.in[12] + (size_t)L_ * 384 * DM, 384, DM, 0, 32, nullptr, Wb + W_BR / 2, DM, 384, RmId{}, scr, gw_, ngw_, lane, base_); \
    cvt_matrix(args.in[13] + (size_t)L_ * 256 * DM, 256, DM, 0, 32, nullptr, Wb + W_BR / 2, DM, 768, RmId{}, scr, gw_, ngw_, lane, base_); \
    cvt_matrix(args.in[14] + (size_t)L_ * DM * DM, DM, DM, 0, 32, nullptr, Wb + W_OUT / 2, DM, 0, RmId{}, scr, gw_, ngw_, lane, base_); \
    cvt_matrix(args.in[16] + (size_t)L_ * DM * FF, DM, FF, 0, FF / 32, args.in[15] + L_ * DM, Wb + W_GU2 / 2, DM, 0, RmGU{0}, scr, gw_, ngw_, lane, base_); \
    cvt_matrix(args.in[17] + (size_t)L_ * DM * FF, DM, FF, 0, FF / 32, args.in[15] + L_ * DM, Wb + W_GU2 / 2, DM, 0, RmGU{128}, scr, gw_, ngw_, lane, base_); \
    cvt_matrix(args.in[18] + (size_t)L_ * FF * DM, FF, DM, 0, DM / 32, nullptr, Wb + W_D2 / 2, FF, 0, RmId{}, scr, gw_, ngw_, lane, base_); } while (0)
constexpr int CVT_ITEMS_A = 2 * 16 * 88 + 44 * 32 + 16 * 121 + 4 * 18 + 2 * 24, CVT_ITEMS_B = 16 * 96 + 6 * 32 + 6 * 32 + 4 * 32 + 16 * 32 + 2 * 16 * 88 + 44 * 32;
static_assert(CVT_ITEMS_A % 8 == 0 && CVT_ITEMS_B % 8 == 0, "conversion items come in chunks of 8 (one item per wave)");
struct Frame {
    LAS unsigned char* lds; volatile LAS unsigned* MISC; gu32* ctl;
};

__device__ __forceinline__ void ld8(const bf16* p, float* f) { const v4u w = *(const v4u*)p; f[0] = bflo(w.x); f[1] = bfhi(w.x); f[2] = bflo(w.y); f[3] = bfhi(w.y); f[4] = bflo(w.z); f[5] = bfhi(w.z); f[6] = bflo(w.w); f[7] = bfhi(w.w); }
__device__ __forceinline__ float dot8(const bf16* p, const float* q) { const v4u w = *(const v4u*)p;
    return ((q[0] * bflo(w.x) + q[1] * bfhi(w.x)) + (q[2] * bflo(w.y) + q[3] * bfhi(w.y))) + ((q[4] * bflo(w.z) + q[5] * bfhi(w.z)) + (q[6] * bflo(w.w) + q[7] * bfhi(w.w))); }
__device__ __forceinline__ void axpy8(const bf16* p, float a, float c, float* o) { const v4u w = *(const v4u*)p;
    o[0] = o[0] * c + a * bflo(w.x); o[1] = o[1] * c + a * bfhi(w.x); o[2] = o[2] * c + a * bflo(w.y); o[3] = o[3] * c + a * bfhi(w.y);
    o[4] = o[4] * c + a * bflo(w.z); o[5] = o[5] * c + a * bfhi(w.z); o[6] = o[6] * c + a * bflo(w.w); o[7] = o[7] * c + a * bfhi(w.w); }
__device__ __forceinline__ void st8(bf16* p, const float* o, float s) { v4u w; w.x = pk2(o[0] * s, o[1] * s); w.y = pk2(o[2] * s, o[3] * s); w.z = pk2(o[4] * s, o[5] * s); w.w = pk2(o[6] * s, o[7] * s); *(v4u*)p = w; }

__device__ __forceinline__ void mla_naive_chunk(const bf16* Qm, const bf16* Kn, const bf16* KR, const bf16* Vm, bf16* AO, int b, int h, int chunk, int lane) {
    const int t = chunk * 64 + lane; const size_t rowb = (size_t)b * SEQ;
    float q[96];
#pragma unroll
    for (int c = 0; c < 12; ++c) ld8(Qm + (rowb + t) * 576 + h * 96 + 8 * c, q + 8 * c);
    float m = -1e30f, l = 0.f; float o[64];
#pragma unroll
    for (int d = 0; d < 64; ++d) o[d] = 0.f;
    const int jmax = chunk * 64 + 63;
    for (int j = 0; j <= jmax; ++j) {
        const bf16* kp = Kn + (rowb + j) * 384 + h * 64; const bf16* rp = KR + (rowb + j) * 32; const bf16* vp = Vm + (rowb + j) * 384 + h * 64;
        float s = 0.f;
#pragma unroll
        for (int c = 0; c < 8; ++c) s += dot8(kp + 8 * c, q + 8 * c);
#pragma unroll
        for (int c = 0; c < 4; ++c) s += dot8(rp + 8 * c, q + 64 + 8 * c);
        if (j <= t) { const float mn = fmaxf(m, s), corr = exp2f(m - mn), p = exp2f(s - mn); l = l * corr + p; m = mn;
#pragma unroll
            for (int c = 0; c < 8; ++c) axpy8(vp + 8 * c, p, corr, o + 8 * c); }
    }
    const float inv = 1.0f / l;
#pragma unroll
    for (int c = 0; c < 8; ++c) st8(AO + (rowb + t) * DM + h * 64 + 8 * c, o + 8 * c, inv);
}

__device__ __forceinline__ void moba_naive_chunk(const bf16* proj, const float* kmean, bf16* AO, int b, int h, int chunk, int lane) {
    const int t = chunk * 64 + lane; const size_t rowb = (size_t)b * SEQ; const int b_own = chunk >> 2;
    float q[64];
#pragma unroll
    for (int c = 0; c < 8; ++c) ld8(proj + (rowb + t) * PP + PC_MQ + h * 64 + 8 * c, q + 8 * c);
    const float slope = exp2f(-8.0f * (float)(12 + h + 1) / 18.0f) * LOG2E;
    float v1 = -3e38f, v2 = -3e38f, v3 = -3e38f; int i1 = -1, i2 = -1, i3 = -1;
    for (int n = 0; n < b_own; ++n) { const float* km = kmean + ((size_t)(b * 6 + h) * 16 + n) * 64; float g = 0.f;
#pragma unroll
        for (int c = 0; c < 16; ++c) { const f32x4 k4 = *(const f32x4*)(km + 4 * c); g += (q[4 * c] * k4[0] + q[4 * c + 1] * k4[1]) + (q[4 * c + 2] * k4[2] + q[4 * c + 3] * k4[3]); }
        if (g > v1) { v3 = v2; i3 = i2; v2 = v1; i2 = i1; v1 = g; i1 = n; } else if (g > v2) { v3 = v2; i3 = i2; v2 = g; i2 = n; } else if (g > v3) { v3 = g; i3 = n; } }
    unsigned sel = 0u; if (i1 >= 0) sel |= 1u << i1; if (i2 >= 0) sel |= 1u << i2; if (i3 >= 0) sel |= 1u << i3;
    float m = -1e30f, l = 0.f; float o[64];
#pragma unroll
    for (int d = 0; d < 64; ++d) o[d] = 0.f;
    for (int n = 0; n < b_own; ++n) { const bool mine = (sel >> n) & 1u; if (!__any(mine)) continue;
        for (int kk = 0; kk < 256; ++kk) { const int kpos = n * 256 + kk; const bf16* kp = proj + (rowb + kpos) * PP + PC_MK + h * 64; const bf16* vp = proj + (rowb + kpos) * PP + PC_MV + h * 64;
            float s = 0.f;
#pragma unroll
            for (int c = 0; c < 8; ++c) s += dot8(kp + 8 * c, q + 8 * c);
            s = s - slope * (float)(t - kpos);
            if (mine) { const float mn = fmaxf(m, s), corr = exp2f(m - mn), p = exp2f(s - mn); l = l * corr + p; m = mn;
#pragma unroll
                for (int c = 0; c < 8; ++c) axpy8(vp + 8 * c, p, corr, o + 8 * c); } } }
    for (int kpos = b_own * 256; kpos <= chunk * 64 + 63; ++kpos) { const bf16* kp = proj + (rowb + kpos) * PP + PC_MK + h * 64; const bf16* vp = proj + (rowb + kpos) * PP + PC_MV + h * 64;
        float s = 0.f;
#pragma unroll
        for (int c = 0; c < 8; ++c) s += dot8(kp + 8 * c, q + 8 * c);
        s = s - slope * (float)(t - kpos);
        if (kpos <= t) { const float mn = fmaxf(m, s), corr = exp2f(m - mn), p = exp2f(s - mn); l = l * corr + p; m = mn;
#pragma unroll
            for (int c = 0; c < 8; ++c) axpy8(vp + 8 * c, p, corr, o + 8 * c); } }
    const float inv = 1.0f / l;
#pragma unroll
    for (int c = 0; c < 8; ++c) st8(AO + (rowb + t) * DM + 384 + h * 64 + 8 * c, o + 8 * c, inv);
}

__device__ __forceinline__ void dil_naive_thread(const bf16* proj, bf16* AO, int b, int hg, int t) {
    const size_t rowb = (size_t)b * SEQ;
    float m = -1e30f, l = 0.f; float o[64];
#pragma unroll
    for (int d = 0; d < 64; ++d) o[d] = 0.f;
    for (int g = 0; g < 3; ++g) { const int h = g * 4 + hg, dil = (g == 0) ? 1 : (g == 1) ? 4 : 16; const float slope = exp2f(-8.0f * (float)(h + 1) / 18.0f) * LOG2E;
        float q[64];
#pragma unroll
        for (int c = 0; c < 8; ++c) ld8(proj + (rowb + t) * PP + PC_DQ + h * 64 + 8 * c, q + 8 * c);
        for (int j = 0; j <= 128; ++j) { const int kpos = t - j * dil;
            if (kpos >= 0) { const bf16* kp = proj + (rowb + kpos) * PP + PC_DK + h * 64; const bf16* vp = proj + (rowb + kpos) * PP + PC_DV + h * 64;
                float s = 0.f;
#pragma unroll
                for (int c = 0; c < 8; ++c) s += dot8(kp + 8 * c, q + 8 * c);
                s = s - slope * (float)(j * dil);
                const float mn = fmaxf(m, s), corr = exp2f(m - mn), p = exp2f(s - mn); l = l * corr + p; m = mn;
#pragma unroll
                for (int c = 0; c < 8; ++c) axpy8(vp + 8 * c, p, corr, o + 8 * c); } } }
    const float inv = 1.0f / l;
#pragma unroll
    for (int c = 0; c < 8; ++c) st8(AO + (rowb + t) * DM + 768 + hg * 64 + 8 * c, o + 8 * c, inv);
}

namespace fa {
typedef float f32x16 __attribute__((ext_vector_type(16)));
typedef short bf16x8 __attribute__((ext_vector_type(8)));
typedef short s16x4 __attribute__((ext_vector_type(4)));
#define FLAS __attribute__((address_space(3)))
constexpr float NEG = -1.0e30f, POS = 1.0e30f, RESC_THR = 8.0f;
__device__ __forceinline__ int crow(int r, int hi) { return (r & 3) + 8 * (r >> 2) + 4 * hi; }
__device__ __forceinline__ float xmax(float v) { auto rr = __builtin_amdgcn_permlane32_swap(__float_as_uint(v), __float_as_uint(v), false, false); return fmaxf(__uint_as_float(rr[0]), __uint_as_float(rr[1])); }
__device__ __forceinline__ float xsum(float v) { auto rr = __builtin_amdgcn_permlane32_swap(__float_as_uint(v), __float_as_uint(v), false, false); return __uint_as_float(rr[0]) + __uint_as_float(rr[1]); }
__device__ __forceinline__ float xother(float v, int hi) { auto rr = __builtin_amdgcn_permlane32_swap(__float_as_uint(v), __float_as_uint(v), false, false); return hi ? __uint_as_float(rr[0]) : __uint_as_float(rr[1]); }
__device__ __forceinline__ float max16(const f32x16& a) { float x = fmaxf(fmaxf(a[0], a[1]), fmaxf(a[2], a[3])), y = fmaxf(fmaxf(a[4], a[5]), fmaxf(a[6], a[7])), z = fmaxf(fmaxf(a[8], a[9]), fmaxf(a[10], a[11])), w = fmaxf(fmaxf(a[12], a[13]), fmaxf(a[14], a[15])); return fmaxf(fmaxf(x, y), fmaxf(z, w)); }
__device__ __forceinline__ bf16x8 pack8(const f32x16& p, int s8) {
    v4u w; w.x = pg8::cvt_pk_bf16(p[s8 + 0], p[s8 + 1]); w.y = pg8::cvt_pk_bf16(p[s8 + 2], p[s8 + 3]); w.z = pg8::cvt_pk_bf16(p[s8 + 4], p[s8 + 5]); w.w = pg8::cvt_pk_bf16(p[s8 + 6], p[s8 + 7]);
    return __builtin_bit_cast(bf16x8, w); }
#define FA_MFMA(a, b, c) __builtin_amdgcn_mfma_f32_32x32x16_bf16((a), (b), (c), 0, 0, 0)
template <int DK> __device__ __forceinline__ f32x16 qk_half(const FLAS char* krow, int hi, const bf16x8* qf, const f32x16& c) {
    f32x16 s = c;
#pragma unroll
    for (int d0 = 0; d0 < DK / 16; ++d0) { const bf16x8 kf = *(const FLAS bf16x8*)(krow + d0 * 32 + hi * 16); s = FA_MFMA(kf, qf[d0], s); }
    return s; }
__device__ __forceinline__ void pv_half(f32x16& o0, f32x16& o1, const FLAS char* vrow, int VP, int hi, const f32x16& p) {
#pragma unroll
    for (int s = 0; s < 2; ++s) { const bf16x8 pf = pack8(p, 8 * s);
        const FLAS char* v0 = vrow + (16 * s + 4 * hi) * 2; const FLAS char* v1 = v0 + 32 * VP;
        const s16x4 a0 = *(const FLAS s16x4*)v0, a1 = *(const FLAS s16x4*)(v0 + 16), b0 = *(const FLAS s16x4*)v1, b1 = *(const FLAS s16x4*)(v1 + 16);
        o0 = FA_MFMA(((bf16x8){a0[0], a0[1], a0[2], a0[3], a1[0], a1[1], a1[2], a1[3]}), pf, o0);
        o1 = FA_MFMA(((bf16x8){b0[0], b0[1], b0[2], b0[3], b1[0], b1[1], b1[2], b1[3]}), pf, o1); }
}
typedef short v4i16_t __attribute__((ext_vector_type(4)));
__device__ __forceinline__ s16x4 vtr(const FLAS char* p) { return __builtin_bit_cast(s16x4, __builtin_amdgcn_ds_read_tr16_b64_v4i16((FLAS v4i16_t*)p)); }
__device__ __forceinline__ int tr_lane_off(int lane, int VP) { return (4 * (lane >> 5) + ((lane & 15) >> 2)) * VP + ((lane & 3) * 4 + 16 * ((lane >> 4) & 1)) * 2; }
__device__ __forceinline__ void pv_half_tr(f32x16& o0, f32x16& o1, const FLAS char* vhalf, int VP, const f32x16& p) {
#pragma unroll
    for (int s = 0; s < 2; ++s) { const bf16x8 pf = pack8(p, 8 * s); const FLAS char* a = vhalf + 16 * s * VP;
        const s16x4 a0 = vtr(a), a1 = vtr(a + 8 * VP), b0 = vtr(a + 64), b1 = vtr(a + 8 * VP + 64);
        o0 = FA_MFMA(((bf16x8){a0[0], a0[1], a0[2], a0[3], a1[0], a1[1], a1[2], a1[3]}), pf, o0);
        o1 = FA_MFMA(((bf16x8){b0[0], b0[1], b0[2], b0[3], b1[0], b1[1], b1[2], b1[3]}), pf, o1); }
}
__device__ __forceinline__ void store_o(bf16* orow, const f32x16& o0, const f32x16& o1, float inv, int hi) {
#pragma unroll
    for (int blk = 0; blk < 2; ++blk)
#pragma unroll
        for (int g = 0; g < 4; g += 2) { const f32x16& o = blk ? o1 : o0;
            unsigned ax = pg8::cvt_pk_bf16(o[4 * g] * inv, o[4 * g + 1] * inv), ay = pg8::cvt_pk_bf16(o[4 * g + 2] * inv, o[4 * g + 3] * inv);
            unsigned bx = pg8::cvt_pk_bf16(o[4 * g + 4] * inv, o[4 * g + 5] * inv), by = pg8::cvt_pk_bf16(o[4 * g + 6] * inv, o[4 * g + 7] * inv);
            { auto r = __builtin_amdgcn_permlane32_swap(ax, bx, false, false); ax = r[0]; bx = r[1]; }
            { auto r = __builtin_amdgcn_permlane32_swap(ay, by, false, false); ay = r[0]; by = r[1]; }
            *(v4u*)(orow + 32 * blk + 8 * g + 8 * hi) = (v4u){ax, ay, bx, by}; }
}

template <int DK, bool MOBA>
__device__ __forceinline__ void flash_unit(FLAS char* lds, int tid_in, int b, int qb,
        const bf16* Qh, int qpitch, const bf16* Kh, int kpitch, const bf16* KRb, const bf16* Vh, int vpitch, bf16* Oh,
        const bf16* kmh, const bf16* kml, float slope2) {
    constexpr int KP = DK * 2 + 16, VP = 192, KBUF = 64 * KP, VBUF = 64 * VP;
    int tid = tid_in; asm volatile("" : "+v"(tid));
    const int lane = tid & 63, w = __builtin_amdgcn_readfirstlane(tid >> 6), r32 = lane & 31, hi = lane >> 5;
    const int q0 = qb * 256; (void)b;
    bf16x8 qf[DK / 16];
    { const bf16* qp = Qh + (size_t)(q0 + 32 * w + r32) * qpitch + 8 * hi;
#pragma unroll
      for (int d0 = 0; d0 < DK / 16; ++d0) qf[d0] = *(const bf16x8*)(qp + 16 * d0); }
    unsigned sel = 0u;
    f32x16 cinit;
#pragma unroll
    for (int r = 0; r < 16; ++r) cinit[r] = 0.f;
    if constexpr (MOBA) {
        f32x16 ga = cinit;
#pragma unroll
        for (int d0 = 0; d0 < 4; ++d0) { const bf16x8 ah = *(const bf16x8*)(kmh + (r32 & 15) * 64 + 16 * d0 + 8 * hi), al = *(const bf16x8*)(kml + (r32 & 15) * 64 + 16 * d0 + 8 * hi);
            ga = FA_MFMA(ah, qf[d0], ga); ga = FA_MFMA(al, qf[d0], ga); }
        float g[16];
#pragma unroll
        for (int i = 0; i < 8; ++i) { const float mine = ga[i], oth = xother(mine, hi); const float lo_ = hi ? oth : mine, hi_ = hi ? mine : oth;
            g[(i & 3) + 8 * (i >> 2)] = lo_; g[(i & 3) + 8 * (i >> 2) + 4] = hi_; }
        float v1 = -3e38f, v2 = -3e38f, v3 = -3e38f; int i1 = -1, i2 = -1, i3 = -1;
#pragma unroll
        for (int n = 0; n < 16; ++n) if (n < qb) { const float gv = g[n];
            if (gv > v1) { v3 = v2; i3 = i2; v2 = v1; i2 = i1; v1 = gv; i1 = n; } else if (gv > v2) { v3 = v2; i3 = i2; v2 = gv; i2 = n; } else if (gv > v3) { v3 = gv; i3 = n; } }
        if (i1 >= 0) sel |= 1u << i1; if (i2 >= 0) sel |= 1u << i2; if (i3 >= 0) sel |= 1u << i3;
#pragma unroll
        for (int r = 0; r < 16; ++r) cinit[r] = slope2 * (float)crow(r, hi);
    }
    const float c32 = MOBA ? 32.f * slope2 : 0.f;
    constexpr int CPRK = KP / 16, CPRV = VP / 16, NIK = (64 * CPRK + 63) / 64, NIV = (64 * CPRV + 63) / 64;
    const char* kbase = (const char*)Kh; const char* rbase = (const char*)((DK == 96) ? KRb : Kh); const char* vbase = (const char*)Vh;
    unsigned koffs[2], voffs[2]; bool krope[2];
#pragma unroll
    for (int j = 0; j < 2; ++j) { const int pk = 64 * (w + 8 * j) + lane, rk = pk / CPRK, ck = pk % CPRK; krope[j] = (DK == 96) && ck >= 8 && ck < 12;
        koffs[j] = krope[j] ? (unsigned)(rk * 32 + (ck - 8) * 8) * 2u : (unsigned)(rk * kpitch + (ck < 8 ? ck : 0) * 8) * 2u;
        const int pv = 64 * (w + 8 * j) + lane, rv = pv / CPRV, cv = pv % CPRV; voffs[j] = (unsigned)(rv * vpitch + (cv < 8 ? cv : 0) * 8) * 2u; }
    const int vlo = tr_lane_off(lane, VP);
    const int NT = 4 * (qb + 1);
#define FA_DMA(t, slot) do { const char* kb_ = kbase + (size_t)(t) * 128 * kpitch; const char* rb_ = rbase + (size_t)(t) * 128 * 32; const char* vb_ = vbase + (size_t)(t) * 128 * vpitch; \
        _Pragma("unroll") for (int j = 0; j < 2; ++j) { const int i_ = w + 8 * j; \
            if (i_ < NIK) __builtin_amdgcn_global_load_lds((const unsigned*)((krope[j] ? rb_ : kb_) + koffs[j]), (FLAS unsigned*)(lds + (slot) * KBUF + i_ * 1024), 16, 0, 0); \
            if (i_ < NIV) __builtin_amdgcn_global_load_lds((const unsigned*)(vb_ + voffs[j]), (FLAS unsigned*)(lds + 2 * KBUF + (slot) * VBUF + i_ * 1024), 16, 0, 0); } } while (0)
#define FA_LANDED() asm volatile("s_waitcnt vmcnt(0)" ::: "memory")
    static_assert(NIK <= 16 && NIV <= 16, "two DMA instructions per wave cover a tile");
    FA_DMA(0, 0); FA_LANDED(); __syncthreads();
    float m = MOBA ? NEG : 0.f, l = 0.f; f32x16 o0, o1;
#pragma unroll
    for (int r = 0; r < 16; ++r) { o0[r] = 0.f; o1[r] = 0.f; }
    const int rowrel = 32 * w + r32;
    for (int t = 0; t < NT; ++t) {
        const int buf = t & 1;
        if (t + 1 < NT) FA_DMA(t + 1, buf ^ 1);
        const int n = t >> 2, jd = t & 3; const bool diag = (n == qb);
        bool lane_on = true; if (MOBA && !diag) lane_on = (sel >> n) & 1u;
        bool wave_on = diag ? (64 * jd <= 32 * w + 31) : (MOBA ? (__any(lane_on) != 0) : true);
        if (wave_on) {
            const FLAS char* kt = lds + buf * KBUF + r32 * KP; const FLAS char* vt = lds + 2 * KBUF + buf * VBUF + vlo;
            f32x16 s0 = qk_half<DK>(kt, hi, qf, cinit), s1 = qk_half<DK>(kt + 32 * KP, hi, qf, cinit);
            if (diag && (64 * jd + 63 > 32 * w)) {
#pragma unroll
                for (int r = 0; r < 16; ++r) { const int kr = 64 * jd + crow(r, hi); if (kr > rowrel) s0[r] = NEG; if (kr + 32 > rowrel) s1[r] = NEG; } }
            if constexpr (MOBA) {
                const float tb = slope2 * (float)(64 * t);
                float mx = xmax(fmaxf(max16(s0), max16(s1) + c32)) + tb;
                if (!lane_on) mx = NEG;
                const float mn = fmaxf(m, mx);
                if (__any(mx > m + RESC_THR)) { const float a = __builtin_amdgcn_exp2f(m - mn); l *= a;
#pragma unroll
                    for (int r = 0; r < 16; ++r) { o0[r] *= a; o1[r] *= a; }
                    m = mn; }
                const float mref0 = lane_on ? (m - tb) : POS, mref1 = mref0 - c32;
#pragma unroll
                for (int r = 0; r < 16; ++r) { s0[r] = __builtin_amdgcn_exp2f(s0[r] - mref0); s1[r] = __builtin_amdgcn_exp2f(s1[r] - mref1); }
            } else {
                const float mx = xmax(fmaxf(max16(s0), max16(s1)));
                if (t == 0 || __any(mx > RESC_THR)) { const float d = (t == 0) ? mx : fmaxf(mx, 0.f), a = __builtin_amdgcn_exp2f(-d); m += d; l *= a;
#pragma unroll
                    for (int r = 0; r < 16; ++r) { o0[r] *= a; o1[r] *= a; s0[r] -= d; s1[r] -= d; cinit[r] = -m; } }
#pragma unroll
                for (int r = 0; r < 16; ++r) { s0[r] = __builtin_amdgcn_exp2f(s0[r]); s1[r] = __builtin_amdgcn_exp2f(s1[r]); }
            }
            { float ls = 0.f;
#pragma unroll
              for (int r = 0; r < 16; ++r) ls += s0[r] + s1[r];
              l += ls; }
            pv_half_tr(o0, o1, vt, VP, s0); pv_half_tr(o0, o1, vt + 32 * VP, VP, s1);
        }
        FA_LANDED();
        __syncthreads();
    }
#undef FA_DMA
#undef FA_LANDED
    const float lt = xsum(l);
    store_o(Oh + (size_t)(q0 + 32 * w + r32) * DM, o0, o1, 1.0f / lt, hi);
}

#define SBAR() __builtin_amdgcn_sched_barrier(0)
#define FA_WAIT_BAR(N) asm volatile("s_waitcnt vmcnt(" #N ") lgkmcnt(0)\n\ts_barrier" ::: "memory")
__device__ __forceinline__ void glds16(const void* gsrc, unsigned lds_dst) { unsigned keep;
    asm volatile("s_mov_b32 %0, m0\n\ts_mov_b32 m0, %2\n\ts_nop 0\n\tglobal_load_lds_dwordx4 %1, off\n\ts_mov_b32 m0, %0" : "=&s"(keep) : "v"(gsrc), "s"(lds_dst) : "memory"); }
__device__ __forceinline__ void kload8(bf16x8* kf, const FLAS char* kp) {
    kf[0] = *(const FLAS bf16x8*)(kp);        kf[1] = *(const FLAS bf16x8*)(kp + 512);
    kf[2] = *(const FLAS bf16x8*)(kp + 2048); kf[3] = *(const FLAS bf16x8*)(kp + 2560);
    kf[4] = *(const FLAS bf16x8*)(kp + 4096); kf[5] = *(const FLAS bf16x8*)(kp + 4608);
    kf[6] = *(const FLAS bf16x8*)(kp + 6144); kf[7] = *(const FLAS bf16x8*)(kp + 6656); }
__device__ __forceinline__ void kload2(bf16x8* kf, const FLAS char* kp, int j) { kf[2 * j] = *(const FLAS bf16x8*)(kp + j * 2048); kf[2 * j + 1] = *(const FLAS bf16x8*)(kp + j * 2048 + 512); }
#define MX3(a, b, c) __builtin_fmaxf(__builtin_fmaxf((a), (b)), (c))
__device__ __forceinline__ float rowmax_c(const f32x16& p0, const f32x16& p1, float c32) {
    float a = MX3(p0[0], p0[1], p0[2]), b = MX3(p1[0], p1[1], p1[2]);
#pragma unroll
    for (int r = 3; r < 15; r += 2) { a = MX3(a, p0[r], p0[r + 1]); b = MX3(b, p1[r], p1[r + 1]); }
    a = __builtin_fmaxf(a, p0[15]); b = __builtin_fmaxf(b, p1[15]);
    return xmax(__builtin_fmaxf(a, b + c32)); }
template <int THRL>
__device__ __forceinline__ void moba_unit(FLAS char* lds, int tid_in, int qb_in, const bf16* Qh, const bf16* Kh, const bf16* Vh, bf16* Oh, const bf16* kmh, const bf16* kml, float slope2_in) {
    constexpr int SLOTB = 8192, NSLOT = 3, L_K = 0, L_V = NSLOT * SLOTB, L_WS = 2 * NSLOT * SLOTB, L_OST = 0;
    int tid = tid_in; asm volatile("" : "+v"(tid));
    const int lane = tid & 63, wid = __builtin_amdgcn_readfirstlane(tid >> 6), r32 = lane & 31, hi = lane >> 5;
    const int qb = __builtin_amdgcn_readfirstlane(qb_in), q0 = qb * 256;
    const float slope2 = __builtin_bit_cast(float, __builtin_amdgcn_readfirstlane(__builtin_bit_cast(int, slope2_in)));
    const float c32 = 32.f * slope2, hb = slope2 * (float)(4 * hi);
    const unsigned lds0 = (unsigned)(uintptr_t)lds;
    FLAS float* wsf = (FLAS float*)(lds + L_WS) + wid * 64;
    const bf16* ksrc = Kh + (size_t)lane * 64 + wid * 8;
    const bf16* vsrc = Vh + (size_t)(16 * (wid & 3) + (lane >> 2)) * 64 + (wid >> 2) * 32 + (lane & 3) * 8;
    const unsigned kdst = lds0 + L_K + wid * 1024, vdst = lds0 + L_V + wid * 1024;
#define DMA_K(t, slot) glds16(ksrc + (size_t)(t) * 4096, (unsigned)__builtin_amdgcn_readfirstlane(kdst + (slot)))
#define DMA_V(t, slot) glds16(vsrc + (size_t)(t) * 4096, (unsigned)__builtin_amdgcn_readfirstlane(vdst + (slot)))
    const FLAS char* kp0 = lds + L_K + hi * 1024 + r32 * 16;
    const FLAS char* vp0 = lds + L_V + ((lane >> 4) & 1) * 32 + (lane & 3) * 8 + (4 * hi + ((lane & 15) >> 2)) * 64;
    const int NT = 4 * (qb + 1);
    DMA_K(0, 0); DMA_V(0, 0); DMA_K(1, SLOTB);
    bf16x8 qr[4];
    { const bf16* qp = Qh + (size_t)(q0 + 32 * wid + r32) * 64 + 8 * hi;
#pragma unroll
      for (int d0 = 0; d0 < 4; ++d0) qr[d0] = *(const bf16x8*)(qp + 16 * d0); }
    DMA_K(2, 2 * SLOTB);
    unsigned selq = 1u << qb;
    { f32x16 ga;
#pragma unroll
      for (int r = 0; r < 16; ++r) ga[r] = 0.f;
#pragma unroll
      for (int d0 = 0; d0 < 4; ++d0) { const bf16x8 ah = *(const bf16x8*)(kmh + (r32 & 15) * 64 + 16 * d0 + 8 * hi), al = *(const bf16x8*)(kml + (r32 & 15) * 64 + 16 * d0 + 8 * hi);
          ga = FA_MFMA(ah, qr[d0], ga); ga = FA_MFMA(al, qr[d0], ga); }
      float g[16];
#pragma unroll
      for (int i = 0; i < 8; ++i) { const float mine = ga[i], oth = xother(mine, hi); const float lo_ = hi ? oth : mine, hi_ = hi ? mine : oth;
          g[(i & 3) + 8 * (i >> 2)] = lo_; g[(i & 3) + 8 * (i >> 2) + 4] = hi_; }
      float v1 = -3e38f, v2 = -3e38f, v3 = -3e38f; int i1 = -1, i2 = -1, i3 = -1;
#pragma unroll
      for (int n = 0; n < 16; ++n) if (n < qb) { const float gv = g[n];
          if (gv > v1) { v3 = v2; i3 = i2; v2 = v1; i2 = i1; v1 = gv; i1 = n; } else if (gv > v2) { v3 = v2; i3 = i2; v2 = gv; i2 = n; } else if (gv > v3) { v3 = gv; i3 = n; } }
      if (i1 >= 0) selq |= 1u << i1; if (i2 >= 0) selq |= 1u << i2; if (i3 >= 0) selq |= 1u << i3; }
    float mhat = 0.f, l_reg = 0.f; f32x16 o[2];
#pragma unroll
    for (int r = 0; r < 16; ++r) { o[0][r] = 0.f; o[1][r] = 0.f; }
    f32x16 nb;
    float negbig = -1.0e30f; asm volatile("" : "+v"(negbig));
#define NB_BASE(tt) ((((selq >> ((tt) >> 2)) & 1u) ? (slope2 * (float)(64 * (tt)) - mhat) : negbig) + hb)
#define NB_SET(r, base) nb[r] = __builtin_fmaf(slope2, (float)(((r) & 3) + 8 * ((r) >> 2)), (base))
    { const float b0_ = NB_BASE(0);
#pragma unroll
      for (int r = 0; r < 16; ++r) NB_SET(r, b0_); }
    const int qrel = wid * 32 + r32;
#define CMASK(P0, P1, t) do { const int jb_ = (t) - (NT - 4); if (jb_ >= 0) { const int kb_ = 64 * jb_ + 4 * hi; _Pragma("unroll") for (int r = 0; r < 16; ++r) { const int kv_ = kb_ + (r & 3) + 8 * (r >> 2); if (kv_ > qrel) P0[r] = -INFINITY; if (kv_ + 32 > qrel) P1[r] = -INFINITY; } } } while (0)
    bool resc = false;
#define RESC() do { if (resc) { asm volatile("s_waitcnt lgkmcnt(0)" ::: "memory"); \
        _Pragma("unroll") for (int d_ = 0; d_ < 2; ++d_) _Pragma("unroll") for (int r = 0; r < 16; ++r) o[d_][r] *= wsf[crow(r, hi)]; } } while (0)
    f32x16 pA0, pA1, pB0, pB1; bf16x8 kf[8];
    int sl_prev = 0, sl_cur = 0, sl_next = SLOTB;
#define ROT() do { sl_prev = sl_cur; sl_cur = sl_next; sl_next = (sl_next == (NSLOT - 1) * SLOTB) ? 0 : sl_next + SLOTB; } while (0)
    FA_WAIT_BAR(3);
    { const FLAS char* kb = lds + L_K + hi * 1024 + r32 * 16;
#pragma unroll
      for (int d0 = 0; d0 < 4; ++d0) { const bf16x8 b0 = *(const FLAS bf16x8*)(kb + d0 * 2048), b1 = *(const FLAS bf16x8*)(kb + d0 * 2048 + 512);
          if (d0 == 0) { pA0 = FA_MFMA(b0, qr[0], nb); pA1 = FA_MFMA(b1, qr[0], nb); } else { pA0 = FA_MFMA(b0, qr[d0], pA0); pA1 = FA_MFMA(b1, qr[d0], pA1); } } }
    CMASK(pA0, pA1, 0);
    { const float rm = rowmax_c(pA0, pA1, c32); const float dl = (selq & 1u) ? rm : 0.f; mhat = dl;
#pragma unroll
      for (int r = 0; r < 16; ++r) { pA0[r] = __builtin_amdgcn_exp2f(pA0[r] - dl); pA1[r] = __builtin_amdgcn_exp2f(pA1[r] - dl + c32); }
      const float b1_ = NB_BASE(1);
#pragma unroll
      for (int r = 0; r < 16; ++r) NB_SET(r, b1_); }
    FA_WAIT_BAR(0);
    DMA_K(3, 0); DMA_V(1, SLOTB);
    ROT();
    kload8(kf, kp0 + sl_cur);
    FA_WAIT_BAR(2);
    s16x4 vlo[8], vhi[8]; v4u pw0, pw1, pw2, pw3;
#define PKW(P, B) pg8::cvt_pk_bf16(P[B], P[(B) + 1])
#define PAF(k) __builtin_bit_cast(bf16x8, pw##k)
#define VFR(i) (bf16x8){vlo[i][0], vlo[i][1], vlo[i][2], vlo[i][3], vhi[i][0], vhi[i][1], vhi[i][2], vhi[i][3]}
#define PIN(x) asm volatile("" : "+v"(x))
#define GAPA(MF, A0, A1, A2, A3, W0, W1, PW) do { MF; sacc += A0; sacc += A1; sacc += A2; sacc += A3; PIN(sacc); W0; W1; PIN(PW); SBAR(); } while (0)
#define EX(v) __builtin_amdgcn_exp2f(v)
#define GAPB0(MF, X, B, R0) do { MF; X[B] = EX(X[B]); X[(B) + 1] = EX(X[(B) + 1]); X[(B) + 2] = EX(X[(B) + 2]); X[(B) + 3] = EX(X[(B) + 3]); NB_SET(R0, nbase_); NB_SET((R0) + 1, nbase_); PIN(X); PIN(nb); SBAR(); } while (0)
#define GAPB1(MF, X, B, R0) do { MF; X[B] = EX(X[B] + c32); X[(B) + 1] = EX(X[(B) + 1] + c32); X[(B) + 2] = EX(X[(B) + 2] + c32); X[(B) + 3] = EX(X[(B) + 3] + c32); NB_SET(R0, nbase_); NB_SET((R0) + 1, nbase_); PIN(X); PIN(nb); SBAR(); } while (0)
#define VRD(i) do { vlo[i] = vtr(vp_ + (((i) >> 2) * 4096 + ((i) & 3) * 1024)); vhi[i] = vtr(vp_ + (((i) >> 2) * 4096 + ((i) & 3) * 1024 + 512)); } while (0)
#define KRD(G, j) do { if (G) { kload2(kf, kp0 + sl_next, j); SBAR(); } } while (0)
#define STEP(C0, C1, P0, P1, t, GK, GV, GL) do { SBAR(); \
    const FLAS char* vp_ = vp0 + sl_prev; \
    VRD(0); SBAR(); float sacc = (P0[0] + P0[1]); \
    GAPA(C0 = FA_MFMA(kf[0], qr[0], nb), P0[2], P0[3], P0[4], P0[5],     pw0[0] = PKW(P0, 0), pw0[1] = PKW(P0, 2), pw0); \
    VRD(4); SBAR(); GAPA(C1 = FA_MFMA(kf[1], qr[0], nb), P0[6], P0[7], P0[8], P0[9],     pw0[2] = PKW(P0, 4), pw0[3] = PKW(P0, 6), pw0); \
    VRD(1); SBAR(); GAPA(C0 = FA_MFMA(kf[2], qr[1], C0),   P0[10], P0[11], P0[12], P0[13], pw1[0] = PKW(P0, 8), pw1[1] = PKW(P0, 10), pw1); \
    VRD(5); SBAR(); GAPA(C1 = FA_MFMA(kf[3], qr[1], C1),   P0[14], P0[15], P1[0], P1[1],   pw1[2] = PKW(P0, 12), pw1[3] = PKW(P0, 14), pw1); \
    VRD(2); SBAR(); GAPA(C0 = FA_MFMA(kf[4], qr[2], C0),   P1[2], P1[3], P1[4], P1[5],     pw2[0] = PKW(P1, 0), pw2[1] = PKW(P1, 2), pw2); \
    VRD(6); SBAR(); GAPA(C1 = FA_MFMA(kf[5], qr[2], C1),   P1[6], P1[7], P1[8], P1[9],     pw2[2] = PKW(P1, 4), pw2[3] = PKW(P1, 6), pw2); \
    VRD(3); SBAR(); GAPA(C0 = FA_MFMA(kf[6], qr[3], C0),   P1[10], P1[11], P1[12], P1[13], pw3[0] = PKW(P1, 8), pw3[1] = PKW(P1, 10), pw3); \
    VRD(7); SBAR(); GAPA(C1 = FA_MFMA(kf[7], qr[3], C1),   P1[14], P1[15], 0.f, 0.f,       pw3[2] = PKW(P1, 12), pw3[3] = PKW(P1, 14), pw3); \
    l_reg += sacc; \
    if (GK) { DMA_K((t) + 3, sl_cur); } if (GV) { DMA_V((t) + 1, sl_next); } \
    CMASK(C0, C1, t); \
    { const float rm = rowmax_c(C0, C1, c32); \
      resc = false; \
      if (__builtin_expect(__any(rm > (float)THRL), 0)) { const float dl = __builtin_fmaxf(rm, 0.f); mhat += dl; \
        _Pragma("unroll") for (int r = 0; r < 16; ++r) { C0[r] -= dl; C1[r] -= dl; } \
        const float f = __builtin_amdgcn_exp2f(-dl); l_reg *= f; if (hi == 0) wsf[r32] = f; resc = true; } } \
    const float nbase_ = NB_BASE((t) + 1); \
    SBAR(); \
    GAPB0(o[0] = FA_MFMA(PAF(0), VFR(0), o[0]), C0, 0, 0); \
    GAPB0(o[1] = FA_MFMA(PAF(0), VFR(4), o[1]), C0, 4, 2); \
    KRD(GL, 0); GAPB0(o[0] = FA_MFMA(PAF(1), VFR(1), o[0]), C0, 8, 4); \
    KRD(GL, 1); GAPB0(o[1] = FA_MFMA(PAF(1), VFR(5), o[1]), C0, 12, 6); \
    KRD(GL, 2); GAPB1(o[0] = FA_MFMA(PAF(2), VFR(2), o[0]), C1, 0, 8); \
    KRD(GL, 3); GAPB1(o[1] = FA_MFMA(PAF(2), VFR(6), o[1]), C1, 4, 10); \
    GAPB1(o[0] = FA_MFMA(PAF(3), VFR(3), o[0]), C1, 8, 12); \
    GAPB1(o[1] = FA_MFMA(PAF(3), VFR(7), o[1]), C1, 12, 14); \
    } while (0)
    int t = 1;
#undef CMASK
#define CMASK(P0, P1, t) do { } while (0)
    for (; t + 5 < NT; t += 2) {
        STEP(pB0, pB1, pA0, pA1, t, true, true, true);       FA_WAIT_BAR(2); RESC(); ROT();
        STEP(pA0, pA1, pB0, pB1, t + 1, true, true, true);   FA_WAIT_BAR(2); RESC(); ROT();
    }
#undef CMASK
#define CMASK(P0, P1, t) do { const int jb_ = (t) - (NT - 4); if (jb_ >= 0) { const int kb_ = 64 * jb_ + 4 * hi; _Pragma("unroll") for (int r = 0; r < 16; ++r) { const int kv_ = kb_ + (r & 3) + 8 * (r >> 2); if (kv_ > qrel) P0[r] = -INFINITY; if (kv_ + 32 > qrel) P1[r] = -INFINITY; } } } while (0)
#define ENDW(tt) do { if ((tt) + 3 < NT) { FA_WAIT_BAR(2); } else if ((tt) + 2 < NT) { FA_WAIT_BAR(1); } else { FA_WAIT_BAR(0); } } while (0)
    for (; t + 1 < NT; t += 2) {
        STEP(pB0, pB1, pA0, pA1, t, (t + 3 < NT), (t + 1 < NT), (t + 1 < NT));         ENDW(t);     RESC(); ROT();
        STEP(pA0, pA1, pB0, pB1, t + 1, (t + 4 < NT), (t + 2 < NT), (t + 2 < NT));     ENDW(t + 1); RESC(); ROT();
    }
    STEP(pB0, pB1, pA0, pA1, NT - 1, false, false, false); RESC();
    { float sacc = pB0[0] + pB0[1];
#pragma unroll
      for (int r = 2; r < 16; ++r) sacc += pB0[r];
#pragma unroll
      for (int r = 0; r < 16; ++r) sacc += pB1[r];
      l_reg += sacc;
      pw0 = (v4u){PKW(pB0, 0), PKW(pB0, 2), PKW(pB0, 4), PKW(pB0, 6)}; pw1 = (v4u){PKW(pB0, 8), PKW(pB0, 10), PKW(pB0, 12), PKW(pB0, 14)};
      pw2 = (v4u){PKW(pB1, 0), PKW(pB1, 2), PKW(pB1, 4), PKW(pB1, 6)}; pw3 = (v4u){PKW(pB1, 8), PKW(pB1, 10), PKW(pB1, 12), PKW(pB1, 14)};
      SBAR();
      const FLAS char* vp_ = vp0 + sl_cur;
#pragma unroll
      for (int i = 0; i < 8; ++i) VRD(i);
      o[0] = FA_MFMA(PAF(0), VFR(0), o[0]); o[0] = FA_MFMA(PAF(1), VFR(1), o[0]); o[0] = FA_MFMA(PAF(2), VFR(2), o[0]); o[0] = FA_MFMA(PAF(3), VFR(3), o[0]);
      o[1] = FA_MFMA(PAF(0), VFR(4), o[1]); o[1] = FA_MFMA(PAF(1), VFR(5), o[1]); o[1] = FA_MFMA(PAF(2), VFR(6), o[1]); o[1] = FA_MFMA(PAF(3), VFR(7), o[1]); }
    l_reg = xsum(l_reg);
    if (hi == 0) wsf[32 + r32] = l_reg;
    asm volatile("s_waitcnt lgkmcnt(0)\n\ts_barrier" ::: "memory");
    float rli[16];
#pragma unroll
    for (int r = 0; r < 16; ++r) rli[r] = __builtin_amdgcn_rcpf(wsf[32 + crow(r, hi)]);
    { FLAS bf16* stg = (FLAS bf16*)(lds + L_OST) + wid * 2048;
#pragma unroll
      for (int r = 0; r < 16; ++r) { const int orow = crow(r, hi);
#pragma unroll
          for (int d0 = 0; d0 < 2; ++d0) stg[orow * 64 + d0 * 32 + r32] = (bf16)f2bf(o[d0][r] * rli[r]); }
      asm volatile("s_waitcnt lgkmcnt(0)" ::: "memory");
      bf16* Ow = Oh + (size_t)(q0 + wid * 32) * DM;
#pragma unroll
      for (int i = 0; i < 4; ++i) { const int row = i * 8 + (lane >> 3), ch = lane & 7; const v4u v = *(const FLAS v4u*)(stg + row * 64 + ch * 8); *(v4u*)(Ow + (size_t)row * DM + ch * 8) = v; } }
    asm volatile("s_waitcnt lgkmcnt(0)\n\ts_barrier" ::: "memory");
#undef DMA_K
#undef DMA_V
#undef NB_BASE
#undef NB_SET
#undef CMASK
#undef RESC
#undef ROT
#undef PKW
#undef PAF
#undef VFR
#undef PIN
#undef GAPA
#undef EX
#undef GAPB0
#undef GAPB1
#undef VRD
#undef KRD
#undef STEP
#undef ENDW
}

template <int THRL>
__device__ __forceinline__ void mla_unit(FLAS char* lds, int tid_in, int qb_in, const bf16* Qh, const bf16* Kh, const bf16* KRb, const bf16* Vh, bf16* Oh) {
    constexpr int KSLOT = 12288, VSLOT = 8192, NSLOT = 3, L_K = 0, L_V = NSLOT * KSLOT, L_WS = L_V + NSLOT * VSLOT, L_OST = 0;
    int tid = tid_in; asm volatile("" : "+v"(tid));
    const int lane = tid & 63, wid = __builtin_amdgcn_readfirstlane(tid >> 6), r32 = lane & 31, hi = lane >> 5;
    const int qb = __builtin_amdgcn_readfirstlane(qb_in), q0 = qb * 256;
    const unsigned lds0 = (unsigned)(uintptr_t)lds;
    FLAS float* wsf = (FLAS float*)(lds + L_WS) + wid * 64;
    const bf16* ksrc = Kh + (size_t)lane * 64 + wid * 8;
    const bf16* rsrc = KRb + (size_t)lane * 32 + (wid & 3) * 8;
    const bf16* vsrc = Vh + (size_t)(16 * (wid & 3) + (lane >> 2)) * 64 + (wid >> 2) * 32 + (lane & 3) * 8;
    const unsigned kdst = lds0 + L_K + wid * 1024, rdst = lds0 + L_K + (8 + (wid & 3)) * 1024, vdst = lds0 + L_V + wid * 1024;
    const bool ropew = wid < 4;
#define DMA_K(t, slot) do { glds16(ksrc + (size_t)(t) * 4096, (unsigned)__builtin_amdgcn_readfirstlane(kdst + (slot))); if (ropew) glds16(rsrc + (size_t)(t) * 2048, (unsigned)__builtin_amdgcn_readfirstlane(rdst + (slot))); } while (0)
#define DMA_V(t, slot) glds16(vsrc + (size_t)(t) * 4096, (unsigned)__builtin_amdgcn_readfirstlane(vdst + (slot)))
    const FLAS char* kp0 = lds + L_K + hi * 1024 + r32 * 16;
    const FLAS char* vp0 = lds + L_V + ((lane >> 4) & 1) * 32 + (lane & 3) * 8 + (4 * hi + ((lane & 15) >> 2)) * 64;
    const int NT = 4 * (qb + 1);
    DMA_K(0, 0); DMA_V(0, 0); DMA_K(1, KSLOT);
    bf16x8 qr[6];
    { const bf16* qp = Qh + (size_t)(q0 + 32 * wid + r32) * 96 + 8 * hi;
#pragma unroll
      for (int d0 = 0; d0 < 6; ++d0) qr[d0] = *(const bf16x8*)(qp + 16 * d0); }
    DMA_K(2, 2 * KSLOT);
    float mhat = 0.f, l_reg = 0.f; f32x16 o[2], negm;
#pragma unroll
    for (int r = 0; r < 16; ++r) { o[0][r] = 0.f; o[1][r] = 0.f; negm[r] = 0.f; }
    asm volatile("" : "+v"(negm));
    const int qrel = wid * 32 + r32;
#define CMASK(P0, P1, t) do { const int jb_ = (t) - (NT - 4); if (jb_ >= 0) { const int kb_ = 64 * jb_ + 4 * hi; _Pragma("unroll") for (int r = 0; r < 16; ++r) { const int kv_ = kb_ + (r & 3) + 8 * (r >> 2); if (kv_ > qrel) P0[r] = -INFINITY; if (kv_ + 32 > qrel) P1[r] = -INFINITY; } } } while (0)
    bool resc = false;
#define RESC() do { if (resc) { asm volatile("s_waitcnt lgkmcnt(0)" ::: "memory"); \
        _Pragma("unroll") for (int d_ = 0; d_ < 2; ++d_) _Pragma("unroll") for (int r = 0; r < 16; ++r) o[d_][r] *= wsf[crow(r, hi)]; } } while (0)
    f32x16 pA0, pA1, pB0, pB1; bf16x8 kf[12];
    int ks_cur = 0, ks_next = KSLOT, vs_prev = 0, vs_cur = 0, vs_next = VSLOT;
#define ROT() do { ks_cur = ks_next; ks_next = (ks_next == (NSLOT - 1) * KSLOT) ? 0 : ks_next + KSLOT; vs_prev = vs_cur; vs_cur = vs_next; vs_next = (vs_next == (NSLOT - 1) * VSLOT) ? 0 : vs_next + VSLOT; } while (0)
    FA_WAIT_BAR(0);
    { const FLAS char* kb = lds + L_K + hi * 1024 + r32 * 16;
#pragma unroll
      for (int d0 = 0; d0 < 6; ++d0) { const bf16x8 b0 = *(const FLAS bf16x8*)(kb + d0 * 2048), b1 = *(const FLAS bf16x8*)(kb + d0 * 2048 + 512);
          if (d0 == 0) { pA0 = FA_MFMA(b0, qr[0], negm); pA1 = FA_MFMA(b1, qr[0], negm); } else { pA0 = FA_MFMA(b0, qr[d0], pA0); pA1 = FA_MFMA(b1, qr[d0], pA1); } } }
    CMASK(pA0, pA1, 0);
    { const float rm = rowmax_c(pA0, pA1, 0.f); mhat = rm;
#pragma unroll
      for (int r = 0; r < 16; ++r) { pA0[r] = __builtin_amdgcn_exp2f(pA0[r] - rm); pA1[r] = __builtin_amdgcn_exp2f(pA1[r] - rm); }
#pragma unroll
      for (int r = 0; r < 16; ++r) negm[r] = -mhat;
      asm volatile("" : "+v"(negm)); }
    FA_WAIT_BAR(0);
    DMA_K(3, 0); DMA_V(1, VSLOT);
    ROT();
#pragma unroll
    for (int j = 0; j < 6; ++j) kload2(kf, kp0 + ks_cur, j);
    if (ropew) { FA_WAIT_BAR(3); } else { FA_WAIT_BAR(2); }
    s16x4 vlo[8], vhi[8]; v4u pw0, pw1, pw2, pw3;
#define PKW(P, B) pg8::cvt_pk_bf16(P[B], P[(B) + 1])
#define PAF(k) __builtin_bit_cast(bf16x8, pw##k)
#define VFR(i) (bf16x8){vlo[i][0], vlo[i][1], vlo[i][2], vlo[i][3], vhi[i][0], vhi[i][1], vhi[i][2], vhi[i][3]}
#define PIN(x) asm volatile("" : "+v"(x))
#define GAPA(MF, A0, A1, A2, W0, W1, PW) do { MF; sacc += A0; sacc += A1; sacc += A2; PIN(sacc); W0; W1; PIN(PW); SBAR(); } while (0)
#define GAPA0(MF, A0, A1, A2) do { MF; sacc += A0; sacc += A1; sacc += A2; PIN(sacc); SBAR(); } while (0)
#define EX(v) __builtin_amdgcn_exp2f(v)
#define GAPB(MF, X, B) do { MF; X[B] = EX(X[B]); X[(B) + 1] = EX(X[(B) + 1]); X[(B) + 2] = EX(X[(B) + 2]); X[(B) + 3] = EX(X[(B) + 3]); PIN(X); SBAR(); } while (0)
#define VRD(i) do { vlo[i] = vtr(vp_ + (((i) >> 2) * 4096 + ((i) & 3) * 1024)); vhi[i] = vtr(vp_ + (((i) >> 2) * 4096 + ((i) & 3) * 1024 + 512)); } while (0)
#define KRD(G, j) do { if (G) { kload2(kf, kp0 + ks_next, j); SBAR(); } } while (0)
#define STEP(C0, C1, P0, P1, t, GK, GV, GL) do { SBAR(); \
    const FLAS char* vp_ = vp0 + vs_prev; \
    float sacc = (P0[0] + P0[1]); \
    GAPA(C0 = FA_MFMA(kf[0], qr[0], negm), P0[2], P0[3], P0[4],      pw0[0] = PKW(P0, 0), pw0[1] = PKW(P0, 2), pw0); \
    GAPA(C1 = FA_MFMA(kf[1], qr[0], negm), P0[5], P0[6], P0[7],      pw0[2] = PKW(P0, 4), pw0[3] = PKW(P0, 6), pw0); \
    GAPA(C0 = FA_MFMA(kf[2], qr[1], C0),   P0[8], P0[9], P0[10],     pw1[0] = PKW(P0, 8), pw1[1] = PKW(P0, 10), pw1); \
    GAPA(C1 = FA_MFMA(kf[3], qr[1], C1),   P0[11], P0[12], P0[13],   pw1[2] = PKW(P0, 12), pw1[3] = PKW(P0, 14), pw1); \
    VRD(0); SBAR(); GAPA(C0 = FA_MFMA(kf[4], qr[2], C0),   P0[14], P0[15], P1[0],    pw2[0] = PKW(P1, 0), pw2[1] = PKW(P1, 2), pw2); \
    VRD(4); SBAR(); GAPA(C1 = FA_MFMA(kf[5], qr[2], C1),   P1[1], P1[2], P1[3],      pw2[2] = PKW(P1, 4), pw2[3] = PKW(P1, 6), pw2); \
    VRD(1); SBAR(); GAPA(C0 = FA_MFMA(kf[6], qr[3], C0),   P1[4], P1[5], P1[6],      pw3[0] = PKW(P1, 8), pw3[1] = PKW(P1, 10), pw3); \
    VRD(5); SBAR(); GAPA(C1 = FA_MFMA(kf[7], qr[3], C1),   P1[7], P1[8], P1[9],      pw3[2] = PKW(P1, 12), pw3[3] = PKW(P1, 14), pw3); \
    VRD(2); SBAR(); GAPA0(C0 = FA_MFMA(kf[8], qr[4], C0),   P1[10], P1[11], P1[12]); \
    VRD(6); SBAR(); GAPA0(C1 = FA_MFMA(kf[9], qr[4], C1),   P1[13], P1[14], P1[15]); \
    VRD(3); SBAR(); C0 = FA_MFMA(kf[10], qr[5], C0); SBAR(); \
    VRD(7); SBAR(); C1 = FA_MFMA(kf[11], qr[5], C1); SBAR(); \
    l_reg += sacc; \
    if (GK) { DMA_K((t) + 3, ks_cur); } if (GV) { DMA_V((t) + 1, vs_next); } \
    CMASK(C0, C1, t); \
    { const float rm = rowmax_c(C0, C1, 0.f); \
      resc = false; \
      if (__builtin_expect(__any(rm > (float)THRL), 0)) { const float dl = __builtin_fmaxf(rm, 0.f); mhat += dl; \
        _Pragma("unroll") for (int r = 0; r < 16; ++r) { C0[r] -= dl; C1[r] -= dl; } \
        _Pragma("unroll") for (int r = 0; r < 16; ++r) negm[r] = -mhat; asm volatile("" : "+v"(negm)); \
        const float f = __builtin_amdgcn_exp2f(-dl); l_reg *= f; if (hi == 0) wsf[r32] = f; resc = true; } } \
    SBAR(); \
    GAPB(o[0] = FA_MFMA(PAF(0), VFR(0), o[0]), C0, 0); \
    KRD(GL, 0); GAPB(o[1] = FA_MFMA(PAF(0), VFR(4), o[1]), C0, 4); \
    KRD(GL, 1); GAPB(o[0] = FA_MFMA(PAF(1), VFR(1), o[0]), C0, 8); \
    KRD(GL, 2); GAPB(o[1] = FA_MFMA(PAF(1), VFR(5), o[1]), C0, 12); \
    KRD(GL, 3); GAPB(o[0] = FA_MFMA(PAF(2), VFR(2), o[0]), C1, 0); \
    KRD(GL, 4); GAPB(o[1] = FA_MFMA(PAF(2), VFR(6), o[1]), C1, 4); \
    KRD(GL, 5); GAPB(o[0] = FA_MFMA(PAF(3), VFR(3), o[0]), C1, 8); \
    GAPB(o[1] = FA_MFMA(PAF(3), VFR(7), o[1]), C1, 12); \
    } while (0)
#define ENDW(tt) do { const bool gk_ = (tt) + 3 < NT, gv_ = (tt) + 1 < NT; \
        if (gk_ && gv_) { if (ropew) { FA_WAIT_BAR(3); } else { FA_WAIT_BAR(2); } } \
        else if ((tt) + 2 < NT) { FA_WAIT_BAR(1); } \
        else { FA_WAIT_BAR(0); } } while (0)
    int t = 1;
#undef CMASK
#define CMASK(P0, P1, t) do { } while (0)
    for (; t + 5 < NT; t += 2) {
        STEP(pB0, pB1, pA0, pA1, t, true, true, true);       ENDW(t);     RESC(); ROT();
        STEP(pA0, pA1, pB0, pB1, t + 1, true, true, true);   ENDW(t + 1); RESC(); ROT();
    }
#undef CMASK
#define CMASK(P0, P1, t) do { const int jb_ = (t) - (NT - 4); if (jb_ >= 0) { const int kb_ = 64 * jb_ + 4 * hi; _Pragma("unroll") for (int r = 0; r < 16; ++r) { const int kv_ = kb_ + (r & 3) + 8 * (r >> 2); if (kv_ > qrel) P0[r] = -INFINITY; if (kv_ + 32 > qrel) P1[r] = -INFINITY; } } } while (0)
    for (; t + 1 < NT; t += 2) {
        STEP(pB0, pB1, pA0, pA1, t, (t + 3 < NT), (t + 1 < NT), (t + 1 < NT));         ENDW(t);     RESC(); ROT();
        STEP(pA0, pA1, pB0, pB1, t + 1, (t + 4 < NT), (t + 2 < NT), (t + 2 < NT));     ENDW(t + 1); RESC(); ROT();
    }
    STEP(pB0, pB1, pA0, pA1, NT - 1, false, false, false); RESC();
    { float sacc = pB0[0] + pB0[1];
#pragma unroll
      for (int r = 2; r < 16; ++r) sacc += pB0[r];
#pragma unroll
      for (int r = 0; r < 16; ++r) sacc += pB1[r];
      l_reg += sacc;
      pw0 = (v4u){PKW(pB0, 0), PKW(pB0, 2), PKW(pB0, 4), PKW(pB0, 6)}; pw1 = (v4u){PKW(pB0, 8), PKW(pB0, 10), PKW(pB0, 12), PKW(pB0, 14)};
      pw2 = (v4u){PKW(pB1, 0), PKW(pB1, 2), PKW(pB1, 4), PKW(pB1, 6)}; pw3 = (v4u){PKW(pB1, 8), PKW(pB1, 10), PKW(pB1, 12), PKW(pB1, 14)};
      SBAR();
      const FLAS char* vp_ = vp0 + vs_cur;
#pragma unroll
      for (int i = 0; i < 8; ++i) VRD(i);
      o[0] = FA_MFMA(PAF(0), VFR(0), o[0]); o[0] = FA_MFMA(PAF(1), VFR(1), o[0]); o[0] = FA_MFMA(PAF(2), VFR(2), o[0]); o[0] = FA_MFMA(PAF(3), VFR(3), o[0]);
      o[1] = FA_MFMA(PAF(0), VFR(4), o[1]); o[1] = FA_MFMA(PAF(1), VFR(5), o[1]); o[1] = FA_MFMA(PAF(2), VFR(6), o[1]); o[1] = FA_MFMA(PAF(3), VFR(7), o[1]); }
    l_reg = xsum(l_reg);
    if (hi == 0) wsf[32 + r32] = l_reg;
    asm volatile("s_waitcnt lgkmcnt(0)\n\ts_barrier" ::: "memory");
    float rli[16];
#pragma unroll
    for (int r = 0; r < 16; ++r) rli[r] = __builtin_amdgcn_rcpf(wsf[32 + crow(r, hi)]);
    { FLAS bf16* stg = (FLAS bf16*)(lds + L_OST) + wid * 2048;
#pragma unroll
      for (int r = 0; r < 16; ++r) { const int orow = crow(r, hi);
#pragma unroll
          for (int d0 = 0; d0 < 2; ++d0) stg[orow * 64 + d0 * 32 + r32] = (bf16)f2bf(o[d0][r] * rli[r]); }
      asm volatile("s_waitcnt lgkmcnt(0)" ::: "memory");
      bf16* Ow = Oh + (size_t)(q0 + wid * 32) * DM;
#pragma unroll
      for (int i = 0; i < 4; ++i) { const int row = i * 8 + (lane >> 3), ch = lane & 7; const v4u v = *(const FLAS v4u*)(stg + row * 64 + ch * 8); *(v4u*)(Ow + (size_t)row * DM + ch * 8) = v; } }
    asm volatile("s_waitcnt lgkmcnt(0)\n\ts_barrier" ::: "memory");
#undef DMA_K
#undef DMA_V
#undef CMASK
#undef RESC
#undef ROT
#undef PKW
#undef PAF
#undef VFR
#undef PIN
#undef GAPA
#undef GAPA0
#undef EX
#undef GAPB
#undef VRD
#undef KRD
#undef STEP
#undef ENDW
}

__device__ __forceinline__ void dil_phase(FLAS char* lds, int tid_in, int bx, int G, bf16* proj, float* lse) {
    constexpr int KP = 144, VP = 192, VOFF = 384 * KP, NU = BATCH * 12 * 16;
    int tid = tid_in; asm volatile("" : "+v"(tid));
    const int lane = tid & 63, w = __builtin_amdgcn_readfirstlane(tid >> 6), r32 = lane & 31, hi = lane >> 5;
    v4u zz = (v4u){0u, 0u, 0u, 0u}; asm volatile("" : "+v"(zz));
    v4u kr[6], vr[6]; bf16x8 qn[4];
#define DIL_DECODE(u_) const int b_ = (u_) / 192, h_ = ((u_) >> 4) % 12, i16_ = (u_) & 15, g_ = h_ >> 2, dil_ = (g_ == 0) ? 1 : (g_ == 1) ? 4 : 16, nch_ = 16 / dil_, res_ = i16_ / nch_, ch_ = i16_ % nch_, m0_ = 256 * ch_; \
        const size_t rowb_ = (size_t)b_ * SEQ; const bf16* hq_ = proj + ((size_t)(b_ * HSLOTS + SL_DQ + h_) * SEQ) * 64; (void)ch_; (void)hq_
#define DIL_LOAD(u_) do { DIL_DECODE(u_); \
        _Pragma("unroll") for (int i = 0; i < 6; ++i) { const int idx = tid + 512 * i, kk = idx >> 3, kch = idx & 7, mp = m0_ - 128 + kk; kr[i] = zz; vr[i] = zz; \
            if (mp >= 0) { const bf16* p_ = hq_ + (size_t)(mp * dil_ + res_) * 64 + kch * 8; kr[i] = *(const v4u*)(p_ + (size_t)SL_DK * SEQ * 64); vr[i] = *(const v4u*)(p_ + (size_t)SL_DV * SEQ * 64); } } \
        { const size_t qtok_ = (size_t)(m0_ + 32 * w + r32) * dil_ + res_; \
          _Pragma("unroll") for (int d0 = 0; d0 < 4; ++d0) qn[d0] = *(const bf16x8*)(hq_ + qtok_ * 64 + 16 * d0 + 8 * hi); } } while (0)
    int u = bx; if (u >= NU) return;
    DIL_LOAD(u);
    for (; u < NU; u += G) {
        DIL_DECODE(u);
#pragma unroll
        for (int i = 0; i < 6; ++i) { const int idx = tid + 512 * i, kk = idx >> 3, kch = idx & 7; *(FLAS v4u*)(lds + kk * KP + kch * 16) = kr[i]; *(FLAS v4u*)(lds + VOFF + kk * VP + kch * 16) = vr[i]; }
        bf16x8 qf[4];
#pragma unroll
        for (int d0 = 0; d0 < 4; ++d0) qf[d0] = qn[d0];
        const float slope2d = exp2f(-8.0f * (float)(h_ + 1) / 18.0f) * LOG2E * (float)dil_;
        const size_t qrow = rowb_ + (size_t)(m0_ + 32 * w + r32) * dil_ + res_;
        f32x16 cinit;
#pragma unroll
        for (int r = 0; r < 16; ++r) cinit[r] = slope2d * (float)crow(r, hi);
        __syncthreads();
        if (u + G < NU) DIL_LOAD(u + G);
        f32x16 s[5]; float mx = NEG;
#pragma unroll
        for (int i = 0; i < 5; ++i) { s[i] = qk_half<64>(lds + (32 * (w + i) + r32) * KP, hi, qf, cinit);
            const bool dead = (ch_ == 0) && (w + i < 4);
#pragma unroll
            for (int r = 0; r < 16; ++r) { const int krr = crow(r, hi); bool ok = !dead; if (i == 0) ok = ok && (krr >= r32); if (i == 4) ok = ok && (krr <= r32); if (!ok) s[i][r] = NEG; }
            mx = fmaxf(mx, max16(s[i]) + (float)(32 * i) * slope2d); }
        mx = xmax(mx);
        float ls = 0.f; f32x16 o0, o1;
#pragma unroll
        for (int r = 0; r < 16; ++r) { o0[r] = 0.f; o1[r] = 0.f; }
#pragma unroll
        for (int i = 0; i < 5; ++i) { const float mref = mx - (float)(32 * i) * slope2d;
#pragma unroll
            for (int r = 0; r < 16; ++r) { s[i][r] = __builtin_amdgcn_exp2f(s[i][r] - mref); ls += s[i][r]; }
            pv_half_tr(o0, o1, lds + VOFF + (32 * (w + i)) * VP + tr_lane_off(lane, VP), VP, s[i]); }
        const float lt = xsum(ls);
        if (hi == 0) lse[qrow * 12 + h_] = mx + __builtin_amdgcn_logf(lt) - slope2d * (float)(r32 + 128);
        store_o(proj + ((size_t)(b_ * HSLOTS + SL_DQ + h_) * SEQ + (qrow - rowb_)) * 64, o0, o1, 1.0f / lt, hi);
        __syncthreads();
    }
#undef DIL_LOAD
#undef DIL_DECODE
}
#undef FA_MFMA
}

struct Args { const float* in[20]; float* out; unsigned char* ws; int ph_lo, ph_hi; };
constexpr int PH_PER_LAYER = 11, N_PHASES = 1 + DEPTH * PH_PER_LAYER + 1;

__global__ void __launch_bounds__(NWAVES * 64, 2) mk_fwd(Args args) {
    extern __shared__ __attribute__((aligned(16))) unsigned char lds[];
    Frame F;
    F.lds = (LAS unsigned char*)lds;
    F.MISC = (volatile LAS unsigned*)(F.lds + MISC_OFF);
    unsigned char* ws = args.ws;
    F.ctl = (gu32*)(ws + WS_CTL);
    for (int u = threadIdx.x; u < (LDS_BYTES - LDSCTL_OFF) / 4; u += NWAVES * 64) ((LAS unsigned*)(F.lds + LDSCTL_OFF))[u] = 0u;
    __syncthreads();
    const int wave_s = __builtin_amdgcn_readfirstlane((int)threadIdx.x >> 6);
#define MYTID() (OPQ_S(wave_s) * 64 + lane_id_volatile())
#define STAGGER() do { const unsigned long long t0_ = __builtin_amdgcn_s_memrealtime(); const unsigned long long d_ = (unsigned long long)(MK_STAGGER_TICKS) * (unsigned)((OPQ_S((int)blockIdx.x) * 5) & 7); while (__builtin_amdgcn_s_memrealtime() - t0_ < d_) __builtin_amdgcn_s_sleep(8); } while (0)
#define PHASE_LANES() int tid_ = MYTID(); asm volatile("" : "+v"(tid_)); int G_ = gridDim.x, bx_ = blockIdx.x; asm volatile("" : "+s"(G_), "+s"(bx_)); \
    const int lane = tid_ & 63, wave = __builtin_amdgcn_readfirstlane(tid_ >> 6); const int vcu_ = (G_ % 8 == 0) ? (bx_ % 8) * (G_ / 8) + bx_ / 8 : bx_; const int gw = vcu_ * NWAVES + wave, NGW = G_ * NWAVES; (void)lane; (void)gw; (void)NGW
    XcdBarrier bar; bar.bar = (unsigned*)(F.ctl + CW_BAR); bar.x = 0; bar.st = nullptr;
    if (!MK_PER_PHASE) bar = xcd_barrier_post((unsigned*)(F.ctl + CW_BAR), F.MISC + 8);
#define GRID_BAR() do { if (MK_PER_PHASE) { if (MYTID() == 0) __hip_atomic_store(F.ctl + 0, 0xBADBA0u, RLX_AGENT); } else { for (int xb_ = 0; xb_ <= MK_EXTRA_BAR; ++xb_) xcd_barrier(bar, MYTID() == 0); } } while (0)
    const int lo = args.ph_lo, hi = args.ph_hi;
#define IN(k) (lo <= (k) && (k) < hi)
#define BOTH(k) (IN(k) && IN((k) + 1))

#define PHASE_PTRS() unsigned zo_ = 0u; asm volatile("" : "+s"(zo_)); unsigned char* ws_ = args.ws + zo_;     \
    const float* x_in = args.in[0]; float* out = args.out; \
    float* cosT = (float*)(ws_ + WS_ROPE); float* sinT = cosT + SEQ * 16; float* kmean = (float*)(ws_ + WS_KMEAN); bf16* kmh = (bf16*)(ws_ + WS_KMEAN + 192 * 1024); bf16* kml = kmh + BATCH * 6 * 16 * 64; float* lse = (float*)(ws_ + WS_LSE); (void)kmh; (void)kml; (void)lse; \
    pg8::u64* rsu = (pg8::u64*)(ws_ + WS_RS); float* rsq = (float*)(ws_ + WS_RSQ); float* rskv = (float*)(ws_ + WS_RSKV); \
    bf16* Wb = (bf16*)(ws_ + WS_W); bf16* XB = (bf16*)(ws_ + WS_XB); bf16* PROJ = (bf16*)(ws_ + WS_PROJ); bf16* ACT = PROJ; bf16* GT = PROJ; \
    bf16* QM = (bf16*)(ws_ + WS_QM); bf16* KN = (bf16*)(ws_ + WS_KN); bf16* VM = (bf16*)(ws_ + WS_VM); bf16* KR = (bf16*)(ws_ + WS_KR); \
    bf16* MG = (bf16*)(ws_ + WS_MG); bf16* AO = (bf16*)(ws_ + WS_AO); \
    const pg8::bf16_t* Wgu1 = Wb + W_GU1 / 2; const pg8::bf16_t* Wd1 = Wb + W_D1 / 2; const pg8::bf16_t* Win = Wb + W_IN / 2; const pg8::bf16_t* Wg = Wb + W_G / 2; \
    const pg8::bf16_t* Wuq = Wb + W_UQ / 2; const pg8::bf16_t* Wukv = Wb + W_UKV / 2; const pg8::bf16_t* Wbr = Wb + W_BR / 2; const pg8::bf16_t* Wout = Wb + W_OUT / 2; \
    const pg8::bf16_t* Wgu2 = Wb + W_GU2 / 2; const pg8::bf16_t* Wd2 = Wb + W_D2 / 2; \
    (void)x_in; (void)out; (void)cosT; (void)sinT; (void)kmean; (void)rsu; (void)rsq; (void)rskv; (void)XB; (void)ACT; (void)GT; (void)QM; (void)KN; (void)VM; (void)KR; (void)MG; (void)AO; \
    (void)Wgu1; (void)Wd1; (void)Win; (void)Wg; (void)Wuq; (void)Wukv; (void)Wbr; (void)Wout; (void)Wgu2; (void)Wd2

    if (IN(0)) { PHASE_LANES(); PHASE_PTRS();
        for (int m = gw; m < T; m += NGW) { const GAS f32x4* xr = (const GAS f32x4*)(x_in + (size_t)m * DM) + 2 * lane; f32x4 v[4]; float s = 0.f;
#pragma unroll
            for (int j = 0; j < 4; ++j) { v[j] = xr[128 * (j >> 1) + (j & 1)]; s += (v[j].x * v[j].x + v[j].y * v[j].y) + (v[j].z * v[j].z + v[j].w * v[j].w); }
            s = wave_sum(s);
            GAS v4u* o16 = (GAS v4u*)(XB + (size_t)m * DM) + lane;
#pragma unroll
            for (int j = 0; j < 2; ++j) o16[64 * j] = (v4u){pk2(v[2 * j].x, v[2 * j].y), pk2(v[2 * j].z, v[2 * j].w), pk2(v[2 * j + 1].x, v[2 * j + 1].y), pk2(v[2 * j + 1].z, v[2 * j + 1].w)};
            if (lane == 0) rsu[m] = (pg8::u64)(s * pg8::RS_FIX); }
        for (int idx = gw * 64 + lane; idx < SEQ * 16; idx += NGW * 64) { const int pos = idx >> 4, i = idx & 15; const int a = i & 3, e = i >> 2;
            const double mm = a == 0 ? 1.0 : a == 1 ? 0.5623413251903491 : a == 2 ? 0.31622776601683794 : 0.1778279410038923;
            const double pe = e == 0 ? 1.0 : e == 1 ? 0.1 : e == 2 ? 0.01 : 0.001;
            const float inv = (float)(mm * pe); const float angf = (float)pos * inv;
            const double rev = (double)angf * 0.15915494309189535; const float fr = (float)(rev - __builtin_rint(rev));
            cosT[idx] = __builtin_amdgcn_cosf(fr); sinT[idx] = __builtin_amdgcn_sinf(fr); }
        { LAS float* scr = (LAS float*)(F.lds + RING_OFF + wave * 16384); CVT_SET_A(0, gw, NGW);
          v4u z = (v4u){0u, 0u, 0u, 0u}; asm volatile("" : "+v"(z)); const int gt = gw * 64 + lane, NTH = NGW * 64;
          for (int i = gt; i < 224 * 1024 / 8; i += NTH) *(GAS v4u*)(Wb + W_IN / 2 + (size_t)3872 * 1024 + (size_t)i * 8) = z;
          for (int i = gt; i < 192 * 256 / 8; i += NTH) *(GAS v4u*)(Wb + W_UQ / 2 + (size_t)576 * 256 + (size_t)i * 8) = z;
          for (int i = gt; i < 768 * 16; i += NTH) *(GAS v4u*)(Wb + W_UKV / 2 + (size_t)(i >> 4) * 256 + 128 + (i & 15) * 8) = z; }
        if (BOTH(0)) GRID_BAR();
    }

    for (int l = 0; l < DEPTH; ++l) {
#pragma nounroll
      for (int ph = 1; ph <= 10; ++ph) {
        if (ph == 6) continue;
        if (ph == 1) { PHASE_PTRS();
            pg8::Gemm g{XB, Wgu1, T, 2 * FF, DM, DM, DM}; pg8::StaticOrder S; S.init(T, 2 * FF, OPQ_S((int)gridDim.x), OPQ_S((int)blockIdx.x));
            pg8::EpiSwiGLU E{ACT, FF, rsu + (size_t)(3 * l + 0) * T};
            for (int rep = 0; rep < ((MK_DOUBLE & 1) ? 2 : 1); ++rep)
            pg8::gemm_phase<pg8::EpiSwiGLU, pg8::StaticOrder, true>(F.lds + RING_OFF, g, S, E, MYTID());
        }
        if (ph == 2) { PHASE_PTRS();
            pg8::Gemm g{ACT, Wd1, T, DM, FF, FF, FF}; pg8::StaticOrder S; S.init(T, DM, OPQ_S((int)gridDim.x), OPQ_S((int)blockIdx.x));
            pg8::EpiResid E{XB, rsu + (size_t)(3 * l + 1) * T, 0.5f};
            pg8::gemm_phase<pg8::EpiResid, pg8::StaticOrder, true>(F.lds + RING_OFF, g, S, E, MYTID());
        }
        if (ph == 3) { PHASE_PTRS();
            pg8::Gemm g{XB, Win, T, 4096, DM, DM, DM}; pg8::StaticOrder S; S.init(T, 4096, OPQ_S((int)gridDim.x), OPQ_S((int)blockIdx.x));
            pg8::EpiProj E{PROJ, rsu + (size_t)(3 * l + 1) * T, rsq, rskv};
            for (int rep = 0; rep < ((MK_DOUBLE & 4) ? 2 : 1); ++rep)
            pg8::gemm_phase<pg8::EpiProj, pg8::StaticOrder, true>(F.lds + RING_OFF, g, S, E, MYTID());
        }
        if (ph == 4) { PHASE_PTRS();
            { pg8::Gemm g{PROJ + PTOK_OFF, Wuq, T, 1536, 256, PTP, 256}; pg8::UpOrder S; S.init(T, 1536, OPQ_S((int)gridDim.x), OPQ_S((int)blockIdx.x));
              pg8::EpiUp E{QM, KN, VM, rsq, rskv, cosT, sinT};
              pg8::gemm_phase<pg8::EpiUp, pg8::UpOrder, true>(F.lds + RING_OFF, g, S, E, MYTID()); }
            PHASE_LANES();
            for (int idx = gw * 64 + lane; idx < T * 2; idx += NGW * 64) { const int row = idx >> 1, c = idx & 1, pos = row & (SEQ - 1);
                const v4u a1 = *(const v4u*)(PROJ + PTOK_OFF + (size_t)row * PTP + 384 + 8 * c), a2 = *(const v4u*)(PROJ + PTOK_OFF + (size_t)row * PTP + 384 + 16 + 8 * c);
                const f32x4 c0 = *(const f32x4*)(cosT + pos * 16 + 8 * c), c1 = *(const f32x4*)(cosT + pos * 16 + 8 * c + 4), s0 = *(const f32x4*)(sinT + pos * 16 + 8 * c), s1 = *(const f32x4*)(sinT + pos * 16 + 8 * c + 4);
                float t1[8], t2[8], cc[8], ss[8], o1[8], o2[8];
                t1[0] = bflo(a1.x); t1[1] = bfhi(a1.x); t1[2] = bflo(a1.y); t1[3] = bfhi(a1.y); t1[4] = bflo(a1.z); t1[5] = bfhi(a1.z); t1[6] = bflo(a1.w); t1[7] = bfhi(a1.w);
                t2[0] = bflo(a2.x); t2[1] = bfhi(a2.x); t2[2] = bflo(a2.y); t2[3] = bfhi(a2.y); t2[4] = bflo(a2.z); t2[5] = bfhi(a2.z); t2[6] = bflo(a2.w); t2[7] = bfhi(a2.w);
#pragma unroll
                for (int j = 0; j < 4; ++j) { cc[j] = c0[j]; cc[4 + j] = c1[j]; ss[j] = s0[j]; ss[4 + j] = s1[j]; }
#pragma unroll
                for (int j = 0; j < 8; ++j) { o1[j] = t1[j] * cc[j] - t2[j] * ss[j]; o2[j] = t1[j] * ss[j] + t2[j] * cc[j]; }
                *(v4u*)(KR + (size_t)row * 32 + 8 * c) = (v4u){pk2(o1[0], o1[1]), pk2(o1[2], o1[3]), pk2(o1[4], o1[5]), pk2(o1[6], o1[7])};
                *(v4u*)(KR + (size_t)row * 32 + 16 + 8 * c) = (v4u){pk2(o2[0], o2[1]), pk2(o2[2], o2[3]), pk2(o2[4], o2[5]), pk2(o2[6], o2[7])}; }
            for (int u = gw; u < BATCH * 6 * 16; u += NGW) { const int n = u & 15, bh = u >> 4, b = bh / 6, h = bh % 6, dc = lane & 7, ks = lane >> 3;
                const bf16* kp = PROJ + ((size_t)(b * HSLOTS + SL_MK + h) * SEQ + n * 256 + ks) * 64 + dc * 8; float a[8];
#pragma unroll
                for (int j = 0; j < 8; ++j) a[j] = 0.f;
#pragma unroll 1
                for (int i0 = 0; i0 < 32; i0 += 16) { v4u kw[16];
#pragma unroll
                    for (int i = 0; i < 16; ++i) kw[i] = *(const v4u*)(kp + (size_t)(8 * (i0 + i)) * 64);
#pragma unroll
                    for (int i = 0; i < 16; ++i) { a[0] += bflo(kw[i].x); a[1] += bfhi(kw[i].x); a[2] += bflo(kw[i].y); a[3] += bfhi(kw[i].y); a[4] += bflo(kw[i].z); a[5] += bfhi(kw[i].z); a[6] += bflo(kw[i].w); a[7] += bfhi(kw[i].w); } }
#pragma unroll
                for (int j = 0; j < 8; ++j) { a[j] += __shfl_xor(a[j], 8); a[j] += __shfl_xor(a[j], 16); a[j] += __shfl_xor(a[j], 32); }
                if (ks == 0) {
#pragma unroll
                    for (int j = 0; j < 8; ++j) { const int idx = u * 64 + dc * 8 + j; const float km = a[j] * (1.0f / 256.0f); kmean[idx] = km; const unsigned hb = f2bf(km); kmh[idx] = (bf16)hb; kml[idx] = (bf16)f2bf(km - __uint_as_float(hb << 16)); } } }
#if MK_NAIVE_DIL
            for (int gid = gw * 64 + lane; gid < BATCH * 4 * SEQ; gid += NGW * 64) dil_naive_thread(PROJ, AO, gid >> 14, (gid >> 12) & 3, gid & (SEQ - 1));
#else
            __syncthreads();
            fa::dil_phase((LAS char*)(F.lds + RING_OFF), tid_, bx_, G_, PROJ, lse);
#endif
        }
        if (ph == 5) { PHASE_LANES(); PHASE_PTRS();
#if !MK_NAIVE_DIL
            for (int idx0 = gw * 64 + lane; idx0 < T * 32; idx0 += 4 * NGW * 64) { float lv[4][3]; v4u av[4][3];
#pragma unroll
                for (int q = 0; q < 4; ++q) { int idx = idx0 + q * NGW * 64; idx = idx < T * 32 ? idx : T * 32 - 1; const int row = idx >> 5, hg = (idx >> 3) & 3, c = idx & 7;
                    const bf16* op = PROJ + ((size_t)((row >> 12) * HSLOTS + SL_DQ + hg) * SEQ + (row & (SEQ - 1))) * 64 + c * 8;
#pragma unroll
                    for (int g = 0; g < 3; ++g) { lv[q][g] = lse[(size_t)row * 12 + 4 * g + hg]; av[q][g] = *(const v4u*)(op + (size_t)(4 * g) * SEQ * 64); } }
#pragma unroll
                for (int q = 0; q < 4; ++q) { const int idx = idx0 + q * NGW * 64; if (idx < T * 32) { const int row = idx >> 5, hg = (idx >> 3) & 3, c = idx & 7;
                    const float l0 = lv[q][0], l1 = lv[q][1], l2 = lv[q][2], lm = fmaxf(l0, fmaxf(l1, l2));
                    float w0 = exp2f(l0 - lm), w1 = exp2f(l1 - lm), w2 = exp2f(l2 - lm); const float wi = 1.0f / (w0 + w1 + w2); w0 *= wi; w1 *= wi; w2 *= wi;
                    const v4u x0 = av[q][0], x1 = av[q][1], x2 = av[q][2]; float r[8];
                    r[0] = w0 * bflo(x0.x) + w1 * bflo(x1.x) + w2 * bflo(x2.x); r[1] = w0 * bfhi(x0.x) + w1 * bfhi(x1.x) + w2 * bfhi(x2.x);
                    r[2] = w0 * bflo(x0.y) + w1 * bflo(x1.y) + w2 * bflo(x2.y); r[3] = w0 * bfhi(x0.y) + w1 * bfhi(x1.y) + w2 * bfhi(x2.y);
                    r[4] = w0 * bflo(x0.z) + w1 * bflo(x1.z) + w2 * bflo(x2.z); r[5] = w0 * bfhi(x0.z) + w1 * bfhi(x1.z) + w2 * bfhi(x2.z);
                    r[6] = w0 * bflo(x0.w) + w1 * bflo(x1.w) + w2 * bflo(x2.w); r[7] = w0 * bfhi(x0.w) + w1 * bfhi(x1.w) + w2 * bfhi(x2.w);
                    st8(AO + (size_t)row * DM + 768 + hg * 64 + c * 8, r, 1.0f); } } }
#endif
            for (int wrep = 0; wrep < 4; ++wrep) { const int which = wrep >> 1, rep = wrep & 1; if (rep == 1 && !((MK_DOUBLE >> (3 + which)) & 1)) continue;
                const bool naive = which == 0 ? (MK_NAIVE_MLA != 0) : (MK_NAIVE_MOBA != 0);
                if (naive) {
                    for (int u = gw; u < 48 * 32; u += NGW) { const int bh = u >> 5, cp = u & 31, b = bh / 6, h = bh % 6;
                        if (which == 0) { mla_naive_chunk(QM, KN, KR, VM, AO, b, h, cp, lane); mla_naive_chunk(QM, KN, KR, VM, AO, b, h, 63 - cp, lane); }
                        else { moba_naive_chunk(PROJ, kmean, AO, b, h, cp, lane); moba_naive_chunk(PROJ, kmean, AO, b, h, 63 - cp, lane); } }
                } else {
                    gu32* head = F.ctl + CW_QUEUE + 64 * (2 * l + which) + 64 * 8 * rep;
                    for (;;) {
                        if (tid_ == 0) F.MISC[16] = __hip_atomic_fetch_add(head, 1u, RLX_AGENT);
                        __syncthreads();
                        const int u = __builtin_amdgcn_readfirstlane((int)F.MISC[16]);
                        if (u >= 48 * 16) break;
                        const int qb = 15 - u / 48, bh = u % 48, b = bh / 6, h = bh % 6;
                        if (which == 0) fa::mla_unit<8>((LAS char*)(F.lds + RING_OFF), tid_, qb, QM + (size_t)bh * SEQ * 96, KN + (size_t)bh * SEQ * 64, KR + (size_t)b * SEQ * 32, VM + (size_t)bh * SEQ * 64, AO + (size_t)b * SEQ * DM + h * 64);
                        else fa::moba_unit<8>((LAS char*)(F.lds + RING_OFF), tid_, qb, PROJ + (size_t)(b * HSLOTS + SL_MQ + h) * SEQ * 64, PROJ + (size_t)(b * HSLOTS + SL_MK + h) * SEQ * 64, PROJ + (size_t)(b * HSLOTS + SL_MV + h) * SEQ * 64, AO + (size_t)b * SEQ * DM + 384 + h * 64,
                                              kmh + (size_t)bh * 1024, kml + (size_t)bh * 1024, exp2f(-8.0f * (float)(12 + h + 1) / 18.0f) * LOG2E);
                    }
                    __syncthreads();
                }
            }
        }
        if (ph == 7) { PHASE_PTRS();
            { pg8::Gemm g{XB, Wg, T, DM, DM, DM, DM, AO, Wbr}; pg8::FusedOrder S; S.init(T, DM, OPQ_S((int)gridDim.x), OPQ_S((int)blockIdx.x));
              pg8::EpiFused E{GT + (size_t)OPQ_S((int)blockIdx.x) * 65536, MG, rsu + (size_t)(3 * l + 1) * T};
              pg8::gemm_phase<pg8::EpiFused, pg8::FusedOrder, true>(F.lds + RING_OFF, g, S, E, MYTID()); }
        }
        if (ph == 8) { PHASE_PTRS();
            pg8::Gemm g{MG, Wout, T, DM, DM, DM, DM}; pg8::StaticOrder S; S.init(T, DM, OPQ_S((int)gridDim.x), OPQ_S((int)blockIdx.x));
            pg8::EpiResid E{XB, rsu + (size_t)(3 * l + 2) * T, 1.0f};
            pg8::gemm_phase<pg8::EpiResid, pg8::StaticOrder, true>(F.lds + RING_OFF, g, S, E, MYTID());
        }
        if (ph == 9) { PHASE_PTRS();
            pg8::Gemm g{XB, Wgu2, T, 2 * FF, DM, DM, DM}; pg8::StaticOrder S; S.init(T, 2 * FF, OPQ_S((int)gridDim.x), OPQ_S((int)blockIdx.x));
            pg8::EpiSwiGLU E{ACT, FF, rsu + (size_t)(3 * l + 2) * T};
            for (int rep = 0; rep < ((MK_DOUBLE & 1) ? 2 : 1); ++rep)
            pg8::gemm_phase<pg8::EpiSwiGLU, pg8::StaticOrder, true>(F.lds + RING_OFF, g, S, E, MYTID());
        }
        if (ph == 10) { PHASE_PTRS();
            pg8::Gemm g{ACT, Wd2, T, DM, FF, FF, FF}; pg8::StaticOrder S; S.init(T, DM, OPQ_S((int)gridDim.x), OPQ_S((int)blockIdx.x));
            pg8::EpiResid E{XB, rsu + (size_t)(3 * (l + 1)) * T, 0.5f};
            pg8::gemm_phase<pg8::EpiResid, pg8::StaticOrder, true>(F.lds + RING_OFF, g, S, E, MYTID());
        }
        { PHASE_LANES(); PHASE_PTRS();
          const int nB = CVT_ITEMS_B / 8, nA = (l + 1 < DEPTH) ? CVT_ITEMS_A / 8 : 0;
          gu32* qB = F.ctl + CW_QUEUE + 64 * (32 + l); gu32* qA = F.ctl + CW_QUEUE + 64 * (40 + l);
          LAS float* scr = (LAS float*)(F.lds + RING_OFF + 63488 + wave * 8448);
          int mand = (ph == 5) ? 1 : (ph == 10) ? 2 : 0;
          const int opt = (ph <= 4) ? 1 : (ph <= 9) ? 2 : 0;
          bool arrived = false; unsigned gen_ = 0u;
          asm volatile("s_waitcnt vmcnt(0)" ::: "memory");
          __syncthreads();
          for (;;) {
              if (mand == 0 && !arrived) { arrived = true; if (tid_ == 0) F.MISC[20] = xcd_barrier_arrive(bar, gen_) ? 1u : 0u; }
              const int q = mand ? mand : opt, nq = (q == 1) ? nB : (q == 2) ? nA : 0;
              if (tid_ == 0) { bool rel = false;
                  if (arrived) { rel = F.MISC[20] != 0u; if (!rel && xcd_barrier_poll(bar, gen_)) { rel = true; F.MISC[20] = 1u; } }
                  if (!rel) F.MISC[21] = (q == 1) ? __hip_atomic_fetch_add(qB, 1u, RLX_AGENT) : (q == 2) ? __hip_atomic_fetch_add(qA, 1u, RLX_AGENT) : 0x7fffffffu; }
              __syncthreads();
              if (arrived && F.MISC[20] != 0u) break;
              const int t_ = __builtin_amdgcn_readfirstlane((int)F.MISC[21]);
              if (t_ < nq) { const int it_ = t_ * 8 + wave; int lane_o_ = lane; asm volatile("" : "+v"(lane_o_));
                  { const int lane = lane_o_; if (q == 1) CVT_SET_B(l, it_, 0x40000000); else CVT_SET_A(l + 1, it_, 0x40000000); }
                  asm volatile("s_waitcnt vmcnt(0)" ::: "memory"); }
              else if (mand) mand = 0;
              else if (tid_ == 0) { xcd_barrier_spin(bar, gen_); F.MISC[20] = 1u; }
              __syncthreads();
          }
          __syncthreads(); }
      }
    }
    if (IN(N_PHASES - 1)) { PHASE_LANES(); PHASE_PTRS();
        const float* gain = args.in[19];
        for (int m = gw; m < T; m += NGW) { float v[16]; ld8(XB + (size_t)m * DM + lane * 16, v); ld8(XB + (size_t)m * DM + lane * 16 + 8, v + 8); float s2 = 0.f;
#pragma unroll
            for (int j = 0; j < 16; ++j) s2 += v[j] * v[j];
            const float r = 1.0f / sqrtf(wave_sum(s2) * (1.0f / DM) + NORM_EPS);
#pragma unroll
            for (int j = 0; j < 4; ++j) { const f32x4 gn = *((const f32x4*)gain + lane * 4 + j); *((GAS f32x4*)(out + (size_t)m * DM) + lane * 4 + j) = (f32x4){v[4 * j] * r * gn[0], v[4 * j + 1] * r * gn[1], v[4 * j + 2] * r * gn[2], v[4 * j + 3] * r * gn[3]}; } }
    }
#undef IN
#undef BOTH
#undef GRID_BAR
}


extern "C" void kernel_launch(void* const* d_in, const int* in_sizes, int n_in, void* d_out, int out_size, void* d_ws, size_t ws_size, hipStream_t stream) {
    static int grid = 0;
    if (grid == 0) {
        if (n_in != 20 || in_sizes[0] != T * DM || out_size != T * DM || ws_size < WS_END) { fprintf(stderr, "kernel_launch: unexpected shapes / workspace (n_in %d, ws %zu, need %zu)\n", n_in, ws_size, (size_t)WS_END); grid = -1; return; }
        int dev = 0, cus = 0, per_cu = 0;
        if (hipGetDevice(&dev) != hipSuccess || hipDeviceGetAttribute(&cus, hipDeviceAttributeMultiprocessorCount, dev) != hipSuccess) { grid = -1; return; }
        if (hipFuncSetAttribute((const void*)mk_fwd, hipFuncAttributeMaxDynamicSharedMemorySize, LDS_BYTES) != hipSuccess) { fprintf(stderr, "kernel_launch: hipFuncSetAttribute failed\n"); grid = -1; return; }
        if (hipOccupancyMaxActiveBlocksPerMultiprocessor(&per_cu, (const void*)mk_fwd, NWAVES * 64, LDS_BYTES) != hipSuccess || per_cu < 1)
            fprintf(stderr, "kernel_launch: note: occupancy query reports %d workgroups per CU\n", per_cu);
        (void)hipGetLastError();
        grid = cus;
    }
    if (grid < 0) return;
    if (hipMemsetAsync((char*)d_ws + WS_CTL, 0, CTL_ZERO_BYTES, stream) != hipSuccess) return;
    Args a{};
    for (int i = 0; i < 20; ++i) a.in[i] = (const float*)d_in[i];
    a.out = (float*)d_out; a.ws = (unsigned char*)d_ws;
#if MK_PER_PHASE
    for (int p = 0; p < N_PHASES; ++p) { if (p > MK_STOP_AFTER && p != N_PHASES - 1) continue; a.ph_lo = p; a.ph_hi = p + 1; hipLaunchKernelGGL(mk_fwd, dim3(grid), dim3(NWAVES * 64), LDS_BYTES, stream, a); }
#else
    a.ph_lo = 0; a.ph_hi = N_PHASES;
    hipLaunchKernelGGL(mk_fwd, dim3(grid), dim3(NWAVES * 64), LDS_BYTES, stream, a);
#endif
}
```

```cpp
#include <hip/hip_runtime.h>
#include <cstdio>
#include <cstdint>

#ifndef MK_PER_PHASE
#define MK_PER_PHASE 0
#endif

#ifndef MK_DOUBLE
#define MK_DOUBLE 0
#endif
#ifndef MK_STAGGER_TICKS
#define MK_STAGGER_TICKS 300
#endif
#ifndef MK_EXTRA_BAR
#define MK_EXTRA_BAR 0
#endif
#ifndef MK_NAIVE_MLA
#define MK_NAIVE_MLA 0
#endif
#ifndef MK_NAIVE_MOBA
#define MK_NAIVE_MOBA 0
#endif
#ifndef MK_NAIVE_DIL
#define MK_NAIVE_DIL 0
#endif
#ifndef MK_STOP_AFTER
#define MK_STOP_AFTER 999
#endif
constexpr int BATCH = 8, SEQ = 4096, DM = 1024, DEPTH = 4, FF = 2816, T = BATCH * SEQ;
constexpr int PP = 4096;
constexpr int HSLOTS = 54, SL_DQ = 0, SL_DK = 12, SL_DV = 24, SL_MQ = 36, SL_MK = 42, SL_MV = 48, PTP = 640;
constexpr size_t PTOK_OFF = (size_t)8 * HSLOTS * 4096 * 64;
constexpr int PC_DQ = 0, PC_DK = 768, PC_DV = 1536, PC_MQ = 2304, PC_MK = 2688, PC_MV = 3072, PC_CKV = 3456, PC_CQ = 3584, PC_KR = 3840;
constexpr int IN_COLS = 6944;
constexpr float NORM_EPS = 1e-6f;
constexpr float LOG2E = 1.4426950408889634f, QSCALE64 = 0.125f * LOG2E, QSCALE96 = 0.10206207261596575f * LOG2E;

namespace pg8 {
#define PG8_LAS __attribute__((address_space(3)))
typedef unsigned short bf16_t;
typedef short bf16x8 __attribute__((ext_vector_type(8)));
typedef float f32x4 __attribute__((ext_vector_type(4)));
typedef unsigned u32x4 __attribute__((ext_vector_type(4)));
typedef unsigned u32x2 __attribute__((ext_vector_type(2)));
typedef unsigned long long u64;
constexpr int BM = 256, BK = 64, HALF = 128, HTB = HALF * BK * 2, STAGE_BYTES = 8 * HTB, NXCD = 8, WGM = 8;

__host__ __device__ __forceinline__ int lds_byte(int r, int c) { const int st = (r >> 4) * 2 + (c >> 5), rr = r & 15, cc = c & 31, ob = rr * 64 + cc * 2; return st * 1024 + (ob ^ (((ob >> 9) & 1) << 5)); }
__host__ __device__ __forceinline__ void stage_rc(int b, int& R, int& C) { const int st = b / 1024, sb = b % 1024, swz = sb ^ (((sb >> 9) & 1) << 5); R = (st >> 1) * 16 + swz / 64; C = (st & 1) * 32 + (swz % 64) / 2; }
__host__ __device__ __forceinline__ int perm32(int rho) { const int n = rho >> 4, i = rho & 15; return 8 * (i >> 2) + 4 * n + (i & 3); }

struct Unit { int pm, pn, sub, ka, kb, nt, sel; };
struct Gemm { const bf16_t* A; const bf16_t* Bt; int M, N, K, lda, ldb; const bf16_t* A1; const bf16_t* Bt1; };

struct StaticOrder {
    int nM, nN, nwg, G, c;
    __host__ __device__ void init(int M, int N, int G_, int c_) { nM = M / BM; nN = N / BM; nwg = nM * nN; G = G_; c = c_; }
    __host__ __device__ bool next(int i, Unit& u) const {
        const long L = (long)i * G + c; if (L >= nwg) return false;
        int wgid = (int)L; { const int q = nwg / NXCD, r = nwg % NXCD, xcd = wgid % NXCD, off = wgid / NXCD; wgid = (xcd < r ? xcd * (q + 1) : r * (q + 1) + (xcd - r) * q) + off; }
        const int nig = WGM * nN, gid = wgid / nig, fm = gid * WGM; constexpr int gsz = WGM;
        u.pm = fm + ((wgid % nig) % gsz); u.pn = (wgid % nig) / gsz; u.sub = 0; u.ka = 0; u.kb = 0; u.nt = 0; u.sel = 0; return true;
    }
    __device__ __forceinline__ void a_ready(const Unit&) const {}
    __device__ __forceinline__ void done(const Unit&) const {}
};

typedef float f32x2_t __attribute__((ext_vector_type(2))); typedef __bf16 bf16x2_t __attribute__((ext_vector_type(2)));
struct MergeOrder : StaticOrder {
    __host__ __device__ bool next(int i, Unit& u) const { if (!StaticOrder::next(i / 3, u)) return false; u.sub = i % 3; u.ka = u.sub * 768; u.kb = u.ka; u.nt = (u.sub == 2) ? 4 : 6; return true; }
};
struct UpOrder : StaticOrder {
    __host__ __device__ bool next(int i, Unit& u) const { if (!StaticOrder::next(i, u)) return false; u.ka = (u.pn < 3 ? 128 : 0) * 2; return true; }
};
__device__ __forceinline__ unsigned cvt_pk_bf16(float lo, float hi) { f32x2_t v = {lo, hi}; bf16x2_t b = __builtin_convertvector(v, bf16x2_t); return __builtin_bit_cast(unsigned, b); }
__device__ __forceinline__ float bflo(unsigned w) { return __uint_as_float(w << 16); }
__device__ __forceinline__ float bfhi(unsigned w) { return __uint_as_float(w & 0xffff0000u); }

template <int NP> __device__ __forceinline__ float row_scale(const float* p, int row, float invn) {
    float s = 0.f;
#pragma unroll
    for (int i = 0; i < NP / 4; ++i) { const f32x4 a = *(const f32x4*)(p + (size_t)row * NP + 4 * i); s += (a[0] + a[1]) + (a[2] + a[3]); }
    return __builtin_amdgcn_rsqf(s * invn + NORM_EPS);
}
constexpr float RS_FIX = 16777216.0f, RS_UNFIX = 1.0f / 16777216.0f;
constexpr int RS_LDS_OFF = 131072 + 2048;
__device__ __forceinline__ void row_scales8(const PG8_LAS unsigned char* ldsbase, int wr, int fr, float (&sc)[2][4]) {
    const PG8_LAS u64* p = (const PG8_LAS u64*)(ldsbase + RS_LDS_OFF) + wr * 64 + fr;
#pragma unroll
    for (int ai = 0; ai < 2; ++ai)
#pragma unroll
        for (int m = 0; m < 4; ++m) sc[ai][m] = __builtin_amdgcn_rsqf((float)p[ai * HALF + m * 16] * (RS_UNFIX / DM) + NORM_EPS);
}
__device__ __forceinline__ float silu_f(float a) { return a * __builtin_amdgcn_rcpf(1.0f + __builtin_amdgcn_exp2f(-1.4426950408889634f * a)); }
__device__ __forceinline__ float sigm_f(float a) { return __builtin_amdgcn_rcpf(1.0f + __builtin_amdgcn_exp2f(-1.4426950408889634f * a)); }

struct EpiSwiGLU { static constexpr bool PERM = true, AFTER_DRAIN = false, RS_PREFETCH = true; static __device__ __forceinline__ bool rs_wanted(const Unit&) { return true; }
    bf16_t* O; int ldc; const u64* rsu;
    __device__ __forceinline__ void operator()(const f32x4 (&acc)[2][2][4][2], const Unit& u, int wr, int wc, int fr, int fq, const PG8_LAS unsigned char* ldsbase) const {
        const int row0 = u.pm * BM + wr * 64 + fr, col0 = u.pn * HALF + wc * 32 + 8 * fq;
        const PG8_LAS u64* p = (const PG8_LAS u64*)(ldsbase + RS_LDS_OFF) + wr * 64 + fr;
#pragma unroll
        for (int ai = 0; ai < 2; ++ai)
#pragma unroll
            for (int m = 0; m < 4; ++m) { const int row = row0 + ai * HALF + m * 16;
                const float v = (float)p[ai * HALF + m * 16] * (RS_UNFIX / DM) + NORM_EPS, k = -1.4426950408889634f * __builtin_amdgcn_rsqf(v);
                float y[8];
#pragma unroll
                for (int n = 0; n < 2; ++n)
#pragma unroll
                    for (int j = 0; j < 4; j += 2) { const f32x2_t g2 = {acc[ai][0][m][n][j], acc[ai][0][m][n][j + 1]}, u2 = {acc[ai][1][m][n][j], acc[ai][1][m][n][j + 1]};
                        const f32x2_t kk = {k, k}, vv = {v, v};
                        const f32x2_t t2 = g2 * kk; const f32x2_t e2 = {__builtin_amdgcn_exp2f(t2[0]), __builtin_amdgcn_exp2f(t2[1])};
                        const f32x2_t d2 = __builtin_elementwise_fma(e2, vv, vv); const f32x2_t r2 = {__builtin_amdgcn_rcpf(d2[0]), __builtin_amdgcn_rcpf(d2[1])};
                        const f32x2_t y2 = (g2 * u2) * r2; y[4 * n + j] = y2[0]; y[4 * n + j + 1] = y2[1]; }
                u32x4 w; w.x = cvt_pk_bf16(y[0], y[1]); w.y = cvt_pk_bf16(y[2], y[3]); w.z = cvt_pk_bf16(y[4], y[5]); w.w = cvt_pk_bf16(y[6], y[7]);
                *(u32x4*)(O + (size_t)row * ldc + col0) = w; }
    }
};
struct EpiResid { static constexpr bool PERM = true, AFTER_DRAIN = false, RS_PREFETCH = false;
    bf16_t* xb; u64* rsu; float alpha;
    __device__ __forceinline__ void operator()(const f32x4 (&acc)[2][2][4][2], const Unit& u, int wr, int wc, int fr, int fq, const PG8_LAS unsigned char* ldsbase) const {
        const int row0 = u.pm * BM + wr * 64 + fr, col0 = u.pn * BM + wc * 32 + 8 * fq;
#pragma unroll
        for (int ai = 0; ai < 2; ++ai) {
            u32x4 b[4][2];
#pragma unroll
            for (int m = 0; m < 4; ++m)
#pragma unroll
                for (int bj = 0; bj < 2; ++bj) b[m][bj] = *(const u32x4*)(xb + (size_t)(row0 + ai * HALF + m * 16) * DM + col0 + bj * HALF);
#pragma unroll
            for (int m = 0; m < 4; ++m) { const int row = row0 + ai * HALF + m * 16; float ss = 0.f;
#pragma unroll
                for (int bj = 0; bj < 2; ++bj) { const u32x4 p = b[m][bj]; const f32x4 a0 = acc[ai][bj][m][0], a1 = acc[ai][bj][m][1]; float o[8];
                    o[0] = bflo(p.x) + alpha * a0[0]; o[1] = bfhi(p.x) + alpha * a0[1]; o[2] = bflo(p.y) + alpha * a0[2]; o[3] = bfhi(p.y) + alpha * a0[3];
                    o[4] = bflo(p.z) + alpha * a1[0]; o[5] = bfhi(p.z) + alpha * a1[1]; o[6] = bflo(p.w) + alpha * a1[2]; o[7] = bfhi(p.w) + alpha * a1[3];
                    u32x4 w; w.x = cvt_pk_bf16(o[0], o[1]); w.y = cvt_pk_bf16(o[2], o[3]); w.z = cvt_pk_bf16(o[4], o[5]); w.w = cvt_pk_bf16(o[6], o[7]);
                    *(u32x4*)(xb + (size_t)row * DM + col0 + bj * HALF) = w;
#pragma unroll
                    for (int j = 0; j < 8; ++j) ss += o[j] * o[j]; }
                ss += __shfl_xor(ss, 16); ss += __shfl_xor(ss, 32);
                if (fq == 0) __hip_atomic_fetch_add(rsu + row, (u64)(ss * RS_FIX), __ATOMIC_RELAXED, __HIP_MEMORY_SCOPE_AGENT); }
        }
    }
};
struct EpiProj { static constexpr bool PERM = true, AFTER_DRAIN = false, RS_PREFETCH = true; static __device__ __forceinline__ bool rs_wanted(const Unit&) { return true; }
    bf16_t* O; const u64* rsu; float* rsq; float* rskv;
    __device__ __forceinline__ void operator()(const f32x4 (&acc)[2][2][4][2], const Unit& u, int wr, int wc, int fr, int fq, const PG8_LAS unsigned char* ldsbase) const {
        const int row0 = u.pm * BM + wr * 64 + fr, col0 = u.pn * BM + wc * 32 + 8 * fq;
        float sc[2][4]; row_scales8(ldsbase, wr, fr, sc);
        const int bt = u.pm >> 4, tok0 = (u.pm & 15) * BM + wr * 64 + fr;
        bf16_t* dst[2]; int pitch[2]; float qs[2];
#pragma unroll
        for (int bj = 0; bj < 2; ++bj) { const bool hm = (u.pn * 2 + bj < 27);
            qs[bj] = (u.pn < 3 || u.pn == 9 || (u.pn == 10 && bj == 0)) ? QSCALE64 : 1.0f;
            pitch[bj] = hm ? 64 : PTP;
            dst[bj] = hm ? O + ((size_t)(bt * HSLOTS + (u.pn * 4 + bj * 2 + (wc >> 1))) * SEQ + tok0) * 64 + (wc & 1) * 32 + 8 * fq
                         : O + PTOK_OFF + (size_t)(bt * SEQ + tok0) * PTP + (col0 + bj * HALF - 3456); }
#pragma unroll
        for (int ai = 0; ai < 2; ++ai)
#pragma unroll
            for (int m = 0; m < 4; ++m) { const float s = sc[ai][m]; const int r = ai * HALF + m * 16;
#pragma unroll
                for (int bj = 0; bj < 2; ++bj) { const float sq = s * qs[bj];
                    const f32x4 v0 = acc[ai][bj][m][0] * sq, v1 = acc[ai][bj][m][1] * sq;
                    u32x4 w; w.x = cvt_pk_bf16(v0[0], v0[1]); w.y = cvt_pk_bf16(v0[2], v0[3]); w.z = cvt_pk_bf16(v1[0], v1[1]); w.w = cvt_pk_bf16(v1[2], v1[3]);
                    *(u32x4*)(dst[bj] + (size_t)(r * pitch[bj])) = w; } }
        if (u.pn == 13 || u.pn == 14) { const bool isq = (u.pn == 14);
#pragma unroll
            for (int ai = 0; ai < 2; ++ai)
#pragma unroll
                for (int m = 0; m < 4; ++m) { const int row = row0 + ai * HALF + m * 16; const float s = sc[ai][m]; float ss = 0.f;
#pragma unroll
                    for (int bj = 0; bj < 2; ++bj) { if (bj == 0 && !isq) continue;
                        const f32x4 v0 = acc[ai][bj][m][0] * s, v1 = acc[ai][bj][m][1] * s;
                        ss += ((v0[0] * v0[0] + v0[1] * v0[1]) + (v0[2] * v0[2] + v0[3] * v0[3])) + ((v1[0] * v1[0] + v1[1] * v1[1]) + (v1[2] * v1[2] + v1[3] * v1[3])); }
                    ss += __shfl_xor(ss, 16); ss += __shfl_xor(ss, 32);
                    if (fq == 0) { if (isq) rsq[(size_t)row * 4 + wc] = ss; else rskv[(size_t)row * 4 + wc] = ss; } } }
    }
};
struct EpiQup { static constexpr bool PERM = false, AFTER_DRAIN = false, RS_PREFETCH = false;
    bf16_t* Q; const float* rsq; const float* cosT; const float* sinT;
    __device__ __forceinline__ void operator()(const f32x4 (&acc)[2][2][4][2], const Unit& u, int wr, int wc, int fr, int fq, const PG8_LAS unsigned char* ldsbase) const {
        const int row0 = u.pm * BM + wr * 64 + fr;
        const int c32a = u.pn * BM + wc * 32, c32b = c32a + HALF;
        const bool ropea = (c32a < 576) && (c32a % 96) == 64, ropeb = (c32b < 576) && (c32b % 96) == 64, ropeany = ropea || ropeb;
#pragma unroll
        for (int ai = 0; ai < 2; ++ai) {
            f32x4 rsv[4], cs[4], sn[4];
#pragma unroll
            for (int m = 0; m < 4; ++m) { rsv[m] = *(const f32x4*)(rsq + (size_t)(row0 + ai * HALF + m * 16) * 4); cs[m] = (f32x4){0.f, 0.f, 0.f, 0.f}; sn[m] = cs[m]; }
            if (ropeany) {
#pragma unroll
                for (int m = 0; m < 4; ++m) { const int pos = (row0 + ai * HALF + m * 16) & (SEQ - 1); cs[m] = *(const f32x4*)(cosT + pos * 16 + 4 * fq); sn[m] = *(const f32x4*)(sinT + pos * 16 + 4 * fq); } }
            float sc[4];
#pragma unroll
            for (int m = 0; m < 4; ++m) { const f32x4 a = rsv[m]; sc[m] = __builtin_amdgcn_rsqf(((a[0] + a[1]) + (a[2] + a[3])) * (1.0f / 256.0f) + NORM_EPS) * QSCALE96; }
#pragma unroll
            for (int bj = 0; bj < 2; ++bj) { const int c32 = bj ? c32b : c32a; if (c32 >= 576) continue; const bool rope = bj ? ropeb : ropea;
#pragma unroll
                for (int m = 0; m < 4; ++m) { const int row = row0 + ai * HALF + m * 16; const float s = sc[m];
                    f32x4 v0 = acc[ai][bj][m][0] * s, v1 = acc[ai][bj][m][1] * s;
                    if (rope) { const f32x4 o0 = v0 * cs[m] - v1 * sn[m], o1 = v0 * sn[m] + v1 * cs[m]; v0 = o0; v1 = o1; }
                    u32x2 w0, w1; w0.x = cvt_pk_bf16(v0[0], v0[1]); w0.y = cvt_pk_bf16(v0[2], v0[3]); w1.x = cvt_pk_bf16(v1[0], v1[1]); w1.y = cvt_pk_bf16(v1[2], v1[3]);
                    { auto r = __builtin_amdgcn_permlane16_swap(w0.x, w1.x, false, false); w0.x = r[0]; w1.x = r[1]; }
                    { auto r = __builtin_amdgcn_permlane16_swap(w0.y, w1.y, false, false); w0.y = r[0]; w1.y = r[1]; }
                    bf16_t* p = Q + ((size_t)((row >> 12) * 6 + c32 / 96) * SEQ + (row & (SEQ - 1))) * 96 + (c32 % 96) + (fq & 1) * 16 + (fq >> 1) * 8; *(u32x4*)p = (u32x4){w0.x, w0.y, w1.x, w1.y}; } } }
    }
};
struct EpiKVup { static constexpr bool PERM = true, AFTER_DRAIN = false, RS_PREFETCH = false;
    bf16_t* Kn; bf16_t* Vm; const float* rskv;
    __device__ __forceinline__ void operator()(const f32x4 (&acc)[2][2][4][2], const Unit& u, int wr, int wc, int fr, int fq, const PG8_LAS unsigned char* ldsbase) const {
        const int row0 = u.pm * BM + wr * 64 + fr;
#pragma unroll
        for (int bj = 0; bj < 2; ++bj) { const int h = 2 * u.pn + bj; bf16_t* dst = (wc < 2 ? Kn + h * 64 + wc * 32 : Vm + h * 64 + (wc - 2) * 32) + 8 * fq;
#pragma unroll
            for (int ai = 0; ai < 2; ++ai)
#pragma unroll
                for (int m = 0; m < 4; ++m) { const int row = row0 + ai * HALF + m * 16; const float s = row_scale<4>(rskv, row, 1.0f / 128.0f);
                    const f32x4 v0 = acc[ai][bj][m][0] * s, v1 = acc[ai][bj][m][1] * s;
                    u32x4 w; w.x = cvt_pk_bf16(v0[0], v0[1]); w.y = cvt_pk_bf16(v0[2], v0[3]); w.z = cvt_pk_bf16(v1[0], v1[1]); w.w = cvt_pk_bf16(v1[2], v1[3]);
                    *(u32x4*)(dst + (size_t)row * 384) = w; } }
    }
};
struct EpiUp { static constexpr bool PERM = false, AFTER_DRAIN = false, RS_PREFETCH = false;
    bf16_t* Q; bf16_t* Kn; bf16_t* Vm; const float* rsq; const float* rskv; const float* cosT; const float* sinT;
    __device__ __forceinline__ void operator()(const f32x4 (&acc)[2][2][4][2], const Unit& u, int wr, int wc, int fr, int fq, const PG8_LAS unsigned char* ldsbase) const {
        const int row0 = u.pm * BM + wr * 64 + fr;
        if (u.pn < 3) { EpiQup E{Q, rsq, cosT, sinT}; E(acc, u, wr, wc, fr, fq, ldsbase); return; }
        f32x4 rsv[2][4]; float sc[2][4];
#pragma unroll
        for (int ai = 0; ai < 2; ++ai)
#pragma unroll
            for (int m = 0; m < 4; ++m) rsv[ai][m] = *(const f32x4*)(rskv + (size_t)(row0 + ai * HALF + m * 16) * 4);
#pragma unroll
        for (int ai = 0; ai < 2; ++ai)
#pragma unroll
            for (int m = 0; m < 4; ++m) { const f32x4 a = rsv[ai][m]; sc[ai][m] = __builtin_amdgcn_rsqf(((a[0] + a[1]) + (a[2] + a[3])) * (1.0f / 128.0f) + NORM_EPS); }
#pragma unroll
        for (int bj = 0; bj < 2; ++bj) { const int h = 2 * (u.pn - 3) + bj; bf16_t* dst = (wc < 2 ? Kn + wc * 32 : Vm + (wc - 2) * 32) + (fq & 1) * 16 + (fq >> 1) * 8;
#pragma unroll
            for (int ai = 0; ai < 2; ++ai)
#pragma unroll
                for (int m = 0; m < 4; ++m) { const int row = row0 + ai * HALF + m * 16; const float s = sc[ai][m];
                    const f32x4 v0 = acc[ai][bj][m][0] * s, v1 = acc[ai][bj][m][1] * s;
                    u32x2 w0, w1; w0.x = cvt_pk_bf16(v0[0], v0[1]); w0.y = cvt_pk_bf16(v0[2], v0[3]); w1.x = cvt_pk_bf16(v1[0], v1[1]); w1.y = cvt_pk_bf16(v1[2], v1[3]);
                    { auto r = __builtin_amdgcn_permlane16_swap(w0.x, w1.x, false, false); w0.x = r[0]; w1.x = r[1]; }
                    { auto r = __builtin_amdgcn_permlane16_swap(w0.y, w1.y, false, false); w0.y = r[0]; w1.y = r[1]; }
                    { bf16_t* p = dst + ((size_t)((row >> 12) * 6 + h) * SEQ + (row & (SEQ - 1))) * 64; *(u32x4*)p = (u32x4){w0.x, w0.y, w1.x, w1.y}; } } }
    }
};
struct EpiGate { static constexpr bool PERM = true, AFTER_DRAIN = false, RS_PREFETCH = true; static __device__ __forceinline__ bool rs_wanted(const Unit&) { return true; }
    bf16_t* O; const u64* rsu;
    __device__ __forceinline__ void operator()(const f32x4 (&acc)[2][2][4][2], const Unit& u, int wr, int wc, int fr, int fq, const PG8_LAS unsigned char* ldsbase) const {
        const int row0 = u.pm * BM + wr * 64 + fr, col0 = u.pn * BM + wc * 32 + 8 * fq;
        float sc[2][4]; row_scales8(ldsbase, wr, fr, sc);
#pragma unroll
        for (int ai = 0; ai < 2; ++ai)
#pragma unroll
            for (int m = 0; m < 4; ++m) { const int row = row0 + ai * HALF + m * 16; const float s = sc[ai][m];
#pragma unroll
                for (int bj = 0; bj < 2; ++bj) { float y[8];
#pragma unroll
                    for (int n = 0; n < 2; ++n)
#pragma unroll
                        for (int j = 0; j < 4; ++j) y[4 * n + j] = sigm_f(acc[ai][bj][m][n][j] * s);
                    u32x4 w; w.x = cvt_pk_bf16(y[0], y[1]); w.y = cvt_pk_bf16(y[2], y[3]); w.z = cvt_pk_bf16(y[4], y[5]); w.w = cvt_pk_bf16(y[6], y[7]);
                    *(u32x4*)(O + (size_t)row * 3072 + col0 + bj * HALF) = w; } }
    }
};
struct EpiMerge { static constexpr bool PERM = true, AFTER_DRAIN = false, RS_PREFETCH = false;
    const bf16_t* G; bf16_t* Mg;
    __device__ __forceinline__ void operator()(const f32x4 (&acc)[2][2][4][2], const Unit& u, int wr, int wc, int fr, int fq, const PG8_LAS unsigned char* ldsbase) const {
        const int row0 = u.pm * BM + wr * 64 + fr, col0 = u.pn * BM + wc * 32 + 8 * fq; const bool first = (u.sub == 0); const bf16_t* Gs = G + u.sub * 1024;
#pragma unroll
        for (int ai = 0; ai < 2; ++ai) {
            u32x4 gv[4][2], pv[4][2];
#pragma unroll
            for (int m = 0; m < 4; ++m)
#pragma unroll
                for (int bj = 0; bj < 2; ++bj) { const int row = row0 + ai * HALF + m * 16; gv[m][bj] = *(const u32x4*)(Gs + (size_t)row * 3072 + col0 + bj * HALF);
                    pv[m][bj] = (u32x4){0u, 0u, 0u, 0u}; if (!first) pv[m][bj] = *(const u32x4*)(Mg + (size_t)row * DM + col0 + bj * HALF); }
#pragma unroll
            for (int m = 0; m < 4; ++m)
#pragma unroll
                for (int bj = 0; bj < 2; ++bj) { const int row = row0 + ai * HALF + m * 16; const u32x4 g = gv[m][bj], p = pv[m][bj];
                    const f32x4 a0 = acc[ai][bj][m][0], a1 = acc[ai][bj][m][1];
                    u32x4 w;
                    w.x = cvt_pk_bf16(bflo(p.x) + bflo(g.x) * a0[0], bfhi(p.x) + bfhi(g.x) * a0[1]);
                    w.y = cvt_pk_bf16(bflo(p.y) + bflo(g.y) * a0[2], bfhi(p.y) + bfhi(g.y) * a0[3]);
                    w.z = cvt_pk_bf16(bflo(p.z) + bflo(g.z) * a1[0], bfhi(p.z) + bfhi(g.z) * a1[1]);
                    w.w = cvt_pk_bf16(bflo(p.w) + bflo(g.w) * a1[2], bfhi(p.w) + bfhi(g.w) * a1[3]);
                    *(u32x4*)(Mg + (size_t)row * DM + col0 + bj * HALF) = w; }
        }
    }
};

struct FusedOrder : StaticOrder {
    __host__ __device__ bool next(int i, Unit& u) const { if (!StaticOrder::next(i / 6, u)) return false; const int j = i % 6, br = j >> 1; u.sub = j;
        if ((j & 1) == 0) { u.sel = 0; u.ka = 0; u.kb = br * (1024 * 1024 * 2); u.nt = 16; } else { u.sel = 1; u.ka = br * 768; u.kb = u.ka; u.nt = (br == 2) ? 4 : 6; }
        return true; }
};
struct EpiFused { static constexpr bool PERM = true, AFTER_DRAIN = false, RS_PREFETCH = true; static __device__ __forceinline__ bool rs_wanted(const Unit& u) { return (u.sub & 1) == 0; }
    bf16_t* gs; bf16_t* Mg; const u64* rsu;
    __device__ __forceinline__ void operator()(const f32x4 (&acc)[2][2][4][2], const Unit& u, int wr, int wc, int fr, int fq, const PG8_LAS unsigned char* ldsbase) const {
        int tid = (wr * 4 + wc) * 64 + fq * 16 + fr; asm volatile("" : "+v"(tid));
        const int row0 = u.pm * BM + wr * 64 + fr, col0 = u.pn * BM + wc * 32 + 8 * fq;
        if ((u.sub & 1) == 0) {
            float sc[2][4]; row_scales8(ldsbase, wr, fr, sc);
#pragma unroll
            for (int ai = 0; ai < 2; ++ai)
#pragma unroll
                for (int m = 0; m < 4; ++m) { const float ks = -1.4426950408889634f * sc[ai][m];
#pragma unroll
                    for (int bj = 0; bj < 2; ++bj) { float y[8];
#pragma unroll
                        for (int n = 0; n < 2; ++n)
#pragma unroll
                            for (int j = 0; j < 4; j += 2) { const f32x2_t a2 = {acc[ai][bj][m][n][j], acc[ai][bj][m][n][j + 1]}, k2 = {ks, ks}, one2 = {1.0f, 1.0f};
                                const f32x2_t t2 = a2 * k2; const f32x2_t e2 = {__builtin_amdgcn_exp2f(t2[0]), __builtin_amdgcn_exp2f(t2[1])}; const f32x2_t d2 = e2 + one2;
                                y[4 * n + j] = __builtin_amdgcn_rcpf(d2[0]); y[4 * n + j + 1] = __builtin_amdgcn_rcpf(d2[1]); }
                        u32x4 w; w.x = cvt_pk_bf16(y[0], y[1]); w.y = cvt_pk_bf16(y[2], y[3]); w.z = cvt_pk_bf16(y[4], y[5]); w.w = cvt_pk_bf16(y[6], y[7]);
                        *(u32x4*)(gs + (size_t)((((ai * 4 + m) * 2 + bj) * 512 + tid) * 8)) = w; } }
        } else {
            const bool first = (u.sub == 1);
#pragma unroll
            for (int ai = 0; ai < 2; ++ai) {
                u32x4 gv[4][2], pv[4][2];
#pragma unroll
                for (int m = 0; m < 4; ++m)
#pragma unroll
                    for (int bj = 0; bj < 2; ++bj) { const int row = row0 + ai * HALF + m * 16; gv[m][bj] = *(const u32x4*)(gs + (size_t)((((ai * 4 + m) * 2 + bj) * 512 + tid) * 8));
                        pv[m][bj] = (u32x4){0u, 0u, 0u, 0u}; if (!first) pv[m][bj] = *(const u32x4*)(Mg + (size_t)row * DM + col0 + bj * HALF); }
#pragma unroll
                for (int m = 0; m < 4; ++m)
#pragma unroll
                    for (int bj = 0; bj < 2; ++bj) { const int row = row0 + ai * HALF + m * 16; const u32x4 g = gv[m][bj], p = pv[m][bj];
                        const f32x4 a0 = acc[ai][bj][m][0], a1 = acc[ai][bj][m][1];
                        u32x4 w;
                        w.x = cvt_pk_bf16(bflo(p.x) + bflo(g.x) * a0[0], bfhi(p.x) + bfhi(g.x) * a0[1]);
                        w.y = cvt_pk_bf16(bflo(p.y) + bflo(g.y) * a0[2], bfhi(p.y) + bfhi(g.y) * a0[3]);
                        w.z = cvt_pk_bf16(bflo(p.z) + bflo(g.z) * a1[0], bfhi(p.z) + bfhi(g.z) * a1[1]);
                        w.w = cvt_pk_bf16(bflo(p.w) + bflo(g.w) * a1[2], bfhi(p.w) + bfhi(g.w) * a1[3]);
                        *(u32x4*)(Mg + (size_t)row * DM + col0 + bj * HALF) = w; } }
        }
    }
};

template <class Epi, class Sched, bool ALIGN_EPI = false>
__device__ __forceinline__ void gemm_phase(PG8_LAS unsigned char* lds, const Gemm g, const Sched& S, const Epi& E, int tid_in) {
    int tid_ = tid_in; asm volatile("" : "+v"(tid_));
    const int tid = tid_, wid = __builtin_amdgcn_readfirstlane(tid >> 6), lane = tid & 63, wr = wid >> 2, wc = wid & 3, fr = lane & 15, fq = lane >> 4;
    int K = g.K; asm volatile("" : "+s"(K)); const int nt = K / BK;
    unsigned voffA[2], voffB[2];
#pragma unroll
    for (int i = 0; i < 2; ++i) { int R, C; stage_rc(tid * 16 + i * 8192, R, C); const int Rb = Epi::PERM ? ((R & ~31) + perm32(R & 31)) : R;
        voffA[i] = (unsigned)(R * g.lda + C) * 2u; voffB[i] = (unsigned)(Rb * g.ldb + C) * 2u; }
    const size_t kstep = (size_t)(BK * 2);
    const size_t hstepA = (size_t)HALF * g.lda * 2, hstepB = (size_t)HALF * g.ldb * 2;
    const size_t tstepA = 2 * hstepA, tstepB = 2 * hstepB;
    const unsigned ldsw = (unsigned)wid * 1024u;
    const int aoff = lds_byte(wr * 64 + fr, fq * 8), boff = lds_byte(wc * 32 + fr, fq * 8);
#define PG8_SA(b, h) (((b) * 2 + (h)) * HTB)
#define PG8_SB(b, h) ((4 + (b) * 2 + (h)) * HTB)
#define PG8_STAGE(bufoff, gbase, voff) do { _Pragma("unroll") for (int _i = 0; _i < 2; ++_i) \
        __builtin_amdgcn_global_load_lds((const unsigned*)((const char*)(gbase) + (voff)[_i]), (PG8_LAS unsigned*)(lds + (bufoff) + ldsw + _i * 8192), 16, 0, 0); } while (0)
#define PG8_LDA(dst, b, h) do { _Pragma("unroll") for (int m = 0; m < 4; ++m) _Pragma("unroll") for (int k = 0; k < 2; ++k) dst[m][k] = *(const PG8_LAS bf16x8*)(lds + PG8_SA(b, h) + aoff + m * 2048 + k * 1024); } while (0)
#define PG8_LDB(dst, b, h) do { _Pragma("unroll") for (int n = 0; n < 2; ++n) _Pragma("unroll") for (int k = 0; k < 2; ++k) dst[n][k] = *(const PG8_LAS bf16x8*)(lds + PG8_SB(b, h) + boff + n * 2048 + k * 1024); } while (0)
#define PG8_MMA(ai, bj, At, Bt) do { __builtin_amdgcn_s_setprio(1); _Pragma("unroll") for (int m = 0; m < 4; ++m) _Pragma("unroll") for (int n = 0; n < 2; ++n) _Pragma("unroll") for (int k = 0; k < 2; ++k) \
        acc[ai][bj][m][n] = __builtin_amdgcn_mfma_f32_16x16x32_bf16(Bt[n][k], At[m][k], acc[ai][bj][m][n], 0, 0, 0); __builtin_amdgcn_s_setprio(0); } while (0)
#define PG8_WAIT_V(n) asm volatile("s_waitcnt vmcnt(" #n ")" ::: "memory")
#define PG8_WAIT_L(n) asm volatile("s_waitcnt lgkmcnt(" #n ")" ::: "memory")
#define PG8_BAR __builtin_amdgcn_s_barrier()
#define PG8_SCHED __builtin_amdgcn_sched_barrier(0)
    Unit cur, nxt; int ui = 0;
    if (!S.next(0, cur)) return;
    f32x4 acc[2][2][4][2];
#pragma unroll
    for (int a = 0; a < 2; ++a)
#pragma unroll
        for (int b = 0; b < 2; ++b)
#pragma unroll
            for (int m = 0; m < 4; ++m)
#pragma unroll
                for (int n = 0; n < 2; ++n) acc[a][b][m][n] = (f32x4){0.f, 0.f, 0.f, 0.f};
    bf16x8 At[4][2], B0[2][2], B1[2][2];
    const char* cA = (const char*)(cur.sel ? g.A1 : g.A) + (size_t)cur.pm * tstepA + cur.ka; const char* cB = (const char*)(cur.sel ? g.Bt1 : g.Bt) + (size_t)cur.pn * tstepB + cur.kb;
    S.a_ready(cur);
    PG8_STAGE(PG8_SB(0, 0), cB, voffB); PG8_STAGE(PG8_SB(0, 1), cB + hstepB, voffB); PG8_STAGE(PG8_SA(0, 0), cA, voffA); PG8_STAGE(PG8_SA(0, 1), cA + hstepA, voffA);
    if (wr == 1) PG8_BAR;
    PG8_WAIT_V(2); PG8_BAR;
    PG8_STAGE(PG8_SB(1, 0), cB + kstep, voffB); PG8_STAGE(PG8_SA(1, 0), cA + kstep, voffA); PG8_STAGE(PG8_SB(1, 1), cB + hstepB + kstep, voffB);
    PG8_WAIT_V(6); PG8_BAR;
    for (;;) {
        const bool has_next = S.next(ui + 1, nxt);
        const char* nA = has_next ? (const char*)(nxt.sel ? g.A1 : g.A) + (size_t)nxt.pm * tstepA + nxt.ka : cA; const char* nB = has_next ? (const char*)(nxt.sel ? g.Bt1 : g.Bt) + (size_t)nxt.pn * tstepB + nxt.kb : cB;
        const int ntc = cur.nt ? cur.nt : nt;
        int t = 0;
        do {
            const bool last = (t == ntc - 2);
            const char* a1 = cA + (size_t)(t + 1) * kstep;
            const char* a2 = last ? nA : cA + (size_t)(t + 2) * kstep; const char* b2 = last ? nB : cB + (size_t)(t + 2) * kstep;
            const char* a3 = a2 + kstep; const char* b3 = b2 + kstep;
            if (last && has_next) S.a_ready(nxt);
            if constexpr (Epi::RS_PREFETCH) { if (last && Epi::rs_wanted(cur)) __builtin_amdgcn_global_load_lds((const unsigned*)(E.rsu + (size_t)cur.pm * BM) + tid, (PG8_LAS unsigned*)(lds + RS_LDS_OFF + wid * 256), 4, 0, 0); }
            PG8_LDB(B0, 0, 0); PG8_LDB(B1, 0, 1); PG8_SCHED; PG8_LDA(At, 0, 0); PG8_STAGE(PG8_SA(1, 1), a1 + hstepA, voffA);
            PG8_WAIT_V(8); PG8_WAIT_L(0); PG8_BAR; PG8_MMA(0, 0, At, B0); PG8_MMA(0, 1, At, B1); PG8_BAR; PG8_SCHED;
            PG8_LDA(At, 0, 1); PG8_STAGE(PG8_SB(0, 0), b2, voffB); PG8_STAGE(PG8_SB(0, 1), b2 + hstepB, voffB); PG8_STAGE(PG8_SA(0, 0), a2, voffA);
            PG8_WAIT_V(8); PG8_WAIT_L(0); PG8_BAR; PG8_MMA(1, 0, At, B0); PG8_MMA(1, 1, At, B1); PG8_BAR; PG8_SCHED;
            PG8_LDB(B0, 1, 0); PG8_LDB(B1, 1, 1); PG8_SCHED; PG8_LDA(At, 1, 0); PG8_STAGE(PG8_SA(0, 1), a2 + hstepA, voffA);
            PG8_WAIT_V(8); PG8_WAIT_L(0); PG8_BAR; PG8_MMA(0, 0, At, B0); PG8_MMA(0, 1, At, B1); PG8_BAR; PG8_SCHED;
            PG8_LDA(At, 1, 1); PG8_STAGE(PG8_SB(1, 0), b3, voffB); PG8_STAGE(PG8_SB(1, 1), b3 + hstepB, voffB); PG8_STAGE(PG8_SA(1, 0), a3, voffA);
            PG8_WAIT_V(8); PG8_WAIT_L(0); PG8_BAR; PG8_MMA(1, 0, At, B0); PG8_MMA(1, 1, At, B1); PG8_BAR; PG8_SCHED;
            t += 2;
        } while (t < ntc);
        if constexpr (ALIGN_EPI) { if (wr == 0) PG8_BAR; }
        E(acc, cur, wr, wc, fr, fq, lds); S.done(cur);
        if (!has_next) break;
#pragma unroll
        for (int a = 0; a < 2; ++a)
#pragma unroll
            for (int b = 0; b < 2; ++b)
#pragma unroll
                for (int m = 0; m < 4; ++m)
#pragma unroll
                    for (int n = 0; n < 2; ++n) acc[a][b][m][n] = (f32x4){0.f, 0.f, 0.f, 0.f};
        cur = nxt; cA = nA; cB = nB; ++ui;
        if constexpr (ALIGN_EPI) { if (wr == 1) PG8_BAR; }
    }
    PG8_WAIT_V(0);
    if constexpr (!ALIGN_EPI) { if (wr == 0) PG8_BAR; }
    PG8_BAR;
#undef PG8_SA
#undef PG8_SB
#undef PG8_STAGE
#undef PG8_LDA
#undef PG8_LDB
#undef PG8_MMA
#undef PG8_WAIT_V
#undef PG8_WAIT_L
#undef PG8_BAR
#undef PG8_SCHED
}
}

constexpr int NWAVES = 8;
constexpr size_t MiB = 1u << 20;
constexpr size_t WS_CTL = 0, CTL_ZERO_BYTES = 6 * MiB;
constexpr size_t WS_ROPE = 1 * MiB;
constexpr size_t WS_KMEAN = WS_ROPE + 512 * 1024;
constexpr size_t WS_RS = 2 * MiB;
constexpr size_t WS_RSQ = 6 * MiB;
constexpr size_t WS_RSKV = WS_RSQ + 512 * 1024;
constexpr size_t WS_W = 7 * MiB;
constexpr size_t W_GU1 = 0, W_D1 = W_GU1 + (size_t)5632 * 1024 * 2, W_IN = W_D1 + (size_t)1024 * 2816 * 2, W_G = W_IN + (size_t)4096 * 1024 * 2,
                 W_UQ = W_G + (size_t)3072 * 1024 * 2, W_UKV = W_UQ + (size_t)768 * 256 * 2, W_BR = W_UKV + (size_t)768 * 256 * 2, W_OUT = W_BR + (size_t)1024 * 1024 * 2,
                 W_GU2 = W_OUT + (size_t)1024 * 1024 * 2, W_D2 = W_GU2 + (size_t)5632 * 1024 * 2, W_END = W_D2 + (size_t)1024 * 2816 * 2;
static_assert(W_END <= 52 * MiB, "weights region");
constexpr size_t WS_XB = 59 * MiB;
constexpr size_t WS_PROJ = 123 * MiB;
constexpr size_t WS_QM = 379 * MiB;
constexpr size_t WS_KN = 415 * MiB;
constexpr size_t WS_VM = 439 * MiB;
constexpr size_t WS_KR = 463 * MiB;
constexpr size_t WS_MG = WS_QM;
constexpr size_t WS_AO = 465 * MiB;
constexpr size_t WS_LSE = 529 * MiB;
constexpr size_t WS_END = 531 * MiB;
static_assert(WS_RS + (size_t)13 * T * 8 <= WS_RSQ && WS_RSQ + MiB <= WS_W && WS_W + 52 * MiB <= WS_XB && WS_RSQ <= CTL_ZERO_BYTES + 0 * MiB + WS_RSQ, "d_ws map");
constexpr int CW_BAR = 4096;
constexpr int CW_QUEUE = 8192;

constexpr int RING_OFF = 0, RING_BYTES = 131072;
constexpr int LDSCTL_OFF = RING_BYTES, MISC_OFF = LDSCTL_OFF + 320;
constexpr int LDS_BYTES = 147456;

#define GAS __attribute__((address_space(1)))
#define LAS __attribute__((address_space(3)))
typedef unsigned short bf16;
typedef unsigned v4u __attribute__((ext_vector_type(4)));
typedef unsigned v2u __attribute__((ext_vector_type(2)));
typedef float f32x4 __attribute__((ext_vector_type(4)));
typedef GAS unsigned gu32;
#define RLX_AGENT __ATOMIC_RELAXED, __HIP_MEMORY_SCOPE_AGENT
#define LDS_WAIT() asm volatile("s_waitcnt lgkmcnt(0)" ::: "memory")
__device__ __forceinline__ unsigned f2bf(float f) { unsigned u = __builtin_bit_cast(unsigned, f); return (u + 0x7fffu + ((u >> 16) & 1u)) >> 16; }
__device__ __forceinline__ unsigned pk2(float lo, float hi) { return f2bf(lo) | (f2bf(hi) << 16); }
__device__ __forceinline__ float bflo(unsigned w) { return __uint_as_float(w << 16); }
__device__ __forceinline__ float bfhi(unsigned w) { return __uint_as_float(w & 0xffff0000u); }

#define XB_TMO      128
#define XB_XCNT(j)  (256  + 64 * (j))
#define XB_XSUB(j)  (1280 + 64 * (j))
#define XB_XGEN(j)  (2304 + 64 * (j))
#define XB_TOP      3328
#define XB_TOPGEN   3392
#define XCD_BAR_WORDS 3456
#define XB_SPIN_CAP (1u << 20)

__device__ __forceinline__ unsigned xb_ld(unsigned* p)              { return __hip_atomic_load(p, __ATOMIC_RELAXED, __HIP_MEMORY_SCOPE_AGENT); }
__device__ __forceinline__ unsigned xb_add(unsigned* p, unsigned v) { return __hip_atomic_fetch_add(p, v, __ATOMIC_RELAXED, __HIP_MEMORY_SCOPE_AGENT); }
__device__ __forceinline__ unsigned xb_xcc_id() { return (unsigned)__builtin_amdgcn_s_getreg((3 << 11) | 20) & 0xFu; }
#define XB_SPIN(cond, bar) do { unsigned _sp = 0; while (cond) { __builtin_amdgcn_s_sleep(1); \
    if ((++_sp & 255u) == 0u) { if (xb_ld(&(bar)[XB_TMO])) break; if (_sp > XB_SPIN_CAP) { atomicAdd(&(bar)[XB_TMO], 1u); break; } } } } while (0)

struct XcdBarrier { unsigned* bar; unsigned x; volatile LAS unsigned* st; };

__device__ __forceinline__ XcdBarrier xcd_barrier_post(unsigned* bar, volatile LAS unsigned* st) {
    XcdBarrier b; b.bar = bar; b.x = xb_xcc_id(); b.st = st;
    if (threadIdx.x == 0) (void)xb_add(&bar[XB_XCNT(b.x)], 1u);
    return b;
}
__device__ __forceinline__ void xcd_barrier_complete(unsigned* bar, unsigned x, unsigned& nloc, unsigned& nx) {
    const unsigned G = gridDim.x * gridDim.y * gridDim.z;
    unsigned sum, cnt, mine, sp = 0u;
    for (;;) {
        sum = 0u; cnt = 0u; mine = 0u;
#pragma unroll
        for (unsigned j = 0; j < 16; ++j) { const unsigned c = xb_ld(&bar[XB_XCNT(j)]); sum += c; cnt += (c > 0u) ? 1u : 0u; mine = (j == x) ? c : mine; }
        if (sum == G) break;
        __builtin_amdgcn_s_sleep(1);
        if ((++sp & 255u) == 0u) { if (xb_ld(&bar[XB_TMO])) break; if (sp > XB_SPIN_CAP) { atomicAdd(&bar[XB_TMO], 1u); break; } }
    }
    nloc = mine > 0u ? mine : 1u; nx = cnt > 0u ? cnt : 1u;
}
__device__ __forceinline__ void xcd_barrier(const XcdBarrier& b, bool leader) {
    asm volatile("s_waitcnt vmcnt(0)" ::: "memory");
    __syncthreads();
    if (leader) {
        unsigned* bar = b.bar; asm volatile("" : "+s"(bar));
        __builtin_amdgcn_s_waitcnt(0);
        unsigned nloc = b.st[0], nx = b.st[1];
        if (nloc == 0u) { xcd_barrier_complete(bar, b.x, nloc, nx); b.st[0] = nloc; b.st[1] = nx; }
        const unsigned old = xb_add(&bar[XB_XSUB(b.x)], 1u);
        const unsigned gen = old / nloc;
        if (old + 1u == (gen + 1u) * nloc) {
            __builtin_amdgcn_fence(__ATOMIC_RELEASE, "agent");
            asm volatile("s_waitcnt vmcnt(0)" ::: "memory");
            const unsigned og = xb_add(&bar[XB_TOP], 1u);
            const unsigned tg = og / nx;
            if (og + 1u == (tg + 1u) * nx) xb_add(&bar[XB_TOPGEN], 1u);
            else XB_SPIN(xb_ld(&bar[XB_TOPGEN]) == tg, bar);
            __builtin_amdgcn_fence(__ATOMIC_ACQUIRE, "agent");
            xb_add(&bar[XB_XGEN(b.x)], 1u);
            asm volatile("s_waitcnt vmcnt(0)" ::: "memory");
        } else {
            XB_SPIN(xb_ld(&bar[XB_XGEN(b.x)]) == gen, bar);
            __builtin_amdgcn_fence(__ATOMIC_ACQUIRE, "agent");
            asm volatile("s_waitcnt vmcnt(0)" ::: "memory");
        }
    }
    __syncthreads();
}

__device__ __forceinline__ float wave_sum(float v) {
#pragma unroll
    for (int o = 1; o < 64; o <<= 1) v += __shfl_xor(v, o);
    return v;
}
__device__ __forceinline__ void cvt_item(const float* W, int N, const float* gain, bf16* WT, int dpitch, int dkoff, int k0, int n0, int drow0, LAS float* scr, int lane) {
    float wv[32];
#pragma unroll
    for (int i = 0; i < 32; ++i) { const int kk = 2 * i + (lane >> 5); wv[i] = __builtin_nontemporal_load(W + (size_t)(k0 + kk) * N + n0 + (lane & 31)); }
#pragma unroll
    for (int i = 0; i < 32; ++i) { const int kk = 2 * i + (lane >> 5); float v = wv[i]; if (gain) v *= gain[k0 + kk]; scr[kk * 33 + (lane & 31)] = v; }
    LDS_WAIT(); asm volatile("" ::: "memory");
    const int c = lane & 7;
#pragma unroll
    for (int j = 0; j < 4; ++j) { const int n = (lane >> 3) + 8 * j; const LAS float* s = scr + (8 * c) * 33 + n;
        v4u o; o.x = pk2(s[0 * 33], s[1 * 33]); o.y = pk2(s[2 * 33], s[3 * 33]); o.z = pk2(s[4 * 33], s[5 * 33]); o.w = pk2(s[6 * 33], s[7 * 33]);
        *(GAS v4u*)(WT + (size_t)(drow0 + n) * dpitch + dkoff + k0 + 8 * c) = o; }
    LDS_WAIT(); asm volatile("" ::: "memory");
}
template <class RowMap>
__device__ __forceinline__ void cvt_matrix(const float* W, int K, int N, int nb0, int nblk, const float* gain, bf16* WT, int dpitch, int dkoff, const RowMap& RM, LAS float* scr, int gw, int NGW, int lane, int& base) {
    const int nit = (K / 64) * nblk;
    int first = gw - (base % NGW); if (first < 0) first += NGW;
    for (int it = first; it < nit; it += NGW) { const int kb = it / nblk, nb = nb0 + it % nblk; cvt_item(W, N, gain, WT, dpitch, dkoff, 64 * kb, 32 * nb, RM(32 * nb), scr, lane); }
    base += nit;
}
struct RmId { __device__ __forceinline__ int operator()(int n0) const { return n0; } };
struct RmGU { int add; __device__ __forceinline__ int operator()(int n0) const { return 256 * (n0 / 128) + (n0 % 128) + add; } };
struct RmIn { __device__ __forceinline__ int operator()(int n0) const {
    if (n0 < 256) return PC_CQ + n0; if (n0 < 384) return PC_CKV + (n0 - 256); if (n0 < 416) return PC_KR + (n0 - 384); if (n0 < 1568) return PC_MQ + (n0 - 416); if (n0 < 3872) return PC_DQ + (n0 - 1568);
    return 4096 + (n0 - 3872); } };
static_assert(W_G == W_IN + (size_t)4096 * 1024 * 2, "gate weights follow w_in");

__device__ __forceinline__ int OPQ_S(int v) { asm volatile("" : "+s"(v)); return v; }
__device__ __forceinline__ int lane_id_volatile() { int l; asm volatile("v_mbcnt_lo_u32_b32 %0, -1, 0\n\tv_mbcnt_hi_u32_b32 %0, -1, %0" : "=v"(l)); return l; }

#define CVT_SET_A(L, gw_, ngw_) do { int base_ = 0; const int L_ = (L); \
    cvt_matrix(args.in[2] + (size_t)L_ * DM * FF, DM, FF, 0, FF / 32, args.in[1] + L_ * DM, Wb + W_GU1 / 2, DM, 0, RmGU{0}, scr, gw_, ngw_, lane, base_); \
    cvt_matrix(args.in[3] + (size_t)L_ * DM * FF, DM, FF, 0, FF / 32, args.in[1] + L_ * DM, Wb + W_GU1 / 2, DM, 0, RmGU{128}, scr, gw_, ngw_, lane, base_); \
    cvt_matrix(args.in[4] + (size_t)L_ * FF * DM, FF, DM, 0, DM / 32, nullptr, Wb + W_D1 / 2, FF, 0, RmId{}, scr, gw_, ngw_, lane, base_); \
    cvt_matrix(args.in[6] + (size_t)L_ * DM * IN_COLS, DM, IN_COLS, 0, 121, args.in[5] + L_ * DM, Wb + W_IN / 2, DM, 0, RmIn{}, scr, gw_, ngw_, lane, base_); \
    cvt_matrix(args.in[8] + (size_t)L_ * 256 * 576, 256, 576, 0, 18, args.in[7] + L_ * 256, Wb + W_UQ / 2, 256, 0, RmId{}, scr, gw_, ngw_, lane, base_); \
    cvt_matrix(args.in[10] + (size_t)L_ * 128 * 768, 128, 768, 0, 24, args.in[9] + L_ * 128, Wb + W_UKV / 2, 256, 0, RmId{}, scr, gw_, ngw_, lane, base_); } while (0)
#define CVT_SET_B(L, gw_, ngw_) do { int base_ = 0; const int L_ = (L); \
    cvt_matrix(args.in[6] + (size_t)L_ * DM * IN_COLS, DM, IN_COLS, 121, 96, args.in[5] + L_ * DM, Wb + W_IN / 2, DM, 0, RmIn{}, scr, gw_, ngw_, lane, base_); \
    cvt_matrix(args.in[11] + (size_t)L_ * 384 * DM, 384, DM, 0, 32, nullptr, Wb + W_BR / 2, DM, 0, RmId{}, scr, gw_, ngw_, lane, base_); \
    cvt_matrix(args.in[12] + (size_t)L_ * 384 * DM, 384, DM, 0, 32, nullptr, Wb + W_BR / 2, DM, 384, RmId{}, scr, gw_, ngw_, lane, base_); \
    cvt_matrix(args.in[13] + (size_t)L_ * 256 * DM, 256, DM, 0, 32, nullptr, Wb + W_BR / 2, DM, 768, RmId{}, scr, gw_, ngw_, lane, base_); \
    cvt_matrix(args.in[14] + (size_t)L_ * DM * DM, DM, DM, 0, 32, nullptr, Wb + W_OUT / 2, DM, 0, RmId{}, scr, gw_, ngw_, lane, base_); \
    cvt_matrix(args.in[16] + (size_t)L_ * DM * FF, DM, FF, 0, FF / 32, args.in[15] + L_ * DM, Wb + W_GU2 / 2, DM, 0, RmGU{0}, scr, gw_, ngw_, lane, base_); \
    cvt_matrix(args.in[17] + (size_t)L_ * DM * FF, DM, FF, 0, FF / 32, args.in[15] + L_ * DM, Wb + W_GU2 / 2, DM, 0, RmGU{128}, scr, gw_, ngw_, lane, base_); \
    cvt_matrix(args.in[18] + (size_t)L_ * FF * DM, FF, DM, 0, DM / 32, nullptr, Wb + W_D2 / 2, FF, 0, RmId{}, scr, gw_, ngw_, lane, base_); } while (0)
constexpr int CVT_ITEMS_A = 2 * 16 * 88 + 44 * 32 + 16 * 121 + 4 * 18 + 2 * 24, CVT_ITEMS_B = 16 * 96 + 6 * 32 + 6 * 32 + 4 * 32 + 16 * 32 + 2 * 16 * 88 + 44 * 32;
static_assert(CVT_ITEMS_A % 8 == 0 && CVT_ITEMS_B % 8 == 0, "conversion items come in chunks of 8 (one item per wave)");
struct Frame {
    LAS unsigned char* lds; volatile LAS unsigned* MISC; gu32* ctl;
};

__device__ __forceinline__ void ld8(const bf16* p, float* f) { const v4u w = *(const v4u*)p; f[0] = bflo(w.x); f[1] = bfhi(w.x); f[2] = bflo(w.y); f[3] = bfhi(w.y); f[4] = bflo(w.z); f[5] = bfhi(w.z); f[6] = bflo(w.w); f[7] = bfhi(w.w); }
__device__ __forceinline__ float dot8(const bf16* p, const float* q) { const v4u w = *(const v4u*)p;
    return ((q[0] * bflo(w.x) + q[1] * bfhi(w.x)) + (q[2] * bflo(w.y) + q[3] * bfhi(w.y))) + ((q[4] * bflo(w.z) + q[5] * bfhi(w.z)) + (q[6] * bflo(w.w) + q[7] * bfhi(w.w))); }
__device__ __forceinline__ void axpy8(const bf16* p, float a, float c, float* o) { const v4u w = *(const v4u*)p;
    o[0] = o[0] * c + a * bflo(w.x); o[1] = o[1] * c + a * bfhi(w.x); o[2] = o[2] * c + a * bflo(w.y); o[3] = o[3] * c + a * bfhi(w.y);
    o[4] = o[4] * c + a * bflo(w.z); o[5] = o[5] * c + a * bfhi(w.z); o[6] = o[6] * c + a * bflo(w.w); o[7] = o[7] * c + a * bfhi(w.w); }
__device__ __forceinline__ void st8(bf16* p, const float* o, float s) { v4u w; w.x = pk2(o[0] * s, o[1] * s); w.y = pk2(o[2] * s, o[3] * s); w.z = pk2(o[4] * s, o[5] * s); w.w = pk2(o[6] * s, o[7] * s); *(v4u*)p = w; }

__device__ __forceinline__ void mla_naive_chunk(const bf16* Qm, const bf16* Kn, const bf16* KR, const bf16* Vm, bf16* AO, int b, int h, int chunk, int lane) {
    const int t = chunk * 64 + lane; const size_t rowb = (size_t)b * SEQ;
    float q[96];
#pragma unroll
    for (int c = 0; c < 12; ++c) ld8(Qm + (rowb + t) * 576 + h * 96 + 8 * c, q + 8 * c);
    float m = -1e30f, l = 0.f; float o[64];
#pragma unroll
    for (int d = 0; d < 64; ++d) o[d] = 0.f;
    const int jmax = chunk * 64 + 63;
    for (int j = 0; j <= jmax; ++j) {
        const bf16* kp = Kn + (rowb + j) * 384 + h * 64; const bf16* rp = KR + (rowb + j) * 32; const bf16* vp = Vm + (rowb + j) * 384 + h * 64;
        float s = 0.f;
#pragma unroll
        for (int c = 0; c < 8; ++c) s += dot8(kp + 8 * c, q + 8 * c);
#pragma unroll
        for (int c = 0; c < 4; ++c) s += dot8(rp + 8 * c, q + 64 + 8 * c);
        if (j <= t) { const float mn = fmaxf(m, s), corr = exp2f(m - mn), p = exp2f(s - mn); l = l * corr + p; m = mn;
#pragma unroll
            for (int c = 0; c < 8; ++c) axpy8(vp + 8 * c, p, corr, o + 8 * c); }
    }
    const float inv = 1.0f / l;
#pragma unroll
    for (int c = 0; c < 8; ++c) st8(AO + (rowb + t) * DM + h * 64 + 8 * c, o + 8 * c, inv);
}

__device__ __forceinline__ void moba_naive_chunk(const bf16* proj, const float* kmean, bf16* AO, int b, int h, int chunk, int lane) {
    const int t = chunk * 64 + lane; const size_t rowb = (size_t)b * SEQ; const int b_own = chunk >> 2;
    float q[64];
#pragma unroll
    for (int c = 0; c < 8; ++c) ld8(proj + (rowb + t) * PP + PC_MQ + h * 64 + 8 * c, q + 8 * c);
    const float slope = exp2f(-8.0f * (float)(12 + h + 1) / 18.0f) * LOG2E;
    float v1 = -3e38f, v2 = -3e38f, v3 = -3e38f; int i1 = -1, i2 = -1, i3 = -1;
    for (int n = 0; n < b_own; ++n) { const float* km = kmean + ((size_t)(b * 6 + h) * 16 + n) * 64; float g = 0.f;
#pragma unroll
        for (int c = 0; c < 16; ++c) { const f32x4 k4 = *(const f32x4*)(km + 4 * c); g += (q[4 * c] * k4[0] + q[4 * c + 1] * k4[1]) + (q[4 * c + 2] * k4[2] + q[4 * c + 3] * k4[3]); }
        if (g > v1) { v3 = v2; i3 = i2; v2 = v1; i2 = i1; v1 = g; i1 = n; } else if (g > v2) { v3 = v2; i3 = i2; v2 = g; i2 = n; } else if (g > v3) { v3 = g; i3 = n; } }
    unsigned sel = 0u; if (i1 >= 0) sel |= 1u << i1; if (i2 >= 0) sel |= 1u << i2; if (i3 >= 0) sel |= 1u << i3;
    float m = -1e30f, l = 0.f; float o[64];
#pragma unroll
    for (int d = 0; d < 64; ++d) o[d] = 0.f;
    for (int n = 0; n < b_own; ++n) { const bool mine = (sel >> n) & 1u; if (!__any(mine)) continue;
        for (int kk = 0; kk < 256; ++kk) { const int kpos = n * 256 + kk; const bf16* kp = proj + (rowb + kpos) * PP + PC_MK + h * 64; const bf16* vp = proj + (rowb + kpos) * PP + PC_MV + h * 64;
            float s = 0.f;
#pragma unroll
            for (int c = 0; c < 8; ++c) s += dot8(kp + 8 * c, q + 8 * c);
            s = s - slope * (float)(t - kpos);
            if (mine) { const float mn = fmaxf(m, s), corr = exp2f(m - mn), p = exp2f(s - mn); l = l * corr + p; m = mn;
#pragma unroll
                for (int c = 0; c < 8; ++c) axpy8(vp + 8 * c, p, corr, o + 8 * c); } } }
    for (int kpos = b_own * 256; kpos <= chunk * 64 + 63; ++kpos) { const bf16* kp = proj + (rowb + kpos) * PP + PC_MK + h * 64; const bf16* vp = proj + (rowb + kpos) * PP + PC_MV + h * 64;
        float s = 0.f;
#pragma unroll
        for (int c = 0; c < 8; ++c) s += dot8(kp + 8 * c, q + 8 * c);
        s = s - slope * (float)(t - kpos);
        if (kpos <= t) { const float mn = fmaxf(m, s), corr = exp2f(m - mn), p = exp2f(s - mn); l = l * corr + p; m = mn;
#pragma unroll
            for (int c = 0; c < 8; ++c) axpy8(vp + 8 * c, p, corr, o + 8 * c); } }
    const float inv = 1.0f / l;
#pragma unroll
    for (int c = 0; c < 8; ++c) st8(AO + (rowb + t) * DM + 384 + h * 64 + 8 * c, o + 8 * c, inv);
}

__device__ __forceinline__ void dil_naive_thread(const bf16* proj, bf16* AO, int b, int hg, int t) {
    const size_t rowb = (size_t)b * SEQ;
    float m = -1e30f, l = 0.f; float o[64];
#pragma unroll
    for (int d = 0; d < 64; ++d) o[d] = 0.f;
    for (int g = 0; g < 3; ++g) { const int h = g * 4 + hg, dil = (g == 0) ? 1 : (g == 1) ? 4 : 16; const float slope = exp2f(-8.0f * (float)(h + 1) / 18.0f) * LOG2E;
        float q[64];
#pragma unroll
        for (int c = 0; c < 8; ++c) ld8(proj + (rowb + t) * PP + PC_DQ + h * 64 + 8 * c, q + 8 * c);
        for (int j = 0; j <= 128; ++j) { const int kpos = t - j * dil;
            if (kpos >= 0) { const bf16* kp = proj + (rowb + kpos) * PP + PC_DK + h * 64; const bf16* vp = proj + (rowb + kpos) * PP + PC_DV + h * 64;
                float s = 0.f;
#pragma unroll
                for (int c = 0; c < 8; ++c) s += dot8(kp + 8 * c, q + 8 * c);
                s = s - slope * (float)(j * dil);
                const float mn = fmaxf(m, s), corr = exp2f(m - mn), p = exp2f(s - mn); l = l * corr + p; m = mn;
#pragma unroll
                for (int c = 0; c < 8; ++c) axpy8(vp + 8 * c, p, corr, o + 8 * c); } } }
    const float inv = 1.0f / l;
#pragma unroll
    for (int c = 0; c < 8; ++c) st8(AO + (rowb + t) * DM + 768 + hg * 64 + 8 * c, o + 8 * c, inv);
}

namespace fa {
typedef float f32x16 __attribute__((ext_vector_type(16)));
typedef short bf16x8 __attribute__((ext_vector_type(8)));
typedef short s16x4 __attribute__((ext_vector_type(4)));
#define FLAS __attribute__((address_space(3)))
constexpr float NEG = -1.0e30f, POS = 1.0e30f, RESC_THR = 8.0f;
__device__ __forceinline__ int crow(int r, int hi) { return (r & 3) + 8 * (r >> 2) + 4 * hi; }
__device__ __forceinline__ float xmax(float v) { auto rr = __builtin_amdgcn_permlane32_swap(__float_as_uint(v), __float_as_uint(v), false, false); return fmaxf(__uint_as_float(rr[0]), __uint_as_float(rr[1])); }
__device__ __forceinline__ float xsum(float v) { auto rr = __builtin_amdgcn_permlane32_swap(__float_as_uint(v), __float_as_uint(v), false, false); return __uint_as_float(rr[0]) + __uint_as_float(rr[1]); }
__device__ __forceinline__ float xother(float v, int hi) { auto rr = __builtin_amdgcn_permlane32_swap(__float_as_uint(v), __float_as_uint(v), false, false); return hi ? __uint_as_float(rr[0]) : __uint_as_float(rr[1]); }
__device__ __forceinline__ float max16(const f32x16& a) { float x = fmaxf(fmaxf(a[0], a[1]), fmaxf(a[2], a[3])), y = fmaxf(fmaxf(a[4], a[5]), fmaxf(a[6], a[7])), z = fmaxf(fmaxf(a[8], a[9]), fmaxf(a[10], a[11])), w = fmaxf(fmaxf(a[12], a[13]), fmaxf(a[14], a[15])); return fmaxf(fmaxf(x, y), fmaxf(z, w)); }
__device__ __forceinline__ bf16x8 pack8(const f32x16& p, int s8) {
    v4u w; w.x = pg8::cvt_pk_bf16(p[s8 + 0], p[s8 + 1]); w.y = pg8::cvt_pk_bf16(p[s8 + 2], p[s8 + 3]); w.z = pg8::cvt_pk_bf16(p[s8 + 4], p[s8 + 5]); w.w = pg8::cvt_pk_bf16(p[s8 + 6], p[s8 + 7]);
    return __builtin_bit_cast(bf16x8, w); }
#define FA_MFMA(a, b, c) __builtin_amdgcn_mfma_f32_32x32x16_bf16((a), (b), (c), 0, 0, 0)
template <int DK> __device__ __forceinline__ f32x16 qk_half(const FLAS char* krow, int hi, const bf16x8* qf, const f32x16& c) {
    f32x16 s = c;
#pragma unroll
    for (int d0 = 0; d0 < DK / 16; ++d0) { const bf16x8 kf = *(const FLAS bf16x8*)(krow + d0 * 32 + hi * 16); s = FA_MFMA(kf, qf[d0], s); }
    return s; }
__device__ __forceinline__ void pv_half(f32x16& o0, f32x16& o1, const FLAS char* vrow, int VP, int hi, const f32x16& p) {
#pragma unroll
    for (int s = 0; s < 2; ++s) { const bf16x8 pf = pack8(p, 8 * s);
        const FLAS char* v0 = vrow + (16 * s + 4 * hi) * 2; const FLAS char* v1 = v0 + 32 * VP;
        const s16x4 a0 = *(const FLAS s16x4*)v0, a1 = *(const FLAS s16x4*)(v0 + 16), b0 = *(const FLAS s16x4*)v1, b1 = *(const FLAS s16x4*)(v1 + 16);
        o0 = FA_MFMA(((bf16x8){a0[0], a0[1], a0[2], a0[3], a1[0], a1[1], a1[2], a1[3]}), pf, o0);
        o1 = FA_MFMA(((bf16x8){b0[0], b0[1], b0[2], b0[3], b1[0], b1[1], b1[2], b1[3]}), pf, o1); }
}
typedef short v4i16_t __attribute__((ext_vector_type(4)));
__device__ __forceinline__ s16x4 vtr(const FLAS char* p) { return __builtin_bit_cast(s16x4, __builtin_amdgcn_ds_read_tr16_b64_v4i16((FLAS v4i16_t*)p)); }
__device__ __forceinline__ int tr_lane_off(int lane, int VP) { return (4 * (lane >> 5) + ((lane & 15) >> 2)) * VP + ((lane & 3) * 4 + 16 * ((lane >> 4) & 1)) * 2; }
__device__ __forceinline__ void pv_half_tr(f32x16& o0, f32x16& o1, const FLAS char* vhalf, int VP, const f32x16& p) {
#pragma unroll
    for (int s = 0; s < 2; ++s) { const bf16x8 pf = pack8(p, 8 * s); const FLAS char* a = vhalf + 16 * s * VP;
        const s16x4 a0 = vtr(a), a1 = vtr(a + 8 * VP), b0 = vtr(a + 64), b1 = vtr(a + 8 * VP + 64);
        o0 = FA_MFMA(((bf16x8){a0[0], a0[1], a0[2], a0[3], a1[0], a1[1], a1[2], a1[3]}), pf, o0);
        o1 = FA_MFMA(((bf16x8){b0[0], b0[1], b0[2], b0[3], b1[0], b1[1], b1[2], b1[3]}), pf, o1); }
}
__device__ __forceinline__ void store_o(bf16* orow, const f32x16& o0, const f32x16& o1, float inv, int hi) {
#pragma unroll
    for (int blk = 0; blk < 2; ++blk)
#pragma unroll
        for (int g = 0; g < 4; g += 2) { const f32x16& o = blk ? o1 : o0;
            unsigned ax = pg8::cvt_pk_bf16(o[4 * g] * inv, o[4 * g + 1] * inv), ay = pg8::cvt_pk_bf16(o[4 * g + 2] * inv, o[4 * g + 3] * inv);
            unsigned bx = pg8::cvt_pk_bf16(o[4 * g + 4] * inv, o[4 * g + 5] * inv), by = pg8::cvt_pk_bf16(o[4 * g + 6] * inv, o[4 * g + 7] * inv);
            { auto r = __builtin_amdgcn_permlane32_swap(ax, bx, false, false); ax = r[0]; bx = r[1]; }
            { auto r = __builtin_amdgcn_permlane32_swap(ay, by, false, false); ay = r[0]; by = r[1]; }
            *(v4u*)(orow + 32 * blk + 8 * g + 8 * hi) = (v4u){ax, ay, bx, by}; }
}

template <int DK, bool MOBA>
__device__ __forceinline__ void flash_unit(FLAS char* lds, int tid_in, int b, int qb,
        const bf16* Qh, int qpitch, const bf16* Kh, int kpitch, const bf16* KRb, const bf16* Vh, int vpitch, bf16* Oh,
        const bf16* kmh, const bf16* kml, float slope2) {
    constexpr int KP = DK * 2 + 16, VP = 192, KBUF = 64 * KP, VBUF = 64 * VP;
    int tid = tid_in; asm volatile("" : "+v"(tid));
    const int lane = tid & 63, w = __builtin_amdgcn_readfirstlane(tid >> 6), r32 = lane & 31, hi = lane >> 5;
    const int q0 = qb * 256; (void)b;
    bf16x8 qf[DK / 16];
    { const bf16* qp = Qh + (size_t)(q0 + 32 * w + r32) * qpitch + 8 * hi;
#pragma unroll
      for (int d0 = 0; d0 < DK / 16; ++d0) qf[d0] = *(const bf16x8*)(qp + 16 * d0); }
    unsigned sel = 0u;
    f32x16 cinit;
#pragma unroll
    for (int r = 0; r < 16; ++r) cinit[r] = 0.f;
    if constexpr (MOBA) {
        f32x16 ga = cinit;
#pragma unroll
        for (int d0 = 0; d0 < 4; ++d0) { const bf16x8 ah = *(const bf16x8*)(kmh + (r32 & 15) * 64 + 16 * d0 + 8 * hi), al = *(const bf16x8*)(kml + (r32 & 15) * 64 + 16 * d0 + 8 * hi);
            ga = FA_MFMA(ah, qf[d0], ga); ga = FA_MFMA(al, qf[d0], ga); }
        float g[16];
#pragma unroll
        for (int i = 0; i < 8; ++i) { const float mine = ga[i], oth = xother(mine, hi); const float lo_ = hi ? oth : mine, hi_ = hi ? mine : oth;
            g[(i & 3) + 8 * (i >> 2)] = lo_; g[(i & 3) + 8 * (i >> 2) + 4] = hi_; }
        float v1 = -3e38f, v2 = -3e38f, v3 = -3e38f; int i1 = -1, i2 = -1, i3 = -1;
#pragma unroll
        for (int n = 0; n < 16; ++n) if (n < qb) { const float gv = g[n];
            if (gv > v1) { v3 = v2; i3 = i2; v2 = v1; i2 = i1; v1 = gv; i1 = n; } else if (gv > v2) { v3 = v2; i3 = i2; v2 = gv; i2 = n; } else if (gv > v3) { v3 = gv; i3 = n; } }
        if (i1 >= 0) sel |= 1u << i1; if (i2 >= 0) sel |= 1u << i2; if (i3 >= 0) sel |= 1u << i3;
#pragma unroll
        for (int r = 0; r < 16; ++r) cinit[r] = slope2 * (float)crow(r, hi);
    }
    const float c32 = MOBA ? 32.f * slope2 : 0.f;
    constexpr int CPRK = KP / 16, CPRV = VP / 16, NIK = (64 * CPRK + 63) / 64, NIV = (64 * CPRV + 63) / 64;
    const char* kbase = (const char*)Kh; const char* rbase = (const char*)((DK == 96) ? KRb : Kh); const char* vbase = (const char*)Vh;
    unsigned koffs[2], voffs[2]; bool krope[2];
#pragma unroll
    for (int j = 0; j < 2; ++j) { const int pk = 64 * (w + 8 * j) + lane, rk = pk / CPRK, ck = pk % CPRK; krope[j] = (DK == 96) && ck >= 8 && ck < 12;
        koffs[j] = krope[j] ? (unsigned)(rk * 32 + (ck - 8) * 8) * 2u : (unsigned)(rk * kpitch + (ck < 8 ? ck : 0) * 8) * 2u;
        const int pv = 64 * (w + 8 * j) + lane, rv = pv / CPRV, cv = pv % CPRV; voffs[j] = (unsigned)(rv * vpitch + (cv < 8 ? cv : 0) * 8) * 2u; }
    const int vlo = tr_lane_off(lane, VP);
    const int NT = 4 * (qb + 1);
#define FA_DMA(t, slot) do { const char* kb_ = kbase + (size_t)(t) * 128 * kpitch; const char* rb_ = rbase + (size_t)(t) * 128 * 32; const char* vb_ = vbase + (size_t)(t) * 128 * vpitch; \
        _Pragma("unroll") for (int j = 0; j < 2; ++j) { const int i_ = w + 8 * j; \
            if (i_ < NIK) __builtin_amdgcn_global_load_lds((const unsigned*)((krope[j] ? rb_ : kb_) + koffs[j]), (FLAS unsigned*)(lds + (slot) * KBUF + i_ * 1024), 16, 0, 0); \
            if (i_ < NIV) __builtin_amdgcn_global_load_lds((const unsigned*)(vb_ + voffs[j]), (FLAS unsigned*)(lds + 2 * KBUF + (slot) * VBUF + i_ * 1024), 16, 0, 0); } } while (0)
#define FA_LANDED() asm volatile("s_waitcnt vmcnt(0)" ::: "memory")
    static_assert(NIK <= 16 && NIV <= 16, "two DMA instructions per wave cover a tile");
    FA_DMA(0, 0); FA_LANDED(); __syncthreads();
    float m = MOBA ? NEG : 0.f, l = 0.f; f32x16 o0, o1;
#pragma unroll
    for (int r = 0; r < 16; ++r) { o0[r] = 0.f; o1[r] = 0.f; }
    const int rowrel = 32 * w + r32;
    for (int t = 0; t < NT; ++t) {
        const int buf = t & 1;
        if (t + 1 < NT) FA_DMA(t + 1, buf ^ 1);
        const int n = t >> 2, jd = t & 3; const bool diag = (n == qb);
        bool lane_on = true; if (MOBA && !diag) lane_on = (sel >> n) & 1u;
        bool wave_on = diag ? (64 * jd <= 32 * w + 31) : (MOBA ? (__any(lane_on) != 0) : true);
        if (wave_on) {
            const FLAS char* kt = lds + buf * KBUF + r32 * KP; const FLAS char* vt = lds + 2 * KBUF + buf * VBUF + vlo;
            f32x16 s0 = qk_half<DK>(kt, hi, qf, cinit), s1 = qk_half<DK>(kt + 32 * KP, hi, qf, cinit);
            if (diag && (64 * jd + 63 > 32 * w)) {
#pragma unroll
                for (int r = 0; r < 16; ++r) { const int kr = 64 * jd + crow(r, hi); if (kr > rowrel) s0[r] = NEG; if (kr + 32 > rowrel) s1[r] = NEG; } }
            if constexpr (MOBA) {
                const float tb = slope2 * (float)(64 * t);
                float mx = xmax(fmaxf(max16(s0), max16(s1) + c32)) + tb;
                if (!lane_on) mx = NEG;
                const float mn = fmaxf(m, mx);
                if (__any(mx > m + RESC_THR)) { const float a = __builtin_amdgcn_exp2f(m - mn); l *= a;
#pragma unroll
                    for (int r = 0; r < 16; ++r) { o0[r] *= a; o1[r] *= a; }
                    m = mn; }
                const float mref0 = lane_on ? (m - tb) : POS, mref1 = mref0 - c32;
#pragma unroll
                for (int r = 0; r < 16; ++r) { s0[r] = __builtin_amdgcn_exp2f(s0[r] - mref0); s1[r] = __builtin_amdgcn_exp2f(s1[r] - mref1); }
            } else {
                const float mx = xmax(fmaxf(max16(s0), max16(s1)));
                if (t == 0 || __any(mx > RESC_THR)) { const float d = (t == 0) ? mx : fmaxf(mx, 0.f), a = __builtin_amdgcn_exp2f(-d); m += d; l *= a;
#pragma unroll
                    for (int r = 0; r < 16; ++r) { o0[r] *= a; o1[r] *= a; s0[r] -= d; s1[r] -= d; cinit[r] = -m; } }
#pragma unroll
                for (int r = 0; r < 16; ++r) { s0[r] = __builtin_amdgcn_exp2f(s0[r]); s1[r] = __builtin_amdgcn_exp2f(s1[r]); }
            }
            { float ls = 0.f;
#pragma unroll
              for (int r = 0; r < 16; ++r) ls += s0[r] + s1[r];
              l += ls; }
            pv_half_tr(o0, o1, vt, VP, s0); pv_half_tr(o0, o1, vt + 32 * VP, VP, s1);
        }
        FA_LANDED();
        __syncthreads();
    }
#undef FA_DMA
#undef FA_LANDED
    const float lt = xsum(l);
    store_o(Oh + (size_t)(q0 + 32 * w + r32) * DM, o0, o1, 1.0f / lt, hi);
}

#define SBAR() __builtin_amdgcn_sched_barrier(0)
#define FA_WAIT_BAR(N) asm volatile("s_waitcnt vmcnt(" #N ") lgkmcnt(0)\n\ts_barrier" ::: "memory")
__device__ __forceinline__ void glds16(const void* gsrc, unsigned lds_dst) { unsigned keep;
    asm volatile("s_mov_b32 %0, m0\n\ts_mov_b32 m0, %2\n\ts_nop 0\n\tglobal_load_lds_dwordx4 %1, off\n\ts_mov_b32 m0, %0" : "=&s"(keep) : "v"(gsrc), "s"(lds_dst) : "memory"); }
__device__ __forceinline__ void kload8(bf16x8* kf, const FLAS char* kp) {
    kf[0] = *(const FLAS bf16x8*)(kp);        kf[1] = *(const FLAS bf16x8*)(kp + 512);
    kf[2] = *(const FLAS bf16x8*)(kp + 2048); kf[3] = *(const FLAS bf16x8*)(kp + 2560);
    kf[4] = *(const FLAS bf16x8*)(kp + 4096); kf[5] = *(const FLAS bf16x8*)(kp + 4608);
    kf[6] = *(const FLAS bf16x8*)(kp + 6144); kf[7] = *(const FLAS bf16x8*)(kp + 6656); }
__device__ __forceinline__ void kload2(bf16x8* kf, const FLAS char* kp, int j) { kf[2 * j] = *(const FLAS bf16x8*)(kp + j * 2048); kf[2 * j + 1] = *(const FLAS bf16x8*)(kp + j * 2048 + 512); }
#define MX3(a, b, c) __builtin_fmaxf(__builtin_fmaxf((a), (b)), (c))
__device__ __forceinline__ float rowmax_c(const f32x16& p0, const f32x16& p1, float c32) {
    float a = MX3(p0[0], p0[1], p0[2]), b = MX3(p1[0], p1[1], p1[2]);
#pragma unroll
    for (int r = 3; r < 15; r += 2) { a = MX3(a, p0[r], p0[r + 1]); b = MX3(b, p1[r], p1[r + 1]); }
    a = __builtin_fmaxf(a, p0[15]); b = __builtin_fmaxf(b, p1[15]);
    return xmax(__builtin_fmaxf(a, b + c32)); }
template <int THRL>
__device__ __forceinline__ void moba_unit(FLAS char* lds, int tid_in, int qb_in, const bf16* Qh, const bf16* Kh, const bf16* Vh, bf16* Oh, const bf16* kmh, const bf16* kml, float slope2_in) {
    constexpr int SLOTB = 8192, NSLOT = 3, L_K = 0, L_V = NSLOT * SLOTB, L_WS = 2 * NSLOT * SLOTB, L_OST = 0;
    int tid = tid_in; asm volatile("" : "+v"(tid));
    const int lane = tid & 63, wid = __builtin_amdgcn_readfirstlane(tid >> 6), r32 = lane & 31, hi = lane >> 5;
    const int qb = __builtin_amdgcn_readfirstlane(qb_in), q0 = qb * 256;
    const float slope2 = __builtin_bit_cast(float, __builtin_amdgcn_readfirstlane(__builtin_bit_cast(int, slope2_in)));
    const float c32 = 32.f * slope2, hb = slope2 * (float)(4 * hi);
    const unsigned lds0 = (unsigned)(uintptr_t)lds;
    FLAS float* wsf = (FLAS float*)(lds + L_WS) + wid * 64;
    const bf16* ksrc = Kh + (size_t)lane * 64 + wid * 8;
    const bf16* vsrc = Vh + (size_t)(16 * (wid & 3) + (lane >> 2)) * 64 + (wid >> 2) * 32 + (lane & 3) * 8;
    const unsigned kdst = lds0 + L_K + wid * 1024, vdst = lds0 + L_V + wid * 1024;
#define DMA_K(t, slot) glds16(ksrc + (size_t)(t) * 4096, (unsigned)__builtin_amdgcn_readfirstlane(kdst + (slot)))
#define DMA_V(t, slot) glds16(vsrc + (size_t)(t) * 4096, (unsigned)__builtin_amdgcn_readfirstlane(vdst + (slot)))
    const FLAS char* kp0 = lds + L_K + hi * 1024 + r32 * 16;
    const FLAS char* vp0 = lds + L_V + ((lane >> 4) & 1) * 32 + (lane & 3) * 8 + (4 * hi + ((lane & 15) >> 2)) * 64;
    const int NT = 4 * (qb + 1);
    DMA_K(0, 0); DMA_V(0, 0); DMA_K(1, SLOTB);
    bf16x8 qr[4];
    { const bf16* qp = Qh + (size_t)(q0 + 32 * wid + r32) * 64 + 8 * hi;
#pragma unroll
      for (int d0 = 0; d0 < 4; ++d0) qr[d0] = *(const bf16x8*)(qp + 16 * d0); }
    DMA_K(2, 2 * SLOTB);
    unsigned selq = 1u << qb;
    { f32x16 ga;
#pragma unroll
      for (int r = 0; r < 16; ++r) ga[r] = 0.f;
#pragma unroll
      for (int d0 = 0; d0 < 4; ++d0) { const bf16x8 ah = *(const bf16x8*)(kmh + (r32 & 15) * 64 + 16 * d0 + 8 * hi), al = *(const bf16x8*)(kml + (r32 & 15) * 64 + 16 * d0 + 8 * hi);
          ga = FA_MFMA(ah, qr[d0], ga); ga = FA_MFMA(al, qr[d0], ga); }
      float g[16];
#pragma unroll
      for (int i = 0; i < 8; ++i) { const float mine = ga[i], oth = xother(mine, hi); const float lo_ = hi ? oth : mine, hi_ = hi ? mine : oth;
          g[(i & 3) + 8 * (i >> 2)] = lo_; g[(i & 3) + 8 * (i >> 2) + 4] = hi_; }
      float v1 = -3e38f, v2 = -3e38f, v3 = -3e38f; int i1 = -1, i2 = -1, i3 = -1;
#pragma unroll
      for (int n = 0; n < 16; ++n) if (n < qb) { const float gv = g[n];
          if (gv > v1) { v3 = v2; i3 = i2; v2 = v1; i2 = i1; v1 = gv; i1 = n; } else if (gv > v2) { v3 = v2; i3 = i2; v2 = gv; i2 = n; } else if (gv > v3) { v3 = gv; i3 = n; } }
      if (i1 >= 0) selq |= 1u << i1; if (i2 >= 0) selq |= 1u << i2; if (i3 >= 0) selq |= 1u << i3; }
    float mhat = 0.f, l_reg = 0.f; f32x16 o[2];
#pragma unroll
    for (int r = 0; r < 16; ++r) { o[0][r] = 0.f; o[1][r] = 0.f; }
    f32x16 nb;
    float negbig = -1.0e30f; asm volatile("" : "+v"(negbig));
#define NB_BASE(tt) ((((selq >> ((tt) >> 2)) & 1u) ? (slope2 * (float)(64 * (tt)) - mhat) : negbig) + hb)
#define NB_SET(r, base) nb[r] = __builtin_fmaf(slope2, (float)(((r) & 3) + 8 * ((r) >> 2)), (base))
    { const float b0_ = NB_BASE(0);
#pragma unroll
      for (int r = 0; r < 16; ++r) NB_SET(r, b0_); }
    const int qrel = wid * 32 + r32;
#define CMASK(P0, P1, t) do { const int jb_ = (t) - (NT - 4); if (jb_ >= 0) { const int kb_ = 64 * jb_ + 4 * hi; _Pragma("unroll") for (int r = 0; r < 16; ++r) { const int kv_ = kb_ + (r & 3) + 8 * (r >> 2); if (kv_ > qrel) P0[r] = -INFINITY; if (kv_ + 32 > qrel) P1[r] = -INFINITY; } } } while (0)
    bool resc = false;
#define RESC() do { if (resc) { asm volatile("s_waitcnt lgkmcnt(0)" ::: "memory"); \
        _Pragma("unroll") for (int d_ = 0; d_ < 2; ++d_) _Pragma("unroll") for (int r = 0; r < 16; ++r) o[d_][r] *= wsf[crow(r, hi)]; } } while (0)
    f32x16 pA0, pA1, pB0, pB1; bf16x8 kf[8];
    int sl_prev = 0, sl_cur = 0, sl_next = SLOTB;
#define ROT() do { sl_prev = sl_cur; sl_cur = sl_next; sl_next = (sl_next == (NSLOT - 1) * SLOTB) ? 0 : sl_next + SLOTB; } while (0)
    FA_WAIT_BAR(3);
    { const FLAS char* kb = lds + L_K + hi * 1024 + r32 * 16;
#pragma unroll
      for (int d0 = 0; d0 < 4; ++d0) { const bf16x8 b0 = *(const FLAS bf16x8*)(kb + d0 * 2048), b1 = *(const FLAS bf16x8*)(kb + d0 * 2048 + 512);
          if (d0 == 0) { pA0 = FA_MFMA(b0, qr[0], nb); pA1 = FA_MFMA(b1, qr[0], nb); } else { pA0 = FA_MFMA(b0, qr[d0], pA0); pA1 = FA_MFMA(b1, qr[d0], pA1); } } }
    CMASK(pA0, pA1, 0);
    { const float rm = rowmax_c(pA0, pA1, c32); const float dl = (selq & 1u) ? rm : 0.f; mhat = dl;
#pragma unroll
      for (int r = 0; r < 16; ++r) { pA0[r] = __builtin_amdgcn_exp2f(pA0[r] - dl); pA1[r] = __builtin_amdgcn_exp2f(pA1[r] - dl + c32); }
      const float b1_ = NB_BASE(1);
#pragma unroll
      for (int r = 0; r < 16; ++r) NB_SET(r, b1_); }
    FA_WAIT_BAR(0);
    DMA_K(3, 0); DMA_V(1, SLOTB);
    ROT();
    kload8(kf, kp0 + sl_cur);
    FA_WAIT_BAR(2);
    s16x4 vlo[8], vhi[8]; v4u pw0, pw1, pw2, pw3;
#define PKW(P, B) pg8::cvt_pk_bf16(P[B], P[(B) + 1])
#define PAF(k) __builtin_bit_cast(bf16x8, pw##k)
#define VFR(i) (bf16x8){vlo[i][0], vlo[i][1], vlo[i][2], vlo[i][3], vhi[i][0], vhi[i][1], vhi[i][2], vhi[i][3]}
#define PIN(x) asm volatile("" : "+v"(x))
#define GAPA(MF, A0, A1, A2, A3, W0, W1, PW) do { MF; sacc += A0; sacc += A1; sacc += A2; sacc += A3; PIN(sacc); W0; W1; PIN(PW); SBAR(); } while (0)
#define EX(v) __builtin_amdgcn_exp2f(v)
#define GAPB0(MF, X, B, R0) do { MF; X[B] = EX(X[B]); X[(B) + 1] = EX(X[(B) + 1]); X[(B) + 2] = EX(X[(B) + 2]); X[(B) + 3] = EX(X[(B) + 3]); NB_SET(R0, nbase_); NB_SET((R0) + 1, nbase_); PIN(X); PIN(nb); SBAR(); } while (0)
#define GAPB1(MF, X, B, R0) do { MF; X[B] = EX(X[B] + c32); X[(B) + 1] = EX(X[(B) + 1] + c32); X[(B) + 2] = EX(X[(B) + 2] + c32); X[(B) + 3] = EX(X[(B) + 3] + c32); NB_SET(R0, nbase_); NB_SET((R0) + 1, nbase_); PIN(X); PIN(nb); SBAR(); } while (0)
#define VRD(i) do { vlo[i] = vtr(vp_ + (((i) >> 2) * 4096 + ((i) & 3) * 1024)); vhi[i] = vtr(vp_ + (((i) >> 2) * 4096 + ((i) & 3) * 1024 + 512)); } while (0)
#define KRD(G, j) do { if (G) { kload2(kf, kp0 + sl_next, j); SBAR(); } } while (0)
#define STEP(C0, C1, P0, P1, t, GK, GV, GL) do { SBAR(); \
    const FLAS char* vp_ = vp0 + sl_prev; \
    VRD(0); SBAR(); float sacc = (P0[0] + P0[1]); \
    GAPA(C0 = FA_MFMA(kf[0], qr[0], nb), P0[2], P0[3], P0[4], P0[5],     pw0[0] = PKW(P0, 0), pw0[1] = PKW(P0, 2), pw0); \
    VRD(4); SBAR(); GAPA(C0 = FA_MFMA(kf[2], qr[1], C0), P0[6], P0[7], P0[8], P0[9],     pw0[2] = PKW(P0, 4), pw0[3] = PKW(P0, 6), pw0); \
    VRD(1); SBAR(); GAPA(C0 = FA_MFMA(kf[4], qr[2], C0),   P0[10], P0[11], P0[12], P0[13], pw1[0] = PKW(P0, 8), pw1[1] = PKW(P0, 10), pw1); \
    VRD(5); SBAR(); GAPA(C0 = FA_MFMA(kf[6], qr[3], C0),   P0[14], P0[15], P1[0], P1[1],   pw1[2] = PKW(P0, 12), pw1[3] = PKW(P0, 14), pw1); \
    VRD(2); SBAR(); GAPA(C1 = FA_MFMA(kf[1], qr[0], nb),   P1[2], P1[3], P1[4], P1[5],     pw2[0] = PKW(P1, 0), pw2[1] = PKW(P1, 2), pw2); \
    VRD(6); SBAR(); GAPA(C1 = FA_MFMA(kf[3], qr[1], C1),   P1[6], P1[7], P1[8], P1[9],     pw2[2] = PKW(P1, 4), pw2[3] = PKW(P1, 6), pw2); \
    VRD(3); SBAR(); GAPA(C1 = FA_MFMA(kf[5], qr[2], C1),   P1[10], P1[11], P1[12], P1[13], pw3[0] = PKW(P1, 8), pw3[1] = PKW(P1, 10), pw3); \
    VRD(7); SBAR(); GAPA(C1 = FA_MFMA(kf[7], qr[3], C1),   P1[14], P1[15], 0.f, 0.f,       pw3[2] = PKW(P1, 12), pw3[3] = PKW(P1, 14), pw3); \
    l_reg += sacc; \
    if (GK) { DMA_K((t) + 3, sl_cur); } if (GV) { DMA_V((t) + 1, sl_next); } \
    CMASK(C0, C1, t); \
    { const float rm = rowmax_c(C0, C1, c32); \
      resc = false; \
      if (__builtin_expect(__any(rm > (float)THRL), 0)) { const float dl = __builtin_fmaxf(rm, 0.f); mhat += dl; \
        _Pragma("unroll") for (int r = 0; r < 16; ++r) { C0[r] -= dl; C1[r] -= dl; } \
        const float f = __builtin_amdgcn_exp2f(-dl); l_reg *= f; if (hi == 0) wsf[r32] = f; resc = true; } } \
    const float nbase_ = NB_BASE((t) + 1); \
    SBAR(); \
    GAPB0(o[0] = FA_MFMA(PAF(0), VFR(0), o[0]), C0, 0, 0); \
    GAPB0(o[1] = FA_MFMA(PAF(0), VFR(4), o[1]), C0, 4, 2); \
    KRD(GL, 0); GAPB0(o[0] = FA_MFMA(PAF(1), VFR(1), o[0]), C0, 8, 4); \
    KRD(GL, 1); GAPB0(o[1] = FA_MFMA(PAF(1), VFR(5), o[1]), C0, 12, 6); \
    KRD(GL, 2); GAPB1(o[0] = FA_MFMA(PAF(2), VFR(2), o[0]), C1, 0, 8); \
    KRD(GL, 3); GAPB1(o[1] = FA_MFMA(PAF(2), VFR(6), o[1]), C1, 4, 10); \
    GAPB1(o[0] = FA_MFMA(PAF(3), VFR(3), o[0]), C1, 8, 12); \
    GAPB1(o[1] = FA_MFMA(PAF(3), VFR(7), o[1]), C1, 12, 14); \
    } while (0)
    int t = 1;
#undef CMASK
#define CMASK(P0, P1, t) do { } while (0)
    for (; t + 5 < NT; t += 2) {
        STEP(pB0, pB1, pA0, pA1, t, true, true, true);       FA_WAIT_BAR(2); RESC(); ROT();
        STEP(pA0, pA1, pB0, pB1, t + 1, true, true, true);   FA_WAIT_BAR(2); RESC(); ROT();
    }
#undef CMASK
#define CMASK(P0, P1, t) do { const int jb_ = (t) - (NT - 4); if (jb_ >= 0) { const int kb_ = 64 * jb_ + 4 * hi; _Pragma("unroll") for (int r = 0; r < 16; ++r) { const int kv_ = kb_ + (r & 3) + 8 * (r >> 2); if (kv_ > qrel) P0[r] = -INFINITY; if (kv_ + 32 > qrel) P1[r] = -INFINITY; } } } while (0)
#define ENDW(tt) do { if ((tt) + 3 < NT) { FA_WAIT_BAR(2); } else if ((tt) + 2 < NT) { FA_WAIT_BAR(1); } else { FA_WAIT_BAR(0); } } while (0)
    for (; t + 1 < NT; t += 2) {
        STEP(pB0, pB1, pA0, pA1, t, (t + 3 < NT), (t + 1 < NT), (t + 1 < NT));         ENDW(t);     RESC(); ROT();
        STEP(pA0, pA1, pB0, pB1, t + 1, (t + 4 < NT), (t + 2 < NT), (t + 2 < NT));     ENDW(t + 1); RESC(); ROT();
    }
    STEP(pB0, pB1, pA0, pA1, NT - 1, false, false, false); RESC();
    { float sacc = pB0[0] + pB0[1];
#pragma unroll
      for (int r = 2; r < 16; ++r) sacc += pB0[r];
#pragma unroll
      for (int r = 0; r < 16; ++r) sacc += pB1[r];
      l_reg += sacc;
      pw0 = (v4u){PKW(pB0, 0), PKW(pB0, 2), PKW(pB0, 4), PKW(pB0, 6)}; pw1 = (v4u){PKW(pB0, 8), PKW(pB0, 10), PKW(pB0, 12), PKW(pB0, 14)};
      pw2 = (v4u){PKW(pB1, 0), PKW(pB1, 2), PKW(pB1, 4), PKW(pB1, 6)}; pw3 = (v4u){PKW(pB1, 8), PKW(pB1, 10), PKW(pB1, 12), PKW(pB1, 14)};
      SBAR();
      const FLAS char* vp_ = vp0 + sl_cur;
#pragma unroll
      for (int i = 0; i < 8; ++i) VRD(i);
      o[0] = FA_MFMA(PAF(0), VFR(0), o[0]); o[0] = FA_MFMA(PAF(1), VFR(1), o[0]); o[0] = FA_MFMA(PAF(2), VFR(2), o[0]); o[0] = FA_MFMA(PAF(3), VFR(3), o[0]);
      o[1] = FA_MFMA(PAF(0), VFR(4), o[1]); o[1] = FA_MFMA(PAF(1), VFR(5), o[1]); o[1] = FA_MFMA(PAF(2), VFR(6), o[1]); o[1] = FA_MFMA(PAF(3), VFR(7), o[1]); }
    l_reg = xsum(l_reg);
    if (hi == 0) wsf[32 + r32] = l_reg;
    asm volatile("s_waitcnt lgkmcnt(0)\n\ts_barrier" ::: "memory");
    float rli[16];
#pragma unroll
    for (int r = 0; r < 16; ++r) rli[r] = __builtin_amdgcn_rcpf(wsf[32 + crow(r, hi)]);
    { FLAS bf16* stg = (FLAS bf16*)(lds + L_OST) + wid * 2048;
#pragma unroll
      for (int r = 0; r < 16; ++r) { const int orow = crow(r, hi);
#pragma unroll
          for (int d0 = 0; d0 < 2; ++d0) stg[orow * 64 + d0 * 32 + r32] = (bf16)f2bf(o[d0][r] * rli[r]); }
      asm volatile("s_waitcnt lgkmcnt(0)" ::: "memory");
      bf16* Ow = Oh + (size_t)(q0 + wid * 32) * DM;
#pragma unroll
      for (int i = 0; i < 4; ++i) { const int row = i * 8 + (lane >> 3), ch = lane & 7; const v4u v = *(const FLAS v4u*)(stg + row * 64 + ch * 8); *(v4u*)(Ow + (size_t)row * DM + ch * 8) = v; } }
    asm volatile("s_waitcnt lgkmcnt(0)\n\ts_barrier" ::: "memory");
#undef DMA_K
#undef DMA_V
#undef NB_BASE
#undef NB_SET
#undef CMASK
#undef RESC
#undef ROT
#undef PKW
#undef PAF
#undef VFR
#undef PIN
#undef GAPA
#undef EX
#undef GAPB0
#undef GAPB1
#undef VRD
#undef KRD
#undef STEP
#undef ENDW
}

template <int THRL>
__device__ __forceinline__ void mla_unit(FLAS char* lds, int tid_in, int qb_in, const bf16* Qh, const bf16* Kh, const bf16* KRb, const bf16* Vh, bf16* Oh) {
    constexpr int KSLOT = 12288, VSLOT = 8192, NSLOT = 3, L_K = 0, L_V = NSLOT * KSLOT, L_WS = L_V + NSLOT * VSLOT, L_OST = 0;
    int tid = tid_in; asm volatile("" : "+v"(tid));
    const int lane = tid & 63, wid = __builtin_amdgcn_readfirstlane(tid >> 6), r32 = lane & 31, hi = lane >> 5;
    const int qb = __builtin_amdgcn_readfirstlane(qb_in), q0 = qb * 256;
    const unsigned lds0 = (unsigned)(uintptr_t)lds;
    FLAS float* wsf = (FLAS float*)(lds + L_WS) + wid * 64;
    const bf16* ksrc = Kh + (size_t)lane * 64 + wid * 8;
    const bf16* rsrc = KRb + (size_t)lane * 32 + (wid & 3) * 8;
    const bf16* vsrc = Vh + (size_t)(16 * (wid & 3) + (lane >> 2)) * 64 + (wid >> 2) * 32 + (lane & 3) * 8;
    const unsigned kdst = lds0 + L_K + wid * 1024, rdst = lds0 + L_K + (8 + (wid & 3)) * 1024, vdst = lds0 + L_V + wid * 1024;
    const bool ropew = wid < 4;
#define DMA_K(t, slot) do { glds16(ksrc + (size_t)(t) * 4096, (unsigned)__builtin_amdgcn_readfirstlane(kdst + (slot))); if (ropew) glds16(rsrc + (size_t)(t) * 2048, (unsigned)__builtin_amdgcn_readfirstlane(rdst + (slot))); } while (0)
#define DMA_V(t, slot) glds16(vsrc + (size_t)(t) * 4096, (unsigned)__builtin_amdgcn_readfirstlane(vdst + (slot)))
    const FLAS char* kp0 = lds + L_K + hi * 1024 + r32 * 16;
    const FLAS char* vp0 = lds + L_V + ((lane >> 4) & 1) * 32 + (lane & 3) * 8 + (4 * hi + ((lane & 15) >> 2)) * 64;
    const int NT = 4 * (qb + 1);
    DMA_K(0, 0); DMA_V(0, 0); DMA_K(1, KSLOT);
    bf16x8 qr[6];
    { const bf16* qp = Qh + (size_t)(q0 + 32 * wid + r32) * 96 + 8 * hi;
#pragma unroll
      for (int d0 = 0; d0 < 6; ++d0) qr[d0] = *(const bf16x8*)(qp + 16 * d0); }
    DMA_K(2, 2 * KSLOT);
    float mhat = 0.f, l_reg = 0.f; f32x16 o[2], negm;
#pragma unroll
    for (int r = 0; r < 16; ++r) { o[0][r] = 0.f; o[1][r] = 0.f; negm[r] = 0.f; }
    asm volatile("" : "+v"(negm));
    const int qrel = wid * 32 + r32;
#define CMASK(P0, P1, t) do { const int jb_ = (t) - (NT - 4); if (jb_ >= 0) { const int kb_ = 64 * jb_ + 4 * hi; _Pragma("unroll") for (int r = 0; r < 16; ++r) { const int kv_ = kb_ + (r & 3) + 8 * (r >> 2); if (kv_ > qrel) P0[r] = -INFINITY; if (kv_ + 32 > qrel) P1[r] = -INFINITY; } } } while (0)
    bool resc = false;
#define RESC() do { if (resc) { asm volatile("s_waitcnt lgkmcnt(0)" ::: "memory"); \
        _Pragma("unroll") for (int d_ = 0; d_ < 2; ++d_) _Pragma("unroll") for (int r = 0; r < 16; ++r) o[d_][r] *= wsf[crow(r, hi)]; } } while (0)
    f32x16 pA0, pA1, pB0, pB1; bf16x8 kf[12];
    int ks_cur = 0, ks_next = KSLOT, vs_prev = 0, vs_cur = 0, vs_next = VSLOT;
#define ROT() do { ks_cur = ks_next; ks_next = (ks_next == (NSLOT - 1) * KSLOT) ? 0 : ks_next + KSLOT; vs_prev = vs_cur; vs_cur = vs_next; vs_next = (vs_next == (NSLOT - 1) * VSLOT) ? 0 : vs_next + VSLOT; } while (0)
    FA_WAIT_BAR(0);
    { const FLAS char* kb = lds + L_K + hi * 1024 + r32 * 16;
#pragma unroll
      for (int d0 = 0; d0 < 6; ++d0) { const bf16x8 b0 = *(const FLAS bf16x8*)(kb + d0 * 2048), b1 = *(const FLAS bf16x8*)(kb + d0 * 2048 + 512);
          if (d0 == 0) { pA0 = FA_MFMA(b0, qr[0], negm); pA1 = FA_MFMA(b1, qr[0], negm); } else { pA0 = FA_MFMA(b0, qr[d0], pA0); pA1 = FA_MFMA(b1, qr[d0], pA1); } } }
    CMASK(pA0, pA1, 0);
    { const float rm = rowmax_c(pA0, pA1, 0.f); mhat = rm;
#pragma unroll
      for (int r = 0; r < 16; ++r) { pA0[r] = __builtin_amdgcn_exp2f(pA0[r] - rm); pA1[r] = __builtin_amdgcn_exp2f(pA1[r] - rm); }
#pragma unroll
      for (int r = 0; r < 16; ++r) negm[r] = -mhat;
      asm volatile("" : "+v"(negm)); }
    FA_WAIT_BAR(0);
    DMA_K(3, 0); DMA_V(1, VSLOT);
    ROT();
#pragma unroll
    for (int j = 0; j < 6; ++j) kload2(kf, kp0 + ks_cur, j);
    if (ropew) { FA_WAIT_BAR(3); } else { FA_WAIT_BAR(2); }
    s16x4 vlo[8], vhi[8]; v4u pw0, pw1, pw2, pw3;
#define PKW(P, B) pg8::cvt_pk_bf16(P[B], P[(B) + 1])
#define PAF(k) __builtin_bit_cast(bf16x8, pw##k)
#define VFR(i) (bf16x8){vlo[i][0], vlo[i][1], vlo[i][2], vlo[i][3], vhi[i][0], vhi[i][1], vhi[i][2], vhi[i][3]}
#define PIN(x) asm volatile("" : "+v"(x))
#define GAPA(MF, A0, A1, A2, W0, W1, PW) do { MF; sacc += A0; sacc += A1; sacc += A2; PIN(sacc); W0; W1; PIN(PW); SBAR(); } while (0)
#define GAPA0(MF, A0, A1, A2) do { MF; sacc += A0; sacc += A1; sacc += A2; PIN(sacc); SBAR(); } while (0)
#define EX(v) __builtin_amdgcn_exp2f(v)
#define GAPB(MF, X, B) do { MF; X[B] = EX(X[B]); X[(B) + 1] = EX(X[(B) + 1]); X[(B) + 2] = EX(X[(B) + 2]); X[(B) + 3] = EX(X[(B) + 3]); PIN(X); SBAR(); } while (0)
#define VRD(i) do { vlo[i] = vtr(vp_ + (((i) >> 2) * 4096 + ((i) & 3) * 1024)); vhi[i] = vtr(vp_ + (((i) >> 2) * 4096 + ((i) & 3) * 1024 + 512)); } while (0)
#define KRD(G, j) do { if (G) { kload2(kf, kp0 + ks_next, j); SBAR(); } } while (0)
#define STEP(C0, C1, P0, P1, t, GK, GV, GL) do { SBAR(); \
    const FLAS char* vp_ = vp0 + vs_prev; \
    float sacc = (P0[0] + P0[1]); \
    GAPA(C0 = FA_MFMA(kf[0], qr[0], negm), P0[2], P0[3], P0[4],      pw0[0] = PKW(P0, 0), pw0[1] = PKW(P0, 2), pw0); \
    GAPA(C0 = FA_MFMA(kf[2], qr[1], C0), P0[5], P0[6], P0[7],      pw0[2] = PKW(P0, 4), pw0[3] = PKW(P0, 6), pw0); \
    GAPA(C0 = FA_MFMA(kf[4], qr[2], C0),   P0[8], P0[9], P0[10],     pw1[0] = PKW(P0, 8), pw1[1] = PKW(P0, 10), pw1); \
    GAPA(C0 = FA_MFMA(kf[6], qr[3], C0),   P0[11], P0[12], P0[13],   pw1[2] = PKW(P0, 12), pw1[3] = PKW(P0, 14), pw1); \
    VRD(0); SBAR(); GAPA(C0 = FA_MFMA(kf[8], qr[4], C0),   P0[14], P0[15], P1[0],    pw2[0] = PKW(P1, 0), pw2[1] = PKW(P1, 2), pw2); \
    VRD(4); SBAR(); GAPA(C0 = FA_MFMA(kf[10], qr[5], C0),   P1[1], P1[2], P1[3],      pw2[2] = PKW(P1, 4), pw2[3] = PKW(P1, 6), pw2); \
    VRD(1); SBAR(); GAPA(C1 = FA_MFMA(kf[1], qr[0], negm),   P1[4], P1[5], P1[6],      pw3[0] = PKW(P1, 8), pw3[1] = PKW(P1, 10), pw3); \
    VRD(5); SBAR(); GAPA(C1 = FA_MFMA(kf[3], qr[1], C1),   P1[7], P1[8], P1[9],      pw3[2] = PKW(P1, 12), pw3[3] = PKW(P1, 14), pw3); \
    VRD(2); SBAR(); GAPA0(C1 = FA_MFMA(kf[5], qr[2], C1),   P1[10], P1[11], P1[12]); \
    VRD(6); SBAR(); GAPA0(C1 = FA_MFMA(kf[7], qr[3], C1),   P1[13], P1[14], P1[15]); \
    VRD(3); SBAR(); C1 = FA_MFMA(kf[9], qr[4], C1); SBAR(); \
    VRD(7); SBAR(); C1 = FA_MFMA(kf[11], qr[5], C1); SBAR(); \
    l_reg += sacc; \
    if (GK) { DMA_K((t) + 3, ks_cur); } if (GV) { DMA_V((t) + 1, vs_next); } \
    CMASK(C0, C1, t); \
    { const float rm = rowmax_c(C0, C1, 0.f); \
      resc = false; \
      if (__builtin_expect(__any(rm > (float)THRL), 0)) { const float dl = __builtin_fmaxf(rm, 0.f); mhat += dl; \
        _Pragma("unroll") for (int r = 0; r < 16; ++r) { C0[r] -= dl; C1[r] -= dl; } \
        _Pragma("unroll") for (int r = 0; r < 16; ++r) negm[r] = -mhat; asm volatile("" : "+v"(negm)); \
        const float f = __builtin_amdgcn_exp2f(-dl); l_reg *= f; if (hi == 0) wsf[r32] = f; resc = true; } } \
    SBAR(); \
    GAPB(o[0] = FA_MFMA(PAF(0), VFR(0), o[0]), C0, 0); \
    KRD(GL, 0); GAPB(o[1] = FA_MFMA(PAF(0), VFR(4), o[1]), C0, 4); \
    KRD(GL, 1); GAPB(o[0] = FA_MFMA(PAF(1), VFR(1), o[0]), C0, 8); \
    KRD(GL, 2); GAPB(o[1] = FA_MFMA(PAF(1), VFR(5), o[1]), C0, 12); \
    KRD(GL, 3); GAPB(o[0] = FA_MFMA(PAF(2), VFR(2), o[0]), C1, 0); \
    KRD(GL, 4); GAPB(o[1] = FA_MFMA(PAF(2), VFR(6), o[1]), C1, 4); \
    KRD(GL, 5); GAPB(o[0] = FA_MFMA(PAF(3), VFR(3), o[0]), C1, 8); \
    GAPB(o[1] = FA_MFMA(PAF(3), VFR(7), o[1]), C1, 12); \
    } while (0)
#define ENDW(tt) do { const bool gk_ = (tt) + 3 < NT, gv_ = (tt) + 1 < NT; \
        if (gk_ && gv_) { if (ropew) { FA_WAIT_BAR(3); } else { FA_WAIT_BAR(2); } } \
        else if ((tt) + 2 < NT) { FA_WAIT_BAR(1); } \
        else { FA_WAIT_BAR(0); } } while (0)
    int t = 1;
#undef CMASK
#define CMASK(P0, P1, t) do { } while (0)
    for (; t + 5 < NT; t += 2) {
        STEP(pB0, pB1, pA0, pA1, t, true, true, true);       ENDW(t);     RESC(); ROT();
        STEP(pA0, pA1, pB0, pB1, t + 1, true, true, true);   ENDW(t + 1); RESC(); ROT();
    }
#undef CMASK
#define CMASK(P0, P1, t) do { const int jb_ = (t) - (NT - 4); if (jb_ >= 0) { const int kb_ = 64 * jb_ + 4 * hi; _Pragma("unroll") for (int r = 0; r < 16; ++r) { const int kv_ = kb_ + (r & 3) + 8 * (r >> 2); if (kv_ > qrel) P0[r] = -INFINITY; if (kv_ + 32 > qrel) P1[r] = -INFINITY; } } } while (0)
    for (; t + 1 < NT; t += 2) {
        STEP(pB0, pB1, pA0, pA1, t, (t + 3 < NT), (t + 1 < NT), (t + 1 < NT));         ENDW(t);     RESC(); ROT();
        STEP(pA0, pA1, pB0, pB1, t + 1, (t + 4 < NT), (t + 2 < NT), (t + 2 < NT));     ENDW(t + 1); RESC(); ROT();
    }
    STEP(pB0, pB1, pA0, pA1, NT - 1, false, false, false); RESC();
    { float sacc = pB0[0] + pB0[1];
#pragma unroll
      for (int r = 2; r < 16; ++r) sacc += pB0[r];
#pragma unroll
      for (int r = 0; r < 16; ++r) sacc += pB1[r];
      l_reg += sacc;
      pw0 = (v4u){PKW(pB0, 0), PKW(pB0, 2), PKW(pB0, 4), PKW(pB0, 6)}; pw1 = (v4u){PKW(pB0, 8), PKW(pB0, 10), PKW(pB0, 12), PKW(pB0, 14)};
      pw2 = (v4u){PKW(pB1, 0), PKW(pB1, 2), PKW(pB1, 4), PKW(pB1, 6)}; pw3 = (v4u){PKW(pB1, 8), PKW(pB1, 10), PKW(pB1, 12), PKW(pB1, 14)};
      SBAR();
      const FLAS char* vp_ = vp0 + vs_cur;
#pragma unroll
      for (int i = 0; i < 8; ++i) VRD(i);
      o[0] = FA_MFMA(PAF(0), VFR(0), o[0]); o[0] = FA_MFMA(PAF(1), VFR(1), o[0]); o[0] = FA_MFMA(PAF(2), VFR(2), o[0]); o[0] = FA_MFMA(PAF(3), VFR(3), o[0]);
      o[1] = FA_MFMA(PAF(0), VFR(4), o[1]); o[1] = FA_MFMA(PAF(1), VFR(5), o[1]); o[1] = FA_MFMA(PAF(2), VFR(6), o[1]); o[1] = FA_MFMA(PAF(3), VFR(7), o[1]); }
    l_reg = xsum(l_reg);
    if (hi == 0) wsf[32 + r32] = l_reg;
    asm volatile("s_waitcnt lgkmcnt(0)\n\ts_barrier" ::: "memory");
    float rli[16];
#pragma unroll
    for (int r = 0; r < 16; ++r) rli[r] = __builtin_amdgcn_rcpf(wsf[32 + crow(r, hi)]);
    { FLAS bf16* stg = (FLAS bf16*)(lds + L_OST) + wid * 2048;
#pragma unroll
      for (int r = 0; r < 16; ++r) { const int orow = crow(r, hi);
#pragma unroll
          for (int d0 = 0; d0 < 2; ++d0) stg[orow * 64 + d0 * 32 + r32] = (bf16)f2bf(o[d0][r] * rli[r]); }
      asm volatile("s_waitcnt lgkmcnt(0)" ::: "memory");
      bf16* Ow = Oh + (size_t)(q0 + wid * 32) * DM;
#pragma unroll
      for (int i = 0; i < 4; ++i) { const int row = i * 8 + (lane >> 3), ch = lane & 7; const v4u v = *(const FLAS v4u*)(stg + row * 64 + ch * 8); *(v4u*)(Ow + (size_t)row * DM + ch * 8) = v; } }
    asm volatile("s_waitcnt lgkmcnt(0)\n\ts_barrier" ::: "memory");
#undef DMA_K
#undef DMA_V
#undef CMASK
#undef RESC
#undef ROT
#undef PKW
#undef PAF
#undef VFR
#undef PIN
#undef GAPA
#undef GAPA0
#undef EX
#undef GAPB
#undef VRD
#undef KRD
#undef STEP
#undef ENDW
}

__device__ __forceinline__ void dil_phase(FLAS char* lds, int tid_in, int bx, int G, bf16* proj, float* lse) {
    constexpr int KP = 144, VP = 192, VOFF = 384 * KP, NU = BATCH * 12 * 16;
    int tid = tid_in; asm volatile("" : "+v"(tid));
    const int lane = tid & 63, w = __builtin_amdgcn_readfirstlane(tid >> 6), r32 = lane & 31, hi = lane >> 5;
    v4u zz = (v4u){0u, 0u, 0u, 0u}; asm volatile("" : "+v"(zz));
    v4u kr[6], vr[6]; bf16x8 qn[4];
#define DIL_DECODE(u_) const int b_ = (u_) / 192, h_ = ((u_) >> 4) % 12, i16_ = (u_) & 15, g_ = h_ >> 2, dil_ = (g_ == 0) ? 1 : (g_ == 1) ? 4 : 16, nch_ = 16 / dil_, res_ = i16_ / nch_, ch_ = i16_ % nch_, m0_ = 256 * ch_; \
        const size_t rowb_ = (size_t)b_ * SEQ; const bf16* hq_ = proj + ((size_t)(b_ * HSLOTS + SL_DQ + h_) * SEQ) * 64; (void)ch_; (void)hq_
#define DIL_LOAD(u_) do { DIL_DECODE(u_); \
        _Pragma("unroll") for (int i = 0; i < 6; ++i) { const int idx = tid + 512 * i, kk = idx >> 3, kch = idx & 7, mp = m0_ - 128 + kk; kr[i] = zz; vr[i] = zz; \
            if (mp >= 0) { const bf16* p_ = hq_ + (size_t)(mp * dil_ + res_) * 64 + kch * 8; kr[i] = *(const v4u*)(p_ + (size_t)SL_DK * SEQ * 64); vr[i] = *(const v4u*)(p_ + (size_t)SL_DV * SEQ * 64); } } \
        { const size_t qtok_ = (size_t)(m0_ + 32 * w + r32) * dil_ + res_; \
          _Pragma("unroll") for (int d0 = 0; d0 < 4; ++d0) qn[d0] = *(const bf16x8*)(hq_ + qtok_ * 64 + 16 * d0 + 8 * hi); } } while (0)
    int u = bx; if (u >= NU) return;
    DIL_LOAD(u);
    for (; u < NU; u += G) {
        DIL_DECODE(u);
#pragma unroll
        for (int i = 0; i < 6; ++i) { const int idx = tid + 512 * i, kk = idx >> 3, kch = idx & 7; *(FLAS v4u*)(lds + kk * KP + kch * 16) = kr[i]; *(FLAS v4u*)(lds + VOFF + kk * VP + kch * 16) = vr[i]; }
        bf16x8 qf[4];
#pragma unroll
        for (int d0 = 0; d0 < 4; ++d0) qf[d0] = qn[d0];
        const float slope2d = exp2f(-8.0f * (float)(h_ + 1) / 18.0f) * LOG2E * (float)dil_;
        const size_t qrow = rowb_ + (size_t)(m0_ + 32 * w + r32) * dil_ + res_;
        f32x16 cinit;
#pragma unroll
        for (int r = 0; r < 16; ++r) cinit[r] = slope2d * (float)crow(r, hi);
        __syncthreads();
        if (u + G < NU) DIL_LOAD(u + G);
        f32x16 s[5]; float mx = NEG;
#pragma unroll
        for (int i = 0; i < 5; ++i) { s[i] = qk_half<64>(lds + (32 * (w + i) + r32) * KP, hi, qf, cinit);
            const bool dead = (ch_ == 0) && (w + i < 4);
#pragma unroll
            for (int r = 0; r < 16; ++r) { const int krr = crow(r, hi); bool ok = !dead; if (i == 0) ok = ok && (krr >= r32); if (i == 4) ok = ok && (krr <= r32); if (!ok) s[i][r] = NEG; }
            mx = fmaxf(mx, max16(s[i]) + (float)(32 * i) * slope2d); }
        mx = xmax(mx);
        float ls = 0.f; f32x16 o0, o1;
#pragma unroll
        for (int r = 0; r < 16; ++r) { o0[r] = 0.f; o1[r] = 0.f; }
#pragma unroll
        for (int i = 0; i < 5; ++i) { const float mref = mx - (float)(32 * i) * slope2d;
#pragma unroll
            for (int r = 0; r < 16; ++r) { s[i][r] = __builtin_amdgcn_exp2f(s[i][r] - mref); ls += s[i][r]; }
            pv_half_tr(o0, o1, lds + VOFF + (32 * (w + i)) * VP + tr_lane_off(lane, VP), VP, s[i]); }
        const float lt = xsum(ls);
        if (hi == 0) lse[qrow * 12 + h_] = mx + __builtin_amdgcn_logf(lt) - slope2d * (float)(r32 + 128);
        store_o(proj + ((size_t)(b_ * HSLOTS + SL_DQ + h_) * SEQ + (qrow - rowb_)) * 64, o0, o1, 1.0f / lt, hi);
        __syncthreads();
    }
#undef DIL_LOAD
#undef DIL_DECODE
}
#undef FA_MFMA
}

struct Args { const float* in[20]; float* out; unsigned char* ws; int ph_lo, ph_hi; };
constexpr int PH_PER_LAYER = 11, N_PHASES = 1 + DEPTH * PH_PER_LAYER + 1;

__global__ void __launch_bounds__(NWAVES * 64, 2) mk_fwd(Args args) {
    extern __shared__ __attribute__((aligned(16))) unsigned char lds[];
    Frame F;
    F.lds = (LAS unsigned char*)lds;
    F.MISC = (volatile LAS unsigned*)(F.lds + MISC_OFF);
    unsigned char* ws = args.ws;
    F.ctl = (gu32*)(ws + WS_CTL);
    for (int u = threadIdx.x; u < (LDS_BYTES - LDSCTL_OFF) / 4; u += NWAVES * 64) ((LAS unsigned*)(F.lds + LDSCTL_OFF))[u] = 0u;
    __syncthreads();
    const int wave_s = __builtin_amdgcn_readfirstlane((int)threadIdx.x >> 6);
#define MYTID() (OPQ_S(wave_s) * 64 + lane_id_volatile())
#define STAGGER() do { const unsigned long long t0_ = __builtin_amdgcn_s_memrealtime(); const unsigned long long d_ = (unsigned long long)(MK_STAGGER_TICKS) * (unsigned)((OPQ_S((int)blockIdx.x) * 5) & 7); while (__builtin_amdgcn_s_memrealtime() - t0_ < d_) __builtin_amdgcn_s_sleep(8); } while (0)
#define PHASE_LANES() int tid_ = MYTID(); asm volatile("" : "+v"(tid_)); int G_ = gridDim.x, bx_ = blockIdx.x; asm volatile("" : "+s"(G_), "+s"(bx_)); \
    const int lane = tid_ & 63, wave = __builtin_amdgcn_readfirstlane(tid_ >> 6); const int vcu_ = (G_ % 8 == 0) ? (bx_ % 8) * (G_ / 8) + bx_ / 8 : bx_; const int gw = vcu_ * NWAVES + wave, NGW = G_ * NWAVES; (void)lane; (void)gw; (void)NGW
    XcdBarrier bar; bar.bar = (unsigned*)(F.ctl + CW_BAR); bar.x = 0; bar.st = nullptr;
    if (!MK_PER_PHASE) bar = xcd_barrier_post((unsigned*)(F.ctl + CW_BAR), F.MISC + 8);
#define GRID_BAR() do { if (MK_PER_PHASE) { if (MYTID() == 0) __hip_atomic_store(F.ctl + 0, 0xBADBA0u, RLX_AGENT); } else { for (int xb_ = 0; xb_ <= MK_EXTRA_BAR; ++xb_) xcd_barrier(bar, MYTID() == 0); } } while (0)
    const int lo = args.ph_lo, hi = args.ph_hi;
#define IN(k) (lo <= (k) && (k) < hi)
#define BOTH(k) (IN(k) && IN((k) + 1))

#define PHASE_PTRS() unsigned zo_ = 0u; asm volatile("" : "+s"(zo_)); unsigned char* ws_ = args.ws + zo_;     \
    const float* x_in = args.in[0]; float* out = args.out; \
    float* cosT = (float*)(ws_ + WS_ROPE); float* sinT = cosT + SEQ * 16; float* kmean = (float*)(ws_ + WS_KMEAN); bf16* kmh = (bf16*)(ws_ + WS_KMEAN + 192 * 1024); bf16* kml = kmh + BATCH * 6 * 16 * 64; float* lse = (float*)(ws_ + WS_LSE); (void)kmh; (void)kml; (void)lse; \
    pg8::u64* rsu = (pg8::u64*)(ws_ + WS_RS); float* rsq = (float*)(ws_ + WS_RSQ); float* rskv = (float*)(ws_ + WS_RSKV); \
    bf16* Wb = (bf16*)(ws_ + WS_W); bf16* XB = (bf16*)(ws_ + WS_XB); bf16* PROJ = (bf16*)(ws_ + WS_PROJ); bf16* ACT = PROJ; bf16* GT = PROJ; \
    bf16* QM = (bf16*)(ws_ + WS_QM); bf16* KN = (bf16*)(ws_ + WS_KN); bf16* VM = (bf16*)(ws_ + WS_VM); bf16* KR = (bf16*)(ws_ + WS_KR); \
    bf16* MG = (bf16*)(ws_ + WS_MG); bf16* AO = (bf16*)(ws_ + WS_AO); \
    const pg8::bf16_t* Wgu1 = Wb + W_GU1 / 2; const pg8::bf16_t* Wd1 = Wb + W_D1 / 2; const pg8::bf16_t* Win = Wb + W_IN / 2; const pg8::bf16_t* Wg = Wb + W_G / 2; \
    const pg8::bf16_t* Wuq = Wb + W_UQ / 2; const pg8::bf16_t* Wukv = Wb + W_UKV / 2; const pg8::bf16_t* Wbr = Wb + W_BR / 2; const pg8::bf16_t* Wout = Wb + W_OUT / 2; \
    const pg8::bf16_t* Wgu2 = Wb + W_GU2 / 2; const pg8::bf16_t* Wd2 = Wb + W_D2 / 2; \
    (void)x_in; (void)out; (void)cosT; (void)sinT; (void)kmean; (void)rsu; (void)rsq; (void)rskv; (void)XB; (void)ACT; (void)GT; (void)QM; (void)KN; (void)VM; (void)KR; (void)MG; (void)AO; \
    (void)Wgu1; (void)Wd1; (void)Win; (void)Wg; (void)Wuq; (void)Wukv; (void)Wbr; (void)Wout; (void)Wgu2; (void)Wd2

    if (IN(0)) { PHASE_LANES(); PHASE_PTRS();
        for (int m = gw; m < T; m += NGW) { const GAS f32x4* xr = (const GAS f32x4*)(x_in + (size_t)m * DM) + 2 * lane; f32x4 v[4]; float s = 0.f;
#pragma unroll
            for (int j = 0; j < 4; ++j) { v[j] = xr[128 * (j >> 1) + (j & 1)]; s += (v[j].x * v[j].x + v[j].y * v[j].y) + (v[j].z * v[j].z + v[j].w * v[j].w); }
            s = wave_sum(s);
            GAS v4u* o16 = (GAS v4u*)(XB + (size_t)m * DM) + lane;
#pragma unroll
            for (int j = 0; j < 2; ++j) o16[64 * j] = (v4u){pk2(v[2 * j].x, v[2 * j].y), pk2(v[2 * j].z, v[2 * j].w), pk2(v[2 * j + 1].x, v[2 * j + 1].y), pk2(v[2 * j + 1].z, v[2 * j + 1].w)};
            if (lane == 0) rsu[m] = (pg8::u64)(s * pg8::RS_FIX); }
        for (int idx = gw * 64 + lane; idx < SEQ * 16; idx += NGW * 64) { const int pos = idx >> 4, i = idx & 15; const int a = i & 3, e = i >> 2;
            const double mm = a == 0 ? 1.0 : a == 1 ? 0.5623413251903491 : a == 2 ? 0.31622776601683794 : 0.1778279410038923;
            const double pe = e == 0 ? 1.0 : e == 1 ? 0.1 : e == 2 ? 0.01 : 0.001;
            const float inv = (float)(mm * pe); const float angf = (float)pos * inv;
            const double rev = (double)angf * 0.15915494309189535; const float fr = (float)(rev - __builtin_rint(rev));
            cosT[idx] = __builtin_amdgcn_cosf(fr); sinT[idx] = __builtin_amdgcn_sinf(fr); }
        { LAS float* scr = (LAS float*)(F.lds + RING_OFF + wave * 16384); CVT_SET_A(0, gw, NGW);
          v4u z = (v4u){0u, 0u, 0u, 0u}; asm volatile("" : "+v"(z)); const int gt = gw * 64 + lane, NTH = NGW * 64;
          for (int i = gt; i < 224 * 1024 / 8; i += NTH) *(GAS v4u*)(Wb + W_IN / 2 + (size_t)3872 * 1024 + (size_t)i * 8) = z;
          for (int i = gt; i < 192 * 256 / 8; i += NTH) *(GAS v4u*)(Wb + W_UQ / 2 + (size_t)576 * 256 + (size_t)i * 8) = z;
          for (int i = gt; i < 768 * 16; i += NTH) *(GAS v4u*)(Wb + W_UKV / 2 + (size_t)(i >> 4) * 256 + 128 + (i & 15) * 8) = z; }
        if (BOTH(0)) GRID_BAR();
    }

    for (int l = 0; l < DEPTH; ++l) {
        const int pb = 1 + l * PH_PER_LAYER;
        if (IN(pb + 1)) { PHASE_PTRS();
            pg8::Gemm g{XB, Wgu1, T, 2 * FF, DM, DM, DM}; pg8::StaticOrder S; S.init(T, 2 * FF, OPQ_S((int)gridDim.x), OPQ_S((int)blockIdx.x));
            pg8::EpiSwiGLU E{ACT, FF, rsu + (size_t)(3 * l + 0) * T};
            for (int rep = 0; rep < ((MK_DOUBLE & 1) ? 2 : 1); ++rep)
            pg8::gemm_phase<pg8::EpiSwiGLU, pg8::StaticOrder, true>(F.lds + RING_OFF, g, S, E, MYTID());
            if (BOTH(pb + 1)) GRID_BAR();
        }
        if (IN(pb + 2)) { PHASE_PTRS();
            pg8::Gemm g{ACT, Wd1, T, DM, FF, FF, FF}; pg8::StaticOrder S; S.init(T, DM, OPQ_S((int)gridDim.x), OPQ_S((int)blockIdx.x));
            pg8::EpiResid E{XB, rsu + (size_t)(3 * l + 1) * T, 0.5f};
            pg8::gemm_phase<pg8::EpiResid, pg8::StaticOrder, true>(F.lds + RING_OFF, g, S, E, MYTID());
            if (BOTH(pb + 2)) GRID_BAR();
        }
        if (IN(pb + 3)) { PHASE_PTRS();
            pg8::Gemm g{XB, Win, T, 4096, DM, DM, DM}; pg8::StaticOrder S; S.init(T, 4096, OPQ_S((int)gridDim.x), OPQ_S((int)blockIdx.x));
            pg8::EpiProj E{PROJ, rsu + (size_t)(3 * l + 1) * T, rsq, rskv};
            for (int rep = 0; rep < ((MK_DOUBLE & 4) ? 2 : 1); ++rep)
            pg8::gemm_phase<pg8::EpiProj, pg8::StaticOrder, true>(F.lds + RING_OFF, g, S, E, MYTID());
            if (BOTH(pb + 3)) GRID_BAR();
        }
        if (IN(pb + 4)) { PHASE_PTRS();
            { pg8::Gemm g{PROJ + PTOK_OFF, Wuq, T, 1536, 256, PTP, 256}; pg8::UpOrder S; S.init(T, 1536, OPQ_S((int)gridDim.x), OPQ_S((int)blockIdx.x));
              pg8::EpiUp E{QM, KN, VM, rsq, rskv, cosT, sinT};
              pg8::gemm_phase<pg8::EpiUp, pg8::UpOrder, true>(F.lds + RING_OFF, g, S, E, MYTID()); }
            PHASE_LANES();
            for (int idx = gw * 64 + lane; idx < T * 2; idx += NGW * 64) { const int row = idx >> 1, c = idx & 1, pos = row & (SEQ - 1);
                const v4u a1 = *(const v4u*)(PROJ + PTOK_OFF + (size_t)row * PTP + 384 + 8 * c), a2 = *(const v4u*)(PROJ + PTOK_OFF + (size_t)row * PTP + 384 + 16 + 8 * c);
                const f32x4 c0 = *(const f32x4*)(cosT + pos * 16 + 8 * c), c1 = *(const f32x4*)(cosT + pos * 16 + 8 * c + 4), s0 = *(const f32x4*)(sinT + pos * 16 + 8 * c), s1 = *(const f32x4*)(sinT + pos * 16 + 8 * c + 4);
                float t1[8], t2[8], cc[8], ss[8], o1[8], o2[8];
                t1[0] = bflo(a1.x); t1[1] = bfhi(a1.x); t1[2] = bflo(a1.y); t1[3] = bfhi(a1.y); t1[4] = bflo(a1.z); t1[5] = bfhi(a1.z); t1[6] = bflo(a1.w); t1[7] = bfhi(a1.w);
                t2[0] = bflo(a2.x); t2[1] = bfhi(a2.x); t2[2] = bflo(a2.y); t2[3] = bfhi(a2.y); t2[4] = bflo(a2.z); t2[5] = bfhi(a2.z); t2[6] = bflo(a2.w); t2[7] = bfhi(a2.w);
#pragma unroll
                for (int j = 0; j < 4; ++j) { cc[j] = c0[j]; cc[4 + j] = c1[j]; ss[j] = s0[j]; ss[4 + j] = s1[j]; }
#pragma unroll
                for (int j = 0; j < 8; ++j) { o1[j] = t1[j] * cc[j] - t2[j] * ss[j]; o2[j] = t1[j] * ss[j] + t2[j] * cc[j]; }
                *(v4u*)(KR + (size_t)row * 32 + 8 * c) = (v4u){pk2(o1[0], o1[1]), pk2(o1[2], o1[3]), pk2(o1[4], o1[5]), pk2(o1[6], o1[7])};
                *(v4u*)(KR + (size_t)row * 32 + 16 + 8 * c) = (v4u){pk2(o2[0], o2[1]), pk2(o2[2], o2[3]), pk2(o2[4], o2[5]), pk2(o2[6], o2[7])}; }
            for (int u = gw; u < BATCH * 6 * 16; u += NGW) { const int n = u & 15, bh = u >> 4, b = bh / 6, h = bh % 6, dc = lane & 7, ks = lane >> 3;
                const bf16* kp = PROJ + ((size_t)(b * HSLOTS + SL_MK + h) * SEQ + n * 256 + ks) * 64 + dc * 8; float a[8];
#pragma unroll
                for (int j = 0; j < 8; ++j) a[j] = 0.f;
#pragma unroll 1
                for (int i0 = 0; i0 < 32; i0 += 16) { v4u kw[16];
#pragma unroll
                    for (int i = 0; i < 16; ++i) kw[i] = *(const v4u*)(kp + (size_t)(8 * (i0 + i)) * 64);
#pragma unroll
                    for (int i = 0; i < 16; ++i) { a[0] += bflo(kw[i].x); a[1] += bfhi(kw[i].x); a[2] += bflo(kw[i].y); a[3] += bfhi(kw[i].y); a[4] += bflo(kw[i].z); a[5] += bfhi(kw[i].z); a[6] += bflo(kw[i].w); a[7] += bfhi(kw[i].w); } }
#pragma unroll
                for (int j = 0; j < 8; ++j) { a[j] += __shfl_xor(a[j], 8); a[j] += __shfl_xor(a[j], 16); a[j] += __shfl_xor(a[j], 32); }
                if (ks == 0) {
#pragma unroll
                    for (int j = 0; j < 8; ++j) { const int idx = u * 64 + dc * 8 + j; const float km = a[j] * (1.0f / 256.0f); kmean[idx] = km; const unsigned hb = f2bf(km); kmh[idx] = (bf16)hb; kml[idx] = (bf16)f2bf(km - __uint_as_float(hb << 16)); } } }
#if MK_NAIVE_DIL
            for (int gid = gw * 64 + lane; gid < BATCH * 4 * SEQ; gid += NGW * 64) dil_naive_thread(PROJ, AO, gid >> 14, (gid >> 12) & 3, gid & (SEQ - 1));
#else
            __syncthreads();
            fa::dil_phase((LAS char*)(F.lds + RING_OFF), tid_, bx_, G_, PROJ, lse);
#endif
            if (BOTH(pb + 4)) GRID_BAR();
        }
        if (IN(pb + 5)) { PHASE_LANES(); PHASE_PTRS();
            const int nchunk = (CVT_ITEMS_B + (l + 1 < DEPTH ? CVT_ITEMS_A : 0)) / 8; gu32* chead = F.ctl + CW_QUEUE + 64 * (32 + l);
            LAS float* scr = (LAS float*)(F.lds + RING_OFF + 63488 + wave * 8448);
#define CVT_CHUNKS(c0_, cnt_) do { for (int c_ = (c0_); c_ < (c0_) + (cnt_) && c_ < nchunk; ++c_) { const int it_ = c_ * 8 + wave; int lane_o_ = lane; asm volatile("" : "+v"(lane_o_)); \
                { const int lane = lane_o_;     \
                if (it_ < CVT_ITEMS_B) CVT_SET_B(l, it_, 0x40000000); else CVT_SET_A(l + 1, it_ - CVT_ITEMS_B, 0x40000000); } } } while (0)
#if !MK_NAIVE_DIL
            for (int idx0 = gw * 64 + lane; idx0 < T * 32; idx0 += 4 * NGW * 64) { float lv[4][3]; v4u av[4][3];
#pragma unroll
                for (int q = 0; q < 4; ++q) { int idx = idx0 + q * NGW * 64; idx = idx < T * 32 ? idx : T * 32 - 1; const int row = idx >> 5, hg = (idx >> 3) & 3, c = idx & 7;
                    const bf16* op = PROJ + ((size_t)((row >> 12) * HSLOTS + SL_DQ + hg) * SEQ + (row & (SEQ - 1))) * 64 + c * 8;
#pragma unroll
                    for (int g = 0; g < 3; ++g) { lv[q][g] = lse[(size_t)row * 12 + 4 * g + hg]; av[q][g] = *(const v4u*)(op + (size_t)(4 * g) * SEQ * 64); } }
#pragma unroll
                for (int q = 0; q < 4; ++q) { const int idx = idx0 + q * NGW * 64; if (idx < T * 32) { const int row = idx >> 5, hg = (idx >> 3) & 3, c = idx & 7;
                    const float l0 = lv[q][0], l1 = lv[q][1], l2 = lv[q][2], lm = fmaxf(l0, fmaxf(l1, l2));
                    float w0 = exp2f(l0 - lm), w1 = exp2f(l1 - lm), w2 = exp2f(l2 - lm); const float wi = 1.0f / (w0 + w1 + w2); w0 *= wi; w1 *= wi; w2 *= wi;
                    const v4u x0 = av[q][0], x1 = av[q][1], x2 = av[q][2]; float r[8];
                    r[0] = w0 * bflo(x0.x) + w1 * bflo(x1.x) + w2 * bflo(x2.x); r[1] = w0 * bfhi(x0.x) + w1 * bfhi(x1.x) + w2 * bfhi(x2.x);
                    r[2] = w0 * bflo(x0.y) + w1 * bflo(x1.y) + w2 * bflo(x2.y); r[3] = w0 * bfhi(x0.y) + w1 * bfhi(x1.y) + w2 * bfhi(x2.y);
                    r[4] = w0 * bflo(x0.z) + w1 * bflo(x1.z) + w2 * bflo(x2.z); r[5] = w0 * bfhi(x0.z) + w1 * bfhi(x1.z) + w2 * bfhi(x2.z);
                    r[6] = w0 * bflo(x0.w) + w1 * bflo(x1.w) + w2 * bflo(x2.w); r[7] = w0 * bfhi(x0.w) + w1 * bfhi(x1.w) + w2 * bfhi(x2.w);
                    st8(AO + (size_t)row * DM + 768 + hg * 64 + c * 8, r, 1.0f); } } }
#endif
            for (int wrep = 0; wrep < 4; ++wrep) { const int which = wrep >> 1, rep = wrep & 1; if (rep == 1 && !((MK_DOUBLE >> (3 + which)) & 1)) continue;
                const bool naive = which == 0 ? (MK_NAIVE_MLA != 0) : (MK_NAIVE_MOBA != 0);
                if (naive) {
                    for (int u = gw; u < 48 * 32; u += NGW) { const int bh = u >> 5, cp = u & 31, b = bh / 6, h = bh % 6;
                        if (which == 0) { mla_naive_chunk(QM, KN, KR, VM, AO, b, h, cp, lane); mla_naive_chunk(QM, KN, KR, VM, AO, b, h, 63 - cp, lane); }
                        else { moba_naive_chunk(PROJ, kmean, AO, b, h, cp, lane); moba_naive_chunk(PROJ, kmean, AO, b, h, 63 - cp, lane); } }
                } else {
                    gu32* head = F.ctl + CW_QUEUE + 64 * (2 * l + which) + 64 * 8 * rep;
                    for (;;) {
                        if (tid_ == 0) { F.MISC[16] = __hip_atomic_fetch_add(head, 1u, RLX_AGENT); if (which == 0 && rep == 0) F.MISC[17] = __hip_atomic_fetch_add(chead, 2u, RLX_AGENT); }
                        __syncthreads();
                        const int u = __builtin_amdgcn_readfirstlane((int)F.MISC[16]);
                        if (which == 0 && rep == 0) { const int c0 = __builtin_amdgcn_readfirstlane((int)F.MISC[17]); CVT_CHUNKS(c0, 2); }
                        if (u >= 48 * 16) break;
                        const int qb = 15 - u / 48, bh = u % 48, b = bh / 6, h = bh % 6;
                        if (which == 0) fa::mla_unit<8>((LAS char*)(F.lds + RING_OFF), tid_, qb, QM + (size_t)bh * SEQ * 96, KN + (size_t)bh * SEQ * 64, KR + (size_t)b * SEQ * 32, VM + (size_t)bh * SEQ * 64, AO + (size_t)b * SEQ * DM + h * 64);
                        else fa::moba_unit<8>((LAS char*)(F.lds + RING_OFF), tid_, qb, PROJ + (size_t)(b * HSLOTS + SL_MQ + h) * SEQ * 64, PROJ + (size_t)(b * HSLOTS + SL_MK + h) * SEQ * 64, PROJ + (size_t)(b * HSLOTS + SL_MV + h) * SEQ * 64, AO + (size_t)b * SEQ * DM + 384 + h * 64,
                                              kmh + (size_t)bh * 1024, kml + (size_t)bh * 1024, exp2f(-8.0f * (float)(12 + h + 1) / 18.0f) * LOG2E);
                    }
                    __syncthreads();
                }
            }
            for (;;) {
                __syncthreads();
                if (tid_ == 0) F.MISC[17] = __hip_atomic_fetch_add(chead, 4u, RLX_AGENT);
                __syncthreads();
                const int c0 = __builtin_amdgcn_readfirstlane((int)F.MISC[17]); if (c0 >= nchunk) break;
                CVT_CHUNKS(c0, 4);
            }
#undef CVT_CHUNKS
            if (BOTH(pb + 5)) GRID_BAR();
        }
        if (IN(pb + 7)) { PHASE_PTRS();
            { pg8::Gemm g{XB, Wg, T, DM, DM, DM, DM, AO, Wbr}; pg8::FusedOrder S; S.init(T, DM, OPQ_S((int)gridDim.x), OPQ_S((int)blockIdx.x));
              pg8::EpiFused E{GT + (size_t)OPQ_S((int)blockIdx.x) * 65536, MG, rsu + (size_t)(3 * l + 1) * T};
              pg8::gemm_phase<pg8::EpiFused, pg8::FusedOrder, true>(F.lds + RING_OFF, g, S, E, MYTID()); }
            if (BOTH(pb + 7)) GRID_BAR();
        }
        if (IN(pb + 8)) { PHASE_PTRS();
            pg8::Gemm g{MG, Wout, T, DM, DM, DM, DM}; pg8::StaticOrder S; S.init(T, DM, OPQ_S((int)gridDim.x), OPQ_S((int)blockIdx.x));
            pg8::EpiResid E{XB, rsu + (size_t)(3 * l + 2) * T, 1.0f};
            pg8::gemm_phase<pg8::EpiResid, pg8::StaticOrder, true>(F.lds + RING_OFF, g, S, E, MYTID());
            if (BOTH(pb + 8)) GRID_BAR();
        }
        if (IN(pb + 9)) { PHASE_PTRS();
            pg8::Gemm g{XB, Wgu2, T, 2 * FF, DM, DM, DM}; pg8::StaticOrder S; S.init(T, 2 * FF, OPQ_S((int)gridDim.x), OPQ_S((int)blockIdx.x));
            pg8::EpiSwiGLU E{ACT, FF, rsu + (size_t)(3 * l + 2) * T};
            for (int rep = 0; rep < ((MK_DOUBLE & 1) ? 2 : 1); ++rep)
            pg8::gemm_phase<pg8::EpiSwiGLU, pg8::StaticOrder, true>(F.lds + RING_OFF, g, S, E, MYTID());
            if (BOTH(pb + 9)) GRID_BAR();
        }
        if (IN(pb + 10)) { PHASE_PTRS();
            pg8::Gemm g{ACT, Wd2, T, DM, FF, FF, FF}; pg8::StaticOrder S; S.init(T, DM, OPQ_S((int)gridDim.x), OPQ_S((int)blockIdx.x));
            pg8::EpiResid E{XB, rsu + (size_t)(3 * (l + 1)) * T, 0.5f};
            pg8::gemm_phase<pg8::EpiResid, pg8::StaticOrder, true>(F.lds + RING_OFF, g, S, E, MYTID());
            if (BOTH(pb + 10)) GRID_BAR();
        }
    }
    if (IN(N_PHASES - 1)) { PHASE_LANES(); PHASE_PTRS();
        const float* gain = args.in[19];
        for (int m = gw; m < T; m += NGW) { float v[16]; ld8(XB + (size_t)m * DM + lane * 16, v); ld8(XB + (size_t)m * DM + lane * 16 + 8, v + 8); float s2 = 0.f;
#pragma unroll
            for (int j = 0; j < 16; ++j) s2 += v[j] * v[j];
            const float r = 1.0f / sqrtf(wave_sum(s2) * (1.0f / DM) + NORM_EPS);
#pragma unroll
            for (int j = 0; j < 4; ++j) { const f32x4 gn = *((const f32x4*)gain + lane * 4 + j); *((GAS f32x4*)(out + (size_t)m * DM) + lane * 4 + j) = (f32x4){v[4 * j] * r * gn[0], v[4 * j + 1] * r * gn[1], v[4 * j + 2] * r * gn[2], v[4 * j + 3] * r * gn[3]}; } }
    }
#undef IN
#undef BOTH
#undef GRID_BAR
}


extern "C" void kernel_launch(void* const* d_in, const int* in_sizes, int n_in, void* d_out, int out_size, void* d_ws, size_t ws_size, hipStream_t stream) {
    static int grid = 0;
    if (grid == 0) {
        if (n_in != 20 || in_sizes[0] != T * DM || out_size != T * DM || ws_size < WS_END) { fprintf(stderr, "kernel_launch: unexpected shapes / workspace (n_in %d, ws %zu, need %zu)\n", n_in, ws_size, (size_t)WS_END); grid = -1; return; }
        int dev = 0, cus = 0, per_cu = 0;
        if (hipGetDevice(&dev) != hipSuccess || hipDeviceGetAttribute(&cus, hipDeviceAttributeMultiprocessorCount, dev) != hipSuccess) { grid = -1; return; }
        if (hipFuncSetAttribute((const void*)mk_fwd, hipFuncAttributeMaxDynamicSharedMemorySize, LDS_BYTES) != hipSuccess) { fprintf(stderr, "kernel_launch: hipFuncSetAttribute failed\n"); grid = -1; return; }
        if (hipOccupancyMaxActiveBlocksPerMultiprocessor(&per_cu, (const void*)mk_fwd, NWAVES * 64, LDS_BYTES) != hipSuccess || per_cu < 1)
            fprintf(stderr, "kernel_launch: note: occupancy query reports %d workgroups per CU\n", per_cu);
        (void)hipGetLastError();
        grid = cus;
    }
    if (grid < 0) return;
    if (hipMemsetAsync((char*)d_ws + WS_CTL, 0, CTL_ZERO_BYTES, stream) != hipSuccess) return;
    Args a{};
    for (int i = 0; i < 20; ++i) a.in[i] = (const float*)d_in[i];
    a.out = (float*)d_out; a.ws = (unsigned char*)d_ws;
#if MK_PER_PHASE
    for (int p = 0; p < N_PHASES; ++p) { if (p > MK_STOP_AFTER && p != N_PHASES - 1) continue; a.ph_lo = p; a.ph_hi = p + 1; hipLaunchKernelGGL(mk_fwd, dim3(grid), dim3(NWAVES * 64), LDS_BYTES, stream, a); }
#else
    a.ph_lo = 0; a.ph_hi = N_PHASES;
    hipLaunchKernelGGL(mk_fwd, dim3(grid), dim3(NWAVES * 64), LDS_BYTES, stream, a);
#endif
}
```
